# Optimizing an MI355X kernel written in HIP

```python
import jax, jax.numpy as jnp
from jax import lax
import numpy as np

D_MODEL = 4096
BATCH = 2
SEQ = 4096
DEPTH = 2

N_META = 16
N_BRANCH = 4
MIX_W = D_MODEL // 4
ML_HEADS = 4
ML_HD = MIX_W // ML_HEADS
ML_CHUNK = 64
SB_HEADS = 8
SB_HD = MIX_W // SB_HEADS
SB_BLOCK = 128
HG_HEADS = 8
HG_HD = MIX_W // HG_HEADS
HG_CHUNK = 64
RG_BLOCKS = 16
RG_BD = MIX_W // RG_BLOCKS
RG_CONV = 4
RG_C = 8.0
D_FF = -(-8 * D_MODEL // (3 * 256)) * 256
EPS = 1e-6
NEG = -1e30

IN_SIZES = (MIX_W, MIX_W, MIX_W, MIX_W, ML_HEADS, ML_HEADS,
            MIX_W, MIX_W, MIX_W,
            MIX_W, MIX_W, MIX_W, MIX_W,
            MIX_W, MIX_W,
            N_BRANCH * D_MODEL)
N_IN = sum(IN_SIZES)
ML_F_OFF = 4 * MIX_W + ML_HEADS

kernel_name = "hybrid_mlstm_stickbreak_hgrn2_rglru_block"


def rmsnorm(x, g):
    xf = x.astype(jnp.float32)
    y = xf * lax.rsqrt(jnp.mean(xf * xf, axis=-1, keepdims=True) + EPS)
    return (y * g.astype(jnp.float32)).astype(x.dtype)


def split_cols(h):
    offs, acc = [], 0
    for s in IN_SIZES[:-1]:
        acc += s
        offs.append(acc)
    return jnp.split(h, offs, axis=-1)


def pad_front(t, n):
    return jnp.pad(t, ((0, 0), (n, 0), (0, 0)))


def to_chunks(t, n_heads, c):
    B, Lp, W = t.shape
    return t.reshape(B, Lp // c, c, n_heads, W // n_heads).transpose(1, 0, 3, 2, 4)


def gate_chunks(g, c):
    B, Lp, H = g.shape
    return g.reshape(B, Lp // c, c, H).transpose(1, 0, 3, 2)


def from_chunks(o):
    nc, B, H, c, d = o.shape
    return o.transpose(1, 0, 3, 2, 4).reshape(B, nc * c, H, d)


def mlstm(q, k, v, o_pre, i_pre, f_pre, g_norm):
    f32 = jnp.float32
    B, L, _ = q.shape
    pad = ML_CHUNK - N_META
    Lp = L + pad
    valid = (jnp.arange(Lp) >= pad)[None, :, None]
    qc = to_chunks(pad_front(q.astype(f32) * ML_HD ** -0.5, pad), ML_HEADS, ML_CHUNK)
    kc = to_chunks(pad_front(k.astype(f32), pad), ML_HEADS, ML_CHUNK)
    vc = to_chunks(pad_front(v.astype(f32), pad), ML_HEADS, ML_CHUNK)
    log_i = gate_chunks(jnp.where(valid, pad_front(i_pre.astype(f32), pad), NEG), ML_CHUNK)
    log_f = gate_chunks(jnp.where(valid, jax.nn.log_sigmoid(pad_front(f_pre.astype(f32), pad)), 0.0), ML_CHUNK)
    causal = jnp.tril(jnp.ones((ML_CHUNK, ML_CHUNK), dtype=bool))

    def step(carry, inp):
        C, n, m = carry
        qb, kb, vb, li, lf = inp
        b = jnp.cumsum(lf, axis=-1)
        D = jnp.where(causal, b[..., :, None] - b[..., None, :] + li[..., None, :], NEG)
        g = b + m[..., None]
        m_out = jnp.maximum(g, jnp.max(D, axis=-1))
        s = jnp.einsum('bhtd,bhsd->bhts', qb, kb) * jnp.exp(D - m_out[..., None])
        inter = jnp.exp(g - m_out)
        num = jnp.einsum('bhts,bhse->bhte', s, vb) + inter[..., None] * jnp.einsum('bhtd,bhde->bhte', qb, C)
        den = jnp.sum(s, axis=-1) + inter * jnp.einsum('bhtd,bhd->bht', qb, n)
        h = num / jnp.maximum(jnp.abs(den), jnp.exp(-m_out))[..., None]
        b_end = b[..., -1]
        wlog = b_end[..., None] - b + li
        m_new = jnp.maximum(b_end + m, jnp.max(wlog, axis=-1))
        w = jnp.exp(wlog - m_new[..., None])
        decay = jnp.exp(b_end + m - m_new)
        C_new = decay[..., None, None] * C + jnp.einsum('bhs,bhsd,bhse->bhde', w, kb, vb)
        n_new = decay[..., None] * n + jnp.einsum('bhs,bhsd->bhd', w, kb)
        return (C_new, n_new, m_new), h

    init = (jnp.zeros((B, ML_HEADS, ML_HD, ML_HD), f32),
            jnp.zeros((B, ML_HEADS, ML_HD), f32),
            jnp.zeros((B, ML_HEADS), f32))
    _, hs = lax.scan(step, init, (qc, kc, vc, log_i, log_f))
    h = rmsnorm(from_chunks(hs)[:, pad:], g_norm)
    return (h.reshape(B, L, MIX_W) * jax.nn.sigmoid(o_pre.astype(f32))).astype(q.dtype)


def stick_breaking(q, k, v, gq, gk):
    f32 = jnp.float32
    B, L, _ = q.shape
    pad = SB_BLOCK - N_META
    Lp = L + pad
    nb = Lp // SB_BLOCK

    def heads(t):
        return pad_front(t.astype(f32), pad).reshape(B, Lp, SB_HEADS, SB_HD).transpose(0, 2, 1, 3)

    qh = rmsnorm(heads(q), gq)
    kh = rmsnorm(heads(k), gk)
    vh = heads(v)
    qb = qh.reshape(B, SB_HEADS, nb, SB_BLOCK, SB_HD).transpose(2, 0, 1, 3, 4)
    key_pos = jnp.arange(Lp)

    def block(args):
        q_blk, blk = args
        z = jnp.einsum('bhtd,bhsd->bhts', q_blk, kh) * SB_HD ** -0.5
        t_pos = blk * SB_BLOCK + jnp.arange(SB_BLOCK)
        vis = (key_pos[None, :] < t_pos[:, None]) & (key_pos[None, :] >= pad)
        log_keep = jnp.where(vis, jax.nn.log_sigmoid(-z), 0.0)
        log_between = lax.cumsum(log_keep, axis=3, reverse=True) - log_keep
        a = jnp.where(vis, jnp.exp(jax.nn.log_sigmoid(z) + log_between), 0.0)
        return jnp.einsum('bhts,bhsd->bhtd', a, vh)

    o = lax.map(block, (qb, jnp.arange(nb)))
    o = o.transpose(1, 0, 3, 2, 4).reshape(B, Lp, MIX_W)[:, pad:]
    return o.astype(q.dtype)


def hgrn2(q, f_pre, i_in, g_pre, lb, g_norm):
    f32 = jnp.float32
    B, L, _ = q.shape
    pad = HG_CHUNK - N_META
    Lp = L + pad
    valid = (jnp.arange(Lp) >= pad)[None, :, None]
    fp = f_pre.astype(f32)
    sig = jax.nn.sigmoid(fp)
    log_f = jnp.log(lb + (1.0 - lb) * sig)
    kk = (1.0 - lb) * (1.0 - sig)
    fc = to_chunks(jnp.where(valid, pad_front(log_f, pad), 0.0), HG_HEADS, HG_CHUNK)
    kc = to_chunks(jnp.where(valid, pad_front(kk, pad), 0.0), HG_HEADS, HG_CHUNK)
    qc = to_chunks(pad_front(jax.nn.silu(q.astype(f32)), pad), HG_HEADS, HG_CHUNK)
    ic = to_chunks(pad_front(i_in.astype(f32), pad), HG_HEADS, HG_CHUNK)
    causal = jnp.tril(jnp.ones((HG_CHUNK, HG_CHUNK), dtype=bool))

    def step(S, inp):
        qb, kb, ib, lf = inp
        b = jnp.cumsum(lf, axis=2)
        diff = b[:, :, :, None, :] - b[:, :, None, :, :]
        decay = jnp.exp(jnp.where(causal[:, :, None], diff, NEG))
        att = jnp.einsum('bhtd,bhtsd,bhsd->bhts', qb, decay, kb)
        o = jnp.einsum('bhts,bhse->bhte', att, ib) + jnp.einsum('bhtd,bhde->bhte', qb * jnp.exp(b), S)
        b_end = b[:, :, -1]
        S_new = jnp.exp(b_end)[..., None] * S + jnp.einsum('bhsd,bhse->bhde', kb * jnp.exp(b_end[:, :, None] - b), ib)
        return S_new, o

    S0 = jnp.zeros((B, HG_HEADS, HG_HD, HG_HD), f32)
    _, os_ = lax.scan(step, S0, (qc, kc, ic, fc))
    o = rmsnorm(from_chunks(os_)[:, pad:], g_norm).reshape(B, L, MIX_W)
    return (o * jax.nn.sigmoid(g_pre.astype(f32))).astype(q.dtype)


def _lin_combine(e1, e2):
    a1, b1 = e1
    a2, b2 = e2
    return a1 * a2, a2 * b1 + b2


def rglru(xb, yb, conv_w, conv_b, wa, ba, wx, bx, lam):
    f32 = jnp.float32
    B, L, W = xb.shape
    xc = lax.conv_general_dilated(xb.astype(f32), conv_w.astype(f32)[:, None, :],
                                  window_strides=(1,), padding=[(RG_CONV - 1, 0)],
                                  dimension_numbers=('NWC', 'WIO', 'NWC'),
                                  feature_group_count=W) + conv_b
    xblk = xc.reshape(B, L, RG_BLOCKS, RG_BD)
    r = jax.nn.sigmoid(jnp.einsum('blni,nij->blnj', xblk, wa).reshape(B, L, W) + ba)
    ig = jax.nn.sigmoid(jnp.einsum('blni,nij->blnj', xblk, wx).reshape(B, L, W) + bx)
    log_a = -RG_C * r * jax.nn.softplus(-lam)
    a = jnp.exp(log_a)
    u = jnp.sqrt(-jnp.expm1(2.0 * log_a)) * (ig * xc)
    _, hseq = lax.associative_scan(_lin_combine, (a, u), axis=1)
    return (hseq * jax.nn.gelu(yb.astype(f32))).astype(xb.dtype)


def setup_inputs(seed: int = 0) -> dict:
    key = jax.random.key(seed)
    ks = jax.random.split(key, 24)

    def nrm(k, shape, scale):
        return jax.random.normal(k, shape, jnp.float32) * scale

    x = nrm(ks[0], (BATCH, SEQ, D_MODEL), 1.0)
    meta = nrm(ks[1], (N_META, D_MODEL), 1.0)
    norm_mix = 1.0 + nrm(ks[2], (DEPTH, D_MODEL), 0.02)
    norm_ffn = 1.0 + nrm(ks[3], (DEPTH, D_MODEL), 0.02)
    w_in = nrm(ks[4], (DEPTH, D_MODEL, N_IN), D_MODEL ** -0.5)
    b_in = nrm(ks[5], (DEPTH, N_IN), 0.02)
    b_in = b_in.at[:, ML_F_OFF:ML_F_OFF + ML_HEADS].add(jnp.linspace(3.0, 6.0, ML_HEADS))
    ml_norm = 1.0 + nrm(ks[6], (DEPTH, ML_HEADS, ML_HD), 0.02)
    sb_q_norm = 1.0 + nrm(ks[7], (DEPTH, SB_HD), 0.02)
    sb_k_norm = 1.0 + nrm(ks[8], (DEPTH, SB_HD), 0.02)
    hg_lb = nrm(ks[9], (DEPTH, MIX_W), 0.1)
    hg_norm = 1.0 + nrm(ks[10], (DEPTH, HG_HEADS, HG_HD), 0.02)
    rg_conv_w = nrm(ks[11], (DEPTH, RG_CONV, MIX_W), RG_CONV ** -0.5)
    rg_conv_b = nrm(ks[12], (DEPTH, MIX_W), 0.02)
    rg_wa = nrm(ks[13], (DEPTH, RG_BLOCKS, RG_BD, RG_BD), RG_BD ** -0.5)
    rg_ba = nrm(ks[14], (DEPTH, MIX_W), 0.02)
    rg_wx = nrm(ks[15], (DEPTH, RG_BLOCKS, RG_BD, RG_BD), RG_BD ** -0.5)
    rg_bx = nrm(ks[16], (DEPTH, MIX_W), 0.02)
    a_pow = jax.random.uniform(ks[17], (DEPTH, MIX_W), jnp.float32, minval=0.9, maxval=0.999)
    p = a_pow ** (1.0 / RG_C)
    rg_lambda = jnp.log(p) - jnp.log1p(-p)
    w_up = nrm(ks[18], (DEPTH, N_BRANCH, MIX_W, D_MODEL), MIX_W ** -0.5)
    w_out = nrm(ks[19], (DEPTH, D_MODEL, D_MODEL), D_MODEL ** -0.5)
    w_ffn_gate = nrm(ks[20], (DEPTH, D_MODEL, D_FF), D_MODEL ** -0.5)
    w_ffn_up = nrm(ks[21], (DEPTH, D_MODEL, D_FF), D_MODEL ** -0.5)
    w_ffn_down = nrm(ks[22], (DEPTH, D_FF, D_MODEL), D_FF ** -0.5)
    return {"x": x, "meta": meta, "norm_mix": norm_mix, "norm_ffn": norm_ffn,
            "w_in": w_in, "b_in": b_in, "ml_norm": ml_norm,
            "sb_q_norm": sb_q_norm, "sb_k_norm": sb_k_norm,
            "hg_lb": hg_lb, "hg_norm": hg_norm,
            "rg_conv_w": rg_conv_w, "rg_conv_b": rg_conv_b, "rg_wa": rg_wa, "rg_ba": rg_ba,
            "rg_wx": rg_wx, "rg_bx": rg_bx, "rg_lambda": rg_lambda,
            "w_up": w_up, "w_out": w_out,
            "w_ffn_gate": w_ffn_gate, "w_ffn_up": w_ffn_up, "w_ffn_down": w_ffn_down}


def reference(x, meta, norm_mix, norm_ffn, w_in, b_in, ml_norm, sb_q_norm, sb_k_norm,
              hg_lb, hg_norm, rg_conv_w, rg_conv_b, rg_wa, rg_ba, rg_wx, rg_bx, rg_lambda,
              w_up, w_out, w_ffn_gate, w_ffn_up, w_ffn_down):
    B = x.shape[0]
    h = jnp.concatenate([jnp.broadcast_to(meta[None].astype(x.dtype), (B, N_META, D_MODEL)), x], axis=1)
    L = h.shape[1]
    p_lb = jax.nn.softmax(hg_lb.astype(jnp.float32), axis=0)
    lower_bounds = jnp.clip(jnp.cumsum(p_lb, axis=0) - p_lb[0:1], 0.0, 0.999)
    for l in range(DEPTH):
        xn = rmsnorm(h, norm_mix[l])
        proj = xn @ w_in[l] + b_in[l]
        (ml_q, ml_k, ml_v, ml_o, ml_i, ml_f, sb_q, sb_k, sb_v,
         hg_q, hg_f, hg_i, hg_g, rg_x, rg_y, gate_pre) = split_cols(proj)
        branches = (
            mlstm(ml_q, ml_k, ml_v, ml_o, ml_i, ml_f, ml_norm[l]),
            stick_breaking(sb_q, sb_k, sb_v, sb_q_norm[l], sb_k_norm[l]),
            hgrn2(hg_q, hg_f, hg_i, hg_g, lower_bounds[l], hg_norm[l]),
            rglru(rg_x, rg_y, rg_conv_w[l], rg_conv_b[l], rg_wa[l], rg_ba[l],
                  rg_wx[l], rg_bx[l], rg_lambda[l]),
        )
        gates = jax.nn.sigmoid(gate_pre.reshape(B, L, N_BRANCH, D_MODEL))
        merged = sum(gates[:, :, kb] * (branches[kb] @ w_up[l, kb]) for kb in range(N_BRANCH))
        h = h + merged @ w_out[l]
        hn = rmsnorm(h, norm_ffn[l])
        h = h + (jax.nn.silu(hn @ w_ffn_gate[l]) * (hn @ w_ffn_up[l])) @ w_ffn_down[l]
    return h[:, N_META:]
```

```cpp
#include <hip/hip_runtime.h>
#include <cstdio>
#include <cstdint>
#define MK_N_LAUNCHES 1
namespace pg8 {
#define PG8_LAS __attribute__((address_space(3)))
typedef unsigned short bf16_t;
typedef short bf16x8 __attribute__((ext_vector_type(8)));
typedef float f32x4 __attribute__((ext_vector_type(4)));
typedef unsigned u32x4 __attribute__((ext_vector_type(4)));
constexpr int BM = 256, BK = 64, HALF = 128, HTB = HALF * BK * 2  , STAGE_BYTES = 8 * HTB, NXCD = 8, WGM = 8;

__host__ __device__ __forceinline__ int lds_byte(int r, int c) { const int st = (r >> 4) * 2 + (c >> 5), rr = r & 15, cc = c & 31, ob = rr * 64 + cc * 2; return st * 1024 + (ob ^ (((ob >> 9) & 1) << 5)); }
__host__ __device__ __forceinline__ void stage_rc(int b, int& R, int& C) { const int st = b / 1024, sb = b % 1024, swz = sb ^ (((sb >> 9) & 1) << 5); R = (st >> 1) * 16 + swz / 64; C = (st & 1) * 32 + (swz % 64) / 2; }
__host__ __device__ __forceinline__ int perm32(int rho) { const int n = rho >> 4, i = rho & 15; return 8 * (i >> 2) + 4 * n + (i & 3); }

struct Unit { int pm, pn; };
struct Gemm { const bf16_t* A; const bf16_t* Bt; int M, N, K, lda, ldb; };

struct StaticOrder {
    int nM, nN, nwg, G, c;
    __host__ __device__ void init(int M, int N, int G_, int c_) { nM = M / BM; nN = N / BM; nwg = nM * nN; G = G_; c = c_; }
    __host__ __device__ bool next(int i, Unit& u) const {
        const long L = (long)i * G + c; if (L >= nwg) return false;
        int wgid = (int)L; { const int q = nwg / NXCD, r = nwg % NXCD, xcd = wgid % NXCD, off = wgid / NXCD; wgid = (xcd < r ? xcd * (q + 1) : r * (q + 1) + (xcd - r) * q) + off; }
        const int nig = WGM * nN, gid = wgid / nig, fm = gid * WGM, gsz = (nM - fm) < WGM ? (nM - fm) : WGM;
        u.pm = fm + ((wgid % nig) % gsz); u.pn = (wgid % nig) / gsz; return true;
    }
    __device__ __forceinline__ void a_ready(const Unit&) const {}
    __device__ __forceinline__ void done(const Unit&) const {}
};

__device__ __forceinline__ unsigned cvt_pk_bf16(float lo, float hi) { unsigned r; asm volatile("v_cvt_pk_bf16_f32 %0, %1, %2" : "=v"(r) : "v"(lo), "v"(hi)); return r; }
typedef float f32x2 __attribute__((ext_vector_type(2)));
typedef float f32x2 __attribute__((ext_vector_type(2)));
__device__ __forceinline__ float bf_lo(unsigned w) { return __uint_as_float(w << 16); }
__device__ __forceinline__ float bf_hi(unsigned w) { return __uint_as_float(w & 0xffff0000u); }
__device__ __forceinline__ float fast_sigmoid(float x) { return __builtin_amdgcn_rcpf(1.0f + __expf(-x)); }

struct EpiProj {
    static constexpr bool PERM = true, AFTER_DRAIN = false, MID = false; static constexpr int SEG = 16;
    bf16_t* O; int ldc; const float* bias; int shift_from, bias_shift;
    __device__ __forceinline__ void operator()(const f32x4 (&acc)[2][2][4][2], const Unit& u, int wr, int wc, int fr, int fq) const {
        const int row0 = u.pm * BM + wr * 64 + fr; const int colt = u.pn * BM;
        const int col0 = colt + wc * 32 + 8 * fq; const float* bp = bias + col0 + (colt >= shift_from ? bias_shift : 0);
        f32x4 bv[2][2];
#pragma unroll
        for (int bj = 0; bj < 2; ++bj)
#pragma unroll
            for (int n = 0; n < 2; ++n) bv[bj][n] = *(const f32x4*)(bp + bj * HALF + 4 * n);
#pragma unroll
        for (int ai = 0; ai < 2; ++ai)
#pragma unroll
            for (int m = 0; m < 4; ++m) { bf16_t* rowp = O + (size_t)(row0 + ai * HALF + m * 16) * ldc + col0;
#pragma unroll
                for (int bj = 0; bj < 2; ++bj) { const f32x4 v0 = acc[ai][bj][m][0] + bv[bj][0], v1 = acc[ai][bj][m][1] + bv[bj][1];
                    u32x4 w; w.x = cvt_pk_bf16(v0[0], v0[1]); w.y = cvt_pk_bf16(v0[2], v0[3]); w.z = cvt_pk_bf16(v1[0], v1[1]); w.w = cvt_pk_bf16(v1[2], v1[3]);
                    *(u32x4*)(rowp + bj * HALF) = w; } }
    }
};

struct EpiUpGate {
    static constexpr bool PERM = true, AFTER_DRAIN = false, MID = true; static constexpr int SEG = 16;
    bf16_t* O; int ldc; const bf16_t* G; int ldg;
    __device__ __forceinline__ void mid(f32x4 (&acc)[2][2][4][2], const Unit& u, int seg, int wr, int wc, int fr, int fq) const {
        const int row0 = u.pm * BM + wr * 64 + fr; const int col0 = u.pn * BM + wc * 32 + 8 * fq;
#pragma unroll
        for (int ai = 0; ai < 2; ++ai)
#pragma unroll
            for (int m = 0; m < 4; ++m) { const bf16_t* gp = G + (size_t)(row0 + ai * HALF + m * 16) * ldg + seg * 4096 + col0;
#pragma unroll
                for (int bj = 0; bj < 2; ++bj) { const u32x4 a = *(const u32x4*)(gp + bj * HALF), b = *(const u32x4*)(gp + 4096 + bj * HALF);
                    const unsigned aw[4] = {a.x, a.y, a.z, a.w}, bw[4] = {b.x, b.y, b.z, b.w};
#pragma unroll
                    for (int j = 0; j < 4; ++j) {
                        const float x0l = fmaxf(bf_lo(aw[j]), -60.f), x0h = fmaxf(bf_hi(aw[j]), -60.f), x1l = fmaxf(bf_lo(bw[j]), -60.f), x1h = fmaxf(bf_hi(bw[j]), -60.f);
                        const float rl = (1.0f + __expf(-x1l)) * __builtin_amdgcn_rcpf(1.0f + __expf(-x0l)), rh = (1.0f + __expf(-x1h)) * __builtin_amdgcn_rcpf(1.0f + __expf(-x0h));
                        acc[ai][bj][m][j >> 1][(j & 1) * 2] *= rl; acc[ai][bj][m][j >> 1][(j & 1) * 2 + 1] *= rh; } }
                asm volatile("" ::: "memory"); }
    }
    __device__ __forceinline__ void operator()(const f32x4 (&acc)[2][2][4][2], const Unit& u, int wr, int wc, int fr, int fq) const {
        const int row0 = u.pm * BM + wr * 64 + fr; const int col0 = u.pn * BM + wc * 32 + 8 * fq;
#pragma unroll
        for (int ai = 0; ai < 2; ++ai)
#pragma unroll
            for (int m = 0; m < 4; ++m) { const int row = row0 + ai * HALF + m * 16; const bf16_t* gp = G + (size_t)row * ldg + 3 * 4096 + col0; bf16_t* rowp = O + (size_t)row * ldc + col0;
#pragma unroll
                for (int bj = 0; bj < 2; ++bj) { const u32x4 a = *(const u32x4*)(gp + bj * HALF); const unsigned aw[4] = {a.x, a.y, a.z, a.w}; float o[8];
#pragma unroll
                    for (int j = 0; j < 4; ++j) { const float gl = fast_sigmoid(fmaxf(bf_lo(aw[j]), -60.f)), gh = fast_sigmoid(fmaxf(bf_hi(aw[j]), -60.f));
                        o[2 * j] = acc[ai][bj][m][j >> 1][(j & 1) * 2] * gl; o[2 * j + 1] = acc[ai][bj][m][j >> 1][(j & 1) * 2 + 1] * gh; }
                    u32x4 w; w.x = cvt_pk_bf16(o[0], o[1]); w.y = cvt_pk_bf16(o[2], o[3]); w.z = cvt_pk_bf16(o[4], o[5]); w.w = cvt_pk_bf16(o[6], o[7]);
                    *(u32x4*)(rowp + bj * HALF) = w; }
                asm volatile("" ::: "memory"); }
    }
};

struct EpiResid {
    static constexpr bool PERM = false, AFTER_DRAIN = false, MID = false; static constexpr int SEG = 16;
    const float* src_real; float* dst_real; float* meta;
    __device__ __forceinline__ void operator()(const f32x4 (&acc)[2][2][4][2], const Unit& u, int wr, int wc, int fr, int fq) const {
        const int rl = wr * 64 + fr, col0 = u.pn * BM + wc * 32 + 4 * fq;
        const float* s; float* d;
        if (u.pm < 32) { s = src_real + (size_t)u.pm * BM * 4096; d = dst_real + (size_t)u.pm * BM * 4096; } else { s = meta; d = meta; }
#pragma unroll
        for (int ai = 0; ai < 2; ++ai)
#pragma unroll
            for (int m = 0; m < 4; ++m) { const size_t off = (size_t)(rl + ai * HALF + m * 16) * 4096 + col0;
#pragma unroll
                for (int bj = 0; bj < 2; ++bj)
#pragma unroll
                    for (int n = 0; n < 2; ++n) { const f32x4 r = *(const f32x4*)(s + off + bj * HALF + n * 16); *(f32x4*)(d + off + bj * HALF + n * 16) = r + acc[ai][bj][m][n]; }
                asm volatile("" ::: "memory"); }
    }
};

struct EpiSwiGLU {
    static constexpr bool PERM = true, AFTER_DRAIN = false, MID = false; static constexpr int SEG = 16;
    bf16_t* O; int ldc;
    __device__ __forceinline__ void operator()(const f32x4 (&acc)[2][2][4][2], const Unit& u, int wr, int wc, int fr, int fq) const {
        const int row0 = u.pm * BM + wr * 64 + fr; const int col0 = u.pn * HALF + wc * 32 + 8 * fq;
#pragma unroll
        for (int ai = 0; ai < 2; ++ai)
#pragma unroll
            for (int m = 0; m < 4; ++m) { float o[8];
#pragma unroll
                for (int n = 0; n < 2; ++n)
#pragma unroll
                    for (int j = 0; j < 4; ++j) { const float gv = acc[ai][0][m][n][j], uv = acc[ai][1][m][n][j]; o[4 * n + j] = gv * fast_sigmoid(gv) * uv; }
                u32x4 w; w.x = cvt_pk_bf16(o[0], o[1]); w.y = cvt_pk_bf16(o[2], o[3]); w.z = cvt_pk_bf16(o[4], o[5]); w.w = cvt_pk_bf16(o[6], o[7]);
                *(u32x4*)(O + (size_t)(row0 + ai * HALF + m * 16) * ldc + col0) = w; }
    }
};
template <class Epi, class Sched, bool ALIGN_EPI = false, bool SP2 = false>
__device__ __forceinline__ void gemm_phase(PG8_LAS unsigned char* lds, const Gemm g, const Sched& S, const Epi& E, const int tid) {
    const int wid = __builtin_amdgcn_readfirstlane(tid >> 6), lane = tid & 63, wr = wid >> 2, wc = wid & 3, fr = lane & 15, fq = lane >> 4;
    const int K = g.K, nt = K / BK;
    unsigned voffA[2], voffB[2];
#pragma unroll
    for (int i = 0; i < 2; ++i) { int R, C; stage_rc(tid * 16 + i * 8192, R, C); const int Rb = Epi::PERM ? ((R & ~31) + perm32(R & 31)) : R;
        voffA[i] = (unsigned)(R * g.lda + C) * 2u; voffB[i] = (unsigned)(Rb * g.ldb + C) * 2u; }
    const size_t kstep = (size_t)(BK * 2);
    const size_t hstepA = (size_t)HALF * g.lda * 2, hstepB = (size_t)HALF * g.ldb * 2;
    const size_t tstepA = 2 * hstepA, tstepB = 2 * hstepB;
    const unsigned ldsw = (unsigned)wid * 1024u;
    const int aoff = lds_byte(wr * 64 + fr, fq * 8), boff = lds_byte(wc * 32 + fr, fq * 8);
#define PG8_SA(b, h) (((b) * 2 + (h)) * HTB)
#define PG8_SB(b, h) ((4 + (b) * 2 + (h)) * HTB)
#define PG8_STAGE(bufoff, gbase, voff) do { _Pragma("unroll") for (int _i = 0; _i < 2; ++_i) \
        __builtin_amdgcn_global_load_lds((const unsigned*)((const char*)(gbase) + (voff)[_i]), (PG8_LAS unsigned*)(lds + (bufoff) + ldsw + _i * 8192), 16, 0, 0); } while (0)
#define PG8_LDA(dst, b, h) do { _Pragma("unroll") for (int m = 0; m < 4; ++m) _Pragma("unroll") for (int k = 0; k < 2; ++k) dst[m][k] = *(const PG8_LAS bf16x8*)(lds + PG8_SA(b, h) + aoff + m * 2048 + k * 1024); } while (0)
#define PG8_LDB(dst, b, h) do { _Pragma("unroll") for (int n = 0; n < 2; ++n) _Pragma("unroll") for (int k = 0; k < 2; ++k) dst[n][k] = *(const PG8_LAS bf16x8*)(lds + PG8_SB(b, h) + boff + n * 2048 + k * 1024); } while (0)
#define PG8_MMA(ai, bj, At, Bt) do { __builtin_amdgcn_s_setprio(1); _Pragma("unroll") for (int m = 0; m < 4; ++m) _Pragma("unroll") for (int n = 0; n < 2; ++n) _Pragma("unroll") for (int k = 0; k < 2; ++k) \
        acc[ai][bj][m][n] = __builtin_amdgcn_mfma_f32_16x16x32_bf16(Bt[n][k], At[m][k], acc[ai][bj][m][n], 0, 0, 0); __builtin_amdgcn_s_setprio(0); } while (0)
#define PG8_WAIT_V(n) asm volatile("s_waitcnt vmcnt(" #n ")" ::: "memory")
#define PG8_WAIT_L(n) asm volatile("s_waitcnt lgkmcnt(" #n ")" ::: "memory")
#define PG8_BAR __builtin_amdgcn_s_barrier()
#define PG8_SCHED __builtin_amdgcn_sched_barrier(0)
    Unit cur, nxt; int ui = 0;
    if (!S.next(0, cur)) return;
    f32x4 acc[2][2][4][2];
#pragma unroll
    for (int a = 0; a < 2; ++a)
#pragma unroll
        for (int b = 0; b < 2; ++b)
#pragma unroll
            for (int m = 0; m < 4; ++m)
#pragma unroll
                for (int n = 0; n < 2; ++n) acc[a][b][m][n] = (f32x4){0.f, 0.f, 0.f, 0.f};
    bf16x8 At[4][2], B0[2][2], B1[2][2];
    const char* cA = (const char*)g.A + (size_t)cur.pm * tstepA; const char* cB = (const char*)g.Bt + (size_t)cur.pn * tstepB;
    S.a_ready(cur);
    if constexpr (SP2) {
        PG8_STAGE(PG8_SB(0, 0), cB, voffB); PG8_STAGE(PG8_SB(0, 1), cB + hstepB, voffB); PG8_STAGE(PG8_SA(0, 0), cA, voffA); PG8_STAGE(PG8_SA(0, 1), cA + hstepA, voffA);
        if (wr == 1) PG8_BAR;
        PG8_WAIT_V(2); PG8_BAR;
        PG8_STAGE(PG8_SB(1, 0), cB + kstep, voffB); PG8_STAGE(PG8_SA(1, 0), cA + kstep, voffA); PG8_STAGE(PG8_SB(1, 1), cB + hstepB + kstep, voffB);
        PG8_WAIT_V(6); PG8_BAR;
    } else {
        PG8_STAGE(PG8_SB(0, 0), cB, voffB); PG8_STAGE(PG8_SA(0, 0), cA, voffA); PG8_STAGE(PG8_SB(0, 1), cB + hstepB, voffB); PG8_STAGE(PG8_SA(0, 1), cA + hstepA, voffA);
        if (wr == 1) PG8_BAR;
        PG8_WAIT_V(4); PG8_BAR;
        PG8_STAGE(PG8_SB(1, 0), cB + kstep, voffB); PG8_STAGE(PG8_SA(1, 0), cA + kstep, voffA); PG8_STAGE(PG8_SB(1, 1), cB + hstepB + kstep, voffB);
        PG8_WAIT_V(6); PG8_BAR;
    }
    for (;;) {
        const bool has_next = S.next(ui + 1, nxt);
        const char* nA = has_next ? (const char*)g.A + (size_t)nxt.pm * tstepA : cA; const char* nB = has_next ? (const char*)g.Bt + (size_t)nxt.pn * tstepB : cB;
        for (int t = 0; t < nt; t += 2) {
            const bool last = (t == nt - 2);
            const char* a1 = cA + (size_t)(t + 1) * kstep;
            const char* a2 = last ? nA : cA + (size_t)(t + 2) * kstep; const char* b2 = last ? nB : cB + (size_t)(t + 2) * kstep;
            const char* a3 = a2 + kstep; const char* b3 = b2 + kstep;
            if (last && has_next) S.a_ready(nxt);
            if constexpr (SP2) {
            PG8_LDB(B0, 0, 0); PG8_LDB(B1, 0, 1); PG8_SCHED; PG8_LDA(At, 0, 0); PG8_STAGE(PG8_SA(1, 1), a1 + hstepA, voffA);
            PG8_WAIT_V(8); PG8_WAIT_L(0); PG8_BAR; PG8_MMA(0, 0, At, B0); PG8_MMA(0, 1, At, B1); PG8_BAR; PG8_SCHED;
            PG8_LDA(At, 0, 1); PG8_STAGE(PG8_SB(0, 0), b2, voffB); PG8_STAGE(PG8_SB(0, 1), b2 + hstepB, voffB); PG8_STAGE(PG8_SA(0, 0), a2, voffA);
            PG8_WAIT_V(8); PG8_WAIT_L(0); PG8_BAR; PG8_MMA(1, 0, At, B0); PG8_MMA(1, 1, At, B1); PG8_BAR; PG8_SCHED;
            PG8_LDB(B0, 1, 0); PG8_LDB(B1, 1, 1); PG8_SCHED; PG8_LDA(At, 1, 0); PG8_STAGE(PG8_SA(0, 1), a2 + hstepA, voffA);
            PG8_WAIT_V(8); PG8_WAIT_L(0); PG8_BAR; PG8_MMA(0, 0, At, B0); PG8_MMA(0, 1, At, B1); PG8_BAR; PG8_SCHED;
            PG8_LDA(At, 1, 1); PG8_STAGE(PG8_SB(1, 0), b3, voffB); PG8_STAGE(PG8_SB(1, 1), b3 + hstepB, voffB); PG8_STAGE(PG8_SA(1, 0), a3, voffA);
            PG8_WAIT_V(8); PG8_WAIT_L(0); PG8_BAR; PG8_MMA(1, 0, At, B0); PG8_MMA(1, 1, At, B1); PG8_BAR; PG8_SCHED;
            } else {
            PG8_LDB(B0, 0, 0); PG8_SCHED; PG8_LDA(At, 0, 0); PG8_STAGE(PG8_SA(1, 1), a1 + hstepA, voffA);
            PG8_WAIT_L(8); PG8_BAR; PG8_WAIT_L(0); PG8_MMA(0, 0, At, B0); PG8_BAR; PG8_SCHED;
            PG8_LDB(B1, 0, 1); PG8_STAGE(PG8_SB(0, 0), b2, voffB);
            PG8_BAR; PG8_WAIT_L(0); PG8_MMA(0, 1, At, B1); PG8_BAR;
            PG8_LDA(At, 0, 1); PG8_STAGE(PG8_SA(0, 0), a2, voffA);
            PG8_BAR; PG8_WAIT_L(0); PG8_MMA(1, 0, At, B0); PG8_BAR; PG8_SCHED;
            PG8_STAGE(PG8_SB(0, 1), b2 + hstepB, voffB);
            PG8_WAIT_V(6); PG8_BAR; PG8_MMA(1, 1, At, B1); PG8_BAR;
            PG8_LDB(B0, 1, 0); PG8_SCHED; PG8_LDA(At, 1, 0); PG8_STAGE(PG8_SA(0, 1), a2 + hstepA, voffA);
            PG8_WAIT_L(8); PG8_BAR; PG8_WAIT_L(0); PG8_MMA(0, 0, At, B0); PG8_BAR; PG8_SCHED;
            PG8_LDB(B1, 1, 1); PG8_STAGE(PG8_SB(1, 0), b3, voffB);
            PG8_BAR; PG8_WAIT_L(0); PG8_MMA(0, 1, At, B1); PG8_BAR;
            PG8_LDA(At, 1, 1); PG8_STAGE(PG8_SA(1, 0), a3, voffA);
            PG8_BAR; PG8_WAIT_L(0); PG8_MMA(1, 0, At, B0); PG8_BAR; PG8_SCHED;
            PG8_STAGE(PG8_SB(1, 1), b3 + hstepB, voffB);
            PG8_WAIT_V(6); PG8_BAR; PG8_MMA(1, 1, At, B1); PG8_BAR;
            }
            if constexpr (Epi::MID) { if (!last && ((t + 2) % Epi::SEG) == 0) E.mid(acc, cur, (t + 2) / Epi::SEG - 1, wr, wc, fr, fq); }
        }
        if constexpr (ALIGN_EPI) { if (wr == 0) PG8_BAR; }
        if constexpr (!Epi::AFTER_DRAIN) { E(acc, cur, wr, wc, fr, fq); S.done(cur); }
        if (!has_next) break;
#pragma unroll
        for (int a = 0; a < 2; ++a)
#pragma unroll
            for (int b = 0; b < 2; ++b)
#pragma unroll
                for (int m = 0; m < 4; ++m)
#pragma unroll
                    for (int n = 0; n < 2; ++n) acc[a][b][m][n] = (f32x4){0.f, 0.f, 0.f, 0.f};
        cur = nxt; cA = nA; cB = nB; ++ui;
        if constexpr (ALIGN_EPI) { if (wr == 1) PG8_BAR; }
    }
    PG8_WAIT_V(0);
    if constexpr (!ALIGN_EPI) { if (wr == 0) PG8_BAR; }
    PG8_BAR;
    if constexpr (Epi::AFTER_DRAIN) { E.fused(acc, cur, wr, wc, fr, fq, lds, wid, lane); S.done(cur); }
#undef PG8_SA
#undef PG8_SB
#undef PG8_STAGE
#undef PG8_LDA
#undef PG8_LDB
#undef PG8_MMA
#undef PG8_WAIT_V
#undef PG8_WAIT_L
#undef PG8_BAR
#undef PG8_SCHED
}
}
constexpr int D = 4096, TREAL = 8192, NMETA = 16, MROWS = 8448, METAROW = 8192;
constexpr int MIXW = 1024, NPROJ = 29696, NIN = 29704, DFF = 11008, NGU = 22016, NLAYER = 2;
constexpr int PC_MLQ = 0, PC_MLK = 1024, PC_MLV = 2048, PC_MLO = 3072, PC_SBQ = 4096, PC_SBK = 5120, PC_SBV = 6144, PC_HGQ = 7168, PC_HGF = 8192, PC_HGI = 9216, PC_HGG = 10240, PC_RGX = 11264, PC_RGY = 12288, PC_GATE = 13312;
constexpr int NCH = 65;
constexpr float EPS = 1e-6f, NEGF = -1e30f;
constexpr int NWAVES = 8, NTHR = 512;

constexpr size_t MiB = 1u << 20;
constexpr size_t al(size_t x) { return (x + MiB - 1) / MiB * MiB; }
constexpr size_t WS_CTL = 0, CTL_ZERO_BYTES = 1 * MiB;
constexpr size_t SZ_WIN = (size_t)NPROJ * D * 2, SZ_WSQ = (size_t)D * D * 2, SZ_WGU = (size_t)NGU * D * 2, SZ_WD = (size_t)D * DFF * 2;
constexpr size_t WS_WIN = 1 * MiB;
constexpr size_t WS_WUP = WS_WIN + al(2 * SZ_WIN);
constexpr size_t WS_WOUT = WS_WUP + al(2 * SZ_WSQ);
constexpr size_t WS_WGU = WS_WOUT + al(2 * SZ_WSQ);
constexpr size_t WS_WD = WS_WGU + al(2 * SZ_WGU);
constexpr size_t WS_PROJ = WS_WD + al(2 * SZ_WD);
constexpr size_t WS_ACT = WS_PROJ;
constexpr size_t WS_XN = WS_PROJ + al((size_t)MROWS * NPROJ * 2);
constexpr size_t WS_BR = WS_XN + al((size_t)MROWS * D * 2);
constexpr size_t WS_MG = WS_BR + al((size_t)MROWS * D * 2);
constexpr size_t WS_HMETA = WS_MG + al((size_t)MROWS * D * 2);
constexpr size_t WS_GIF = WS_HMETA + al((size_t)256 * D * 4);
constexpr size_t WS_WIF = WS_GIF + al((size_t)MROWS * 8 * 4);
constexpr size_t WS_LB = WS_WIF + al((size_t)2 * 8 * D * 4);
constexpr size_t WS_MLS = WS_LB + MiB;
constexpr size_t WS_MLN = WS_MLS + al((size_t)520 * 65536 * 4);
constexpr size_t WS_MLSC = WS_MLN + al((size_t)520 * 256 * 4);
constexpr size_t WS_HGS = WS_MLSC + MiB;
constexpr size_t WS_HGE = WS_HGS + al((size_t)1040 * 16384 * 4);
constexpr size_t WS_RGH = WS_HGE + al((size_t)1040 * 128 * 4);
constexpr size_t WS_RGP = WS_RGH + al((size_t)MROWS * 1024 * 4);
constexpr size_t WS_RGT = WS_RGP + al((size_t)MROWS * 1024 * 4);
constexpr size_t WS_END = WS_RGT + al((size_t)3 * 2 * 65 * 1024 * 4);
static_assert(WS_END <= (size_t)2300 * MiB, "workspace map");
constexpr int CW_BAR = 4096;

constexpr int RING_BYTES = 131072;
constexpr int LDSCTL_OFF = RING_BYTES + 8192, MISC_OFF = LDSCTL_OFF + 320;
constexpr int LDS_BYTES = 147456;
static_assert(MISC_OFF + 128 <= LDS_BYTES, "LDS map");

#define GAS __attribute__((address_space(1)))
#define LAS __attribute__((address_space(3)))
typedef unsigned short bf16;
typedef unsigned v4u __attribute__((ext_vector_type(4)));
typedef unsigned v2u __attribute__((ext_vector_type(2)));
typedef float f32x4 __attribute__((ext_vector_type(4)));
typedef float f32x2 __attribute__((ext_vector_type(2)));
typedef GAS unsigned gu32;
#define RLX_AGENT __ATOMIC_RELAXED, __HIP_MEMORY_SCOPE_AGENT
#define LDS_WAIT() asm volatile("s_waitcnt lgkmcnt(0)" ::: "memory")
#define VM_WAIT() asm volatile("s_waitcnt vmcnt(0)" ::: "memory")
__device__ __forceinline__ unsigned f2bf(float f) { unsigned u = __builtin_bit_cast(unsigned, f); return (u + 0x7fffu + ((u >> 16) & 1u)) >> 16; }
__device__ __forceinline__ unsigned pk2(float lo, float hi) { return f2bf(lo) | (f2bf(hi) << 16); }
__device__ __forceinline__ float bflo(unsigned w) { return __uint_as_float(w << 16); }
__device__ __forceinline__ float bfhi(unsigned w) { return __uint_as_float(w & 0xffff0000u); }
__device__ __forceinline__ float bf1(bf16 b) { return __uint_as_float(((unsigned)b) << 16); }
__device__ __forceinline__ void unpack8(const v4u w, float (&o)[8]) { o[0] = bflo(w.x); o[1] = bfhi(w.x); o[2] = bflo(w.y); o[3] = bfhi(w.y); o[4] = bflo(w.z); o[5] = bfhi(w.z); o[6] = bflo(w.w); o[7] = bfhi(w.w); }
__device__ __forceinline__ float wave_sum(float v) {
#pragma unroll
    for (int o = 1; o < 64; o <<= 1) v += __shfl_xor(v, o);
    return v;
}
__device__ __forceinline__ float wave_max(float v) {
#pragma unroll
    for (int o = 1; o < 64; o <<= 1) v = fmaxf(v, __shfl_xor(v, o));
    return v;
}
__device__ __forceinline__ float wave_incl_sum(float v, int lane) {
#pragma unroll
    for (int o = 1; o < 64; o <<= 1) { const float t = __shfl_up(v, o); if (lane >= o) v += t; }
    return v;
}
__device__ __forceinline__ float wave_incl_max(float v, int lane) {
#pragma unroll
    for (int o = 1; o < 64; o <<= 1) { const float t = __shfl_up(v, o); if (lane >= o) v = fmaxf(v, t); }
    return v;
}
__device__ __forceinline__ float sigmoidf_(float x) { return 1.0f / (1.0f + expf(-x)); }
__device__ __forceinline__ float log_sigmoidf_(float x) { return fminf(x, 0.f) - log1pf(expf(-fabsf(x))); }
__device__ __forceinline__ float softplusf_(float x) { return fmaxf(x, 0.f) + log1pf(expf(-fabsf(x))); }
__device__ __forceinline__ int seq_row(int b, int p) { return p < NMETA ? METAROW + p : b * 4096 + p - NMETA; }
#define XB_TMO      128
#define XB_XCNT(j)  (256  + 64 * (j))
#define XB_XSUB(j)  (1280 + 64 * (j))
#define XB_XGEN(j)  (2304 + 64 * (j))
#define XB_TOP      3328
#define XB_TOPGEN   3392
#define XCD_BAR_WORDS 3456
#define XB_SPIN_CAP (1u << 18)

__device__ __forceinline__ unsigned xb_ld(unsigned* p)              { return __hip_atomic_load(p, __ATOMIC_RELAXED, __HIP_MEMORY_SCOPE_AGENT); }
__device__ __forceinline__ unsigned xb_add(unsigned* p, unsigned v) { return __hip_atomic_fetch_add(p, v, __ATOMIC_RELAXED, __HIP_MEMORY_SCOPE_AGENT); }
__device__ __forceinline__ unsigned xb_xcc_id() { return (unsigned)__builtin_amdgcn_s_getreg((3 << 11) | 20) & 0xFu; }
#define XB_SPIN(cond, bar) do { unsigned _sp = 0; while (cond) { __builtin_amdgcn_s_sleep(1); \
    if ((++_sp & 255u) == 0u) { if (xb_ld(&(bar)[XB_TMO])) break; if (_sp > XB_SPIN_CAP) { atomicAdd(&(bar)[XB_TMO], 1u); break; } } } } while (0)

struct XcdBarrier {
    unsigned* bar; unsigned x;
    volatile LAS unsigned* st;
};

__device__ __forceinline__ XcdBarrier xcd_barrier_post(unsigned* bar, volatile LAS unsigned* st) {
    XcdBarrier b; b.bar = bar; b.x = xb_xcc_id(); b.st = st;
    if (threadIdx.x == 0) (void)xb_add(&bar[XB_XCNT(b.x)], 1u);
    return b;
}
__device__ __forceinline__ void xcd_barrier_complete(unsigned* bar, unsigned x, unsigned& nloc, unsigned& nx) {
    const unsigned G = gridDim.x * gridDim.y * gridDim.z;
    unsigned sum, cnt, mine, sp = 0u;
    for (;;) {
        sum = 0u; cnt = 0u; mine = 0u;
#pragma unroll
        for (unsigned j = 0; j < 16; ++j) { const unsigned c = xb_ld(&bar[XB_XCNT(j)]); sum += c; cnt += (c > 0u) ? 1u : 0u; mine = (j == x) ? c : mine; }
        if (sum == G) break;
        __builtin_amdgcn_s_sleep(1);
        if ((++sp & 255u) == 0u) { if (xb_ld(&bar[XB_TMO])) break; if (sp > XB_SPIN_CAP) { atomicAdd(&bar[XB_TMO], 1u); break; } }
    }
    nloc = mine > 0u ? mine : 1u; nx = cnt > 0u ? cnt : 1u;
}

__device__ __forceinline__ void xcd_barrier(const XcdBarrier& b) {
    asm volatile("s_waitcnt vmcnt(0)" ::: "memory");
    __syncthreads();
    if (threadIdx.x == 0) {
        unsigned* bar = b.bar;
        __builtin_amdgcn_s_waitcnt(0);
        unsigned nloc = b.st[0], nx = b.st[1];
        if (nloc == 0u) { xcd_barrier_complete(bar, b.x, nloc, nx); b.st[0] = nloc; b.st[1] = nx; }
        const unsigned old = xb_add(&bar[XB_XSUB(b.x)], 1u);
        const unsigned gen = old / nloc;
        if (old + 1u == (gen + 1u) * nloc) {
            __builtin_amdgcn_fence(__ATOMIC_RELEASE, "agent");
            asm volatile("s_waitcnt vmcnt(0)" ::: "memory");
            const unsigned og = xb_add(&bar[XB_TOP], 1u);
            const unsigned tg = og / nx;
            if (og + 1u == (tg + 1u) * nx) xb_add(&bar[XB_TOPGEN], 1u);
            else XB_SPIN(xb_ld(&bar[XB_TOPGEN]) == tg, bar);
            __builtin_amdgcn_fence(__ATOMIC_ACQUIRE, "agent");
            xb_add(&bar[XB_XGEN(b.x)], 1u);
            asm volatile("s_waitcnt vmcnt(0)" ::: "memory");
        } else {
            XB_SPIN(xb_ld(&bar[XB_XGEN(b.x)]) == gen, bar);
            __builtin_amdgcn_fence(__ATOMIC_ACQUIRE, "agent");
            asm volatile("s_waitcnt vmcnt(0)" ::: "memory");
        }
    }
    __syncthreads();
}
struct P0Item { const float* src; bf16* dst; int ldw, K; };
struct P0Strip { const float* src0; bf16* dst0; int ldw, K, kb_lo, kb_n; };
constexpr int NSTRIP_DN = 2 * NLAYER * 64, NSTRIP_L = 464 + 344 + 64 + 64, NSTRIP = NSTRIP_DN + NLAYER * NSTRIP_L;
__device__ __forceinline__ P0Strip p0_strip(const float* const* in, unsigned char* ws, int s) {
    P0Strip o;
    if (s < NSTRIP_DN) { const int l = s >> 7, rem = s & 127, nb = rem >> 1, half = rem & 1;
        o.ldw = D; o.K = DFF; o.src0 = in[22] + (size_t)l * DFF * D + 64 * nb; o.dst0 = (bf16*)(ws + WS_WD + (size_t)l * SZ_WD) + (size_t)(64 * nb) * DFF; o.kb_lo = 86 * half; o.kb_n = 86; return o; }
    s -= NSTRIP_DN; const int l = s / NSTRIP_L; int r = s - l * NSTRIP_L; o.K = D; o.kb_lo = 0; o.kb_n = 64;
    if (r < 464) { o.ldw = NIN; o.src0 = in[4] + (size_t)l * D * NIN + 64 * r + (r >= 64 ? 8 : 0); o.dst0 = (bf16*)(ws + WS_WIN + (size_t)l * SZ_WIN) + (size_t)(64 * r) * D; return o; } r -= 464;
    if (r < 344) { const int which = r / 172, nb = r % 172, n0 = 64 * nb; o.ldw = DFF; o.src0 = in[20 + which] + (size_t)l * D * DFF + n0; o.dst0 = (bf16*)(ws + WS_WGU + (size_t)l * SZ_WGU) + (size_t)((n0 >> 7) * 256 + which * 128 + (n0 & 127)) * D; return o; } r -= 344;
    if (r < 64) { o.ldw = D; o.src0 = in[18] + (size_t)l * D * D + 64 * r; o.dst0 = (bf16*)(ws + WS_WUP + (size_t)l * SZ_WSQ) + (size_t)(64 * r) * D; return o; } r -= 64;
    { o.ldw = D; o.src0 = in[19] + (size_t)l * D * D + 64 * r; o.dst0 = (bf16*)(ws + WS_WOUT + (size_t)l * SZ_WSQ) + (size_t)(64 * r) * D; return o; }
}
__device__ __forceinline__ P0Item p0_item(const P0Strip& S, int kb) { P0Item o; o.src = S.src0 + (size_t)(64 * kb) * S.ldw; o.dst = S.dst0 + 64 * kb; o.ldw = S.ldw; o.K = S.K; return o; }
__device__ __forceinline__ void p0_load(const P0Item& I, f32x4 (&v)[16], int lane) {
    const float* p = I.src + (size_t)(2 * (lane >> 4)) * I.ldw + 4 * (lane & 15);
#pragma unroll
    for (int j = 0; j < 16; ++j) v[j] = *(const f32x4*)(p + (size_t)(8 * (j >> 1) + (j & 1)) * I.ldw);
}
__device__ __forceinline__ void p0_store(const P0Item& I, const f32x4 (&v)[16], unsigned* scr, int lane) {
    const int l15 = lane & 15, l4 = lane >> 4;
#pragma unroll
    for (int m = 0; m < 8; ++m)
#pragma unroll
        for (int i = 0; i < 4; ++i) scr[(4 * l15 + i) * 33 + 4 * m + l4] = pk2(v[2 * m][i], v[2 * m + 1][i]);
    LDS_WAIT(); asm volatile("" ::: "memory");
    const int c = lane & 7;
#pragma unroll
    for (int j = 0; j < 8; ++j) { const int n = (lane >> 3) + 8 * j; const unsigned* s = scr + n * 33 + 4 * c;
        v4u o; o.x = s[0]; o.y = s[1]; o.z = s[2]; o.w = s[3];
        *(v4u*)(I.dst + (size_t)n * I.K + 8 * c) = o; }
    LDS_WAIT(); asm volatile("" ::: "memory");
}
__device__ __forceinline__ void p0_prologue(const float* const* in, unsigned char* ws, unsigned char* lds, int bxp, int Gp, int wave, int lane, int gtid, int NGT) {
    unsigned* scr = (unsigned*)(lds + wave * 16384);
    const float* w_in = in[4];
    for (int sidx = bxp; sidx < NSTRIP; sidx += Gp) {
        const P0Strip S = p0_strip(in, ws, sidx); const int hi = S.kb_lo + S.kb_n; int kb = S.kb_lo + wave; f32x4 va[16], vb[16];
        if (kb < hi) p0_load(p0_item(S, kb), va, lane);
        while (kb < hi) {
            const int k1 = kb + NWAVES; if (k1 < hi) p0_load(p0_item(S, k1), vb, lane);
            p0_store(p0_item(S, kb), va, scr, lane);
            if (k1 >= hi) break;
            const int k2 = k1 + NWAVES; if (k2 < hi) p0_load(p0_item(S, k2), va, lane);
            p0_store(p0_item(S, k1), vb, scr, lane);
            kb = k2; }
    }
    { float* hm = (float*)(ws + WS_HMETA); const float* meta = in[1];
      for (int i = gtid; i < 256 * D; i += NGT) hm[i] = (i < NMETA * D) ? meta[i] : 0.f; }
    { unsigned* brp = (unsigned*)(ws + WS_BR + (size_t)(TREAL + NMETA) * D * 2);
      for (int i = gtid; i < (MROWS - TREAL - NMETA) * D / 2; i += NGT) brp[i] = 0u; }
    { float* wif = (float*)(ws + WS_WIF);
      for (int i = gtid; i < NLAYER * 8 * D; i += NGT) { const int l = i / (8 * D), j = (i / D) & 7, k = i % D; wif[i] = w_in[((size_t)l * D + k) * NIN + 4096 + j]; } }
    { float* lb = (float*)(ws + WS_LB); const float* hl = in[9];
      for (int i = gtid; i < 1024; i += NGT) { const float a0 = hl[i], a1 = hl[1024 + i], mx = fmaxf(a0, a1), e0 = expf(a0 - mx), e1 = expf(a1 - mx); const float p1 = e1 / (e0 + e1);
          lb[i] = 0.f; lb[1024 + i] = fminf(fmaxf(p1, 0.f), 0.999f); } }
}

template <bool GATES> __device__ __forceinline__ void norm_rows(const float* hreal, const float* hmeta, const float* gain, bf16* XN, int nrows, const float* wif, const float* bif, float* gif, int gw, int NGW, int lane) {
    for (int row = gw; row < nrows; row += NGW) {
        const float* hr = row < TREAL ? hreal + (size_t)row * D : hmeta + (size_t)(row - TREAL) * D;
        f32x4 v[16]; float ss = 0.f;
#pragma unroll
        for (int j = 0; j < 8; ++j) { const float* p = hr + 512 * j + 8 * lane; v[2 * j] = *(const f32x4*)p; v[2 * j + 1] = *(const f32x4*)(p + 4);
            ss += (v[2 * j].x * v[2 * j].x + v[2 * j].y * v[2 * j].y) + (v[2 * j].z * v[2 * j].z + v[2 * j].w * v[2 * j].w) + (v[2 * j + 1].x * v[2 * j + 1].x + v[2 * j + 1].y * v[2 * j + 1].y) + (v[2 * j + 1].z * v[2 * j + 1].z + v[2 * j + 1].w * v[2 * j + 1].w); }
        const float rstd = 1.0f / sqrtf(wave_sum(ss) * (1.0f / D) + EPS);
#pragma unroll
        for (int j = 0; j < 8; ++j) { const float* gp = gain + 512 * j + 8 * lane; const f32x4 g0 = *(const f32x4*)gp, g1 = *(const f32x4*)(gp + 4);
            v[2 * j] = v[2 * j] * rstd * g0; v[2 * j + 1] = v[2 * j + 1] * rstd * g1;
            v4u o; o.x = pk2(v[2 * j].x, v[2 * j].y); o.y = pk2(v[2 * j].z, v[2 * j].w); o.z = pk2(v[2 * j + 1].x, v[2 * j + 1].y); o.w = pk2(v[2 * j + 1].z, v[2 * j + 1].w);
            *(v4u*)(XN + (size_t)row * D + 512 * j + 8 * lane) = o; }
        if (GATES) { float mine = 0.f;
#pragma unroll
            for (int jj = 0; jj < 8; ++jj) { float dot = 0.f; const float* wp = wif + jj * D + 8 * lane;
#pragma unroll
                for (int j = 0; j < 8; ++j) { const f32x4 w0 = *(const f32x4*)(wp + 512 * j), w1 = *(const f32x4*)(wp + 512 * j + 4);
                    dot += (v[2 * j].x * w0.x + v[2 * j].y * w0.y) + (v[2 * j].z * w0.z + v[2 * j].w * w0.w) + (v[2 * j + 1].x * w1.x + v[2 * j + 1].y * w1.y) + (v[2 * j + 1].z * w1.z + v[2 * j + 1].w * w1.w); }
                dot = wave_sum(dot); if (lane == jj) mine = dot + bif[jj]; }
            if (lane < 8) gif[(size_t)row * 8 + lane] = mine; }
    }
}

__device__ __forceinline__ void mlstm_A(const bf16* PROJ, const float* GIF, float* MLS, float* MLN, float* MLSC, int u, unsigned char* lds, int tid) {
    const int c = u % NCH, bh = u / NCH, h = bh & 3, b = bh >> 2, lane = tid & 63;
    float* kw = (float*)lds; float* vs = kw + 64 * 256; float* wsc = (float*)(lds + RING_BYTES);
    if (tid < 64) {
        const int p = 64 * c + lane - 48; float lf = 0.f, li = NEGF;
        if (p >= 0) { const int row = seq_row(b, p); li = GIF[(size_t)row * 8 + h]; lf = log_sigmoidf_(GIF[(size_t)row * 8 + 4 + h]); }
        const float bc = wave_incl_sum(lf, lane); const float bend = __shfl(bc, 63);
        const float wl = bend - bc + li; const float a = wave_max(wl);
        wsc[lane] = expf(wl - a);
        if (lane == 0) { MLSC[u] = a; MLSC[520 + u] = bend; }
    }
    __syncthreads();
#pragma unroll
    for (int j = 0; j < 4; ++j) { const int id = tid + 512 * j, r = id >> 5, cp = id & 31, p = 64 * c + r - 48;
        float kv[8], vv[8];
        if (p >= 0) { const size_t ro = (size_t)seq_row(b, p) * NPROJ + h * 256 + cp * 8; const v4u kr = *(const v4u*)(PROJ + ro + PC_MLK), vr = *(const v4u*)(PROJ + ro + PC_MLV);
            unpack8(kr, kv); unpack8(vr, vv); const float w = wsc[r];
#pragma unroll
            for (int q = 0; q < 8; ++q) kv[q] *= w; }
        else {
#pragma unroll
            for (int q = 0; q < 8; ++q) { kv[q] = 0.f; vv[q] = 0.f; } }
        *(f32x4*)(kw + r * 256 + cp * 8) = (f32x4){kv[0], kv[1], kv[2], kv[3]}; *(f32x4*)(kw + r * 256 + cp * 8 + 4) = (f32x4){kv[4], kv[5], kv[6], kv[7]};
        *(f32x4*)(vs + r * 256 + cp * 8) = (f32x4){vv[0], vv[1], vv[2], vv[3]}; *(f32x4*)(vs + r * 256 + cp * 8 + 4) = (f32x4){vv[4], vv[5], vv[6], vv[7]}; }
    __syncthreads();
    const int d0 = (tid >> 4) * 8, e0 = (tid & 15) * 16;
    f32x4 acc[8][4]; float nacc[8];
#pragma unroll
    for (int i = 0; i < 8; ++i) { nacc[i] = 0.f;
#pragma unroll
        for (int q = 0; q < 4; ++q) acc[i][q] = (f32x4){0.f, 0.f, 0.f, 0.f}; }
    for (int s = 0; s < 64; ++s) {
        const f32x4 k0 = *(const f32x4*)(kw + s * 256 + d0), k1 = *(const f32x4*)(kw + s * 256 + d0 + 4);
        const float kd[8] = {k0.x, k0.y, k0.z, k0.w, k1.x, k1.y, k1.z, k1.w};
        f32x4 v4[4];
#pragma unroll
        for (int q = 0; q < 4; ++q) v4[q] = *(const f32x4*)(vs + s * 256 + e0 + 4 * q);
#pragma unroll
        for (int i = 0; i < 8; ++i) { nacc[i] += kd[i];
#pragma unroll
            for (int q = 0; q < 4; ++q) acc[i][q] += v4[q] * kd[i]; }
    }
    float* out = MLS + (size_t)u * 65536;
#pragma unroll
    for (int i = 0; i < 8; ++i)
#pragma unroll
        for (int q = 0; q < 4; ++q) *(f32x4*)(out + (d0 + i) * 256 + e0 + 4 * q) = acc[i][q];
    if ((tid & 15) == 0) {
#pragma unroll
        for (int i = 0; i < 8; ++i) MLN[(size_t)u * 256 + d0 + i] = nacc[i]; }
    __syncthreads();
}
__device__ __forceinline__ void mlstm_B(float* MLS, float* MLN, float* MLSC, int unit, unsigned char* lds, int tid) {
    const int chain = unit >> 5, slice = unit & 31;
    float* alpha = (float*)lds; float* beta = alpha + 80;
    if (tid == 0) { float m = 0.f;
        for (int c = 0; c < NCH; ++c) { const float a = MLSC[chain * NCH + c], be = MLSC[520 + chain * NCH + c]; const float mn = fmaxf(be + m, a);
            alpha[c] = expf(be + m - mn); beta[c] = expf(a - mn); if (slice == 0) MLSC[1040 + chain * NCH + c] = m; m = mn; } }
    __syncthreads();
    { const int off = slice * 2048 + tid * 4; f32x4 st = (f32x4){0.f, 0.f, 0.f, 0.f};
#pragma unroll 5
      for (int c = 0; c < NCH; ++c) { float* p = MLS + (size_t)(chain * NCH + c) * 65536 + off; const f32x4 d = *(const f32x4*)p; *(f32x4*)p = st; st = st * alpha[c] + d * beta[c]; } }
    if (slice == 0 && tid < 64) { const int off = tid * 4; f32x4 st = (f32x4){0.f, 0.f, 0.f, 0.f};
      for (int c = 0; c < NCH; ++c) { float* p = MLN + (size_t)(chain * NCH + c) * 256 + off; const f32x4 d = *(const f32x4*)p; *(f32x4*)p = st; st = st * alpha[c] + d * beta[c]; } }
    __syncthreads();
}
__device__ __forceinline__ void mlstm_C(const bf16* PROJ, const float* GIF, const float* MLS, const float* MLN, const float* MLSC, const float* ml_norm, bf16* BR, int u, unsigned char* lds, int tid) {
    const int c = u % NCH, bh = u / NCH, h = bh & 3, b = bh >> 2, lane = tid & 63, wave = tid >> 6;
    bf16* Qs = (bf16*)lds; bf16* Ks = Qs + 64 * 256; bf16* Vs = Ks + 64 * 256; float* S = (float*)(lds + 98304);
    float* bcs = (float*)(lds + RING_BYTES); float* lis = bcs + 64; float* mout = lis + 64; float* inter = mout + 64; float* den = inter + 64; float* ns = den + 64;
    if (tid < 64) {
        const int p = 64 * c + lane - 48; float lf = 0.f, li = NEGF;
        if (p >= 0) { const int row = seq_row(b, p); li = GIF[(size_t)row * 8 + h]; lf = log_sigmoidf_(GIF[(size_t)row * 8 + 4 + h]); }
        const float bc = wave_incl_sum(lf, lane); const float pm = wave_incl_max(li - bc, lane); const float mc = MLSC[1040 + u];
        const float mo = fmaxf(bc + mc, bc + pm);
        bcs[lane] = bc; lis[lane] = li; mout[lane] = mo; inter[lane] = expf(bc + mc - mo);
    } else if (tid < 128) { *(f32x4*)(ns + (tid - 64) * 4) = *(const f32x4*)(MLN + (size_t)u * 256 + (tid - 64) * 4); }
#pragma unroll
    for (int j = 0; j < 4; ++j) { const int id = tid + 512 * j, r = id >> 5, cp = id & 31, p = 64 * c + r - 48;
        v4u qr = (v4u){0u, 0u, 0u, 0u}, kr = qr, vr = qr;
        if (p >= 0) { const size_t ro = (size_t)seq_row(b, p) * NPROJ + h * 256 + cp * 8; qr = *(const v4u*)(PROJ + ro + PC_MLQ); kr = *(const v4u*)(PROJ + ro + PC_MLK); vr = *(const v4u*)(PROJ + ro + PC_MLV); }
        *(v4u*)(Qs + r * 256 + cp * 8) = qr; *(v4u*)(Ks + r * 256 + cp * 8) = kr; *(v4u*)(Vs + r * 256 + cp * 8) = vr; }
    __syncthreads();
    {
        const int t = tid >> 3, sg = tid & 7; float dot[8]; float qn = 0.f;
#pragma unroll
        for (int j = 0; j < 8; ++j) dot[j] = 0.f;
        for (int d8 = 0; d8 < 32; ++d8) { float q8[8]; unpack8(*(const v4u*)(Qs + t * 256 + d8 * 8), q8);
#pragma unroll
            for (int j = 0; j < 8; ++j) { float k8[8]; unpack8(*(const v4u*)(Ks + (sg * 8 + j) * 256 + d8 * 8), k8);
#pragma unroll
                for (int i = 0; i < 8; ++i) dot[j] += q8[i] * k8[i]; }
            if ((d8 >> 2) == sg) {
#pragma unroll
                for (int i = 0; i < 8; ++i) qn += q8[i] * ns[d8 * 8 + i]; } }
        const float bt = bcs[t], mo = mout[t]; float rs = 0.f;
#pragma unroll
        for (int j = 0; j < 8; ++j) { const int s = sg * 8 + j; float val = 0.f; if (s <= t) val = dot[j] * 0.0625f * expf(bt - bcs[s] + lis[s] - mo); S[t * 64 + s] = val; rs += val; }
        rs += __shfl_xor(rs, 1); rs += __shfl_xor(rs, 2); rs += __shfl_xor(rs, 4);
        qn += __shfl_xor(qn, 1); qn += __shfl_xor(qn, 2); qn += __shfl_xor(qn, 4);
        if (sg == 0) den[t] = rs + inter[t] * qn * 0.0625f;
    }
    __syncthreads();
    const int e = tid & 255, th = tid >> 8;
    float* part = (float*)(lds + RING_BYTES + 4096);
    const float gn = ml_norm[h * 256 + e];
    for (int hf = 0; hf < 2; ++hf) {
        const int t0 = 32 * th + 16 * hf;
        float acc[16];
#pragma unroll
        for (int tt = 0; tt < 16; ++tt) acc[tt] = 0.f;
        { const float* Cst = MLS + (size_t)u * 65536;
          for (int d8 = 0; d8 < 32; ++d8) { float cv[8];
#pragma unroll
              for (int i = 0; i < 8; ++i) cv[i] = Cst[(d8 * 8 + i) * 256 + e];
#pragma unroll
              for (int tt = 0; tt < 16; ++tt) { float q8[8]; unpack8(*(const v4u*)(Qs + (t0 + tt) * 256 + d8 * 8), q8);
#pragma unroll
                  for (int i = 0; i < 8; ++i) acc[tt] += q8[i] * cv[i]; } } }
#pragma unroll
        for (int tt = 0; tt < 16; ++tt) acc[tt] *= inter[t0 + tt] * 0.0625f;
        for (int s4 = 0; s4 < 16; ++s4) { float vv[4];
#pragma unroll
            for (int i = 0; i < 4; ++i) vv[i] = bf1(Vs[(s4 * 4 + i) * 256 + e]);
#pragma unroll
            for (int tt = 0; tt < 16; ++tt) { const f32x4 sv = *(const f32x4*)(S + (t0 + tt) * 64 + s4 * 4); acc[tt] += (sv.x * vv[0] + sv.y * vv[1]) + (sv.z * vv[2] + sv.w * vv[3]); } }
#pragma unroll
        for (int tt = 0; tt < 16; ++tt) { const int t = t0 + tt; acc[tt] = acc[tt] / fmaxf(fabsf(den[t]), expf(-mout[t]));
            const float sq = wave_sum(acc[tt] * acc[tt]); if (lane == 0) part[wave * 16 + tt] = sq; }
        __syncthreads();
#pragma unroll
        for (int tt = 0; tt < 16; ++tt) { const int t = t0 + tt, p = 64 * c + t - 48;
            const float ssq = (part[(4 * th) * 16 + tt] + part[(4 * th + 1) * 16 + tt]) + (part[(4 * th + 2) * 16 + tt] + part[(4 * th + 3) * 16 + tt]);
            if (p >= 0 && (c > 0 || b == 0)) { const int row = seq_row(b, p); const float rstd = 1.0f / sqrtf(ssq * (1.0f / 256.0f) + EPS);
                const float og = sigmoidf_(bf1(PROJ[(size_t)row * NPROJ + PC_MLO + h * 256 + e]));
                BR[(size_t)row * D + h * 256 + e] = (bf16)f2bf(acc[tt] * rstd * gn * og); } }
        __syncthreads();
    }
}

__device__ __forceinline__ void hg_cumsum(const bf16* PROJ, const float* LB, int b, int h, int c, float* bcs, float* kks, int d) {
    const float lb = LB[h * 128 + d]; float bacc = 0.f;
    for (int t = 0; t < 64; ++t) { const int p = 64 * c + t - 48; float lf = 0.f, kk = 0.f;
        if (p >= 0) { const float fp = bf1(PROJ[(size_t)seq_row(b, p) * NPROJ + PC_HGF + h * 128 + d]); const float sig = sigmoidf_(fp), nsig = sigmoidf_(-fp);
            lf = logf(lb + (1.0f - lb) * sig); kk = (1.0f - lb) * nsig; }
        bacc += lf; bcs[t * 128 + d] = bacc; kks[t * 128 + d] = kk; }
}
__device__ __forceinline__ void hg_A(const bf16* PROJ, const float* LB, float* HGS, float* HGE, int u, unsigned char* lds, int tid) {
    const int c = u % NCH, bh = u / NCH, h = bh & 7, b = bh >> 3;
    float* bcs = (float*)lds; float* kkw = bcs + 64 * 128; float* iv = kkw + 64 * 128;
    if (tid < 128) hg_cumsum(PROJ, LB, b, h, c, bcs, kkw, tid);
    else { for (int id = tid - 128; id < 1024; id += 384) { const int r = id >> 4, cp = id & 15, p = 64 * c + r - 48; float x[8];
            if (p >= 0) unpack8(*(const v4u*)(PROJ + (size_t)seq_row(b, p) * NPROJ + PC_HGI + h * 128 + cp * 8), x);
            else {
#pragma unroll
                for (int q = 0; q < 8; ++q) x[q] = 0.f; }
            *(f32x4*)(iv + r * 128 + cp * 8) = (f32x4){x[0], x[1], x[2], x[3]}; *(f32x4*)(iv + r * 128 + cp * 8 + 4) = (f32x4){x[4], x[5], x[6], x[7]}; } }
    __syncthreads();
    float escale[16];
#pragma unroll
    for (int k = 0; k < 16; ++k) { const int idx = tid + 512 * k, d = idx & 127; escale[k] = expf(bcs[63 * 128 + d] - bcs[idx]); }
    if (tid < 128) HGE[(size_t)u * 128 + tid] = expf(bcs[63 * 128 + tid]);
#pragma unroll
    for (int k = 0; k < 16; ++k) kkw[tid + 512 * k] *= escale[k];
    __syncthreads();
    const int d0 = (tid >> 4) * 4, e0 = (tid & 15) * 8;
    f32x4 acc[4][2];
#pragma unroll
    for (int i = 0; i < 4; ++i) { acc[i][0] = (f32x4){0.f, 0.f, 0.f, 0.f}; acc[i][1] = acc[i][0]; }
    for (int s = 0; s < 64; ++s) { const f32x4 kd = *(const f32x4*)(kkw + s * 128 + d0); const f32x4 i0 = *(const f32x4*)(iv + s * 128 + e0), i1 = *(const f32x4*)(iv + s * 128 + e0 + 4);
        acc[0][0] += i0 * kd.x; acc[0][1] += i1 * kd.x; acc[1][0] += i0 * kd.y; acc[1][1] += i1 * kd.y; acc[2][0] += i0 * kd.z; acc[2][1] += i1 * kd.z; acc[3][0] += i0 * kd.w; acc[3][1] += i1 * kd.w; }
    float* out = HGS + (size_t)u * 16384;
#pragma unroll
    for (int i = 0; i < 4; ++i) { *(f32x4*)(out + (d0 + i) * 128 + e0) = acc[i][0]; *(f32x4*)(out + (d0 + i) * 128 + e0 + 4) = acc[i][1]; }
    __syncthreads();
}
__device__ __forceinline__ void hg_B(float* HGS, const float* HGE, int unit, int tid) {
    const int chain = unit >> 4, slice = unit & 15, off = slice * 1024 + tid * 2, d = off >> 7; f32x2 st = (f32x2){0.f, 0.f};
#pragma unroll 5
    for (int c = 0; c < NCH; ++c) { const size_t uu = (size_t)chain * NCH + c; float* p = HGS + uu * 16384 + off; const f32x2 dl = *(const f32x2*)p; const float e = HGE[uu * 128 + d]; *(f32x2*)p = st; st = st * e + dl; }
}
__device__ __forceinline__ void hg_C(const bf16* PROJ, const float* LB, const float* HGS, const float* hg_norm, bf16* BR, int u, unsigned char* lds, int tid) {
    const int c = u % NCH, bh = u / NCH, h = bh & 7, b = bh >> 3, lane = tid & 63, wave = tid >> 6;
    float* qs = (float*)lds; float* bcs = qs + 64 * 128; float* kks = bcs + 64 * 128; float* att = kks + 64 * 128; float* H = qs;
    if (tid < 128) hg_cumsum(PROJ, LB, b, h, c, bcs, kks, tid);
    else { for (int id = tid - 128; id < 1024; id += 384) { const int r = id >> 4, cp = id & 15, p = 64 * c + r - 48; float x[8];
            if (p >= 0) { unpack8(*(const v4u*)(PROJ + (size_t)seq_row(b, p) * NPROJ + PC_HGQ + h * 128 + cp * 8), x);
#pragma unroll
                for (int q = 0; q < 8; ++q) x[q] = x[q] * sigmoidf_(x[q]); }
            else {
#pragma unroll
                for (int q = 0; q < 8; ++q) x[q] = 0.f; }
            *(f32x4*)(qs + r * 128 + cp * 8) = (f32x4){x[0], x[1], x[2], x[3]}; *(f32x4*)(qs + r * 128 + cp * 8 + 4) = (f32x4){x[4], x[5], x[6], x[7]}; } }
    __syncthreads();
    { const int t = tid >> 3, sg = tid & 7;
#pragma unroll 1
      for (int j = 0; j < 8; ++j) { const int s = sg * 8 + j; float a = 0.f;
          if (s <= t) { for (int d4 = 0; d4 < 32; ++d4) { const f32x4 q4 = *(const f32x4*)(qs + t * 128 + d4 * 4), k4 = *(const f32x4*)(kks + s * 128 + d4 * 4), bt = *(const f32x4*)(bcs + t * 128 + d4 * 4), bs = *(const f32x4*)(bcs + s * 128 + d4 * 4);
                  a += (q4.x * k4.x * expf(bt.x - bs.x) + q4.y * k4.y * expf(bt.y - bs.y)) + (q4.z * k4.z * expf(bt.z - bs.z) + q4.w * k4.w * expf(bt.w - bs.w)); } }
          att[t * 64 + s] = a; } }
    __syncthreads();
#pragma unroll
    for (int k = 0; k < 16; ++k) { const int idx = tid + 512 * k; bcs[idx] = qs[idx] * expf(bcs[idx]); }
    for (int id = tid; id < 1024; id += 512) { const int r = id >> 4, cp = id & 15, p = 64 * c + r - 48; float x[8];
        if (p >= 0) unpack8(*(const v4u*)(PROJ + (size_t)seq_row(b, p) * NPROJ + PC_HGI + h * 128 + cp * 8), x);
        else {
#pragma unroll
            for (int q = 0; q < 8; ++q) x[q] = 0.f; }
        *(f32x4*)(kks + r * 128 + cp * 8) = (f32x4){x[0], x[1], x[2], x[3]}; *(f32x4*)(kks + r * 128 + cp * 8 + 4) = (f32x4){x[4], x[5], x[6], x[7]}; }
    __syncthreads();
    const int e = tid & 127, tq = tid >> 7; float acc[16];
#pragma unroll
    for (int tt = 0; tt < 16; ++tt) acc[tt] = 0.f;
    { const float* Sst = HGS + (size_t)u * 16384;
      for (int d4 = 0; d4 < 32; ++d4) { float sv[4];
#pragma unroll
          for (int i = 0; i < 4; ++i) sv[i] = Sst[(d4 * 4 + i) * 128 + e];
#pragma unroll
          for (int tt = 0; tt < 16; ++tt) { const f32x4 q4 = *(const f32x4*)(bcs + (16 * tq + tt) * 128 + d4 * 4); acc[tt] += (q4.x * sv[0] + q4.y * sv[1]) + (q4.z * sv[2] + q4.w * sv[3]); } } }
    for (int s4 = 0; s4 < 16; ++s4) { float iv4[4];
#pragma unroll
        for (int i = 0; i < 4; ++i) iv4[i] = kks[(s4 * 4 + i) * 128 + e];
#pragma unroll
        for (int tt = 0; tt < 16; ++tt) { const f32x4 a4 = *(const f32x4*)(att + (16 * tq + tt) * 64 + s4 * 4); acc[tt] += (a4.x * iv4[0] + a4.y * iv4[1]) + (a4.z * iv4[2] + a4.w * iv4[3]); } }
    __syncthreads();
#pragma unroll
    for (int tt = 0; tt < 16; ++tt) H[(16 * tq + tt) * 128 + e] = acc[tt];
    __syncthreads();
    for (int t = wave; t < 64; t += NWAVES) { const int p = 64 * c + t - 48; if (p < 0 || (c == 0 && b != 0)) continue;
        const f32x2 hv = *(const f32x2*)(H + t * 128 + lane * 2); const float ssq = wave_sum(hv.x * hv.x + hv.y * hv.y);
        const float rstd = 1.0f / sqrtf(ssq * (1.0f / 128.0f) + EPS); const int row = seq_row(b, p);
        const f32x2 g = *(const f32x2*)(hg_norm + h * 128 + lane * 2); const unsigned o = *(const unsigned*)(PROJ + (size_t)row * NPROJ + PC_HGG + h * 128 + lane * 2);
        *(unsigned*)(BR + (size_t)row * D + 2048 + h * 128 + lane * 2) = pk2(hv.x * rstd * g.x * sigmoidf_(bflo(o)), hv.y * rstd * g.y * sigmoidf_(bfhi(o))); }
    __syncthreads();
}

__device__ __forceinline__ float rg_x(const bf16* PROJ, int b, int p, int ch) { return p >= 0 ? bf1(PROJ[(size_t)seq_row(b, p) * NPROJ + PC_RGX + ch]) : 0.f; }
__device__ __forceinline__ void rg_A(const bf16* PROJ, const float* conv_w, const float* conv_b, const float* wa, const float* ba, const float* wx, const float* bx, const float* lam, float* RGH, float* RGP, float* RGT, int u, unsigned char* lds, int tid) {
    const int half = u & 1, bc = u >> 1, c = bc % NCH, b = bc / NCH, ch = half * 512 + tid, p0 = 64 * c - 48;
    float* xcs = (float*)lds;
    { const float w0 = conv_w[ch], w1 = conv_w[1024 + ch], w2 = conv_w[2048 + ch], w3 = conv_w[3072 + ch], cb = conv_b[ch];
      float xm3 = rg_x(PROJ, b, p0 - 3, ch), xm2 = rg_x(PROJ, b, p0 - 2, ch), xm1 = rg_x(PROJ, b, p0 - 1, ch);
#pragma unroll 4
      for (int t = 0; t < 64; ++t) { const float x0 = rg_x(PROJ, b, p0 + t, ch); xcs[t * 512 + tid] = cb + (w0 * xm3 + w1 * xm2) + (w2 * xm1 + w3 * x0); xm3 = xm2; xm2 = xm1; xm1 = x0; } }
    __syncthreads();
    const int n = ch >> 6, jj = ch & 63, xb = (n - half * 8) * 64;
    float war[64], wxr[64];
#pragma unroll
    for (int i = 0; i < 64; ++i) { war[i] = wa[(n * 64 + i) * 64 + jj]; wxr[i] = wx[(n * 64 + i) * 64 + jj]; }
    const float bav = ba[ch], bxv = bx[ch], sp = softplusf_(-lam[ch]);
    float hh = 0.f, P = 1.f;
    for (int t = (c == 0 ? 48 : 0); t < 64; ++t) { float ra = bav, ri = bxv;
#pragma unroll
        for (int i4 = 0; i4 < 16; ++i4) { const f32x4 x4 = *(const f32x4*)(xcs + t * 512 + xb + i4 * 4);
            ra += (x4.x * war[i4 * 4] + x4.y * war[i4 * 4 + 1]) + (x4.z * war[i4 * 4 + 2] + x4.w * war[i4 * 4 + 3]);
            ri += (x4.x * wxr[i4 * 4] + x4.y * wxr[i4 * 4 + 1]) + (x4.z * wxr[i4 * 4 + 2] + x4.w * wxr[i4 * 4 + 3]); }
        const float r = sigmoidf_(ra), ig = sigmoidf_(ri), la = -8.0f * r * sp, a = expf(la), uu = sqrtf(-expm1f(2.0f * la)) * ig * xcs[t * 512 + tid];
        hh = a * hh + uu; P *= a;
        if (c > 0 || b == 0) { const size_t ro = (size_t)seq_row(b, p0 + t) * 1024 + ch; RGH[ro] = hh; RGP[ro] = P; } }
    RGT[(size_t)(0 * 2 + b) * NCH * 1024 + c * 1024 + ch] = P; RGT[(size_t)(1 * 2 + b) * NCH * 1024 + c * 1024 + ch] = hh;
    __syncthreads();
}
__device__ __forceinline__ void rg_B(float* RGT, int gtid) {
    const int b = gtid >> 10, ch = gtid & 1023; float carry = 0.f;
    const float* A = RGT + (size_t)(0 * 2 + b) * NCH * 1024 + ch; const float* Hh = RGT + (size_t)(1 * 2 + b) * NCH * 1024 + ch; float* Cc = RGT + (size_t)(2 * 2 + b) * NCH * 1024 + ch;
#pragma unroll 5
    for (int c = 0; c < NCH; ++c) { const float a = A[c * 1024], hv = Hh[c * 1024]; Cc[c * 1024] = carry; carry = a * carry + hv; }
}
__device__ __forceinline__ float gelu_tanh(float y) { return 0.5f * y * (1.0f + tanhf(0.7978845608028654f * (y + 0.044715f * y * y * y))); }
__device__ __forceinline__ void rg_C(const bf16* PROJ, const float* RGH, const float* RGP, const float* RGT, bf16* BR, int gw, int NGW, int lane) {
    for (int row = gw; row < TREAL + NMETA; row += NGW) {
        const int b = row < TREAL ? (row >> 12) : 0, p = row < TREAL ? (row & 4095) + NMETA : row - TREAL, c = (p + 48) >> 6;
        const float* Cc = RGT + (size_t)(2 * 2 + b) * NCH * 1024 + c * 1024;
#pragma unroll
        for (int j = 0; j < 2; ++j) { const int ch = j * 512 + lane * 8; float y[8]; unpack8(*(const v4u*)(PROJ + (size_t)row * NPROJ + PC_RGY + ch), y); float o[8];
#pragma unroll
            for (int q = 0; q < 2; ++q) { const f32x4 hl = *(const f32x4*)(RGH + (size_t)row * 1024 + ch + 4 * q), pp = *(const f32x4*)(RGP + (size_t)row * 1024 + ch + 4 * q), cc = *(const f32x4*)(Cc + ch + 4 * q);
                const f32x4 hv = hl + pp * cc; o[4 * q] = hv.x * gelu_tanh(y[4 * q]); o[4 * q + 1] = hv.y * gelu_tanh(y[4 * q + 1]); o[4 * q + 2] = hv.z * gelu_tanh(y[4 * q + 2]); o[4 * q + 3] = hv.w * gelu_tanh(y[4 * q + 3]); }
            v4u w; w.x = pk2(o[0], o[1]); w.y = pk2(o[2], o[3]); w.z = pk2(o[4], o[5]); w.w = pk2(o[6], o[7]);
            *(v4u*)(BR + (size_t)row * D + 3072 + ch) = w; }
    }
}

__device__ __forceinline__ void sb_unit(const bf16* PROJ, const float* gq, const float* gk, bf16* BR, int b, int h, int i, unsigned char* lds, int tid) {
    float* Kt = (float*)lds; float* Vt = Kt + 64 * 128;
    const int qi = tid >> 2, part = tid & 3, p = 128 * i + qi - 112; const bool valid = p >= 0;
    float q[32], o[32];
    { float ss = 0.f;
      if (valid) { const bf16* qp = PROJ + (size_t)seq_row(b, p) * NPROJ + PC_SBQ + h * 128 + part * 32;
#pragma unroll
          for (int j = 0; j < 4; ++j) { float x[8]; unpack8(*(const v4u*)(qp + 8 * j), x);
#pragma unroll
              for (int k = 0; k < 8; ++k) { q[8 * j + k] = x[k]; ss += x[k] * x[k]; } } }
      else {
#pragma unroll
          for (int j = 0; j < 32; ++j) q[j] = 0.f; }
      ss += __shfl_xor(ss, 1); ss += __shfl_xor(ss, 2);
      const float sc = 0.08838834764831845f / sqrtf(ss * (1.0f / 128.0f) + EPS);
#pragma unroll
      for (int j = 0; j < 32; ++j) { q[j] *= sc * gq[part * 32 + j]; o[j] = 0.f; } }
    float between = 0.f;
    const int kt_hi = (i == 0) ? 0 : 2 * i;
    for (int kt = kt_hi; kt >= 0; --kt) {
        { const int kr = tid >> 3, sg = tid & 7, pk = 64 * kt + kr; float ka[8], kb[8], va[8], vb[8]; float ss = 0.f;
          if (pk < 4096 + NMETA) { const bf16* rp = PROJ + (size_t)seq_row(b, pk) * NPROJ + h * 128 + sg * 16;
              unpack8(*(const v4u*)(rp + PC_SBK), ka); unpack8(*(const v4u*)(rp + PC_SBK + 8), kb);
              unpack8(*(const v4u*)(rp + PC_SBV), va); unpack8(*(const v4u*)(rp + PC_SBV + 8), vb);
#pragma unroll
              for (int k = 0; k < 8; ++k) ss += ka[k] * ka[k] + kb[k] * kb[k]; }
          else {
#pragma unroll
              for (int k = 0; k < 8; ++k) { ka[k] = 0.f; kb[k] = 0.f; va[k] = 0.f; vb[k] = 0.f; } }
          ss += __shfl_xor(ss, 1); ss += __shfl_xor(ss, 2); ss += __shfl_xor(ss, 4);
          const float rstd = 1.0f / sqrtf(ss * (1.0f / 128.0f) + EPS);
          const f32x4 g0 = *(const f32x4*)(gk + sg * 16), g1 = *(const f32x4*)(gk + sg * 16 + 4), g2 = *(const f32x4*)(gk + sg * 16 + 8), g3 = *(const f32x4*)(gk + sg * 16 + 12);
          float* kd = Kt + kr * 128 + sg * 16; float* vd = Vt + kr * 128 + sg * 16;
          *(f32x4*)(kd) = (f32x4){ka[0] * rstd * g0.x, ka[1] * rstd * g0.y, ka[2] * rstd * g0.z, ka[3] * rstd * g0.w};
          *(f32x4*)(kd + 4) = (f32x4){ka[4] * rstd * g1.x, ka[5] * rstd * g1.y, ka[6] * rstd * g1.z, ka[7] * rstd * g1.w};
          *(f32x4*)(kd + 8) = (f32x4){kb[0] * rstd * g2.x, kb[1] * rstd * g2.y, kb[2] * rstd * g2.z, kb[3] * rstd * g2.w};
          *(f32x4*)(kd + 12) = (f32x4){kb[4] * rstd * g3.x, kb[5] * rstd * g3.y, kb[6] * rstd * g3.z, kb[7] * rstd * g3.w};
          *(f32x4*)(vd) = (f32x4){va[0], va[1], va[2], va[3]}; *(f32x4*)(vd + 4) = (f32x4){va[4], va[5], va[6], va[7]};
          *(f32x4*)(vd + 8) = (f32x4){vb[0], vb[1], vb[2], vb[3]}; *(f32x4*)(vd + 12) = (f32x4){vb[4], vb[5], vb[6], vb[7]}; }
        __syncthreads();
        for (int s = 63; s >= 0; --s) { const int pk = 64 * kt + s; float z = 0.f;
#pragma unroll
            for (int j4 = 0; j4 < 8; ++j4) { const f32x4 k4 = *(const f32x4*)(Kt + s * 128 + part * 32 + j4 * 4); z += (q[4 * j4] * k4.x + q[4 * j4 + 1] * k4.y) + (q[4 * j4 + 2] * k4.z + q[4 * j4 + 3] * k4.w); }
            z += __shfl_xor(z, 1); z += __shfl_xor(z, 2);
            if (pk < p) { const float sp = softplusf_(z); const float a = expf(z - sp + between); between -= sp;
#pragma unroll
                for (int j4 = 0; j4 < 8; ++j4) { const f32x4 v4 = *(const f32x4*)(Vt + s * 128 + part * 32 + j4 * 4); o[4 * j4] += a * v4.x; o[4 * j4 + 1] += a * v4.y; o[4 * j4 + 2] += a * v4.z; o[4 * j4 + 3] += a * v4.w; } } }
        { volatile unsigned* flg = (volatile unsigned*)(lds + RING_BYTES) + (kt & 1) * 8;
          const int alldone = __all((!valid || between < -104.0f) ? 1 : 0);
          if ((tid & 63) == 0) flg[tid >> 6] = alldone ? 1u : 0u;
          __syncthreads();
          unsigned d = 1u;
#pragma unroll
          for (int w = 0; w < NWAVES; ++w) d &= flg[w];
          if (d) break; }
    }
    if (valid && (i > 0 || b == 0)) { bf16* op = BR + (size_t)seq_row(b, p) * D + 1024 + h * 128 + part * 32;
#pragma unroll
        for (int j = 0; j < 4; ++j) { v4u w; w.x = pk2(o[8 * j], o[8 * j + 1]); w.y = pk2(o[8 * j + 2], o[8 * j + 3]); w.z = pk2(o[8 * j + 4], o[8 * j + 5]); w.w = pk2(o[8 * j + 6], o[8 * j + 7]); *(v4u*)(op + 8 * j) = w; } }
    __syncthreads();
}
#ifndef REP_P0
#define REP_P0 1
#endif
#ifndef REP_A
#define REP_A 1
#endif
#ifndef REP_C
#define REP_C 1
#endif
#ifndef REP_G1
#define REP_G1 1
#endif
#ifndef REP_G8
#define REP_G8 1
#endif
#ifndef MK_N_LAUNCHES
#define MK_N_LAUNCHES 1
#endif
constexpr int N_PHASES = 1 + 10 * NLAYER;
struct Args { const float* in[23]; float* out; unsigned char* ws; int ph_lo, ph_hi; };
static_assert(sizeof(Args) == 23 * 8 + 8 + 8 + 8, "Args has no padding bytes");

template <int LO, int HI> __global__ void __launch_bounds__(NTHR, 2) fwd_kernel(Args args) {
    extern __shared__ __attribute__((aligned(16))) unsigned char lds[];
    const int tid = threadIdx.x;
    const int G = gridDim.x, bx = blockIdx.x;
    const int vcu = (G % 8 == 0) ? (bx % 8) * (G / 8) + bx / 8 : bx;
    const int NGW = G * NWAVES, NGT = G * NTHR;
    unsigned char* ws = args.ws;
    unsigned* ctl = (unsigned*)(ws + WS_CTL);
    volatile LAS unsigned* MISC = (volatile LAS unsigned*)((LAS unsigned char*)lds + MISC_OFF);
    for (int u = tid; u < (LDS_BYTES - LDSCTL_OFF) / 4; u += NTHR) ((LAS unsigned*)((LAS unsigned char*)lds + LDSCTL_OFF))[u] = 0u;
    __syncthreads();
    constexpr bool use_bar = (HI - LO) > 1;
    XcdBarrier bar; bar.bar = ctl + CW_BAR; bar.x = 0; bar.st = nullptr;
    if constexpr (use_bar) bar = xcd_barrier_post(ctl + CW_BAR, MISC + 8);
#define IN(k) (LO <= (k) && (k) < HI)
#define PHASE_VARS int tid_ = tid; asm volatile("" : "+v"(tid_)); const int lane_ = tid_ & 63, wave_ = __builtin_amdgcn_readfirstlane(tid_ >> 6), gw_ = vcu * NWAVES + wave_, gtid_ = bx * NTHR + tid_; (void)lane_; (void)wave_; (void)gw_; (void)gtid_;
#define SEAM(k) do { if constexpr (IN(k) && IN((k) + 1)) xcd_barrier(bar); } while (0)

#define PROJ ((bf16*)(ws + WS_PROJ))
#define ACT ((bf16*)(ws + WS_ACT))
#define XN ((bf16*)(ws + WS_XN))
#define BR ((bf16*)(ws + WS_BR))
#define MG ((bf16*)(ws + WS_MG))
#define HMETA ((float*)(ws + WS_HMETA))
#define GIF ((float*)(ws + WS_GIF))
#define WIF ((const float*)(ws + WS_WIF))
#define LBp ((const float*)(ws + WS_LB))
#define MLS ((float*)(ws + WS_MLS))
#define MLN ((float*)(ws + WS_MLN))
#define MLSC ((float*)(ws + WS_MLSC))
#define HGS ((float*)(ws + WS_HGS))
#define HGE ((float*)(ws + WS_HGE))
#define RGH ((float*)(ws + WS_RGH))
#define RGP ((float*)(ws + WS_RGP))
#define RGT ((float*)(ws + WS_RGT))
#define x (args.in[0])
#define out (args.out)

    if constexpr (IN(0)) for (int rep_ = 0; rep_ < REP_P0; ++rep_) { PHASE_VARS p0_prologue(args.in, ws, lds, bx, G, wave_, lane_, gtid_, NGT); }
    SEAM(0);

    {
        constexpr int l = 0;
        constexpr int pb = 1 + 10 * l;
        constexpr bool lastl = (l == NLAYER - 1);
        constexpr int Mtail = lastl ? TREAL : MROWS;
        const float* hsrc = (l == 0) ? x : out;
        if constexpr (IN(pb + 0)) { PHASE_VARS norm_rows<true>(hsrc, HMETA, args.in[2] + l * D, XN, MROWS, WIF + (size_t)l * 8 * D, args.in[5] + (size_t)l * NIN + 4096, GIF, gw_, NGW, lane_); }
        SEAM(pb + 0);
        if constexpr (IN(pb + 1)) for (int rep_ = 0; rep_ < REP_G1; ++rep_) { PHASE_VARS pg8::Gemm g{XN, (const bf16*)(ws + WS_WIN + (size_t)l * SZ_WIN), MROWS, NPROJ, D, D, D}; pg8::StaticOrder S; S.init(MROWS, NPROJ, G, bx);
            pg8::EpiProj E{PROJ, NPROJ, args.in[5] + (size_t)l * NIN, 4096, 8};
            pg8::gemm_phase<pg8::EpiProj, pg8::StaticOrder, true, true>((PG8_LAS unsigned char*)lds, g, S, E, tid_); }
        SEAM(pb + 1);
        if constexpr (IN(pb + 2)) { PHASE_VARS
          for (int rep_ = 0; rep_ < REP_A; ++rep_) {
            for (int u = bx; u < 520; u += G) mlstm_A(PROJ, GIF, MLS, MLN, MLSC, u, lds, tid_);
            for (int u = bx; u < 1040; u += G) hg_A(PROJ, LBp + l * 1024, HGS, HGE, u, lds, tid_);
            for (int u = bx; u < 260; u += G) rg_A(PROJ, args.in[11] + l * 4096, args.in[12] + l * 1024, args.in[13] + l * 65536, args.in[14] + l * 1024, args.in[15] + l * 65536, args.in[16] + l * 1024, args.in[17] + l * 1024, RGH, RGP, RGT, u, lds, tid_);
            for (int r = 0;; ++r) { const int idx = r * G + ((r & 1) ? (G - 1 - bx) : bx); if (r * G >= 520) break; if (idx >= 520) continue;
                int b, h, i; if (idx < 512) { i = 32 - (idx >> 4); b = (idx >> 3) & 1; h = idx & 7; } else { i = 0; b = 0; h = idx - 512; }
                sb_unit(PROJ, args.in[7] + l * 128, args.in[8] + l * 128, BR, b, h, i, lds, tid_); }
          }
        }
        SEAM(pb + 2);
        if constexpr (IN(pb + 3)) { PHASE_VARS
            for (int u = bx; u < 256; u += G) mlstm_B(MLS, MLN, MLSC, u, lds, tid_);
            for (int u = bx; u < 256; u += G) hg_B(HGS, HGE, u, tid_);
            if (gtid_ < 2048) rg_B(RGT, gtid_);
        }
        SEAM(pb + 3);
        if constexpr (IN(pb + 4)) { PHASE_VARS
          for (int rep_ = 0; rep_ < REP_C; ++rep_) {
            for (int u = bx; u < 520; u += G) mlstm_C(PROJ, GIF, MLS, MLN, MLSC, args.in[6] + l * 1024, BR, u, lds, tid_);
            for (int u = bx; u < 1040; u += G) hg_C(PROJ, LBp + l * 1024, HGS, args.in[10] + l * 1024, BR, u, lds, tid_);
            rg_C(PROJ, RGH, RGP, RGT, BR, gw_, NGW, lane_);
          }
        }
        SEAM(pb + 4);
        if constexpr (IN(pb + 5)) { PHASE_VARS pg8::Gemm g{BR, (const bf16*)(ws + WS_WUP + (size_t)l * SZ_WSQ), Mtail, D, D, D, D}; pg8::StaticOrder S; S.init(Mtail, D, G, bx);
            pg8::EpiUpGate E{MG, D, PROJ + PC_GATE, NPROJ};
            pg8::gemm_phase<pg8::EpiUpGate, pg8::StaticOrder, true, true>((PG8_LAS unsigned char*)lds, g, S, E, tid_); }
        SEAM(pb + 5);
        if constexpr (IN(pb + 6)) { PHASE_VARS pg8::Gemm g{MG, (const bf16*)(ws + WS_WOUT + (size_t)l * SZ_WSQ), Mtail, D, D, D, D}; pg8::StaticOrder S; S.init(Mtail, D, G, bx);
            pg8::EpiResid E{hsrc, out, HMETA};
            pg8::gemm_phase<pg8::EpiResid, pg8::StaticOrder, true, true>((PG8_LAS unsigned char*)lds, g, S, E, tid_); }
        SEAM(pb + 6);
        if constexpr (IN(pb + 7)) { PHASE_VARS norm_rows<false>(out, HMETA, args.in[3] + l * D, XN, Mtail, nullptr, nullptr, nullptr, gw_, NGW, lane_); }
        SEAM(pb + 7);
        if constexpr (IN(pb + 8)) for (int rep_ = 0; rep_ < REP_G8; ++rep_) { PHASE_VARS pg8::Gemm g{XN, (const bf16*)(ws + WS_WGU + (size_t)l * SZ_WGU), Mtail, NGU, D, D, D}; pg8::StaticOrder S; S.init(Mtail, NGU, G, bx);
            pg8::EpiSwiGLU E{ACT, DFF};
            pg8::gemm_phase<pg8::EpiSwiGLU, pg8::StaticOrder, true, true>((PG8_LAS unsigned char*)lds, g, S, E, tid_); }
        SEAM(pb + 8);
        if constexpr (IN(pb + 9)) { PHASE_VARS pg8::Gemm g{ACT, (const bf16*)(ws + WS_WD + (size_t)l * SZ_WD), Mtail, D, DFF, DFF, DFF}; pg8::StaticOrder S; S.init(Mtail, D, G, bx);
            pg8::EpiResid E{out, out, HMETA};
            pg8::gemm_phase<pg8::EpiResid, pg8::StaticOrder, true, true>((PG8_LAS unsigned char*)lds, g, S, E, tid_); }
        SEAM(pb + 9);
    }
    {
        constexpr int l = 1;
        constexpr int pb = 1 + 10 * l;
        constexpr bool lastl = (l == NLAYER - 1);
        constexpr int Mtail = lastl ? TREAL : MROWS;
        const float* hsrc = (l == 0) ? x : out;
        if constexpr (IN(pb + 0)) { PHASE_VARS norm_rows<true>(hsrc, HMETA, args.in[2] + l * D, XN, MROWS, WIF + (size_t)l * 8 * D, args.in[5] + (size_t)l * NIN + 4096, GIF, gw_, NGW, lane_); }
        SEAM(pb + 0);
        if constexpr (IN(pb + 1)) for (int rep_ = 0; rep_ < REP_G1; ++rep_) { PHASE_VARS pg8::Gemm g{XN, (const bf16*)(ws + WS_WIN + (size_t)l * SZ_WIN), MROWS, NPROJ, D, D, D}; pg8::StaticOrder S; S.init(MROWS, NPROJ, G, bx);
            pg8::EpiProj E{PROJ, NPROJ, args.in[5] + (size_t)l * NIN, 4096, 8};
            pg8::gemm_phase<pg8::EpiProj, pg8::StaticOrder, true, true>((PG8_LAS unsigned char*)lds, g, S, E, tid_); }
        SEAM(pb + 1);
        if constexpr (IN(pb + 2)) { PHASE_VARS
          for (int rep_ = 0; rep_ < REP_A; ++rep_) {
            for (int u = bx; u < 520; u += G) mlstm_A(PROJ, GIF, MLS, MLN, MLSC, u, lds, tid_);
            for (int u = bx; u < 1040; u += G) hg_A(PROJ, LBp + l * 1024, HGS, HGE, u, lds, tid_);
            for (int u = bx; u < 260; u += G) rg_A(PROJ, args.in[11] + l * 4096, args.in[12] + l * 1024, args.in[13] + l * 65536, args.in[14] + l * 1024, args.in[15] + l * 65536, args.in[16] + l * 1024, args.in[17] + l * 1024, RGH, RGP, RGT, u, lds, tid_);
            for (int r = 0;; ++r) { const int idx = r * G + ((r & 1) ? (G - 1 - bx) : bx); if (r * G >= 520) break; if (idx >= 520) continue;
                int b, h, i; if (idx < 512) { i = 32 - (idx >> 4); b = (idx >> 3) & 1; h = idx & 7; } else { i = 0; b = 0; h = idx - 512; }
                sb_unit(PROJ, args.in[7] + l * 128, args.in[8] + l * 128, BR, b, h, i, lds, tid_); }
          }
        }
        SEAM(pb + 2);
        if constexpr (IN(pb + 3)) { PHASE_VARS
            for (int u = bx; u < 256; u += G) mlstm_B(MLS, MLN, MLSC, u, lds, tid_);
            for (int u = bx; u < 256; u += G) hg_B(HGS, HGE, u, tid_);
            if (gtid_ < 2048) rg_B(RGT, gtid_);
        }
        SEAM(pb + 3);
        if constexpr (IN(pb + 4)) { PHASE_VARS
          for (int rep_ = 0; rep_ < REP_C; ++rep_) {
            for (int u = bx; u < 520; u += G) mlstm_C(PROJ, GIF, MLS, MLN, MLSC, args.in[6] + l * 1024, BR, u, lds, tid_);
            for (int u = bx; u < 1040; u += G) hg_C(PROJ, LBp + l * 1024, HGS, args.in[10] + l * 1024, BR, u, lds, tid_);
            rg_C(PROJ, RGH, RGP, RGT, BR, gw_, NGW, lane_);
          }
        }
        SEAM(pb + 4);
        if constexpr (IN(pb + 5)) { PHASE_VARS pg8::Gemm g{BR, (const bf16*)(ws + WS_WUP + (size_t)l * SZ_WSQ), Mtail, D, D, D, D}; pg8::StaticOrder S; S.init(Mtail, D, G, bx);
            pg8::EpiUpGate E{MG, D, PROJ + PC_GATE, NPROJ};
            pg8::gemm_phase<pg8::EpiUpGate, pg8::StaticOrder, true, true>((PG8_LAS unsigned char*)lds, g, S, E, tid_); }
        SEAM(pb + 5);
        if constexpr (IN(pb + 6)) { PHASE_VARS pg8::Gemm g{MG, (const bf16*)(ws + WS_WOUT + (size_t)l * SZ_WSQ), Mtail, D, D, D, D}; pg8::StaticOrder S; S.init(Mtail, D, G, bx);
            pg8::EpiResid E{hsrc, out, HMETA};
            pg8::gemm_phase<pg8::EpiResid, pg8::StaticOrder, true, true>((PG8_LAS unsigned char*)lds, g, S, E, tid_); }
        SEAM(pb + 6);
        if constexpr (IN(pb + 7)) { PHASE_VARS norm_rows<false>(out, HMETA, args.in[3] + l * D, XN, Mtail, nullptr, nullptr, nullptr, gw_, NGW, lane_); }
        SEAM(pb + 7);
        if constexpr (IN(pb + 8)) for (int rep_ = 0; rep_ < REP_G8; ++rep_) { PHASE_VARS pg8::Gemm g{XN, (const bf16*)(ws + WS_WGU + (size_t)l * SZ_WGU), Mtail, NGU, D, D, D}; pg8::StaticOrder S; S.init(Mtail, NGU, G, bx);
            pg8::EpiSwiGLU E{ACT, DFF};
            pg8::gemm_phase<pg8::EpiSwiGLU, pg8::StaticOrder, true, true>((PG8_LAS unsigned char*)lds, g, S, E, tid_); }
        SEAM(pb + 8);
        if constexpr (IN(pb + 9)) { PHASE_VARS pg8::Gemm g{ACT, (const bf16*)(ws + WS_WD + (size_t)l * SZ_WD), Mtail, D, DFF, DFF, DFF}; pg8::StaticOrder S; S.init(Mtail, D, G, bx);
            pg8::EpiResid E{out, out, HMETA};
            pg8::gemm_phase<pg8::EpiResid, pg8::StaticOrder, true, true>((PG8_LAS unsigned char*)lds, g, S, E, tid_); }
        SEAM(pb + 9);
    }

#undef IN
#undef SEAM
#undef PHASE_VARS
#undef PROJ
#undef ACT
#undef XN
#undef BR
#undef MG
#undef HMETA
#undef GIF
#undef WIF
#undef LBp
#undef MLS
#undef MLN
#undef MLSC
#undef HGS
#undef HGE
#undef RGH
#undef RGP
#undef RGT
#undef x
#undef out
}


#if MK_N_LAUNCHES == 1
template <class F> static void for_each_kernel(F&& f) { f((const void*)fwd_kernel<0, N_PHASES>); }
static void launch_all(const Args& a, int grid, hipStream_t stream) { hipLaunchKernelGGL((fwd_kernel<0, N_PHASES>), dim3(grid), dim3(NTHR), LDS_BYTES, stream, a); }
#else
template <int K> struct PhaseLaunch {
    template <class F> static void each(F&& f) { f((const void*)fwd_kernel<K, K + 1>); PhaseLaunch<K + 1>::each(f); }
    static void go(const Args& a, int grid, hipStream_t stream) { hipLaunchKernelGGL((fwd_kernel<K, K + 1>), dim3(grid), dim3(NTHR), LDS_BYTES, stream, a); PhaseLaunch<K + 1>::go(a, grid, stream); }
};
template <> struct PhaseLaunch<N_PHASES> { template <class F> static void each(F&&) {} static void go(const Args&, int, hipStream_t) {} };
template <class F> static void for_each_kernel(F&& f) { PhaseLaunch<0>::each(f); }
static void launch_all(const Args& a, int grid, hipStream_t stream) { PhaseLaunch<0>::go(a, grid, stream); }
#endif
extern "C" void kernel_launch(void* const* d_in, const int* in_sizes, int n_in, void* d_out, int out_size, void* d_ws, size_t ws_size, hipStream_t stream) {
    static int grid = 0;
    if (grid == 0) {
        if (n_in != 23 || out_size != TREAL * D || ws_size < WS_END) { fprintf(stderr, "kernel_launch: unexpected shapes (n_in %d, out %d, ws %zu < %zu); nothing launched\n", n_in, out_size, ws_size, (size_t)WS_END); grid = -1; return; }
        int dev = 0, cus = 0, per_cu = 0;
        if (hipGetDevice(&dev) != hipSuccess || hipDeviceGetAttribute(&cus, hipDeviceAttributeMultiprocessorCount, dev) != hipSuccess) { grid = -1; return; }
        bool ok = true;
        for_each_kernel([&](const void* f) { if (hipFuncSetAttribute(f, hipFuncAttributeMaxDynamicSharedMemorySize, LDS_BYTES) != hipSuccess) ok = false; });
        if (!ok) { fprintf(stderr, "kernel_launch: hipFuncSetAttribute failed\n"); grid = -1; return; }
        (void)per_cu; (void)hipGetLastError();
        grid = cus;
    }
    if (grid < 0) return;
    (void)in_sizes;
    if (hipMemsetAsync((char*)d_ws + WS_CTL, 0, CTL_ZERO_BYTES, stream) != hipSuccess) return;
    Args a{};
    for (int i = 0; i < 23; ++i) a.in[i] = (const float*)d_in[i];
    a.out = (float*)d_out; a.ws = (unsigned char*)d_ws; a.ph_lo = 0; a.ph_hi = N_PHASES;
    launch_all(a, grid, stream);
}
```

```cpp
#include <hip/hip_runtime.h>
#include <cstdio>
#include <cstdint>
#define MK_N_LAUNCHES 1
namespace pg8 {
#define PG8_LAS __attribute__((address_space(3)))
typedef unsigned short bf16_t;
typedef short bf16x8 __attribute__((ext_vector_type(8)));
typedef float f32x4 __attribute__((ext_vector_type(4)));
typedef unsigned u32x4 __attribute__((ext_vector_type(4)));
constexpr int BM = 256, BK = 64, HALF = 128, HTB = HALF * BK * 2  , STAGE_BYTES = 8 * HTB, NXCD = 8, WGM = 8;

__host__ __device__ __forceinline__ int lds_byte(int r, int c) { const int st = (r >> 4) * 2 + (c >> 5), rr = r & 15, cc = c & 31, ob = rr * 64 + cc * 2; return st * 1024 + (ob ^ (((ob >> 9) & 1) << 5)); }
__host__ __device__ __forceinline__ void stage_rc(int b, int& R, int& C) { const int st = b / 1024, sb = b % 1024, swz = sb ^ (((sb >> 9) & 1) << 5); R = (st >> 1) * 16 + swz / 64; C = (st & 1) * 32 + (swz % 64) / 2; }
__host__ __device__ __forceinline__ int perm32(int rho) { const int n = rho >> 4, i = rho & 15; return 8 * (i >> 2) + 4 * n + (i & 3); }

struct Unit { int pm, pn; };
struct Gemm { const bf16_t* A; const bf16_t* Bt; int M, N, K, lda, ldb; };

struct StaticOrder {
    int nM, nN, nwg, G, c;
    __host__ __device__ void init(int M, int N, int G_, int c_) { nM = M / BM; nN = N / BM; nwg = nM * nN; G = G_; c = c_; }
    __host__ __device__ bool next(int i, Unit& u) const {
        const long L = (long)i * G + c; if (L >= nwg) return false;
        int wgid = (int)L; { const int q = nwg / NXCD, r = nwg % NXCD, xcd = wgid % NXCD, off = wgid / NXCD; wgid = (xcd < r ? xcd * (q + 1) : r * (q + 1) + (xcd - r) * q) + off; }
        const int nig = WGM * nN, gid = wgid / nig, fm = gid * WGM, gsz = (nM - fm) < WGM ? (nM - fm) : WGM;
        u.pm = fm + ((wgid % nig) % gsz); u.pn = (wgid % nig) / gsz; return true;
    }
    __device__ __forceinline__ void a_ready(const Unit&) const {}
    __device__ __forceinline__ void done(const Unit&) const {}
};

__device__ __forceinline__ unsigned cvt_pk_bf16(float lo, float hi) { unsigned r; asm volatile("v_cvt_pk_bf16_f32 %0, %1, %2" : "=v"(r) : "v"(lo), "v"(hi)); return r; }
typedef float f32x2 __attribute__((ext_vector_type(2)));
typedef float f32x2 __attribute__((ext_vector_type(2)));
__device__ __forceinline__ float bf_lo(unsigned w) { return __uint_as_float(w << 16); }
__device__ __forceinline__ float bf_hi(unsigned w) { return __uint_as_float(w & 0xffff0000u); }
__device__ __forceinline__ float fast_sigmoid(float x) { return __builtin_amdgcn_rcpf(1.0f + __expf(-x)); }

struct EpiProj {
    static constexpr bool PERM = true, AFTER_DRAIN = false, MID = false; static constexpr int SEG = 16;
    bf16_t* O; int ldc; const float* bias; int shift_from, bias_shift;
    __device__ __forceinline__ void operator()(const f32x4 (&acc)[2][2][4][2], const Unit& u, int wr, int wc, int fr, int fq) const {
        const int row0 = u.pm * BM + wr * 64 + fr; const int colt = u.pn * BM;
        const int col0 = colt + wc * 32 + 8 * fq; const float* bp = bias + col0 + (colt >= shift_from ? bias_shift : 0);
        f32x4 bv[2][2];
#pragma unroll
        for (int bj = 0; bj < 2; ++bj)
#pragma unroll
            for (int n = 0; n < 2; ++n) bv[bj][n] = *(const f32x4*)(bp + bj * HALF + 4 * n);
#pragma unroll
        for (int ai = 0; ai < 2; ++ai)
#pragma unroll
            for (int m = 0; m < 4; ++m) { bf16_t* rowp = O + (size_t)(row0 + ai * HALF + m * 16) * ldc + col0;
#pragma unroll
                for (int bj = 0; bj < 2; ++bj) { const f32x4 v0 = acc[ai][bj][m][0] + bv[bj][0], v1 = acc[ai][bj][m][1] + bv[bj][1];
                    u32x4 w; w.x = cvt_pk_bf16(v0[0], v0[1]); w.y = cvt_pk_bf16(v0[2], v0[3]); w.z = cvt_pk_bf16(v1[0], v1[1]); w.w = cvt_pk_bf16(v1[2], v1[3]);
                    *(u32x4*)(rowp + bj * HALF) = w; } }
    }
};

struct EpiUpGate {
    static constexpr bool PERM = true, AFTER_DRAIN = false, MID = true; static constexpr int SEG = 16;
    bf16_t* O; int ldc; const bf16_t* G; int ldg;
    __device__ __forceinline__ void mid(f32x4 (&acc)[2][2][4][2], const Unit& u, int seg, int wr, int wc, int fr, int fq) const {
        const int row0 = u.pm * BM + wr * 64 + fr; const int col0 = u.pn * BM + wc * 32 + 8 * fq;
#pragma unroll
        for (int ai = 0; ai < 2; ++ai)
#pragma unroll
            for (int m = 0; m < 4; ++m) { const bf16_t* gp = G + (size_t)(row0 + ai * HALF + m * 16) * ldg + seg * 4096 + col0;
#pragma unroll
                for (int bj = 0; bj < 2; ++bj) { const u32x4 a = *(const u32x4*)(gp + bj * HALF), b = *(const u32x4*)(gp + 4096 + bj * HALF);
                    const unsigned aw[4] = {a.x, a.y, a.z, a.w}, bw[4] = {b.x, b.y, b.z, b.w};
#pragma unroll
                    for (int j = 0; j < 4; ++j) {
                        const float x0l = fmaxf(bf_lo(aw[j]), -60.f), x0h = fmaxf(bf_hi(aw[j]), -60.f), x1l = fmaxf(bf_lo(bw[j]), -60.f), x1h = fmaxf(bf_hi(bw[j]), -60.f);
                        const float rl = (1.0f + __expf(-x1l)) * __builtin_amdgcn_rcpf(1.0f + __expf(-x0l)), rh = (1.0f + __expf(-x1h)) * __builtin_amdgcn_rcpf(1.0f + __expf(-x0h));
                        acc[ai][bj][m][j >> 1][(j & 1) * 2] *= rl; acc[ai][bj][m][j >> 1][(j & 1) * 2 + 1] *= rh; } }
                asm volatile("" ::: "memory"); }
    }
    __device__ __forceinline__ void operator()(const f32x4 (&acc)[2][2][4][2], const Unit& u, int wr, int wc, int fr, int fq) const {
        const int row0 = u.pm * BM + wr * 64 + fr; const int col0 = u.pn * BM + wc * 32 + 8 * fq;
#pragma unroll
        for (int ai = 0; ai < 2; ++ai)
#pragma unroll
            for (int m = 0; m < 4; ++m) { const int row = row0 + ai * HALF + m * 16; const bf16_t* gp = G + (size_t)row * ldg + 3 * 4096 + col0; bf16_t* rowp = O + (size_t)row * ldc + col0;
#pragma unroll
                for (int bj = 0; bj < 2; ++bj) { const u32x4 a = *(const u32x4*)(gp + bj * HALF); const unsigned aw[4] = {a.x, a.y, a.z, a.w}; float o[8];
#pragma unroll
                    for (int j = 0; j < 4; ++j) { const float gl = fast_sigmoid(fmaxf(bf_lo(aw[j]), -60.f)), gh = fast_sigmoid(fmaxf(bf_hi(aw[j]), -60.f));
                        o[2 * j] = acc[ai][bj][m][j >> 1][(j & 1) * 2] * gl; o[2 * j + 1] = acc[ai][bj][m][j >> 1][(j & 1) * 2 + 1] * gh; }
                    u32x4 w; w.x = cvt_pk_bf16(o[0], o[1]); w.y = cvt_pk_bf16(o[2], o[3]); w.z = cvt_pk_bf16(o[4], o[5]); w.w = cvt_pk_bf16(o[6], o[7]);
                    *(u32x4*)(rowp + bj * HALF) = w; }
                asm volatile("" ::: "memory"); }
    }
};

struct EpiResid {
    static constexpr bool PERM = false, AFTER_DRAIN = false, MID = false; static constexpr int SEG = 16;
    const float* src_real; float* dst_real; float* meta;
    __device__ __forceinline__ void operator()(const f32x4 (&acc)[2][2][4][2], const Unit& u, int wr, int wc, int fr, int fq) const {
        const int rl = wr * 64 + fr, col0 = u.pn * BM + wc * 32 + 4 * fq;
        const float* s; float* d;
        if (u.pm < 32) { s = src_real + (size_t)u.pm * BM * 4096; d = dst_real + (size_t)u.pm * BM * 4096; } else { s = meta; d = meta; }
#pragma unroll
        for (int ai = 0; ai < 2; ++ai)
#pragma unroll
            for (int m = 0; m < 4; ++m) { const size_t off = (size_t)(rl + ai * HALF + m * 16) * 4096 + col0;
#pragma unroll
                for (int bj = 0; bj < 2; ++bj)
#pragma unroll
                    for (int n = 0; n < 2; ++n) { const f32x4 r = *(const f32x4*)(s + off + bj * HALF + n * 16); *(f32x4*)(d + off + bj * HALF + n * 16) = r + acc[ai][bj][m][n]; }
                asm volatile("" ::: "memory"); }
    }
};

struct EpiSwiGLU {
    static constexpr bool PERM = true, AFTER_DRAIN = false, MID = false; static constexpr int SEG = 16;
    bf16_t* O; int ldc;
    __device__ __forceinline__ void operator()(const f32x4 (&acc)[2][2][4][2], const Unit& u, int wr, int wc, int fr, int fq) const {
        const int row0 = u.pm * BM + wr * 64 + fr; const int col0 = u.pn * HALF + wc * 32 + 8 * fq;
#pragma unroll
        for (int ai = 0; ai < 2; ++ai)
#pragma unroll
            for (int m = 0; m < 4; ++m) { float o[8];
#pragma unroll
                for (int n = 0; n < 2; ++n)
#pragma unroll
                    for (int j = 0; j < 4; ++j) { const float gv = acc[ai][0][m][n][j], uv = acc[ai][1][m][n][j]; o[4 * n + j] = gv * fast_sigmoid(gv) * uv; }
                u32x4 w; w.x = cvt_pk_bf16(o[0], o[1]); w.y = cvt_pk_bf16(o[2], o[3]); w.z = cvt_pk_bf16(o[4], o[5]); w.w = cvt_pk_bf16(o[6], o[7]);
                *(u32x4*)(O + (size_t)(row0 + ai * HALF + m * 16) * ldc + col0) = w; }
    }
};
template <class Epi, class Sched, bool ALIGN_EPI = false, bool SP2 = false>
__device__ __forceinline__ void gemm_phase(PG8_LAS unsigned char* lds, const Gemm g, const Sched& S, const Epi& E, const int tid) {
    const int wid = __builtin_amdgcn_readfirstlane(tid >> 6), lane = tid & 63, wr = wid >> 2, wc = wid & 3, fr = lane & 15, fq = lane >> 4;
    const int K = g.K, nt = K / BK;
    unsigned voffA[2], voffB[2];
#pragma unroll
    for (int i = 0; i < 2; ++i) { int R, C; stage_rc(tid * 16 + i * 8192, R, C); const int Rb = Epi::PERM ? ((R & ~31) + perm32(R & 31)) : R;
        voffA[i] = (unsigned)(R * g.lda + C) * 2u; voffB[i] = (unsigned)(Rb * g.ldb + C) * 2u; }
    const size_t kstep = (size_t)(BK * 2);
    const size_t hstepA = (size_t)HALF * g.lda * 2, hstepB = (size_t)HALF * g.ldb * 2;
    const size_t tstepA = 2 * hstepA, tstepB = 2 * hstepB;
    const unsigned ldsw = (unsigned)wid * 1024u;
    const int aoff = lds_byte(wr * 64 + fr, fq * 8), boff = lds_byte(wc * 32 + fr, fq * 8);
#define PG8_SA(b, h) (((b) * 2 + (h)) * HTB)
#define PG8_SB(b, h) ((4 + (b) * 2 + (h)) * HTB)
#define PG8_STAGE(bufoff, gbase, voff) do { _Pragma("unroll") for (int _i = 0; _i < 2; ++_i) \
        __builtin_amdgcn_global_load_lds((const unsigned*)((const char*)(gbase) + (voff)[_i]), (PG8_LAS unsigned*)(lds + (bufoff) + ldsw + _i * 8192), 16, 0, 0); } while (0)
#define PG8_LDA(dst, b, h) do { _Pragma("unroll") for (int m = 0; m < 4; ++m) _Pragma("unroll") for (int k = 0; k < 2; ++k) dst[m][k] = *(const PG8_LAS bf16x8*)(lds + PG8_SA(b, h) + aoff + m * 2048 + k * 1024); } while (0)
#define PG8_LDB(dst, b, h) do { _Pragma("unroll") for (int n = 0; n < 2; ++n) _Pragma("unroll") for (int k = 0; k < 2; ++k) dst[n][k] = *(const PG8_LAS bf16x8*)(lds + PG8_SB(b, h) + boff + n * 2048 + k * 1024); } while (0)
#define PG8_MMA(ai, bj, At, Bt) do { __builtin_amdgcn_s_setprio(1); _Pragma("unroll") for (int m = 0; m < 4; ++m) _Pragma("unroll") for (int n = 0; n < 2; ++n) _Pragma("unroll") for (int k = 0; k < 2; ++k) \
        acc[ai][bj][m][n] = __builtin_amdgcn_mfma_f32_16x16x32_bf16(Bt[n][k], At[m][k], acc[ai][bj][m][n], 0, 0, 0); __builtin_amdgcn_s_setprio(0); } while (0)
#define PG8_WAIT_V(n) asm volatile("s_waitcnt vmcnt(" #n ")" ::: "memory")
#define PG8_WAIT_L(n) asm volatile("s_waitcnt lgkmcnt(" #n ")" ::: "memory")
#define PG8_BAR __builtin_amdgcn_s_barrier()
#define PG8_SCHED __builtin_amdgcn_sched_barrier(0)
    Unit cur, nxt; int ui = 0;
    if (!S.next(0, cur)) return;
    f32x4 acc[2][2][4][2];
#pragma unroll
    for (int a = 0; a < 2; ++a)
#pragma unroll
        for (int b = 0; b < 2; ++b)
#pragma unroll
            for (int m = 0; m < 4; ++m)
#pragma unroll
                for (int n = 0; n < 2; ++n) acc[a][b][m][n] = (f32x4){0.f, 0.f, 0.f, 0.f};
    bf16x8 At[4][2], B0[2][2], B1[2][2];
    const char* cA = (const char*)g.A + (size_t)cur.pm * tstepA; const char* cB = (const char*)g.Bt + (size_t)cur.pn * tstepB;
    S.a_ready(cur);
    if constexpr (SP2) {
        PG8_STAGE(PG8_SB(0, 0), cB, voffB); PG8_STAGE(PG8_SB(0, 1), cB + hstepB, voffB); PG8_STAGE(PG8_SA(0, 0), cA, voffA); PG8_STAGE(PG8_SA(0, 1), cA + hstepA, voffA);
        if (wr == 1) PG8_BAR;
        PG8_WAIT_V(2); PG8_BAR;
        PG8_STAGE(PG8_SB(1, 0), cB + kstep, voffB); PG8_STAGE(PG8_SA(1, 0), cA + kstep, voffA); PG8_STAGE(PG8_SB(1, 1), cB + hstepB + kstep, voffB);
        PG8_WAIT_V(6); PG8_BAR;
    } else {
        PG8_STAGE(PG8_SB(0, 0), cB, voffB); PG8_STAGE(PG8_SA(0, 0), cA, voffA); PG8_STAGE(PG8_SB(0, 1), cB + hstepB, voffB); PG8_STAGE(PG8_SA(0, 1), cA + hstepA, voffA);
        if (wr == 1) PG8_BAR;
        PG8_WAIT_V(4); PG8_BAR;
        PG8_STAGE(PG8_SB(1, 0), cB + kstep, voffB); PG8_STAGE(PG8_SA(1, 0), cA + kstep, voffA); PG8_STAGE(PG8_SB(1, 1), cB + hstepB + kstep, voffB);
        PG8_WAIT_V(6); PG8_BAR;
    }
    for (;;) {
        const bool has_next = S.next(ui + 1, nxt);
        const char* nA = has_next ? (const char*)g.A + (size_t)nxt.pm * tstepA : cA; const char* nB = has_next ? (const char*)g.Bt + (size_t)nxt.pn * tstepB : cB;
        for (int t = 0; t < nt; t += 2) {
            const bool last = (t == nt - 2);
            const char* a1 = cA + (size_t)(t + 1) * kstep;
            const char* a2 = last ? nA : cA + (size_t)(t + 2) * kstep; const char* b2 = last ? nB : cB + (size_t)(t + 2) * kstep;
            const char* a3 = a2 + kstep; const char* b3 = b2 + kstep;
            if (last && has_next) S.a_ready(nxt);
            if constexpr (SP2) {
            PG8_LDB(B0, 0, 0); PG8_LDB(B1, 0, 1); PG8_SCHED; PG8_LDA(At, 0, 0); PG8_STAGE(PG8_SA(1, 1), a1 + hstepA, voffA);
            PG8_WAIT_V(8); PG8_WAIT_L(0); PG8_BAR; PG8_MMA(0, 0, At, B0); PG8_MMA(0, 1, At, B1); PG8_BAR; PG8_SCHED;
            PG8_LDA(At, 0, 1); PG8_STAGE(PG8_SB(0, 0), b2, voffB); PG8_STAGE(PG8_SB(0, 1), b2 + hstepB, voffB); PG8_STAGE(PG8_SA(0, 0), a2, voffA);
            PG8_WAIT_V(8); PG8_WAIT_L(0); PG8_BAR; PG8_MMA(1, 0, At, B0); PG8_MMA(1, 1, At, B1); PG8_BAR; PG8_SCHED;
            PG8_LDB(B0, 1, 0); PG8_LDB(B1, 1, 1); PG8_SCHED; PG8_LDA(At, 1, 0); PG8_STAGE(PG8_SA(0, 1), a2 + hstepA, voffA);
            PG8_WAIT_V(8); PG8_WAIT_L(0); PG8_BAR; PG8_MMA(0, 0, At, B0); PG8_MMA(0, 1, At, B1); PG8_BAR; PG8_SCHED;
            PG8_LDA(At, 1, 1); PG8_STAGE(PG8_SB(1, 0), b3, voffB); PG8_STAGE(PG8_SB(1, 1), b3 + hstepB, voffB); PG8_STAGE(PG8_SA(1, 0), a3, voffA);
            PG8_WAIT_V(8); PG8_WAIT_L(0); PG8_BAR; PG8_MMA(1, 0, At, B0); PG8_MMA(1, 1, At, B1); PG8_BAR; PG8_SCHED;
            } else {
            PG8_LDB(B0, 0, 0); PG8_SCHED; PG8_LDA(At, 0, 0); PG8_STAGE(PG8_SA(1, 1), a1 + hstepA, voffA);
            PG8_WAIT_L(8); PG8_BAR; PG8_WAIT_L(0); PG8_MMA(0, 0, At, B0); PG8_BAR; PG8_SCHED;
            PG8_LDB(B1, 0, 1); PG8_STAGE(PG8_SB(0, 0), b2, voffB);
            PG8_BAR; PG8_WAIT_L(0); PG8_MMA(0, 1, At, B1); PG8_BAR;
            PG8_LDA(At, 0, 1); PG8_STAGE(PG8_SA(0, 0), a2, voffA);
            PG8_BAR; PG8_WAIT_L(0); PG8_MMA(1, 0, At, B0); PG8_BAR; PG8_SCHED;
            PG8_STAGE(PG8_SB(0, 1), b2 + hstepB, voffB);
            PG8_WAIT_V(6); PG8_BAR; PG8_MMA(1, 1, At, B1); PG8_BAR;
            PG8_LDB(B0, 1, 0); PG8_SCHED; PG8_LDA(At, 1, 0); PG8_STAGE(PG8_SA(0, 1), a2 + hstepA, voffA);
            PG8_WAIT_L(8); PG8_BAR; PG8_WAIT_L(0); PG8_MMA(0, 0, At, B0); PG8_BAR; PG8_SCHED;
            PG8_LDB(B1, 1, 1); PG8_STAGE(PG8_SB(1, 0), b3, voffB);
            PG8_BAR; PG8_WAIT_L(0); PG8_MMA(0, 1, At, B1); PG8_BAR;
            PG8_LDA(At, 1, 1); PG8_STAGE(PG8_SA(1, 0), a3, voffA);
            PG8_BAR; PG8_WAIT_L(0); PG8_MMA(1, 0, At, B0); PG8_BAR; PG8_SCHED;
            PG8_STAGE(PG8_SB(1, 1), b3 + hstepB, voffB);
            PG8_WAIT_V(6); PG8_BAR; PG8_MMA(1, 1, At, B1); PG8_BAR;
            }
            if constexpr (Epi::MID) { if (!last && ((t + 2) % Epi::SEG) == 0) E.mid(acc, cur, (t + 2) / Epi::SEG - 1, wr, wc, fr, fq); }
        }
        if constexpr (ALIGN_EPI) { if (wr == 0) PG8_BAR; }
        if constexpr (!Epi::AFTER_DRAIN) { E(acc, cur, wr, wc, fr, fq); S.done(cur); }
        if (!has_next) break;
#pragma unroll
        for (int a = 0; a < 2; ++a)
#pragma unroll
            for (int b = 0; b < 2; ++b)
#pragma unroll
                for (int m = 0; m < 4; ++m)
#pragma unroll
                    for (int n = 0; n < 2; ++n) acc[a][b][m][n] = (f32x4){0.f, 0.f, 0.f, 0.f};
        cur = nxt; cA = nA; cB = nB; ++ui;
        if constexpr (ALIGN_EPI) { if (wr == 1) PG8_BAR; }
    }
    PG8_WAIT_V(0);
    if constexpr (!ALIGN_EPI) { if (wr == 0) PG8_BAR; }
    PG8_BAR;
    if constexpr (Epi::AFTER_DRAIN) { E.fused(acc, cur, wr, wc, fr, fq, lds, wid, lane); S.done(cur); }
#undef PG8_SA
#undef PG8_SB
#undef PG8_STAGE
#undef PG8_LDA
#undef PG8_LDB
#undef PG8_MMA
#undef PG8_WAIT_V
#undef PG8_WAIT_L
#undef PG8_BAR
#undef PG8_SCHED
}
}
constexpr int D = 4096, TREAL = 8192, NMETA = 16, MROWS = 8448, METAROW = 8192;
constexpr int MIXW = 1024, NPROJ = 29696, NIN = 29704, DFF = 11008, NGU = 22016, NLAYER = 2;
constexpr int PC_MLQ = 0, PC_MLK = 1024, PC_MLV = 2048, PC_MLO = 3072, PC_SBQ = 4096, PC_SBK = 5120, PC_SBV = 6144, PC_HGQ = 7168, PC_HGF = 8192, PC_HGI = 9216, PC_HGG = 10240, PC_RGX = 11264, PC_RGY = 12288, PC_GATE = 13312;
constexpr int NCH = 65;
constexpr float EPS = 1e-6f, NEGF = -1e30f;
constexpr int NWAVES = 8, NTHR = 512;

constexpr size_t MiB = 1u << 20;
constexpr size_t al(size_t x) { return (x + MiB - 1) / MiB * MiB; }
constexpr size_t WS_CTL = 0, CTL_ZERO_BYTES = 1 * MiB;
constexpr size_t SZ_WIN = (size_t)NPROJ * D * 2, SZ_WSQ = (size_t)D * D * 2, SZ_WGU = (size_t)NGU * D * 2, SZ_WD = (size_t)D * DFF * 2;
constexpr size_t WS_WIN = 1 * MiB;
constexpr size_t WS_WUP = WS_WIN + al(2 * SZ_WIN);
constexpr size_t WS_WOUT = WS_WUP + al(2 * SZ_WSQ);
constexpr size_t WS_WGU = WS_WOUT + al(2 * SZ_WSQ);
constexpr size_t WS_WD = WS_WGU + al(2 * SZ_WGU);
constexpr size_t WS_PROJ = WS_WD + al(2 * SZ_WD);
constexpr size_t WS_ACT = WS_PROJ;
constexpr size_t WS_XN = WS_PROJ + al((size_t)MROWS * NPROJ * 2);
constexpr size_t WS_BR = WS_XN + al((size_t)MROWS * D * 2);
constexpr size_t WS_MG = WS_BR + al((size_t)MROWS * D * 2);
constexpr size_t WS_HMETA = WS_MG + al((size_t)MROWS * D * 2);
constexpr size_t WS_GIF = WS_HMETA + al((size_t)256 * D * 4);
constexpr size_t WS_WIF = WS_GIF + al((size_t)MROWS * 8 * 4);
constexpr size_t WS_LB = WS_WIF + al((size_t)2 * 8 * D * 4);
constexpr size_t WS_MLS = WS_LB + MiB;
constexpr size_t WS_MLN = WS_MLS + al((size_t)520 * 65536 * 4);
constexpr size_t WS_MLSC = WS_MLN + al((size_t)520 * 256 * 4);
constexpr size_t WS_HGS = WS_MLSC + MiB;
constexpr size_t WS_HGE = WS_HGS + al((size_t)1040 * 16384 * 4);
constexpr size_t WS_RGH = WS_HGE + al((size_t)1040 * 128 * 4);
constexpr size_t WS_RGP = WS_RGH + al((size_t)MROWS * 1024 * 4);
constexpr size_t WS_RGT = WS_RGP + al((size_t)MROWS * 1024 * 4);
constexpr size_t WS_END = WS_RGT + al((size_t)3 * 2 * 65 * 1024 * 4);
static_assert(WS_END <= (size_t)2300 * MiB, "workspace map");
constexpr int CW_BAR = 4096;

constexpr int RING_BYTES = 131072;
constexpr int LDSCTL_OFF = RING_BYTES + 8192, MISC_OFF = LDSCTL_OFF + 320;
constexpr int LDS_BYTES = 147456;
static_assert(MISC_OFF + 128 <= LDS_BYTES, "LDS map");

#define GAS __attribute__((address_space(1)))
#define LAS __attribute__((address_space(3)))
typedef unsigned short bf16;
typedef unsigned v4u __attribute__((ext_vector_type(4)));
typedef unsigned v2u __attribute__((ext_vector_type(2)));
typedef float f32x4 __attribute__((ext_vector_type(4)));
typedef float f32x2 __attribute__((ext_vector_type(2)));
typedef GAS unsigned gu32;
#define RLX_AGENT __ATOMIC_RELAXED, __HIP_MEMORY_SCOPE_AGENT
#define LDS_WAIT() asm volatile("s_waitcnt lgkmcnt(0)" ::: "memory")
#define VM_WAIT() asm volatile("s_waitcnt vmcnt(0)" ::: "memory")
__device__ __forceinline__ unsigned f2bf(float f) { unsigned u = __builtin_bit_cast(unsigned, f); return (u + 0x7fffu + ((u >> 16) & 1u)) >> 16; }
__device__ __forceinline__ unsigned pk2(float lo, float hi) { return f2bf(lo) | (f2bf(hi) << 16); }
__device__ __forceinline__ float bflo(unsigned w) { return __uint_as_float(w << 16); }
__device__ __forceinline__ float bfhi(unsigned w) { return __uint_as_float(w & 0xffff0000u); }
__device__ __forceinline__ float bf1(bf16 b) { return __uint_as_float(((unsigned)b) << 16); }
__device__ __forceinline__ void unpack8(const v4u w, float (&o)[8]) { o[0] = bflo(w.x); o[1] = bfhi(w.x); o[2] = bflo(w.y); o[3] = bfhi(w.y); o[4] = bflo(w.z); o[5] = bfhi(w.z); o[6] = bflo(w.w); o[7] = bfhi(w.w); }
__device__ __forceinline__ float wave_sum(float v) {
#pragma unroll
    for (int o = 1; o < 64; o <<= 1) v += __shfl_xor(v, o);
    return v;
}
__device__ __forceinline__ float wave_max(float v) {
#pragma unroll
    for (int o = 1; o < 64; o <<= 1) v = fmaxf(v, __shfl_xor(v, o));
    return v;
}
__device__ __forceinline__ float wave_incl_sum(float v, int lane) {
#pragma unroll
    for (int o = 1; o < 64; o <<= 1) { const float t = __shfl_up(v, o); if (lane >= o) v += t; }
    return v;
}
__device__ __forceinline__ float wave_incl_max(float v, int lane) {
#pragma unroll
    for (int o = 1; o < 64; o <<= 1) { const float t = __shfl_up(v, o); if (lane >= o) v = fmaxf(v, t); }
    return v;
}
__device__ __forceinline__ float sigmoidf_(float x) { return 1.0f / (1.0f + expf(-x)); }
__device__ __forceinline__ float log_sigmoidf_(float x) { return fminf(x, 0.f) - log1pf(expf(-fabsf(x))); }
__device__ __forceinline__ float softplusf_(float x) { return fmaxf(x, 0.f) + log1pf(expf(-fabsf(x))); }
__device__ __forceinline__ int seq_row(int b, int p) { return p < NMETA ? METAROW + p : b * 4096 + p - NMETA; }
#define XB_TMO      128
#define XB_XCNT(j)  (256  + 64 * (j))
#define XB_XSUB(j)  (1280 + 64 * (j))
#define XB_XGEN(j)  (2304 + 64 * (j))
#define XB_TOP      3328
#define XB_TOPGEN   3392
#define XCD_BAR_WORDS 3456
#define XB_SPIN_CAP (1u << 18)

__device__ __forceinline__ unsigned xb_ld(unsigned* p)              { return __hip_atomic_load(p, __ATOMIC_RELAXED, __HIP_MEMORY_SCOPE_AGENT); }
__device__ __forceinline__ unsigned xb_add(unsigned* p, unsigned v) { return __hip_atomic_fetch_add(p, v, __ATOMIC_RELAXED, __HIP_MEMORY_SCOPE_AGENT); }
__device__ __forceinline__ unsigned xb_xcc_id() { return (unsigned)__builtin_amdgcn_s_getreg((3 << 11) | 20) & 0xFu; }
#define XB_SPIN(cond, bar) do { unsigned _sp = 0; while (cond) { __builtin_amdgcn_s_sleep(1); \
    if ((++_sp & 255u) == 0u) { if (xb_ld(&(bar)[XB_TMO])) break; if (_sp > XB_SPIN_CAP) { atomicAdd(&(bar)[XB_TMO], 1u); break; } } } } while (0)

struct XcdBarrier {
    unsigned* bar; unsigned x;
    volatile LAS unsigned* st;
};

__device__ __forceinline__ XcdBarrier xcd_barrier_post(unsigned* bar, volatile LAS unsigned* st) {
    XcdBarrier b; b.bar = bar; b.x = xb_xcc_id(); b.st = st;
    if (threadIdx.x == 0) (void)xb_add(&bar[XB_XCNT(b.x)], 1u);
    return b;
}
__device__ __forceinline__ void xcd_barrier_complete(unsigned* bar, unsigned x, unsigned& nloc, unsigned& nx) {
    const unsigned G = gridDim.x * gridDim.y * gridDim.z;
    unsigned sum, cnt, mine, sp = 0u;
    for (;;) {
        sum = 0u; cnt = 0u; mine = 0u;
#pragma unroll
        for (unsigned j = 0; j < 16; ++j) { const unsigned c = xb_ld(&bar[XB_XCNT(j)]); sum += c; cnt += (c > 0u) ? 1u : 0u; mine = (j == x) ? c : mine; }
        if (sum == G) break;
        __builtin_amdgcn_s_sleep(1);
        if ((++sp & 255u) == 0u) { if (xb_ld(&bar[XB_TMO])) break; if (sp > XB_SPIN_CAP) { atomicAdd(&bar[XB_TMO], 1u); break; } }
    }
    nloc = mine > 0u ? mine : 1u; nx = cnt > 0u ? cnt : 1u;
}

__device__ __forceinline__ void xcd_barrier(const XcdBarrier& b) {
    asm volatile("s_waitcnt vmcnt(0)" ::: "memory");
    __syncthreads();
    if (threadIdx.x == 0) {
        unsigned* bar = b.bar;
        __builtin_amdgcn_s_waitcnt(0);
        unsigned nloc = b.st[0], nx = b.st[1];
        if (nloc == 0u) { xcd_barrier_complete(bar, b.x, nloc, nx); b.st[0] = nloc; b.st[1] = nx; }
        const unsigned old = xb_add(&bar[XB_XSUB(b.x)], 1u);
        const unsigned gen = old / nloc;
        if (old + 1u == (gen + 1u) * nloc) {
            __builtin_amdgcn_fence(__ATOMIC_RELEASE, "agent");
            asm volatile("s_waitcnt vmcnt(0)" ::: "memory");
            const unsigned og = xb_add(&bar[XB_TOP], 1u);
            const unsigned tg = og / nx;
            if (og + 1u == (tg + 1u) * nx) xb_add(&bar[XB_TOPGEN], 1u);
            else XB_SPIN(xb_ld(&bar[XB_TOPGEN]) == tg, bar);
            __builtin_amdgcn_fence(__ATOMIC_ACQUIRE, "agent");
            xb_add(&bar[XB_XGEN(b.x)], 1u);
            asm volatile("s_waitcnt vmcnt(0)" ::: "memory");
        } else {
            XB_SPIN(xb_ld(&bar[XB_XGEN(b.x)]) == gen, bar);
            __builtin_amdgcn_fence(__ATOMIC_ACQUIRE, "agent");
            asm volatile("s_waitcnt vmcnt(0)" ::: "memory");
        }
    }
    __syncthreads();
}
struct P0Item { const float* src; bf16* dst; int ldw, K; };
struct P0Strip { const float* src0; bf16* dst0; int ldw, K, kb_lo, kb_n; };
constexpr int NSTRIP_DN = 2 * NLAYER * 64, NSTRIP_L = 464 + 344 + 64 + 64, NSTRIP = NSTRIP_DN + NLAYER * NSTRIP_L;
__device__ __forceinline__ P0Strip p0_strip(const float* const* in, unsigned char* ws, int s) {
    P0Strip o;
    if (s < NSTRIP_DN) { const int l = s >> 7, rem = s & 127, nb = rem >> 1, half = rem & 1;
        o.ldw = D; o.K = DFF; o.src0 = in[22] + (size_t)l * DFF * D + 64 * nb; o.dst0 = (bf16*)(ws + WS_WD + (size_t)l * SZ_WD) + (size_t)(64 * nb) * DFF; o.kb_lo = 86 * half; o.kb_n = 86; return o; }
    s -= NSTRIP_DN; const int l = s / NSTRIP_L; int r = s - l * NSTRIP_L; o.K = D; o.kb_lo = 0; o.kb_n = 64;
    if (r < 464) { o.ldw = NIN; o.src0 = in[4] + (size_t)l * D * NIN + 64 * r + (r >= 64 ? 8 : 0); o.dst0 = (bf16*)(ws + WS_WIN + (size_t)l * SZ_WIN) + (size_t)(64 * r) * D; return o; } r -= 464;
    if (r < 344) { const int which = r / 172, nb = r % 172, n0 = 64 * nb; o.ldw = DFF; o.src0 = in[20 + which] + (size_t)l * D * DFF + n0; o.dst0 = (bf16*)(ws + WS_WGU + (size_t)l * SZ_WGU) + (size_t)((n0 >> 7) * 256 + which * 128 + (n0 & 127)) * D; return o; } r -= 344;
    if (r < 64) { o.ldw = D; o.src0 = in[18] + (size_t)l * D * D + 64 * r; o.dst0 = (bf16*)(ws + WS_WUP + (size_t)l * SZ_WSQ) + (size_t)(64 * r) * D; return o; } r -= 64;
    { o.ldw = D; o.src0 = in[19] + (size_t)l * D * D + 64 * r; o.dst0 = (bf16*)(ws + WS_WOUT + (size_t)l * SZ_WSQ) + (size_t)(64 * r) * D; return o; }
}
__device__ __forceinline__ P0Item p0_item(const P0Strip& S, int kb) { P0Item o; o.src = S.src0 + (size_t)(64 * kb) * S.ldw; o.dst = S.dst0 + 64 * kb; o.ldw = S.ldw; o.K = S.K; return o; }
__device__ __forceinline__ void p0_load(const P0Item& I, f32x4 (&v)[16], int lane) {
    const float* p = I.src + (size_t)(2 * (lane >> 4)) * I.ldw + 4 * (lane & 15);
#pragma unroll
    for (int j = 0; j < 16; ++j) v[j] = *(const f32x4*)(p + (size_t)(8 * (j >> 1) + (j & 1)) * I.ldw);
}
__device__ __forceinline__ void p0_store(const P0Item& I, const f32x4 (&v)[16], unsigned* scr, int lane) {
    const int l15 = lane & 15, l4 = lane >> 4;
#pragma unroll
    for (int m = 0; m < 8; ++m)
#pragma unroll
        for (int i = 0; i < 4; ++i) scr[(4 * l15 + i) * 33 + 4 * m + l4] = pk2(v[2 * m][i], v[2 * m + 1][i]);
    LDS_WAIT(); asm volatile("" ::: "memory");
    const int c = lane & 7;
#pragma unroll
    for (int j = 0; j < 8; ++j) { const int n = (lane >> 3) + 8 * j; const unsigned* s = scr + n * 33 + 4 * c;
        v4u o; o.x = s[0]; o.y = s[1]; o.z = s[2]; o.w = s[3];
        *(v4u*)(I.dst + (size_t)n * I.K + 8 * c) = o; }
    LDS_WAIT(); asm volatile("" ::: "memory");
}
__device__ __forceinline__ void p0_prologue(const float* const* in, unsigned char* ws, unsigned char* lds, int bxp, int Gp, int wave, int lane, int gtid, int NGT) {
    unsigned* scr = (unsigned*)(lds + wave * 16384);
    const float* w_in = in[4];
#if defined(PROBE_P0_STORES)
    for (int sidx = bxp; sidx < NSTRIP; sidx += Gp) { const P0Strip S = p0_strip(in, ws, sidx); const int hi = S.kb_lo + S.kb_n;
        for (int kb = S.kb_lo + wave; kb < hi; kb += NWAVES) { const P0Item I = p0_item(S, kb); const int c = lane & 7;
#pragma unroll
            for (int j = 0; j < 8; ++j) { const int n = (lane >> 3) + 8 * j; *(v4u*)(I.dst + (size_t)n * I.K + 8 * c) = (v4u){(unsigned)kb, (unsigned)j, 0u, 0u}; } } }
    VM_WAIT(); __syncthreads();
#endif
#if defined(PROBE_P0_LOADS)
    for (int sidx = bxp; sidx < NSTRIP; sidx += Gp) { const P0Strip S = p0_strip(in, ws, sidx); const int hi = S.kb_lo + S.kb_n; f32x4 va[16];
        for (int kb = S.kb_lo + wave; kb < hi; kb += NWAVES) { p0_load(p0_item(S, kb), va, lane);
#pragma unroll
            for (int j = 0; j < 16; ++j) asm volatile("" :: "v"(va[j])); } }
    VM_WAIT(); __syncthreads();
#endif
    for (int sidx = bxp; sidx < NSTRIP; sidx += Gp) {
        const P0Strip S = p0_strip(in, ws, sidx); const int hi = S.kb_lo + S.kb_n; int kb = S.kb_lo + wave; f32x4 va[16], vb[16];
        if (kb < hi) p0_load(p0_item(S, kb), va, lane);
        while (kb < hi) {
            const int k1 = kb + NWAVES; if (k1 < hi) p0_load(p0_item(S, k1), vb, lane);
            p0_store(p0_item(S, kb), va, scr, lane);
            if (k1 >= hi) break;
            const int k2 = k1 + NWAVES; if (k2 < hi) p0_load(p0_item(S, k2), va, lane);
            p0_store(p0_item(S, k1), vb, scr, lane);
            kb = k2; }
    }
    { float* hm = (float*)(ws + WS_HMETA); const float* meta = in[1];
      for (int i = gtid; i < 256 * D; i += NGT) hm[i] = (i < NMETA * D) ? meta[i] : 0.f; }
    { unsigned* brp = (unsigned*)(ws + WS_BR + (size_t)(TREAL + NMETA) * D * 2);
      for (int i = gtid; i < (MROWS - TREAL - NMETA) * D / 2; i += NGT) brp[i] = 0u; }
    { float* wif = (float*)(ws + WS_WIF);
      for (int it = bxp * NWAVES + wave; it < NLAYER * 64; it += Gp * NWAVES) { const int l = it >> 6, k = 64 * (it & 63) + lane;
          const float* p = w_in + ((size_t)l * D + k) * NIN + 4096; const f32x4 a = *(const f32x4*)p, b = *(const f32x4*)(p + 4);
          float* wq = wif + (size_t)l * 8 * D + k;
          wq[0] = a.x; wq[D] = a.y; wq[2 * D] = a.z; wq[3 * D] = a.w; wq[4 * D] = b.x; wq[5 * D] = b.y; wq[6 * D] = b.z; wq[7 * D] = b.w; } }
    { float* lb = (float*)(ws + WS_LB); const float* hl = in[9];
      for (int i = gtid; i < 1024; i += NGT) { const float a0 = hl[i], a1 = hl[1024 + i], mx = fmaxf(a0, a1), e0 = expf(a0 - mx), e1 = expf(a1 - mx); const float p1 = e1 / (e0 + e1);
          lb[i] = 0.f; lb[1024 + i] = fminf(fmaxf(p1, 0.f), 0.999f); } }
}

template <bool GATES> __device__ __forceinline__ void norm_rows(const float* hreal, const float* hmeta, const float* gain, bf16* XN, int nrows, const float* wif, const float* bif, float* gif, int gw, int NGW, int lane) {
    for (int row = gw; row < nrows; row += NGW) {
        const float* hr = row < TREAL ? hreal + (size_t)row * D : hmeta + (size_t)(row - TREAL) * D;
        f32x4 v[16]; float ss = 0.f;
#pragma unroll
        for (int j = 0; j < 8; ++j) { const float* p = hr + 512 * j + 8 * lane; v[2 * j] = *(const f32x4*)p; v[2 * j + 1] = *(const f32x4*)(p + 4);
            ss += (v[2 * j].x * v[2 * j].x + v[2 * j].y * v[2 * j].y) + (v[2 * j].z * v[2 * j].z + v[2 * j].w * v[2 * j].w) + (v[2 * j + 1].x * v[2 * j + 1].x + v[2 * j + 1].y * v[2 * j + 1].y) + (v[2 * j + 1].z * v[2 * j + 1].z + v[2 * j + 1].w * v[2 * j + 1].w); }
        const float rstd = 1.0f / sqrtf(wave_sum(ss) * (1.0f / D) + EPS);
#pragma unroll
        for (int j = 0; j < 8; ++j) { const float* gp = gain + 512 * j + 8 * lane; const f32x4 g0 = *(const f32x4*)gp, g1 = *(const f32x4*)(gp + 4);
            v[2 * j] = v[2 * j] * rstd * g0; v[2 * j + 1] = v[2 * j + 1] * rstd * g1;
            v4u o; o.x = pk2(v[2 * j].x, v[2 * j].y); o.y = pk2(v[2 * j].z, v[2 * j].w); o.z = pk2(v[2 * j + 1].x, v[2 * j + 1].y); o.w = pk2(v[2 * j + 1].z, v[2 * j + 1].w);
            *(v4u*)(XN + (size_t)row * D + 512 * j + 8 * lane) = o; }
        if (GATES) { float mine = 0.f;
#pragma unroll
            for (int jj = 0; jj < 8; ++jj) { float dot = 0.f; const float* wp = wif + jj * D + 8 * lane;
#pragma unroll
                for (int j = 0; j < 8; ++j) { const f32x4 w0 = *(const f32x4*)(wp + 512 * j), w1 = *(const f32x4*)(wp + 512 * j + 4);
                    dot += (v[2 * j].x * w0.x + v[2 * j].y * w0.y) + (v[2 * j].z * w0.z + v[2 * j].w * w0.w) + (v[2 * j + 1].x * w1.x + v[2 * j + 1].y * w1.y) + (v[2 * j + 1].z * w1.z + v[2 * j + 1].w * w1.w); }
                dot = wave_sum(dot); if (lane == jj) mine = dot + bif[jj]; }
            if (lane < 8) gif[(size_t)row * 8 + lane] = mine; }
    }
}

__device__ __forceinline__ void mlstm_A(const bf16* PROJ, const float* GIF, float* MLS, float* MLN, float* MLSC, int u, unsigned char* lds, int tid) {
    const int c = u % NCH, bh = u / NCH, h = bh & 3, b = bh >> 2, lane = tid & 63;
    float* kw = (float*)lds; float* vs = kw + 64 * 256; float* wsc = (float*)(lds + RING_BYTES);
    if (tid < 64) {
        const int p = 64 * c + lane - 48; float lf = 0.f, li = NEGF;
        if (p >= 0) { const int row = seq_row(b, p); li = GIF[(size_t)row * 8 + h]; lf = log_sigmoidf_(GIF[(size_t)row * 8 + 4 + h]); }
        const float bc = wave_incl_sum(lf, lane); const float bend = __shfl(bc, 63);
        const float wl = bend - bc + li; const float a = wave_max(wl);
        wsc[lane] = expf(wl - a);
        if (lane == 0) { MLSC[u] = a; MLSC[520 + u] = bend; }
    }
    __syncthreads();
#pragma unroll
    for (int j = 0; j < 4; ++j) { const int id = tid + 512 * j, r = id >> 5, cp = id & 31, p = 64 * c + r - 48;
        float kv[8], vv[8];
        if (p >= 0) { const size_t ro = (size_t)seq_row(b, p) * NPROJ + h * 256 + cp * 8; const v4u kr = *(const v4u*)(PROJ + ro + PC_MLK), vr = *(const v4u*)(PROJ + ro + PC_MLV);
            unpack8(kr, kv); unpack8(vr, vv); const float w = wsc[r];
#pragma unroll
            for (int q = 0; q < 8; ++q) kv[q] *= w; }
        else {
#pragma unroll
            for (int q = 0; q < 8; ++q) { kv[q] = 0.f; vv[q] = 0.f; } }
        *(f32x4*)(kw + r * 256 + cp * 8) = (f32x4){kv[0], kv[1], kv[2], kv[3]}; *(f32x4*)(kw + r * 256 + cp * 8 + 4) = (f32x4){kv[4], kv[5], kv[6], kv[7]};
        *(f32x4*)(vs + r * 256 + cp * 8) = (f32x4){vv[0], vv[1], vv[2], vv[3]}; *(f32x4*)(vs + r * 256 + cp * 8 + 4) = (f32x4){vv[4], vv[5], vv[6], vv[7]}; }
    __syncthreads();
    const int d0 = (tid >> 4) * 8, e0 = (tid & 15) * 16;
    f32x4 acc[8][4]; float nacc[8];
#pragma unroll
    for (int i = 0; i < 8; ++i) { nacc[i] = 0.f;
#pragma unroll
        for (int q = 0; q < 4; ++q) acc[i][q] = (f32x4){0.f, 0.f, 0.f, 0.f}; }
    for (int s = 0; s < 64; ++s) {
        const f32x4 k0 = *(const f32x4*)(kw + s * 256 + d0), k1 = *(const f32x4*)(kw + s * 256 + d0 + 4);
        const float kd[8] = {k0.x, k0.y, k0.z, k0.w, k1.x, k1.y, k1.z, k1.w};
        f32x4 v4[4];
#pragma unroll
        for (int q = 0; q < 4; ++q) v4[q] = *(const f32x4*)(vs + s * 256 + e0 + 4 * q);
#pragma unroll
        for (int i = 0; i < 8; ++i) { nacc[i] += kd[i];
#pragma unroll
            for (int q = 0; q < 4; ++q) acc[i][q] += v4[q] * kd[i]; }
    }
    float* out = MLS + (size_t)u * 65536;
#pragma unroll
    for (int i = 0; i < 8; ++i)
#pragma unroll
        for (int q = 0; q < 4; ++q) *(f32x4*)(out + (d0 + i) * 256 + e0 + 4 * q) = acc[i][q];
    if ((tid & 15) == 0) {
#pragma unroll
        for (int i = 0; i < 8; ++i) MLN[(size_t)u * 256 + d0 + i] = nacc[i]; }
    __syncthreads();
}
__device__ __forceinline__ void mlstm_B(float* MLS, float* MLN, float* MLSC, int unit, unsigned char* lds, int tid) {
    const int chain = unit >> 5, slice = unit & 31;
    float* alpha = (float*)lds; float* beta = alpha + 80;
    if (tid == 0) { float m = 0.f;
        for (int c = 0; c < NCH; ++c) { const float a = MLSC[chain * NCH + c], be = MLSC[520 + chain * NCH + c]; const float mn = fmaxf(be + m, a);
            alpha[c] = expf(be + m - mn); beta[c] = expf(a - mn); if (slice == 0) MLSC[1040 + chain * NCH + c] = m; m = mn; } }
    __syncthreads();
    { const int off = slice * 2048 + tid * 4; f32x4 st = (f32x4){0.f, 0.f, 0.f, 0.f};
#pragma unroll 5
      for (int c = 0; c < NCH; ++c) { float* p = MLS + (size_t)(chain * NCH + c) * 65536 + off; const f32x4 d = *(const f32x4*)p; *(f32x4*)p = st; st = st * alpha[c] + d * beta[c]; } }
    if (slice == 0 && tid < 64) { const int off = tid * 4; f32x4 st = (f32x4){0.f, 0.f, 0.f, 0.f};
      for (int c = 0; c < NCH; ++c) { float* p = MLN + (size_t)(chain * NCH + c) * 256 + off; const f32x4 d = *(const f32x4*)p; *(f32x4*)p = st; st = st * alpha[c] + d * beta[c]; } }
    __syncthreads();
}
__device__ __forceinline__ void mlstm_C(const bf16* PROJ, const float* GIF, const float* MLS, const float* MLN, const float* MLSC, const float* ml_norm, bf16* BR, int u, unsigned char* lds, int tid) {
    const int c = u % NCH, bh = u / NCH, h = bh & 3, b = bh >> 2, lane = tid & 63, wave = tid >> 6;
    bf16* Qs = (bf16*)lds; bf16* Ks = Qs + 64 * 256; bf16* Vs = Ks + 64 * 256; float* S = (float*)(lds + 98304);
    float* bcs = (float*)(lds + RING_BYTES); float* lis = bcs + 64; float* mout = lis + 64; float* inter = mout + 64; float* den = inter + 64; float* ns = den + 64;
    if (tid < 64) {
        const int p = 64 * c + lane - 48; float lf = 0.f, li = NEGF;
        if (p >= 0) { const int row = seq_row(b, p); li = GIF[(size_t)row * 8 + h]; lf = log_sigmoidf_(GIF[(size_t)row * 8 + 4 + h]); }
        const float bc = wave_incl_sum(lf, lane); const float pm = wave_incl_max(li - bc, lane); const float mc = MLSC[1040 + u];
        const float mo = fmaxf(bc + mc, bc + pm);
        bcs[lane] = bc; lis[lane] = li; mout[lane] = mo; inter[lane] = expf(bc + mc - mo);
    } else if (tid < 128) { *(f32x4*)(ns + (tid - 64) * 4) = *(const f32x4*)(MLN + (size_t)u * 256 + (tid - 64) * 4); }
#pragma unroll
    for (int j = 0; j < 4; ++j) { const int id = tid + 512 * j, r = id >> 5, cp = id & 31, p = 64 * c + r - 48;
        v4u qr = (v4u){0u, 0u, 0u, 0u}, kr = qr, vr = qr;
        if (p >= 0) { const size_t ro = (size_t)seq_row(b, p) * NPROJ + h * 256 + cp * 8; qr = *(const v4u*)(PROJ + ro + PC_MLQ); kr = *(const v4u*)(PROJ + ro + PC_MLK); vr = *(const v4u*)(PROJ + ro + PC_MLV); }
        *(v4u*)(Qs + r * 256 + cp * 8) = qr; *(v4u*)(Ks + r * 256 + cp * 8) = kr; *(v4u*)(Vs + r * 256 + cp * 8) = vr; }
    __syncthreads();
    {
        const int t = tid >> 3, sg = tid & 7; float dot[8]; float qn = 0.f;
#pragma unroll
        for (int j = 0; j < 8; ++j) dot[j] = 0.f;
        for (int d8 = 0; d8 < 32; ++d8) { float q8[8]; unpack8(*(const v4u*)(Qs + t * 256 + d8 * 8), q8);
#pragma unroll
            for (int j = 0; j < 8; ++j) { float k8[8]; unpack8(*(const v4u*)(Ks + (sg * 8 + j) * 256 + d8 * 8), k8);
#pragma unroll
                for (int i = 0; i < 8; ++i) dot[j] += q8[i] * k8[i]; }
            if ((d8 >> 2) == sg) {
#pragma unroll
                for (int i = 0; i < 8; ++i) qn += q8[i] * ns[d8 * 8 + i]; } }
        const float bt = bcs[t], mo = mout[t]; float rs = 0.f;
#pragma unroll
        for (int j = 0; j < 8; ++j) { const int s = sg * 8 + j; float val = 0.f; if (s <= t) val = dot[j] * 0.0625f * expf(bt - bcs[s] + lis[s] - mo); S[t * 64 + s] = val; rs += val; }
        rs += __shfl_xor(rs, 1); rs += __shfl_xor(rs, 2); rs += __shfl_xor(rs, 4);
        qn += __shfl_xor(qn, 1); qn += __shfl_xor(qn, 2); qn += __shfl_xor(qn, 4);
        if (sg == 0) den[t] = rs + inter[t] * qn * 0.0625f;
    }
    __syncthreads();
    const int e = tid & 255, th = tid >> 8;
    float* part = (float*)(lds + RING_BYTES + 4096);
    const float gn = ml_norm[h * 256 + e];
    for (int hf = 0; hf < 2; ++hf) {
        const int t0 = 32 * th + 16 * hf;
        float acc[16];
#pragma unroll
        for (int tt = 0; tt < 16; ++tt) acc[tt] = 0.f;
        { const float* Cst = MLS + (size_t)u * 65536;
          for (int d8 = 0; d8 < 32; ++d8) { float cv[8];
#pragma unroll
              for (int i = 0; i < 8; ++i) cv[i] = Cst[(d8 * 8 + i) * 256 + e];
#pragma unroll
              for (int tt = 0; tt < 16; ++tt) { float q8[8]; unpack8(*(const v4u*)(Qs + (t0 + tt) * 256 + d8 * 8), q8);
#pragma unroll
                  for (int i = 0; i < 8; ++i) acc[tt] += q8[i] * cv[i]; } } }
#pragma unroll
        for (int tt = 0; tt < 16; ++tt) acc[tt] *= inter[t0 + tt] * 0.0625f;
        for (int s4 = 0; s4 < 16; ++s4) { float vv[4];
#pragma unroll
            for (int i = 0; i < 4; ++i) vv[i] = bf1(Vs[(s4 * 4 + i) * 256 + e]);
#pragma unroll
            for (int tt = 0; tt < 16; ++tt) { const f32x4 sv = *(const f32x4*)(S + (t0 + tt) * 64 + s4 * 4); acc[tt] += (sv.x * vv[0] + sv.y * vv[1]) + (sv.z * vv[2] + sv.w * vv[3]); } }
#pragma unroll
        for (int tt = 0; tt < 16; ++tt) { const int t = t0 + tt; acc[tt] = acc[tt] / fmaxf(fabsf(den[t]), expf(-mout[t]));
            const float sq = wave_sum(acc[tt] * acc[tt]); if (lane == 0) part[wave * 16 + tt] = sq; }
        __syncthreads();
#pragma unroll
        for (int tt = 0; tt < 16; ++tt) { const int t = t0 + tt, p = 64 * c + t - 48;
            const float ssq = (part[(4 * th) * 16 + tt] + part[(4 * th + 1) * 16 + tt]) + (part[(4 * th + 2) * 16 + tt] + part[(4 * th + 3) * 16 + tt]);
            if (p >= 0 && (c > 0 || b == 0)) { const int row = seq_row(b, p); const float rstd = 1.0f / sqrtf(ssq * (1.0f / 256.0f) + EPS);
                const float og = sigmoidf_(bf1(PROJ[(size_t)row * NPROJ + PC_MLO + h * 256 + e]));
                BR[(size_t)row * D + h * 256 + e] = (bf16)f2bf(acc[tt] * rstd * gn * og); } }
        __syncthreads();
    }
}

__device__ __forceinline__ void hg_cumsum(const bf16* PROJ, const float* LB, int b, int h, int c, float* bcs, float* kks, int d) {
    const float lb = LB[h * 128 + d]; float bacc = 0.f;
    for (int t = 0; t < 64; ++t) { const int p = 64 * c + t - 48; float lf = 0.f, kk = 0.f;
        if (p >= 0) { const float fp = bf1(PROJ[(size_t)seq_row(b, p) * NPROJ + PC_HGF + h * 128 + d]); const float sig = sigmoidf_(fp), nsig = sigmoidf_(-fp);
            lf = logf(lb + (1.0f - lb) * sig); kk = (1.0f - lb) * nsig; }
        bacc += lf; bcs[t * 128 + d] = bacc; kks[t * 128 + d] = kk; }
}
__device__ __forceinline__ void hg_A(const bf16* PROJ, const float* LB, float* HGS, float* HGE, int u, unsigned char* lds, int tid) {
    const int c = u % NCH, bh = u / NCH, h = bh & 7, b = bh >> 3;
    float* bcs = (float*)lds; float* kkw = bcs + 64 * 128; float* iv = kkw + 64 * 128;
    if (tid < 128) hg_cumsum(PROJ, LB, b, h, c, bcs, kkw, tid);
    else { for (int id = tid - 128; id < 1024; id += 384) { const int r = id >> 4, cp = id & 15, p = 64 * c + r - 48; float x[8];
            if (p >= 0) unpack8(*(const v4u*)(PROJ + (size_t)seq_row(b, p) * NPROJ + PC_HGI + h * 128 + cp * 8), x);
            else {
#pragma unroll
                for (int q = 0; q < 8; ++q) x[q] = 0.f; }
            *(f32x4*)(iv + r * 128 + cp * 8) = (f32x4){x[0], x[1], x[2], x[3]}; *(f32x4*)(iv + r * 128 + cp * 8 + 4) = (f32x4){x[4], x[5], x[6], x[7]}; } }
    __syncthreads();
    float escale[16];
#pragma unroll
    for (int k = 0; k < 16; ++k) { const int idx = tid + 512 * k, d = idx & 127; escale[k] = expf(bcs[63 * 128 + d] - bcs[idx]); }
    if (tid < 128) HGE[(size_t)u * 128 + tid] = expf(bcs[63 * 128 + tid]);
#pragma unroll
    for (int k = 0; k < 16; ++k) kkw[tid + 512 * k] *= escale[k];
    __syncthreads();
    const int d0 = (tid >> 4) * 4, e0 = (tid & 15) * 8;
    f32x4 acc[4][2];
#pragma unroll
    for (int i = 0; i < 4; ++i) { acc[i][0] = (f32x4){0.f, 0.f, 0.f, 0.f}; acc[i][1] = acc[i][0]; }
    for (int s = 0; s < 64; ++s) { const f32x4 kd = *(const f32x4*)(kkw + s * 128 + d0); const f32x4 i0 = *(const f32x4*)(iv + s * 128 + e0), i1 = *(const f32x4*)(iv + s * 128 + e0 + 4);
        acc[0][0] += i0 * kd.x; acc[0][1] += i1 * kd.x; acc[1][0] += i0 * kd.y; acc[1][1] += i1 * kd.y; acc[2][0] += i0 * kd.z; acc[2][1] += i1 * kd.z; acc[3][0] += i0 * kd.w; acc[3][1] += i1 * kd.w; }
    float* out = HGS + (size_t)u * 16384;
#pragma unroll
    for (int i = 0; i < 4; ++i) { *(f32x4*)(out + (d0 + i) * 128 + e0) = acc[i][0]; *(f32x4*)(out + (d0 + i) * 128 + e0 + 4) = acc[i][1]; }
    __syncthreads();
}
__device__ __forceinline__ void hg_B(float* HGS, const float* HGE, int unit, int tid) {
    const int chain = unit >> 4, slice = unit & 15, off = slice * 1024 + tid * 2, d = off >> 7; f32x2 st = (f32x2){0.f, 0.f};
#pragma unroll 5
    for (int c = 0; c < NCH; ++c) { const size_t uu = (size_t)chain * NCH + c; float* p = HGS + uu * 16384 + off; const f32x2 dl = *(const f32x2*)p; const float e = HGE[uu * 128 + d]; *(f32x2*)p = st; st = st * e + dl; }
}
__device__ __forceinline__ void hg_C(const bf16* PROJ, const float* LB, const float* HGS, const float* hg_norm, bf16* BR, int u, unsigned char* lds, int tid) {
    const int c = u % NCH, bh = u / NCH, h = bh & 7, b = bh >> 3, lane = tid & 63, wave = tid >> 6;
    float* qs = (float*)lds; float* bcs = qs + 64 * 128; float* kks = bcs + 64 * 128; float* att = kks + 64 * 128; float* H = qs;
    if (tid < 128) hg_cumsum(PROJ, LB, b, h, c, bcs, kks, tid);
    else { for (int id = tid - 128; id < 1024; id += 384) { const int r = id >> 4, cp = id & 15, p = 64 * c + r - 48; float x[8];
            if (p >= 0) { unpack8(*(const v4u*)(PROJ + (size_t)seq_row(b, p) * NPROJ + PC_HGQ + h * 128 + cp * 8), x);
#pragma unroll
                for (int q = 0; q < 8; ++q) x[q] = x[q] * sigmoidf_(x[q]); }
            else {
#pragma unroll
                for (int q = 0; q < 8; ++q) x[q] = 0.f; }
            *(f32x4*)(qs + r * 128 + cp * 8) = (f32x4){x[0], x[1], x[2], x[3]}; *(f32x4*)(qs + r * 128 + cp * 8 + 4) = (f32x4){x[4], x[5], x[6], x[7]}; } }
    __syncthreads();
    { const int t = tid >> 3, sg = tid & 7;
#pragma unroll 1
      for (int j = 0; j < 8; ++j) { const int s = sg * 8 + j; float a = 0.f;
          if (s <= t) { for (int d4 = 0; d4 < 32; ++d4) { const f32x4 q4 = *(const f32x4*)(qs + t * 128 + d4 * 4), k4 = *(const f32x4*)(kks + s * 128 + d4 * 4), bt = *(const f32x4*)(bcs + t * 128 + d4 * 4), bs = *(const f32x4*)(bcs + s * 128 + d4 * 4);
                  a += (q4.x * k4.x * expf(bt.x - bs.x) + q4.y * k4.y * expf(bt.y - bs.y)) + (q4.z * k4.z * expf(bt.z - bs.z) + q4.w * k4.w * expf(bt.w - bs.w)); } }
          att[t * 64 + s] = a; } }
    __syncthreads();
#pragma unroll
    for (int k = 0; k < 16; ++k) { const int idx = tid + 512 * k; bcs[idx] = qs[idx] * expf(bcs[idx]); }
    for (int id = tid; id < 1024; id += 512) { const int r = id >> 4, cp = id & 15, p = 64 * c + r - 48; float x[8];
        if (p >= 0) unpack8(*(const v4u*)(PROJ + (size_t)seq_row(b, p) * NPROJ + PC_HGI + h * 128 + cp * 8), x);
        else {
#pragma unroll
            for (int q = 0; q < 8; ++q) x[q] = 0.f; }
        *(f32x4*)(kks + r * 128 + cp * 8) = (f32x4){x[0], x[1], x[2], x[3]}; *(f32x4*)(kks + r * 128 + cp * 8 + 4) = (f32x4){x[4], x[5], x[6], x[7]}; }
    __syncthreads();
    const int e = tid & 127, tq = tid >> 7; float acc[16];
#pragma unroll
    for (int tt = 0; tt < 16; ++tt) acc[tt] = 0.f;
    { const float* Sst = HGS + (size_t)u * 16384;
      for (int d4 = 0; d4 < 32; ++d4) { float sv[4];
#pragma unroll
          for (int i = 0; i < 4; ++i) sv[i] = Sst[(d4 * 4 + i) * 128 + e];
#pragma unroll
          for (int tt = 0; tt < 16; ++tt) { const f32x4 q4 = *(const f32x4*)(bcs + (16 * tq + tt) * 128 + d4 * 4); acc[tt] += (q4.x * sv[0] + q4.y * sv[1]) + (q4.z * sv[2] + q4.w * sv[3]); } } }
    for (int s4 = 0; s4 < 16; ++s4) { float iv4[4];
#pragma unroll
        for (int i = 0; i < 4; ++i) iv4[i] = kks[(s4 * 4 + i) * 128 + e];
#pragma unroll
        for (int tt = 0; tt < 16; ++tt) { const f32x4 a4 = *(const f32x4*)(att + (16 * tq + tt) * 64 + s4 * 4); acc[tt] += (a4.x * iv4[0] + a4.y * iv4[1]) + (a4.z * iv4[2] + a4.w * iv4[3]); } }
    __syncthreads();
#pragma unroll
    for (int tt = 0; tt < 16; ++tt) H[(16 * tq + tt) * 128 + e] = acc[tt];
    __syncthreads();
    for (int t = wave; t < 64; t += NWAVES) { const int p = 64 * c + t - 48; if (p < 0 || (c == 0 && b != 0)) continue;
        const f32x2 hv = *(const f32x2*)(H + t * 128 + lane * 2); const float ssq = wave_sum(hv.x * hv.x + hv.y * hv.y);
        const float rstd = 1.0f / sqrtf(ssq * (1.0f / 128.0f) + EPS); const int row = seq_row(b, p);
        const f32x2 g = *(const f32x2*)(hg_norm + h * 128 + lane * 2); const unsigned o = *(const unsigned*)(PROJ + (size_t)row * NPROJ + PC_HGG + h * 128 + lane * 2);
        *(unsigned*)(BR + (size_t)row * D + 2048 + h * 128 + lane * 2) = pk2(hv.x * rstd * g.x * sigmoidf_(bflo(o)), hv.y * rstd * g.y * sigmoidf_(bfhi(o))); }
    __syncthreads();
}

__device__ __forceinline__ float rg_x(const bf16* PROJ, int b, int p, int ch) { return p >= 0 ? bf1(PROJ[(size_t)seq_row(b, p) * NPROJ + PC_RGX + ch]) : 0.f; }
__device__ __forceinline__ void rg_A(const bf16* PROJ, const float* conv_w, const float* conv_b, const float* wa, const float* ba, const float* wx, const float* bx, const float* lam, float* RGH, float* RGP, float* RGT, int u, unsigned char* lds, int tid) {
    const int half = u & 1, bc = u >> 1, c = bc % NCH, b = bc / NCH, ch = half * 512 + tid, p0 = 64 * c - 48;
    float* xcs = (float*)lds;
    { const float w0 = conv_w[ch], w1 = conv_w[1024 + ch], w2 = conv_w[2048 + ch], w3 = conv_w[3072 + ch], cb = conv_b[ch];
      float xm3 = rg_x(PROJ, b, p0 - 3, ch), xm2 = rg_x(PROJ, b, p0 - 2, ch), xm1 = rg_x(PROJ, b, p0 - 1, ch);
#pragma unroll 4
      for (int t = 0; t < 64; ++t) { const float x0 = rg_x(PROJ, b, p0 + t, ch); xcs[t * 512 + tid] = cb + (w0 * xm3 + w1 * xm2) + (w2 * xm1 + w3 * x0); xm3 = xm2; xm2 = xm1; xm1 = x0; } }
    __syncthreads();
    const int n = ch >> 6, jj = ch & 63, xb = (n - half * 8) * 64;
    float war[64], wxr[64];
#pragma unroll
    for (int i = 0; i < 64; ++i) { war[i] = wa[(n * 64 + i) * 64 + jj]; wxr[i] = wx[(n * 64 + i) * 64 + jj]; }
    const float bav = ba[ch], bxv = bx[ch], sp = softplusf_(-lam[ch]);
    float hh = 0.f, P = 1.f;
    for (int t = (c == 0 ? 48 : 0); t < 64; ++t) { float ra = bav, ri = bxv;
#pragma unroll
        for (int i4 = 0; i4 < 16; ++i4) { const f32x4 x4 = *(const f32x4*)(xcs + t * 512 + xb + i4 * 4);
            ra += (x4.x * war[i4 * 4] + x4.y * war[i4 * 4 + 1]) + (x4.z * war[i4 * 4 + 2] + x4.w * war[i4 * 4 + 3]);
            ri += (x4.x * wxr[i4 * 4] + x4.y * wxr[i4 * 4 + 1]) + (x4.z * wxr[i4 * 4 + 2] + x4.w * wxr[i4 * 4 + 3]); }
        const float r = sigmoidf_(ra), ig = sigmoidf_(ri), la = -8.0f * r * sp, a = expf(la), uu = sqrtf(-expm1f(2.0f * la)) * ig * xcs[t * 512 + tid];
        hh = a * hh + uu; P *= a;
        if (c > 0 || b == 0) { const size_t ro = (size_t)seq_row(b, p0 + t) * 1024 + ch; RGH[ro] = hh; RGP[ro] = P; } }
    RGT[(size_t)(0 * 2 + b) * NCH * 1024 + c * 1024 + ch] = P; RGT[(size_t)(1 * 2 + b) * NCH * 1024 + c * 1024 + ch] = hh;
    __syncthreads();
}
__device__ __forceinline__ void rg_B(float* RGT, int gtid) {
    const int b = gtid >> 10, ch = gtid & 1023; float carry = 0.f;
    const float* A = RGT + (size_t)(0 * 2 + b) * NCH * 1024 + ch; const float* Hh = RGT + (size_t)(1 * 2 + b) * NCH * 1024 + ch; float* Cc = RGT + (size_t)(2 * 2 + b) * NCH * 1024 + ch;
#pragma unroll 5
    for (int c = 0; c < NCH; ++c) { const float a = A[c * 1024], hv = Hh[c * 1024]; Cc[c * 1024] = carry; carry = a * carry + hv; }
}
__device__ __forceinline__ float gelu_tanh(float y) { return 0.5f * y * (1.0f + tanhf(0.7978845608028654f * (y + 0.044715f * y * y * y))); }
__device__ __forceinline__ void rg_C(const bf16* PROJ, const float* RGH, const float* RGP, const float* RGT, bf16* BR, int gw, int NGW, int lane) {
    for (int row = gw; row < TREAL + NMETA; row += NGW) {
        const int b = row < TREAL ? (row >> 12) : 0, p = row < TREAL ? (row & 4095) + NMETA : row - TREAL, c = (p + 48) >> 6;
        const float* Cc = RGT + (size_t)(2 * 2 + b) * NCH * 1024 + c * 1024;
#pragma unroll
        for (int j = 0; j < 2; ++j) { const int ch = j * 512 + lane * 8; float y[8]; unpack8(*(const v4u*)(PROJ + (size_t)row * NPROJ + PC_RGY + ch), y); float o[8];
#pragma unroll
            for (int q = 0; q < 2; ++q) { const f32x4 hl = *(const f32x4*)(RGH + (size_t)row * 1024 + ch + 4 * q), pp = *(const f32x4*)(RGP + (size_t)row * 1024 + ch + 4 * q), cc = *(const f32x4*)(Cc + ch + 4 * q);
                const f32x4 hv = hl + pp * cc; o[4 * q] = hv.x * gelu_tanh(y[4 * q]); o[4 * q + 1] = hv.y * gelu_tanh(y[4 * q + 1]); o[4 * q + 2] = hv.z * gelu_tanh(y[4 * q + 2]); o[4 * q + 3] = hv.w * gelu_tanh(y[4 * q + 3]); }
            v4u w; w.x = pk2(o[0], o[1]); w.y = pk2(o[2], o[3]); w.z = pk2(o[4], o[5]); w.w = pk2(o[6], o[7]);
            *(v4u*)(BR + (size_t)row * D + 3072 + ch) = w; }
    }
}

__device__ __forceinline__ void sb_unit(const bf16* PROJ, const float* gq, const float* gk, bf16* BR, int b, int h, int i, unsigned char* lds, int tid) {
    float* Kt = (float*)lds; float* Vt = Kt + 64 * 128;
    const int qi = tid >> 2, part = tid & 3, p = 128 * i + qi - 112; const bool valid = p >= 0;
    float q[32], o[32];
    { float ss = 0.f;
      if (valid) { const bf16* qp = PROJ + (size_t)seq_row(b, p) * NPROJ + PC_SBQ + h * 128 + part * 32;
#pragma unroll
          for (int j = 0; j < 4; ++j) { float x[8]; unpack8(*(const v4u*)(qp + 8 * j), x);
#pragma unroll
              for (int k = 0; k < 8; ++k) { q[8 * j + k] = x[k]; ss += x[k] * x[k]; } } }
      else {
#pragma unroll
          for (int j = 0; j < 32; ++j) q[j] = 0.f; }
      ss += __shfl_xor(ss, 1); ss += __shfl_xor(ss, 2);
      const float sc = 0.08838834764831845f / sqrtf(ss * (1.0f / 128.0f) + EPS);
#pragma unroll
      for (int j = 0; j < 32; ++j) { q[j] *= sc * gq[part * 32 + j]; o[j] = 0.f; } }
    float between = 0.f;
    const int kt_hi = (i == 0) ? 0 : 2 * i;
    for (int kt = kt_hi; kt >= 0; --kt) {
        { const int kr = tid >> 3, sg = tid & 7, pk = 64 * kt + kr; float ka[8], kb[8], va[8], vb[8]; float ss = 0.f;
          if (pk < 4096 + NMETA) { const bf16* rp = PROJ + (size_t)seq_row(b, pk) * NPROJ + h * 128 + sg * 16;
              unpack8(*(const v4u*)(rp + PC_SBK), ka); unpack8(*(const v4u*)(rp + PC_SBK + 8), kb);
              unpack8(*(const v4u*)(rp + PC_SBV), va); unpack8(*(const v4u*)(rp + PC_SBV + 8), vb);
#pragma unroll
              for (int k = 0; k < 8; ++k) ss += ka[k] * ka[k] + kb[k] * kb[k]; }
          else {
#pragma unroll
              for (int k = 0; k < 8; ++k) { ka[k] = 0.f; kb[k] = 0.f; va[k] = 0.f; vb[k] = 0.f; } }
          ss += __shfl_xor(ss, 1); ss += __shfl_xor(ss, 2); ss += __shfl_xor(ss, 4);
          const float rstd = 1.0f / sqrtf(ss * (1.0f / 128.0f) + EPS);
          const f32x4 g0 = *(const f32x4*)(gk + sg * 16), g1 = *(const f32x4*)(gk + sg * 16 + 4), g2 = *(const f32x4*)(gk + sg * 16 + 8), g3 = *(const f32x4*)(gk + sg * 16 + 12);
          float* kd = Kt + kr * 128 + sg * 16; float* vd = Vt + kr * 128 + sg * 16;
          *(f32x4*)(kd) = (f32x4){ka[0] * rstd * g0.x, ka[1] * rstd * g0.y, ka[2] * rstd * g0.z, ka[3] * rstd * g0.w};
          *(f32x4*)(kd + 4) = (f32x4){ka[4] * rstd * g1.x, ka[5] * rstd * g1.y, ka[6] * rstd * g1.z, ka[7] * rstd * g1.w};
          *(f32x4*)(kd + 8) = (f32x4){kb[0] * rstd * g2.x, kb[1] * rstd * g2.y, kb[2] * rstd * g2.z, kb[3] * rstd * g2.w};
          *(f32x4*)(kd + 12) = (f32x4){kb[4] * rstd * g3.x, kb[5] * rstd * g3.y, kb[6] * rstd * g3.z, kb[7] * rstd * g3.w};
          *(f32x4*)(vd) = (f32x4){va[0], va[1], va[2], va[3]}; *(f32x4*)(vd + 4) = (f32x4){va[4], va[5], va[6], va[7]};
          *(f32x4*)(vd + 8) = (f32x4){vb[0], vb[1], vb[2], vb[3]}; *(f32x4*)(vd + 12) = (f32x4){vb[4], vb[5], vb[6], vb[7]}; }
        __syncthreads();
        for (int s = 63; s >= 0; --s) { const int pk = 64 * kt + s; float z = 0.f;
#pragma unroll
            for (int j4 = 0; j4 < 8; ++j4) { const f32x4 k4 = *(const f32x4*)(Kt + s * 128 + part * 32 + j4 * 4); z += (q[4 * j4] * k4.x + q[4 * j4 + 1] * k4.y) + (q[4 * j4 + 2] * k4.z + q[4 * j4 + 3] * k4.w); }
            z += __shfl_xor(z, 1); z += __shfl_xor(z, 2);
            if (pk < p) { const float sp = softplusf_(z); const float a = expf(z - sp + between); between -= sp;
#pragma unroll
                for (int j4 = 0; j4 < 8; ++j4) { const f32x4 v4 = *(const f32x4*)(Vt + s * 128 + part * 32 + j4 * 4); o[4 * j4] += a * v4.x; o[4 * j4 + 1] += a * v4.y; o[4 * j4 + 2] += a * v4.z; o[4 * j4 + 3] += a * v4.w; } } }
        { volatile unsigned* flg = (volatile unsigned*)(lds + RING_BYTES) + (kt & 1) * 8;
          const int alldone = __all((!valid || between < -104.0f) ? 1 : 0);
          if ((tid & 63) == 0) flg[tid >> 6] = alldone ? 1u : 0u;
          __syncthreads();
          unsigned d = 1u;
#pragma unroll
          for (int w = 0; w < NWAVES; ++w) d &= flg[w];
          if (d) break; }
    }
    if (valid && (i > 0 || b == 0)) { bf16* op = BR + (size_t)seq_row(b, p) * D + 1024 + h * 128 + part * 32;
#pragma unroll
        for (int j = 0; j < 4; ++j) { v4u w; w.x = pk2(o[8 * j], o[8 * j + 1]); w.y = pk2(o[8 * j + 2], o[8 * j + 3]); w.z = pk2(o[8 * j + 4], o[8 * j + 5]); w.w = pk2(o[8 * j + 6], o[8 * j + 7]); *(v4u*)(op + 8 * j) = w; } }
    __syncthreads();
}
#ifndef REP_P0
#define REP_P0 1
#endif
#ifndef REP_A
#define REP_A 1
#endif
#ifndef REP_C
#define REP_C 1
#endif
#ifndef REP_G1
#define REP_G1 1
#endif
#ifndef REP_G8
#define REP_G8 1
#endif
#ifndef MK_N_LAUNCHES
#define MK_N_LAUNCHES 1
#endif
constexpr int N_PHASES = 1 + 10 * NLAYER;
struct Args { const float* in[23]; float* out; unsigned char* ws; int ph_lo, ph_hi; };
static_assert(sizeof(Args) == 23 * 8 + 8 + 8 + 8, "Args has no padding bytes");

template <int LO, int HI> __global__ void __launch_bounds__(NTHR, 2) fwd_kernel(Args args) {
    extern __shared__ __attribute__((aligned(16))) unsigned char lds[];
    const int tid = threadIdx.x;
    const int G = gridDim.x, bx = blockIdx.x;
    const int vcu = (G % 8 == 0) ? (bx % 8) * (G / 8) + bx / 8 : bx;
    const int NGW = G * NWAVES, NGT = G * NTHR;
    unsigned char* ws = args.ws;
    unsigned* ctl = (unsigned*)(ws + WS_CTL);
    volatile LAS unsigned* MISC = (volatile LAS unsigned*)((LAS unsigned char*)lds + MISC_OFF);
    for (int u = tid; u < (LDS_BYTES - LDSCTL_OFF) / 4; u += NTHR) ((LAS unsigned*)((LAS unsigned char*)lds + LDSCTL_OFF))[u] = 0u;
    __syncthreads();
    constexpr bool use_bar = (HI - LO) > 1;
    XcdBarrier bar; bar.bar = ctl + CW_BAR; bar.x = 0; bar.st = nullptr;
    if constexpr (use_bar) bar = xcd_barrier_post(ctl + CW_BAR, MISC + 8);
#define IN(k) (LO <= (k) && (k) < HI)
#define PHASE_VARS int tid_ = tid; asm volatile("" : "+v"(tid_)); const int lane_ = tid_ & 63, wave_ = __builtin_amdgcn_readfirstlane(tid_ >> 6), gw_ = vcu * NWAVES + wave_, gtid_ = bx * NTHR + tid_; (void)lane_; (void)wave_; (void)gw_; (void)gtid_;
#define SEAM(k) do { if constexpr (IN(k) && IN((k) + 1)) xcd_barrier(bar); } while (0)

#define PROJ ((bf16*)(ws + WS_PROJ))
#define ACT ((bf16*)(ws + WS_ACT))
#define XN ((bf16*)(ws + WS_XN))
#define BR ((bf16*)(ws + WS_BR))
#define MG ((bf16*)(ws + WS_MG))
#define HMETA ((float*)(ws + WS_HMETA))
#define GIF ((float*)(ws + WS_GIF))
#define WIF ((const float*)(ws + WS_WIF))
#define LBp ((const float*)(ws + WS_LB))
#define MLS ((float*)(ws + WS_MLS))
#define MLN ((float*)(ws + WS_MLN))
#define MLSC ((float*)(ws + WS_MLSC))
#define HGS ((float*)(ws + WS_HGS))
#define HGE ((float*)(ws + WS_HGE))
#define RGH ((float*)(ws + WS_RGH))
#define RGP ((float*)(ws + WS_RGP))
#define RGT ((float*)(ws + WS_RGT))
#define x (args.in[0])
#define out (args.out)

    if constexpr (IN(0)) for (int rep_ = 0; rep_ < REP_P0; ++rep_) { PHASE_VARS p0_prologue(args.in, ws, lds, bx, G, wave_, lane_, gtid_, NGT); }
    SEAM(0);

    {
        constexpr int l = 0;
        constexpr int pb = 1 + 10 * l;
        constexpr bool lastl = (l == NLAYER - 1);
        constexpr int Mtail = lastl ? TREAL : MROWS;
        const float* hsrc = (l == 0) ? x : out;
        if constexpr (IN(pb + 0)) { PHASE_VARS norm_rows<true>(hsrc, HMETA, args.in[2] + l * D, XN, MROWS, WIF + (size_t)l * 8 * D, args.in[5] + (size_t)l * NIN + 4096, GIF, gw_, NGW, lane_); }
        SEAM(pb + 0);
        if constexpr (IN(pb + 1)) for (int rep_ = 0; rep_ < REP_G1; ++rep_) { PHASE_VARS pg8::Gemm g{XN, (const bf16*)(ws + WS_WIN + (size_t)l * SZ_WIN), MROWS, NPROJ, D, D, D}; pg8::StaticOrder S; S.init(MROWS, NPROJ, G, bx);
            pg8::EpiProj E{PROJ, NPROJ, args.in[5] + (size_t)l * NIN, 4096, 8};
            pg8::gemm_phase<pg8::EpiProj, pg8::StaticOrder, true, true>((PG8_LAS unsigned char*)lds, g, S, E, tid_); }
        SEAM(pb + 1);
        if constexpr (IN(pb + 2)) { PHASE_VARS
          for (int rep_ = 0; rep_ < REP_A; ++rep_) {
            for (int u = bx; u < 520; u += G) mlstm_A(PROJ, GIF, MLS, MLN, MLSC, u, lds, tid_);
            for (int u = bx; u < 1040; u += G) hg_A(PROJ, LBp + l * 1024, HGS, HGE, u, lds, tid_);
            for (int u = bx; u < 260; u += G) rg_A(PROJ, args.in[11] + l * 4096, args.in[12] + l * 1024, args.in[13] + l * 65536, args.in[14] + l * 1024, args.in[15] + l * 65536, args.in[16] + l * 1024, args.in[17] + l * 1024, RGH, RGP, RGT, u, lds, tid_);
            for (int r = 0;; ++r) { const int idx = r * G + ((r & 1) ? (G - 1 - bx) : bx); if (r * G >= 520) break; if (idx >= 520) continue;
                int b, h, i; if (idx < 512) { i = 32 - (idx >> 4); b = (idx >> 3) & 1; h = idx & 7; } else { i = 0; b = 0; h = idx - 512; }
                sb_unit(PROJ, args.in[7] + l * 128, args.in[8] + l * 128, BR, b, h, i, lds, tid_); }
          }
        }
        SEAM(pb + 2);
        if constexpr (IN(pb + 3)) { PHASE_VARS
            for (int u = bx; u < 256; u += G) mlstm_B(MLS, MLN, MLSC, u, lds, tid_);
            for (int u = bx; u < 256; u += G) hg_B(HGS, HGE, u, tid_);
            if (gtid_ < 2048) rg_B(RGT, gtid_);
        }
        SEAM(pb + 3);
        if constexpr (IN(pb + 4)) { PHASE_VARS
          for (int rep_ = 0; rep_ < REP_C; ++rep_) {
            for (int u = bx; u < 520; u += G) mlstm_C(PROJ, GIF, MLS, MLN, MLSC, args.in[6] + l * 1024, BR, u, lds, tid_);
            for (int u = bx; u < 1040; u += G) hg_C(PROJ, LBp + l * 1024, HGS, args.in[10] + l * 1024, BR, u, lds, tid_);
            rg_C(PROJ, RGH, RGP, RGT, BR, gw_, NGW, lane_);
          }
        }
        SEAM(pb + 4);
        if constexpr (IN(pb + 5)) { PHASE_VARS pg8::Gemm g{BR, (const bf16*)(ws + WS_WUP + (size_t)l * SZ_WSQ), Mtail, D, D, D, D}; pg8::StaticOrder S; S.init(Mtail, D, G, bx);
            pg8::EpiUpGate E{MG, D, PROJ + PC_GATE, NPROJ};
            pg8::gemm_phase<pg8::EpiUpGate, pg8::StaticOrder, true, true>((PG8_LAS unsigned char*)lds, g, S, E, tid_); }
        SEAM(pb + 5);
        if constexpr (IN(pb + 6)) { PHASE_VARS pg8::Gemm g{MG, (const bf16*)(ws + WS_WOUT + (size_t)l * SZ_WSQ), Mtail, D, D, D, D}; pg8::StaticOrder S; S.init(Mtail, D, G, bx);
            pg8::EpiResid E{hsrc, out, HMETA};
            pg8::gemm_phase<pg8::EpiResid, pg8::StaticOrder, true, true>((PG8_LAS unsigned char*)lds, g, S, E, tid_); }
        SEAM(pb + 6);
        if constexpr (IN(pb + 7)) { PHASE_VARS norm_rows<false>(out, HMETA, args.in[3] + l * D, XN, Mtail, nullptr, nullptr, nullptr, gw_, NGW, lane_); }
        SEAM(pb + 7);
        if constexpr (IN(pb + 8)) for (int rep_ = 0; rep_ < REP_G8; ++rep_) { PHASE_VARS pg8::Gemm g{XN, (const bf16*)(ws + WS_WGU + (size_t)l * SZ_WGU), Mtail, NGU, D, D, D}; pg8::StaticOrder S; S.init(Mtail, NGU, G, bx);
            pg8::EpiSwiGLU E{ACT, DFF};
            pg8::gemm_phase<pg8::EpiSwiGLU, pg8::StaticOrder, true, true>((PG8_LAS unsigned char*)lds, g, S, E, tid_); }
        SEAM(pb + 8);
        if constexpr (IN(pb + 9)) { PHASE_VARS pg8::Gemm g{ACT, (const bf16*)(ws + WS_WD + (size_t)l * SZ_WD), Mtail, D, DFF, DFF, DFF}; pg8::StaticOrder S; S.init(Mtail, D, G, bx);
            pg8::EpiResid E{out, out, HMETA};
            pg8::gemm_phase<pg8::EpiResid, pg8::StaticOrder, true, true>((PG8_LAS unsigned char*)lds, g, S, E, tid_); }
        SEAM(pb + 9);
    }
    {
        constexpr int l = 1;
        constexpr int pb = 1 + 10 * l;
        constexpr bool lastl = (l == NLAYER - 1);
        constexpr int Mtail = lastl ? TREAL : MROWS;
        const float* hsrc = (l == 0) ? x : out;
        if constexpr (IN(pb + 0)) { PHASE_VARS norm_rows<true>(hsrc, HMETA, args.in[2] + l * D, XN, MROWS, WIF + (size_t)l * 8 * D, args.in[5] + (size_t)l * NIN + 4096, GIF, gw_, NGW, lane_); }
        SEAM(pb + 0);
        if constexpr (IN(pb + 1)) for (int rep_ = 0; rep_ < REP_G1; ++rep_) { PHASE_VARS pg8::Gemm g{XN, (const bf16*)(ws + WS_WIN + (size_t)l * SZ_WIN), MROWS, NPROJ, D, D, D}; pg8::StaticOrder S; S.init(MROWS, NPROJ, G, bx);
            pg8::EpiProj E{PROJ, NPROJ, args.in[5] + (size_t)l * NIN, 4096, 8};
            pg8::gemm_phase<pg8::EpiProj, pg8::StaticOrder, true, true>((PG8_LAS unsigned char*)lds, g, S, E, tid_); }
        SEAM(pb + 1);
        if constexpr (IN(pb + 2)) { PHASE_VARS
          for (int rep_ = 0; rep_ < REP_A; ++rep_) {
            for (int u = bx; u < 520; u += G) mlstm_A(PROJ, GIF, MLS, MLN, MLSC, u, lds, tid_);
            for (int u = bx; u < 1040; u += G) hg_A(PROJ, LBp + l * 1024, HGS, HGE, u, lds, tid_);
            for (int u = bx; u < 260; u += G) rg_A(PROJ, args.in[11] + l * 4096, args.in[12] + l * 1024, args.in[13] + l * 65536, args.in[14] + l * 1024, args.in[15] + l * 65536, args.in[16] + l * 1024, args.in[17] + l * 1024, RGH, RGP, RGT, u, lds, tid_);
            for (int r = 0;; ++r) { const int idx = r * G + ((r & 1) ? (G - 1 - bx) : bx); if (r * G >= 520) break; if (idx >= 520) continue;
                int b, h, i; if (idx < 512) { i = 32 - (idx >> 4); b = (idx >> 3) & 1; h = idx & 7; } else { i = 0; b = 0; h = idx - 512; }
                sb_unit(PROJ, args.in[7] + l * 128, args.in[8] + l * 128, BR, b, h, i, lds, tid_); }
          }
        }
        SEAM(pb + 2);
        if constexpr (IN(pb + 3)) { PHASE_VARS
            for (int u = bx; u < 256; u += G) mlstm_B(MLS, MLN, MLSC, u, lds, tid_);
            for (int u = bx; u < 256; u += G) hg_B(HGS, HGE, u, tid_);
            if (gtid_ < 2048) rg_B(RGT, gtid_);
        }
        SEAM(pb + 3);
        if constexpr (IN(pb + 4)) { PHASE_VARS
          for (int rep_ = 0; rep_ < REP_C; ++rep_) {
            for (int u = bx; u < 520; u += G) mlstm_C(PROJ, GIF, MLS, MLN, MLSC, args.in[6] + l * 1024, BR, u, lds, tid_);
            for (int u = bx; u < 1040; u += G) hg_C(PROJ, LBp + l * 1024, HGS, args.in[10] + l * 1024, BR, u, lds, tid_);
            rg_C(PROJ, RGH, RGP, RGT, BR, gw_, NGW, lane_);
          }
        }
        SEAM(pb + 4);
        if constexpr (IN(pb + 5)) { PHASE_VARS pg8::Gemm g{BR, (const bf16*)(ws + WS_WUP + (size_t)l * SZ_WSQ), Mtail, D, D, D, D}; pg8::StaticOrder S; S.init(Mtail, D, G, bx);
            pg8::EpiUpGate E{MG, D, PROJ + PC_GATE, NPROJ};
            pg8::gemm_phase<pg8::EpiUpGate, pg8::StaticOrder, true, true>((PG8_LAS unsigned char*)lds, g, S, E, tid_); }
        SEAM(pb + 5);
        if constexpr (IN(pb + 6)) { PHASE_VARS pg8::Gemm g{MG, (const bf16*)(ws + WS_WOUT + (size_t)l * SZ_WSQ), Mtail, D, D, D, D}; pg8::StaticOrder S; S.init(Mtail, D, G, bx);
            pg8::EpiResid E{hsrc, out, HMETA};
            pg8::gemm_phase<pg8::EpiResid, pg8::StaticOrder, true, true>((PG8_LAS unsigned char*)lds, g, S, E, tid_); }
        SEAM(pb + 6);
        if constexpr (IN(pb + 7)) { PHASE_VARS norm_rows<false>(out, HMETA, args.in[3] + l * D, XN, Mtail, nullptr, nullptr, nullptr, gw_, NGW, lane_); }
        SEAM(pb + 7);
        if constexpr (IN(pb + 8)) for (int rep_ = 0; rep_ < REP_G8; ++rep_) { PHASE_VARS pg8::Gemm g{XN, (const bf16*)(ws + WS_WGU + (size_t)l * SZ_WGU), Mtail, NGU, D, D, D}; pg8::StaticOrder S; S.init(Mtail, NGU, G, bx);
            pg8::EpiSwiGLU E{ACT, DFF};
            pg8::gemm_phase<pg8::EpiSwiGLU, pg8::StaticOrder, true, true>((PG8_LAS unsigned char*)lds, g, S, E, tid_); }
        SEAM(pb + 8);
        if constexpr (IN(pb + 9)) { PHASE_VARS pg8::Gemm g{ACT, (const bf16*)(ws + WS_WD + (size_t)l * SZ_WD), Mtail, D, DFF, DFF, DFF}; pg8::StaticOrder S; S.init(Mtail, D, G, bx);
            pg8::EpiResid E{out, out, HMETA};
            pg8::gemm_phase<pg8::EpiResid, pg8::StaticOrder, true, true>((PG8_LAS unsigned char*)lds, g, S, E, tid_); }
        SEAM(pb + 9);
    }

#undef IN
#undef SEAM
#undef PHASE_VARS
#undef PROJ
#undef ACT
#undef XN
#undef BR
#undef MG
#undef HMETA
#undef GIF
#undef WIF
#undef LBp
#undef MLS
#undef MLN
#undef MLSC
#undef HGS
#undef HGE
#undef RGH
#undef RGP
#undef RGT
#undef x
#undef out
}


#if MK_N_LAUNCHES == 1
template <class F> static void for_each_kernel(F&& f) { f((const void*)fwd_kernel<0, N_PHASES>); }
static void launch_all(const Args& a, int grid, hipStream_t stream) { hipLaunchKernelGGL((fwd_kernel<0, N_PHASES>), dim3(grid), dim3(NTHR), LDS_BYTES, stream, a); }
#else
template <int K> struct PhaseLaunch {
    template <class F> static void each(F&& f) { f((const void*)fwd_kernel<K, K + 1>); PhaseLaunch<K + 1>::each(f); }
    static void go(const Args& a, int grid, hipStream_t stream) { hipLaunchKernelGGL((fwd_kernel<K, K + 1>), dim3(grid), dim3(NTHR), LDS_BYTES, stream, a); PhaseLaunch<K + 1>::go(a, grid, stream); }
};
template <> struct PhaseLaunch<N_PHASES> { template <class F> static void each(F&&) {} static void go(const Args&, int, hipStream_t) {} };
template <class F> static void for_each_kernel(F&& f) { PhaseLaunch<0>::each(f); }
static void launch_all(const Args& a, int grid, hipStream_t stream) { PhaseLaunch<0>::go(a, grid, stream); }
#endif
extern "C" void kernel_launch(void* const* d_in, const int* in_sizes, int n_in, void* d_out, int out_size, void* d_ws, size_t ws_size, hipStream_t stream) {
    static int grid = 0;
    if (grid == 0) {
        if (n_in != 23 || out_size != TREAL * D || ws_size < WS_END) { fprintf(stderr, "kernel_launch: unexpected shapes (n_in %d, out %d, ws %zu < %zu); nothing launched\n", n_in, out_size, ws_size, (size_t)WS_END); grid = -1; return; }
        int dev = 0, cus = 0, per_cu = 0;
        if (hipGetDevice(&dev) != hipSuccess || hipDeviceGetAttribute(&cus, hipDeviceAttributeMultiprocessorCount, dev) != hipSuccess) { grid = -1; return; }
        bool ok = true;
        for_each_kernel([&](const void* f) { if (hipFuncSetAttribute(f, hipFuncAttributeMaxDynamicSharedMemorySize, LDS_BYTES) != hipSuccess) ok = false; });
        if (!ok) { fprintf(stderr, "kernel_launch: hipFuncSetAttribute failed\n"); grid = -1; return; }
        (void)per_cu; (void)hipGetLastError();
        grid = cus;
    }
    if (grid < 0) return;
    (void)in_sizes;
    if (hipMemsetAsync((char*)d_ws + WS_CTL, 0, CTL_ZERO_BYTES, stream) != hipSuccess) return;
    Args a{};
    for (int i = 0; i < 23; ++i) a.in[i] = (const float*)d_in[i];
    a.out = (float*)d_out; a.ws = (unsigned char*)d_ws; a.ph_lo = 0; a.ph_hi = N_PHASES;
    launch_all(a, grid, stream);
}
```

```cpp
#include <hip/hip_runtime.h>
#include <cstdio>
#include <cstdint>
#define MK_N_LAUNCHES 1
#ifndef PG8_WGM
#define PG8_WGM 8
#endif
namespace pg8 {
#define PG8_LAS __attribute__((address_space(3)))
typedef unsigned short bf16_t;
typedef short bf16x8 __attribute__((ext_vector_type(8)));
typedef float f32x4 __attribute__((ext_vector_type(4)));
typedef unsigned u32x4 __attribute__((ext_vector_type(4)));
constexpr int BM = 256, BK = 64, HALF = 128, HTB = HALF * BK * 2  , STAGE_BYTES = 8 * HTB, NXCD = 8, WGM = PG8_WGM;

__host__ __device__ __forceinline__ int lds_byte(int r, int c) { const int st = (r >> 4) * 2 + (c >> 5), rr = r & 15, cc = c & 31, ob = rr * 64 + cc * 2; return st * 1024 + (ob ^ (((ob >> 9) & 1) << 5)); }
__host__ __device__ __forceinline__ void stage_rc(int b, int& R, int& C) { const int st = b / 1024, sb = b % 1024, swz = sb ^ (((sb >> 9) & 1) << 5); R = (st >> 1) * 16 + swz / 64; C = (st & 1) * 32 + (swz % 64) / 2; }
__host__ __device__ __forceinline__ int perm32(int rho) { const int n = rho >> 4, i = rho & 15; return 8 * (i >> 2) + 4 * n + (i & 3); }

struct Unit { int pm, pn; };
struct Gemm { const bf16_t* A; const bf16_t* Bt; int M, N, K, lda, ldb; };

struct StaticOrder {
    int nM, nN, nwg, G, c;
    __host__ __device__ void init(int M, int N, int G_, int c_) { nM = M / BM; nN = N / BM; nwg = nM * nN; G = G_; c = c_; }
    __host__ __device__ bool next(int i, Unit& u) const {
        const long L = (long)i * G + c; if (L >= nwg) return false;
        int wgid = (int)L;
#if !defined(PG8_NO_XCD_REMAP)
        { const int q = nwg / NXCD, r = nwg % NXCD, xcd = wgid % NXCD, off = wgid / NXCD; wgid = (xcd < r ? xcd * (q + 1) : r * (q + 1) + (xcd - r) * q) + off; }
#endif
        const int nig = WGM * nN, gid = wgid / nig, fm = gid * WGM, gsz = (nM - fm) < WGM ? (nM - fm) : WGM;
        u.pm = fm + ((wgid % nig) % gsz); u.pn = (wgid % nig) / gsz; return true;
    }
    __device__ __forceinline__ void a_ready(const Unit&) const {}
    __device__ __forceinline__ void done(const Unit&) const {}
};

__device__ __forceinline__ unsigned cvt_pk_bf16(float lo, float hi) { unsigned r; asm volatile("v_cvt_pk_bf16_f32 %0, %1, %2" : "=v"(r) : "v"(lo), "v"(hi)); return r; }
typedef float f32x2 __attribute__((ext_vector_type(2)));
typedef float f32x2 __attribute__((ext_vector_type(2)));
__device__ __forceinline__ float bf_lo(unsigned w) { return __uint_as_float(w << 16); }
__device__ __forceinline__ float bf_hi(unsigned w) { return __uint_as_float(w & 0xffff0000u); }
__device__ __forceinline__ float fast_sigmoid(float x) { return __builtin_amdgcn_rcpf(1.0f + __expf(-x)); }

struct EpiProj {
    static constexpr bool PERM = true, AFTER_DRAIN = false, MID = false; static constexpr int SEG = 16;
    bf16_t* O; int ldc; const float* bias; int shift_from, bias_shift, gate_from;
    __device__ __forceinline__ void operator()(const f32x4 (&acc)[2][2][4][2], const Unit& u, int wr, int wc, int fr, int fq) const {
        const int row0 = u.pm * BM + wr * 64 + fr; const int colt = u.pn * BM;
        const int col0 = colt + wc * 32 + 8 * fq; const float* bp = bias + col0 + (colt >= shift_from ? bias_shift : 0);
        const bool isg = colt >= gate_from;
        f32x4 bv[2][2];
#pragma unroll
        for (int bj = 0; bj < 2; ++bj)
#pragma unroll
            for (int n = 0; n < 2; ++n) bv[bj][n] = *(const f32x4*)(bp + bj * HALF + 4 * n);
#pragma unroll
        for (int ai = 0; ai < 2; ++ai)
#pragma unroll
            for (int m = 0; m < 4; ++m) { bf16_t* rowp = O + (size_t)(row0 + ai * HALF + m * 16) * ldc + col0;
#pragma unroll
                for (int bj = 0; bj < 2; ++bj) { f32x4 v0 = acc[ai][bj][m][0] + bv[bj][0], v1 = acc[ai][bj][m][1] + bv[bj][1];
                    if (isg) {
#pragma unroll
                        for (int j = 0; j < 4; ++j) { v0[j] = 1.0f + __expf(-fmaxf(v0[j], -60.f)); v1[j] = 1.0f + __expf(-fmaxf(v1[j], -60.f)); } }
                    u32x4 w; w.x = cvt_pk_bf16(v0[0], v0[1]); w.y = cvt_pk_bf16(v0[2], v0[3]); w.z = cvt_pk_bf16(v1[0], v1[1]); w.w = cvt_pk_bf16(v1[2], v1[3]);
                    __builtin_nontemporal_store(w, (u32x4*)(rowp + bj * HALF)); } }
    }
};

struct EpiUpGate {
    static constexpr bool PERM = true, AFTER_DRAIN = false, MID = true; static constexpr int SEG = 16;
    bf16_t* O; int ldc; const bf16_t* G; int ldg;
    __device__ __forceinline__ void mid(f32x4 (&acc)[2][2][4][2], const Unit& u, int seg, int wr, int wc, int fr, int fq) const {
        const int row0 = u.pm * BM + wr * 64 + fr; const int col0 = u.pn * BM + wc * 32 + 8 * fq;
#pragma unroll
        for (int ai = 0; ai < 2; ++ai) { u32x4 ga[4][2], gb[4][2];
#pragma unroll
            for (int m = 0; m < 4; ++m) { const bf16_t* gp = G + (size_t)(row0 + ai * HALF + m * 16) * ldg + seg * 4096 + col0;
#pragma unroll
                for (int bj = 0; bj < 2; ++bj) { ga[m][bj] = *(const u32x4*)(gp + bj * HALF); gb[m][bj] = *(const u32x4*)(gp + 4096 + bj * HALF); } }
#pragma unroll
            for (int m = 0; m < 4; ++m)
#pragma unroll
                for (int bj = 0; bj < 2; ++bj) { const u32x4 a = ga[m][bj], b = gb[m][bj];
                    const unsigned aw[4] = {a.x, a.y, a.z, a.w}, bw[4] = {b.x, b.y, b.z, b.w};
#pragma unroll
                    for (int j = 0; j < 4; ++j) {
                        const float rl = bf_lo(bw[j]) * __builtin_amdgcn_rcpf(bf_lo(aw[j])), rh = bf_hi(bw[j]) * __builtin_amdgcn_rcpf(bf_hi(aw[j]));
                        acc[ai][bj][m][j >> 1][(j & 1) * 2] *= rl; acc[ai][bj][m][j >> 1][(j & 1) * 2 + 1] *= rh; } }
            asm volatile("" ::: "memory"); }
    }
    __device__ __forceinline__ void operator()(const f32x4 (&acc)[2][2][4][2], const Unit& u, int wr, int wc, int fr, int fq) const {
        const int row0 = u.pm * BM + wr * 64 + fr; const int col0 = u.pn * BM + wc * 32 + 8 * fq;
        u32x4 ga[2][4][2];
#pragma unroll
        for (int ai = 0; ai < 2; ++ai)
#pragma unroll
            for (int m = 0; m < 4; ++m) { const bf16_t* gp = G + (size_t)(row0 + ai * HALF + m * 16) * ldg + 3 * 4096 + col0;
#pragma unroll
                for (int bj = 0; bj < 2; ++bj) ga[ai][m][bj] = *(const u32x4*)(gp + bj * HALF); }
#pragma unroll
        for (int ai = 0; ai < 2; ++ai)
#pragma unroll
            for (int m = 0; m < 4; ++m) { const int row = row0 + ai * HALF + m * 16; bf16_t* rowp = O + (size_t)row * ldc + col0;
#pragma unroll
                for (int bj = 0; bj < 2; ++bj) { const u32x4 a = ga[ai][m][bj]; const unsigned aw[4] = {a.x, a.y, a.z, a.w}; float o[8];
#pragma unroll
                    for (int j = 0; j < 4; ++j) { const float gl = __builtin_amdgcn_rcpf(bf_lo(aw[j])), gh = __builtin_amdgcn_rcpf(bf_hi(aw[j]));
                        o[2 * j] = acc[ai][bj][m][j >> 1][(j & 1) * 2] * gl; o[2 * j + 1] = acc[ai][bj][m][j >> 1][(j & 1) * 2 + 1] * gh; }
                    u32x4 w; w.x = cvt_pk_bf16(o[0], o[1]); w.y = cvt_pk_bf16(o[2], o[3]); w.z = cvt_pk_bf16(o[4], o[5]); w.w = cvt_pk_bf16(o[6], o[7]);
                    *(u32x4*)(rowp + bj * HALF) = w; } }
    }
};

template <bool SB, bool DB> struct EpiResid {
    static constexpr bool PERM = true, AFTER_DRAIN = false, MID = false; static constexpr int SEG = 16;
    const void* src; void* dst;
    __device__ __forceinline__ void operator()(const f32x4 (&acc)[2][2][4][2], const Unit& u, int wr, int wc, int fr, int fq) const {
        const int row0 = u.pm * BM + wr * 64 + fr, col0 = u.pn * BM + wc * 32 + 8 * fq;
        if constexpr (SB) {
            u32x4 rs[2][4][2];
#pragma unroll
            for (int ai = 0; ai < 2; ++ai)
#pragma unroll
                for (int m = 0; m < 4; ++m)
#pragma unroll
                    for (int bj = 0; bj < 2; ++bj) rs[ai][m][bj] = *(const u32x4*)((const bf16_t*)src + (size_t)(row0 + ai * HALF + m * 16) * 4096 + col0 + bj * HALF);
#pragma unroll
            for (int ai = 0; ai < 2; ++ai)
#pragma unroll
                for (int m = 0; m < 4; ++m) { const size_t off = (size_t)(row0 + ai * HALF + m * 16) * 4096 + col0;
#pragma unroll
                    for (int bj = 0; bj < 2; ++bj) { const u32x4 a = rs[ai][m][bj];
                        const f32x4 v0 = (f32x4){bf_lo(a.x), bf_hi(a.x), bf_lo(a.y), bf_hi(a.y)} + acc[ai][bj][m][0], v1 = (f32x4){bf_lo(a.z), bf_hi(a.z), bf_lo(a.w), bf_hi(a.w)} + acc[ai][bj][m][1];
                        if constexpr (DB) { u32x4 w; w.x = cvt_pk_bf16(v0[0], v0[1]); w.y = cvt_pk_bf16(v0[2], v0[3]); w.z = cvt_pk_bf16(v1[0], v1[1]); w.w = cvt_pk_bf16(v1[2], v1[3]);
                            *(u32x4*)((bf16_t*)dst + off + bj * HALF) = w; }
                        else { *(f32x4*)((float*)dst + off + bj * HALF) = v0; *(f32x4*)((float*)dst + off + bj * HALF + 4) = v1; } } }
        } else {
#pragma unroll
            for (int ai = 0; ai < 2; ++ai) { f32x4 rs[4][2][2];
#pragma unroll
                for (int m = 0; m < 4; ++m)
#pragma unroll
                    for (int bj = 0; bj < 2; ++bj) { const float* sp = (const float*)src + (size_t)(row0 + ai * HALF + m * 16) * 4096 + col0 + bj * HALF; rs[m][bj][0] = *(const f32x4*)sp; rs[m][bj][1] = *(const f32x4*)(sp + 4); }
#pragma unroll
                for (int m = 0; m < 4; ++m) { const size_t off = (size_t)(row0 + ai * HALF + m * 16) * 4096 + col0;
#pragma unroll
                    for (int bj = 0; bj < 2; ++bj) { const f32x4 v0 = rs[m][bj][0] + acc[ai][bj][m][0], v1 = rs[m][bj][1] + acc[ai][bj][m][1];
                        if constexpr (DB) { u32x4 w; w.x = cvt_pk_bf16(v0[0], v0[1]); w.y = cvt_pk_bf16(v0[2], v0[3]); w.z = cvt_pk_bf16(v1[0], v1[1]); w.w = cvt_pk_bf16(v1[2], v1[3]);
                            *(u32x4*)((bf16_t*)dst + off + bj * HALF) = w; }
                        else { *(f32x4*)((float*)dst + off + bj * HALF) = v0; *(f32x4*)((float*)dst + off + bj * HALF + 4) = v1; } } }
                asm volatile("" ::: "memory"); }
        }
    }
};

struct EpiSwiGLU {
    static constexpr bool PERM = true, AFTER_DRAIN = false, MID = false; static constexpr int SEG = 16;
    bf16_t* O; int ldc;
    __device__ __forceinline__ void operator()(const f32x4 (&acc)[2][2][4][2], const Unit& u, int wr, int wc, int fr, int fq) const {
        const int row0 = u.pm * BM + wr * 64 + fr; const int col0 = u.pn * HALF + wc * 32 + 8 * fq;
#pragma unroll
        for (int ai = 0; ai < 2; ++ai)
#pragma unroll
            for (int m = 0; m < 4; ++m) { float o[8];
#pragma unroll
                for (int n = 0; n < 2; ++n)
#pragma unroll
                    for (int j = 0; j < 4; ++j) { const float gv = acc[ai][0][m][n][j], uv = acc[ai][1][m][n][j]; o[4 * n + j] = gv * fast_sigmoid(gv) * uv; }
                u32x4 w; w.x = cvt_pk_bf16(o[0], o[1]); w.y = cvt_pk_bf16(o[2], o[3]); w.z = cvt_pk_bf16(o[4], o[5]); w.w = cvt_pk_bf16(o[6], o[7]);
                __builtin_nontemporal_store(w, (u32x4*)(O + (size_t)(row0 + ai * HALF + m * 16) * ldc + col0)); }
    }
};
template <class Epi, class Sched, bool ALIGN_EPI = false, bool SP2 = false>
__device__ __forceinline__ void gemm_phase(PG8_LAS unsigned char* lds, const Gemm g, const Sched& S, const Epi& E, const int tid) {
    const int wid = __builtin_amdgcn_readfirstlane(tid >> 6), lane = tid & 63, wr = wid >> 2, wc = wid & 3, fr = lane & 15, fq = lane >> 4;
    const int K = g.K, nt = K / BK;
    unsigned voffA[2], voffB[2];
#pragma unroll
    for (int i = 0; i < 2; ++i) { int R, C; stage_rc(tid * 16 + i * 8192, R, C); const int Rb = Epi::PERM ? ((R & ~31) + perm32(R & 31)) : R;
        voffA[i] = (unsigned)(R * g.lda + C) * 2u; voffB[i] = (unsigned)(Rb * g.ldb + C) * 2u; }
    const size_t kstep = (size_t)(BK * 2);
    const size_t hstepA = (size_t)HALF * g.lda * 2, hstepB = (size_t)HALF * g.ldb * 2;
    const size_t tstepA = 2 * hstepA, tstepB = 2 * hstepB;
    const unsigned ldsw = (unsigned)wid * 1024u;
    const int aoff = lds_byte(wr * 64 + fr, fq * 8), boff = lds_byte(wc * 32 + fr, fq * 8);
#define PG8_SA(b, h) (((b) * 2 + (h)) * HTB)
#define PG8_SB(b, h) ((4 + (b) * 2 + (h)) * HTB)
#define PG8_STAGE(bufoff, gbase, voff) do { _Pragma("unroll") for (int _i = 0; _i < 2; ++_i) \
        __builtin_amdgcn_global_load_lds((const unsigned*)((const char*)(gbase) + (voff)[_i]), (PG8_LAS unsigned*)(lds + (bufoff) + ldsw + _i * 8192), 16, 0, 0); } while (0)
#define PG8_LDA(dst, b, h) do { _Pragma("unroll") for (int m = 0; m < 4; ++m) _Pragma("unroll") for (int k = 0; k < 2; ++k) dst[m][k] = *(const PG8_LAS bf16x8*)(lds + PG8_SA(b, h) + aoff + m * 2048 + k * 1024); } while (0)
#define PG8_LDB(dst, b, h) do { _Pragma("unroll") for (int n = 0; n < 2; ++n) _Pragma("unroll") for (int k = 0; k < 2; ++k) dst[n][k] = *(const PG8_LAS bf16x8*)(lds + PG8_SB(b, h) + boff + n * 2048 + k * 1024); } while (0)
#define PG8_MMA(ai, bj, At, Bt) do { __builtin_amdgcn_s_setprio(1); _Pragma("unroll") for (int m = 0; m < 4; ++m) _Pragma("unroll") for (int n = 0; n < 2; ++n) _Pragma("unroll") for (int k = 0; k < 2; ++k) \
        acc[ai][bj][m][n] = __builtin_amdgcn_mfma_f32_16x16x32_bf16(Bt[n][k], At[m][k], acc[ai][bj][m][n], 0, 0, 0); __builtin_amdgcn_s_setprio(0); } while (0)
#define PG8_WAIT_V(n) asm volatile("s_waitcnt vmcnt(" #n ")" ::: "memory")
#define PG8_WAIT_L(n) asm volatile("s_waitcnt lgkmcnt(" #n ")" ::: "memory")
#define PG8_BAR __builtin_amdgcn_s_barrier()
#define PG8_SCHED __builtin_amdgcn_sched_barrier(0)
    Unit cur, nxt; int ui = 0;
    if (!S.next(0, cur)) return;
    f32x4 acc[2][2][4][2];
#pragma unroll
    for (int a = 0; a < 2; ++a)
#pragma unroll
        for (int b = 0; b < 2; ++b)
#pragma unroll
            for (int m = 0; m < 4; ++m)
#pragma unroll
                for (int n = 0; n < 2; ++n) acc[a][b][m][n] = (f32x4){0.f, 0.f, 0.f, 0.f};
    bf16x8 At[4][2], B0[2][2], B1[2][2];
    const char* cA = (const char*)g.A + (size_t)cur.pm * tstepA; const char* cB = (const char*)g.Bt + (size_t)cur.pn * tstepB;
    S.a_ready(cur);
    if constexpr (SP2) {
        PG8_STAGE(PG8_SB(0, 0), cB, voffB); PG8_STAGE(PG8_SB(0, 1), cB + hstepB, voffB); PG8_STAGE(PG8_SA(0, 0), cA, voffA); PG8_STAGE(PG8_SA(0, 1), cA + hstepA, voffA);
        if (wr == 1) PG8_BAR;
        PG8_WAIT_V(2); PG8_BAR;
        PG8_STAGE(PG8_SB(1, 0), cB + kstep, voffB); PG8_STAGE(PG8_SA(1, 0), cA + kstep, voffA); PG8_STAGE(PG8_SB(1, 1), cB + hstepB + kstep, voffB);
        PG8_WAIT_V(6); PG8_BAR;
    } else {
        PG8_STAGE(PG8_SB(0, 0), cB, voffB); PG8_STAGE(PG8_SA(0, 0), cA, voffA); PG8_STAGE(PG8_SB(0, 1), cB + hstepB, voffB); PG8_STAGE(PG8_SA(0, 1), cA + hstepA, voffA);
        if (wr == 1) PG8_BAR;
        PG8_WAIT_V(4); PG8_BAR;
        PG8_STAGE(PG8_SB(1, 0), cB + kstep, voffB); PG8_STAGE(PG8_SA(1, 0), cA + kstep, voffA); PG8_STAGE(PG8_SB(1, 1), cB + hstepB + kstep, voffB);
        PG8_WAIT_V(6); PG8_BAR;
    }
    for (;;) {
        const bool has_next = S.next(ui + 1, nxt);
        const char* nA = has_next ? (const char*)g.A + (size_t)nxt.pm * tstepA : cA; const char* nB = has_next ? (const char*)g.Bt + (size_t)nxt.pn * tstepB : cB;
        for (int t = 0; t < nt; t += 2) {
            const bool last = (t == nt - 2);
            const char* a1 = cA + (size_t)(t + 1) * kstep;
            const char* a2 = last ? nA : cA + (size_t)(t + 2) * kstep; const char* b2 = last ? nB : cB + (size_t)(t + 2) * kstep;
            const char* a3 = a2 + kstep; const char* b3 = b2 + kstep;
            if (last && has_next) S.a_ready(nxt);
            if constexpr (SP2) {
            PG8_LDB(B0, 0, 0); PG8_LDB(B1, 0, 1); PG8_SCHED; PG8_LDA(At, 0, 0); PG8_STAGE(PG8_SA(1, 1), a1 + hstepA, voffA);
            PG8_WAIT_V(8); PG8_WAIT_L(0); PG8_BAR; PG8_MMA(0, 0, At, B0); PG8_MMA(0, 1, At, B1); PG8_BAR; PG8_SCHED;
            PG8_LDA(At, 0, 1); PG8_STAGE(PG8_SB(0, 0), b2, voffB); PG8_STAGE(PG8_SB(0, 1), b2 + hstepB, voffB); PG8_STAGE(PG8_SA(0, 0), a2, voffA);
            PG8_WAIT_V(8); PG8_WAIT_L(0); PG8_BAR; PG8_MMA(1, 0, At, B0); PG8_MMA(1, 1, At, B1); PG8_BAR; PG8_SCHED;
            PG8_LDB(B0, 1, 0); PG8_LDB(B1, 1, 1); PG8_SCHED; PG8_LDA(At, 1, 0); PG8_STAGE(PG8_SA(0, 1), a2 + hstepA, voffA);
            PG8_WAIT_V(8); PG8_WAIT_L(0); PG8_BAR; PG8_MMA(0, 0, At, B0); PG8_MMA(0, 1, At, B1); PG8_BAR; PG8_SCHED;
            PG8_LDA(At, 1, 1); PG8_STAGE(PG8_SB(1, 0), b3, voffB); PG8_STAGE(PG8_SB(1, 1), b3 + hstepB, voffB); PG8_STAGE(PG8_SA(1, 0), a3, voffA);
            PG8_WAIT_V(8); PG8_WAIT_L(0); PG8_BAR; PG8_MMA(1, 0, At, B0); PG8_MMA(1, 1, At, B1); PG8_BAR; PG8_SCHED;
            } else {
            PG8_LDB(B0, 0, 0); PG8_SCHED; PG8_LDA(At, 0, 0); PG8_STAGE(PG8_SA(1, 1), a1 + hstepA, voffA);
            PG8_WAIT_L(8); PG8_BAR; PG8_WAIT_L(0); PG8_MMA(0, 0, At, B0); PG8_BAR; PG8_SCHED;
            PG8_LDB(B1, 0, 1); PG8_STAGE(PG8_SB(0, 0), b2, voffB);
            PG8_BAR; PG8_WAIT_L(0); PG8_MMA(0, 1, At, B1); PG8_BAR;
            PG8_LDA(At, 0, 1); PG8_STAGE(PG8_SA(0, 0), a2, voffA);
            PG8_BAR; PG8_WAIT_L(0); PG8_MMA(1, 0, At, B0); PG8_BAR; PG8_SCHED;
            PG8_STAGE(PG8_SB(0, 1), b2 + hstepB, voffB);
            PG8_WAIT_V(6); PG8_BAR; PG8_MMA(1, 1, At, B1); PG8_BAR;
            PG8_LDB(B0, 1, 0); PG8_SCHED; PG8_LDA(At, 1, 0); PG8_STAGE(PG8_SA(0, 1), a2 + hstepA, voffA);
            PG8_WAIT_L(8); PG8_BAR; PG8_WAIT_L(0); PG8_MMA(0, 0, At, B0); PG8_BAR; PG8_SCHED;
            PG8_LDB(B1, 1, 1); PG8_STAGE(PG8_SB(1, 0), b3, voffB);
            PG8_BAR; PG8_WAIT_L(0); PG8_MMA(0, 1, At, B1); PG8_BAR;
            PG8_LDA(At, 1, 1); PG8_STAGE(PG8_SA(1, 0), a3, voffA);
            PG8_BAR; PG8_WAIT_L(0); PG8_MMA(1, 0, At, B0); PG8_BAR; PG8_SCHED;
            PG8_STAGE(PG8_SB(1, 1), b3 + hstepB, voffB);
            PG8_WAIT_V(6); PG8_BAR; PG8_MMA(1, 1, At, B1); PG8_BAR;
            }
            if constexpr (Epi::MID) { if (!last && ((t + 2) % Epi::SEG) == 0) E.mid(acc, cur, (t + 2) / Epi::SEG - 1, wr, wc, fr, fq); }
        }
        if constexpr (ALIGN_EPI) { if (wr == 0) PG8_BAR; }
        if constexpr (!Epi::AFTER_DRAIN) { E(acc, cur, wr, wc, fr, fq); S.done(cur); }
        if (!has_next) break;
#pragma unroll
        for (int a = 0; a < 2; ++a)
#pragma unroll
            for (int b = 0; b < 2; ++b)
#pragma unroll
                for (int m = 0; m < 4; ++m)
#pragma unroll
                    for (int n = 0; n < 2; ++n) acc[a][b][m][n] = (f32x4){0.f, 0.f, 0.f, 0.f};
        cur = nxt; cA = nA; cB = nB; ++ui;
        if constexpr (ALIGN_EPI) { if (wr == 1) PG8_BAR; }
    }
    PG8_WAIT_V(0);
    if constexpr (!ALIGN_EPI) { if (wr == 0) PG8_BAR; }
    PG8_BAR;
    if constexpr (Epi::AFTER_DRAIN) { E.fused(acc, cur, wr, wc, fr, fq, lds, wid, lane); S.done(cur); }
#undef PG8_SA
#undef PG8_SB
#undef PG8_STAGE
#undef PG8_LDA
#undef PG8_LDB
#undef PG8_MMA
#undef PG8_WAIT_V
#undef PG8_WAIT_L
#undef PG8_BAR
#undef PG8_SCHED
}
}
constexpr int D = 4096, TREAL = 8192, NMETA = 16, MROWS = 8448, METAROW = 8192;
constexpr int MIXW = 1024, NPROJ = 29696, NIN = 29704, DFF = 11008, NGU = 22016, NLAYER = 2;
constexpr int PC_MLQ = 0, PC_MLK = 1024, PC_MLV = 2048, PC_MLO = 3072, PC_SBQ = 4096, PC_SBK = 5120, PC_SBV = 6144, PC_HGQ = 7168, PC_HGF = 8192, PC_HGI = 9216, PC_HGG = 10240, PC_RGX = 11264, PC_RGY = 12288, PC_GATE = 13312;
constexpr int NCH = 65;
constexpr float EPS = 1e-6f, NEGF = -1e30f;
constexpr int NWAVES = 8, NTHR = 512;

constexpr size_t MiB = 1u << 20;
constexpr size_t al(size_t x) { return (x + MiB - 1) / MiB * MiB; }
constexpr size_t WS_CTL = 0, CTL_ZERO_BYTES = 1 * MiB;
constexpr size_t SZ_WIN = (size_t)NPROJ * D * 2, SZ_WSQ = (size_t)D * D * 2, SZ_WGU = (size_t)NGU * D * 2, SZ_WD = (size_t)D * DFF * 2;
constexpr size_t WS_WIN = 1 * MiB;
constexpr size_t WS_WUP = WS_WIN + al(2 * SZ_WIN);
constexpr size_t WS_WOUT = WS_WUP + al(2 * SZ_WSQ);
constexpr size_t WS_WGU = WS_WOUT + al(2 * SZ_WSQ);
constexpr size_t WS_WD = WS_WGU + al(2 * SZ_WGU);
constexpr size_t WS_PROJ = WS_WD + al(2 * SZ_WD);
constexpr size_t WS_ACT = WS_PROJ;
constexpr size_t WS_XN = WS_PROJ + al((size_t)MROWS * NPROJ * 2);
constexpr size_t WS_BR = WS_XN + al((size_t)MROWS * D * 2);
constexpr size_t WS_MG = WS_BR + al((size_t)MROWS * D * 2);
constexpr size_t WS_HMETA = WS_MG + al((size_t)MROWS * D * 2);
constexpr size_t WS_GIF = WS_HMETA + al((size_t)256 * D * 4);
constexpr size_t WS_WIF = WS_GIF + al((size_t)MROWS * 8 * 4);
constexpr size_t WS_LB = WS_WIF + al((size_t)2 * 8 * D * 4);
constexpr size_t WS_MLS = WS_LB + MiB;
constexpr size_t WS_MLN = WS_MLS + al((size_t)520 * 65536 * 4);
constexpr size_t WS_MLSC = WS_MLN + al((size_t)520 * 256 * 4);
constexpr size_t WS_HGS = WS_MLSC + MiB;
constexpr size_t WS_HGE = WS_HGS + al((size_t)1040 * 16384 * 4);
constexpr size_t WS_RGH = WS_HGE + al((size_t)1040 * 128 * 4);
constexpr size_t WS_RGP = WS_RGH + al((size_t)MROWS * 1024 * 4);
constexpr size_t WS_RGT = WS_RGP + al((size_t)MROWS * 1024 * 4);
constexpr size_t WS_MLCT = WS_RGT + al((size_t)3 * 2 * 65 * 1024 * 4);
constexpr size_t MLCT_UNIT = (size_t)17 * 8 * 64 * 8;
constexpr size_t WS_HB = WS_MLCT + al((size_t)520 * MLCT_UNIT * 2);
constexpr size_t WS_END = WS_HB + al((size_t)TREAL * D * 2);
static_assert(WS_END <= (size_t)2300 * MiB, "workspace map");
constexpr int CW_BAR = 4096;

constexpr int RING_BYTES = 131072;
constexpr int LDSCTL_OFF = RING_BYTES + 8192, MISC_OFF = LDSCTL_OFF + 320;
constexpr int LDS_BYTES = 147456;
static_assert(MISC_OFF + 128 <= LDS_BYTES, "LDS map");

#define GAS __attribute__((address_space(1)))
#define LAS __attribute__((address_space(3)))
typedef unsigned short bf16;
typedef unsigned v4u __attribute__((ext_vector_type(4)));
typedef unsigned v2u __attribute__((ext_vector_type(2)));
typedef float f32x4 __attribute__((ext_vector_type(4)));
typedef float f32x2 __attribute__((ext_vector_type(2)));
typedef GAS unsigned gu32;
#define RLX_AGENT __ATOMIC_RELAXED, __HIP_MEMORY_SCOPE_AGENT
#define LDS_WAIT() asm volatile("s_waitcnt lgkmcnt(0)" ::: "memory")
#define VM_WAIT() asm volatile("s_waitcnt vmcnt(0)" ::: "memory")
typedef float f32x2c_ __attribute__((ext_vector_type(2)));
typedef __bf16 bf16x2c_ __attribute__((ext_vector_type(2)));
__device__ __forceinline__ unsigned pk2(float lo, float hi) { const f32x2c_ v = {lo, hi}; const bf16x2c_ b = __builtin_convertvector(v, bf16x2c_); return __builtin_bit_cast(unsigned, b); }
__device__ __forceinline__ unsigned f2bf(float f) { const __bf16 b = (__bf16)f; return (unsigned)__builtin_bit_cast(unsigned short, b); }
__device__ __forceinline__ float bflo(unsigned w) { return __uint_as_float(w << 16); }
__device__ __forceinline__ float bfhi(unsigned w) { return __uint_as_float(w & 0xffff0000u); }
__device__ __forceinline__ float bf1(bf16 b) { return __uint_as_float(((unsigned)b) << 16); }
__device__ __forceinline__ void unpack8(const v4u w, float (&o)[8]) { o[0] = bflo(w.x); o[1] = bfhi(w.x); o[2] = bflo(w.y); o[3] = bfhi(w.y); o[4] = bflo(w.z); o[5] = bfhi(w.z); o[6] = bflo(w.w); o[7] = bfhi(w.w); }
__device__ __forceinline__ float wave_sum(float v) {
#pragma unroll
    for (int o = 1; o < 64; o <<= 1) v += __shfl_xor(v, o);
    return v;
}
__device__ __forceinline__ float wave_max(float v) {
#pragma unroll
    for (int o = 1; o < 64; o <<= 1) v = fmaxf(v, __shfl_xor(v, o));
    return v;
}
__device__ __forceinline__ float wave_incl_sum(float v, int lane) {
#pragma unroll
    for (int o = 1; o < 64; o <<= 1) { const float t = __shfl_up(v, o); if (lane >= o) v += t; }
    return v;
}
__device__ __forceinline__ float wave_incl_max(float v, int lane) {
#pragma unroll
    for (int o = 1; o < 64; o <<= 1) { const float t = __shfl_up(v, o); if (lane >= o) v = fmaxf(v, t); }
    return v;
}
__device__ __forceinline__ float sigmoidf_(float x) { return __builtin_amdgcn_rcpf(1.0f + __expf(-x)); }
__device__ __forceinline__ float log_sigmoidf_(float x) { return fminf(x, 0.f) - log1pf(expf(-fabsf(x))); }
__device__ __forceinline__ float softplusf_(float x) { return fmaxf(x, 0.f) + log1pf(expf(-fabsf(x))); }
__device__ __forceinline__ int seq_row(int b, int p) { return p < NMETA ? METAROW + p : b * 4096 + p - NMETA; }
#define XB_TMO      128
#define XB_XCNT(j)  (256  + 64 * (j))
#define XB_XSUB(j)  (1280 + 64 * (j))
#define XB_XGEN(j)  (2304 + 64 * (j))
#define XB_TOP      3328
#define XB_TOPGEN   3392
#define XCD_BAR_WORDS 3456
#define XB_SPIN_CAP (1u << 18)

__device__ __forceinline__ unsigned xb_ld(unsigned* p)              { return __hip_atomic_load(p, __ATOMIC_RELAXED, __HIP_MEMORY_SCOPE_AGENT); }
__device__ __forceinline__ unsigned xb_add(unsigned* p, unsigned v) { return __hip_atomic_fetch_add(p, v, __ATOMIC_RELAXED, __HIP_MEMORY_SCOPE_AGENT); }
__device__ __forceinline__ unsigned xb_xcc_id() { return (unsigned)__builtin_amdgcn_s_getreg((3 << 11) | 20) & 0xFu; }
#define XB_SPIN(cond, bar) do { unsigned _sp = 0; while (cond) { __builtin_amdgcn_s_sleep(1); \
    if ((++_sp & 255u) == 0u) { if (xb_ld(&(bar)[XB_TMO])) break; if (_sp > XB_SPIN_CAP) { atomicAdd(&(bar)[XB_TMO], 1u); break; } } } } while (0)

struct XcdBarrier {
    unsigned* bar; unsigned x;
    volatile LAS unsigned* st;
};

__device__ __forceinline__ XcdBarrier xcd_barrier_post(unsigned* bar, volatile LAS unsigned* st) {
    XcdBarrier b; b.bar = bar; b.x = xb_xcc_id(); b.st = st;
    if (threadIdx.x == 0) (void)xb_add(&bar[XB_XCNT(b.x)], 1u);
    return b;
}
__device__ __forceinline__ void xcd_barrier_complete(unsigned* bar, unsigned x, unsigned& nloc, unsigned& nx) {
    const unsigned G = gridDim.x * gridDim.y * gridDim.z;
    unsigned sum, cnt, mine, sp = 0u;
    for (;;) {
        sum = 0u; cnt = 0u; mine = 0u;
#pragma unroll
        for (unsigned j = 0; j < 16; ++j) { const unsigned c = xb_ld(&bar[XB_XCNT(j)]); sum += c; cnt += (c > 0u) ? 1u : 0u; mine = (j == x) ? c : mine; }
        if (sum == G) break;
        __builtin_amdgcn_s_sleep(1);
        if ((++sp & 255u) == 0u) { if (xb_ld(&bar[XB_TMO])) break; if (sp > XB_SPIN_CAP) { atomicAdd(&bar[XB_TMO], 1u); break; } }
    }
    nloc = mine > 0u ? mine : 1u; nx = cnt > 0u ? cnt : 1u;
}

__device__ __forceinline__ void xcd_barrier(const XcdBarrier& b) {
    asm volatile("s_waitcnt vmcnt(0)" ::: "memory");
    __syncthreads();
    if (threadIdx.x == 0) {
        unsigned* bar = b.bar;
        __builtin_amdgcn_s_waitcnt(0);
        unsigned nloc = b.st[0], nx = b.st[1];
        if (nloc == 0u) { xcd_barrier_complete(bar, b.x, nloc, nx); b.st[0] = nloc; b.st[1] = nx; }
        const unsigned old = xb_add(&bar[XB_XSUB(b.x)], 1u);
        const unsigned gen = old / nloc;
        if (old + 1u == (gen + 1u) * nloc) {
            __builtin_amdgcn_fence(__ATOMIC_RELEASE, "agent");
            asm volatile("s_waitcnt vmcnt(0)" ::: "memory");
            const unsigned og = xb_add(&bar[XB_TOP], 1u);
            const unsigned tg = og / nx;
            if (og + 1u == (tg + 1u) * nx) xb_add(&bar[XB_TOPGEN], 1u);
            else XB_SPIN(xb_ld(&bar[XB_TOPGEN]) == tg, bar);
            __builtin_amdgcn_fence(__ATOMIC_ACQUIRE, "agent");
            xb_add(&bar[XB_XGEN(b.x)], 1u);
            asm volatile("s_waitcnt vmcnt(0)" ::: "memory");
        } else {
            XB_SPIN(xb_ld(&bar[XB_XGEN(b.x)]) == gen, bar);
            __builtin_amdgcn_fence(__ATOMIC_ACQUIRE, "agent");
            asm volatile("s_waitcnt vmcnt(0)" ::: "memory");
        }
    }
    __syncthreads();
}
template <int N> __device__ __forceinline__ float dpp_shr16(float v) { return __builtin_bit_cast(float, __builtin_amdgcn_update_dpp(0, __builtin_bit_cast(int, v), 0x110 + N, 0xf, 0xf, true)); }
typedef __bf16 bf16x2v __attribute__((ext_vector_type(2)));
__device__ __forceinline__ float dot2bf(unsigned a, unsigned b, float acc) { return __builtin_amdgcn_fdot2_f32_bf16(__builtin_bit_cast(bf16x2v, a), __builtin_bit_cast(bf16x2v, b), acc, false); }
typedef short bf16x8v __attribute__((ext_vector_type(8)));
#define MFMA16(a, b, c) __builtin_amdgcn_mfma_f32_16x16x32_bf16(a, b, c, 0, 0, 0)
__device__ __forceinline__ bf16x8v pack8(const float (&x)[8]) { v4u w; w.x = pk2(x[0], x[1]); w.y = pk2(x[2], x[3]); w.z = pk2(x[4], x[5]); w.w = pk2(x[6], x[7]); return __builtin_bit_cast(bf16x8v, w); }
__device__ __forceinline__ float fast_sigmoid_(float x) { return __builtin_amdgcn_rcpf(1.0f + __expf(-x)); }
struct P0Item { const float* src; bf16* dst; int ldw, K; };
struct P0Strip { const float* src0; bf16* dst0; int ldw, K, kb_lo, kb_n; };
constexpr int NSTRIP_DN = 2 * NLAYER * 64, NSTRIP_L = 464 + 344 + 64 + 64, NSTRIP = NSTRIP_DN + NLAYER * NSTRIP_L;
__device__ __forceinline__ P0Strip p0_strip(const float* const* in, unsigned char* ws, int s) {
    P0Strip o;
    if (s < NSTRIP_DN) { const int l = s >> 7, rem = s & 127, nb = rem >> 1, half = rem & 1;
        o.ldw = D; o.K = DFF; o.src0 = in[22] + (size_t)l * DFF * D + 64 * nb; o.dst0 = (bf16*)(ws + WS_WD + (size_t)l * SZ_WD) + (size_t)(64 * nb) * DFF; o.kb_lo = 86 * half; o.kb_n = 86; return o; }
    s -= NSTRIP_DN; const int l = s / NSTRIP_L; int r = s - l * NSTRIP_L; o.K = D; o.kb_lo = 0; o.kb_n = 64;
    if (r < 464) { o.ldw = NIN; o.src0 = in[4] + (size_t)l * D * NIN + 64 * r + (r >= 64 ? 8 : 0); o.dst0 = (bf16*)(ws + WS_WIN + (size_t)l * SZ_WIN) + (size_t)(64 * r) * D; return o; } r -= 464;
    if (r < 344) { const int which = r / 172, nb = r % 172, n0 = 64 * nb; o.ldw = DFF; o.src0 = in[20 + which] + (size_t)l * D * DFF + n0; o.dst0 = (bf16*)(ws + WS_WGU + (size_t)l * SZ_WGU) + (size_t)((n0 >> 7) * 256 + which * 128 + (n0 & 127)) * D; return o; } r -= 344;
    if (r < 64) { o.ldw = D; o.src0 = in[18] + (size_t)l * D * D + 64 * r; o.dst0 = (bf16*)(ws + WS_WUP + (size_t)l * SZ_WSQ) + (size_t)(64 * r) * D; return o; } r -= 64;
    { o.ldw = D; o.src0 = in[19] + (size_t)l * D * D + 64 * r; o.dst0 = (bf16*)(ws + WS_WOUT + (size_t)l * SZ_WSQ) + (size_t)(64 * r) * D; return o; }
}
__device__ __forceinline__ P0Item p0_item(const P0Strip& S, int kb) { P0Item o; o.src = S.src0 + (size_t)(64 * kb) * S.ldw; o.dst = S.dst0 + 64 * kb; o.ldw = S.ldw; o.K = S.K; return o; }
__device__ __forceinline__ void p0_load(const P0Item& I, f32x4 (&v)[16], int lane) {
    const float* p = I.src + (size_t)(2 * (lane >> 4)) * I.ldw + 4 * (lane & 15);
#pragma unroll
#if defined(P0_NT)
    for (int j = 0; j < 16; ++j) v[j] = __builtin_nontemporal_load((const f32x4*)(p + (size_t)(8 * (j >> 1) + (j & 1)) * I.ldw));
#else
    for (int j = 0; j < 16; ++j) v[j] = *(const f32x4*)(p + (size_t)(8 * (j >> 1) + (j & 1)) * I.ldw);
#endif
}
__device__ __forceinline__ void p0_store(const P0Item& I, const f32x4 (&v)[16], unsigned* scr, int lane) {
    const int l15 = lane & 15, l4 = lane >> 4;
#pragma unroll
    for (int m = 0; m < 8; ++m)
#pragma unroll
        for (int i = 0; i < 4; ++i) scr[(4 * l15 + i) * 33 + 4 * m + l4] = pk2(v[2 * m][i], v[2 * m + 1][i]);
    LDS_WAIT(); asm volatile("" ::: "memory");
    const int c = lane & 7;
#pragma unroll
    for (int j = 0; j < 8; ++j) { const int n = (lane >> 3) + 8 * j; const unsigned* s = scr + n * 33 + 4 * c;
        v4u o; o.x = s[0]; o.y = s[1]; o.z = s[2]; o.w = s[3];
        *(v4u*)(I.dst + (size_t)n * I.K + 8 * c) = o; }
    LDS_WAIT(); asm volatile("" ::: "memory");
}
__device__ __forceinline__ void p0_prologue(const float* const* in, unsigned char* ws, unsigned char* lds, int bxp, int Gp, int wave, int lane, int gtid, int NGT) {
    unsigned* scr = (unsigned*)(lds + wave * 16384);
    const float* w_in = in[4];
#if defined(PROBE_P0_STORES)
    for (int sidx = bxp; sidx < NSTRIP; sidx += Gp) { const P0Strip S = p0_strip(in, ws, sidx); const int hi = S.kb_lo + S.kb_n;
        for (int kb = S.kb_lo + wave; kb < hi; kb += NWAVES) { const P0Item I = p0_item(S, kb); const int c = lane & 7;
#pragma unroll
            for (int j = 0; j < 8; ++j) { const int n = (lane >> 3) + 8 * j; *(v4u*)(I.dst + (size_t)n * I.K + 8 * c) = (v4u){(unsigned)kb, (unsigned)j, 0u, 0u}; } } }
    VM_WAIT(); __syncthreads();
#endif
#if defined(PROBE_P0_LOADS)
    for (int sidx = bxp; sidx < NSTRIP; sidx += Gp) { const P0Strip S = p0_strip(in, ws, sidx); const int hi = S.kb_lo + S.kb_n; f32x4 va[16];
        for (int kb = S.kb_lo + wave; kb < hi; kb += NWAVES) { p0_load(p0_item(S, kb), va, lane);
#pragma unroll
            for (int j = 0; j < 16; ++j) asm volatile("" :: "v"(va[j])); } }
    VM_WAIT(); __syncthreads();
#endif
    for (int sidx = bxp; sidx < NSTRIP; sidx += Gp) {
        const P0Strip S = p0_strip(in, ws, sidx); const int hi = S.kb_lo + S.kb_n; int kb = S.kb_lo + wave; f32x4 va[16], vb[16];
        if (kb < hi) p0_load(p0_item(S, kb), va, lane);
        while (kb < hi) {
            const int k1 = kb + NWAVES; if (k1 < hi) p0_load(p0_item(S, k1), vb, lane);
            p0_store(p0_item(S, kb), va, scr, lane);
            if (k1 >= hi) break;
            const int k2 = k1 + NWAVES; if (k2 < hi) p0_load(p0_item(S, k2), va, lane);
            p0_store(p0_item(S, k1), vb, scr, lane);
            kb = k2; }
    }
    { float* hm = (float*)(ws + WS_HMETA); const float* meta = in[1];
      for (int i = gtid; i < 256 * D; i += NGT) hm[i] = (i < NMETA * D) ? meta[i] : 0.f; }
    { unsigned* brp = (unsigned*)(ws + WS_BR + (size_t)(TREAL + NMETA) * D * 2);
      for (int i = gtid; i < (MROWS - TREAL - NMETA) * D / 2; i += NGT) brp[i] = 0u; }
    { float* wif = (float*)(ws + WS_WIF);
      for (int it = bxp * NWAVES + wave; it < NLAYER * 64; it += Gp * NWAVES) { const int l = it >> 6, k = 64 * (it & 63) + lane;
          const float* p = w_in + ((size_t)l * D + k) * NIN + 4096; const f32x4 a = *(const f32x4*)p, b = *(const f32x4*)(p + 4);
          float* wq = wif + (size_t)l * 8 * D + k;
          wq[0] = a.x; wq[D] = a.y; wq[2 * D] = a.z; wq[3 * D] = a.w; wq[4 * D] = b.x; wq[5 * D] = b.y; wq[6 * D] = b.z; wq[7 * D] = b.w; } }
    { float* lb = (float*)(ws + WS_LB); const float* hl = in[9];
      for (int i = gtid; i < 1024; i += NGT) { const float a0 = hl[i], a1 = hl[1024 + i], mx = fmaxf(a0, a1), e0 = expf(a0 - mx), e1 = expf(a1 - mx); const float p1 = e1 / (e0 + e1);
          lb[i] = 0.f; lb[1024 + i] = fminf(fmaxf(p1, 0.f), 0.999f); } }
}

template <bool GATES, bool HBF> __device__ __forceinline__ void norm_rows(const void* hreal, const float* hmeta, const float* gain, bf16* XN, int nrows, const float* wif_g, const float* bif, float* gif, int gw, int NGW, int lane, unsigned char* lds, int tid) {
    const float* wif = (const float*)lds;
    if (GATES) {
        for (int i = tid; i < 8 * D / 4; i += NTHR) *(f32x4*)(lds + (size_t)i * 16) = *(const f32x4*)(wif_g + (size_t)i * 4);
        __syncthreads(); }
    for (int row = gw; row < nrows; row += NGW) {
        f32x4 v[16]; float ss = 0.f;
        const bool real_bf = HBF && row < TREAL;
        const float* hr = row < TREAL ? (const float*)hreal + (size_t)row * D : hmeta + (size_t)(row - TREAL) * D;
        const bf16* hb = (const bf16*)hreal + (size_t)row * D;
#pragma unroll
        for (int j = 0; j < 8; ++j) {
            if (real_bf) { const v4u a = *(const v4u*)(hb + 512 * j + 8 * lane); v[2 * j] = (f32x4){bflo(a.x), bfhi(a.x), bflo(a.y), bfhi(a.y)}; v[2 * j + 1] = (f32x4){bflo(a.z), bfhi(a.z), bflo(a.w), bfhi(a.w)}; }
            else { const float* p = hr + 512 * j + 8 * lane; v[2 * j] = *(const f32x4*)p; v[2 * j + 1] = *(const f32x4*)(p + 4); }
            ss += (v[2 * j].x * v[2 * j].x + v[2 * j].y * v[2 * j].y) + (v[2 * j].z * v[2 * j].z + v[2 * j].w * v[2 * j].w) + (v[2 * j + 1].x * v[2 * j + 1].x + v[2 * j + 1].y * v[2 * j + 1].y) + (v[2 * j + 1].z * v[2 * j + 1].z + v[2 * j + 1].w * v[2 * j + 1].w); }
        const float rstd = __builtin_amdgcn_rsqf(wave_sum(ss) * (1.0f / D) + EPS);
#pragma unroll
        for (int j = 0; j < 8; ++j) { const float* gp = gain + 512 * j + 8 * lane; const f32x4 g0 = *(const f32x4*)gp, g1 = *(const f32x4*)(gp + 4);
            v[2 * j] = v[2 * j] * rstd * g0; v[2 * j + 1] = v[2 * j + 1] * rstd * g1;
            v4u o; o.x = pk2(v[2 * j].x, v[2 * j].y); o.y = pk2(v[2 * j].z, v[2 * j].w); o.z = pk2(v[2 * j + 1].x, v[2 * j + 1].y); o.w = pk2(v[2 * j + 1].z, v[2 * j + 1].w);
            *(v4u*)(XN + (size_t)row * D + 512 * j + 8 * lane) = o; }
        if (GATES) { float mine = 0.f;
#pragma unroll 1
            for (int jj = 0; jj < 8; ++jj) { float dot = 0.f; const float* wp = wif + jj * D + 8 * lane;
#pragma unroll
                for (int j = 0; j < 8; ++j) { const f32x4 w0 = *(const f32x4*)(wp + 512 * j), w1 = *(const f32x4*)(wp + 512 * j + 4);
                    dot += (v[2 * j].x * w0.x + v[2 * j].y * w0.y) + (v[2 * j].z * w0.z + v[2 * j].w * w0.w) + (v[2 * j + 1].x * w1.x + v[2 * j + 1].y * w1.y) + (v[2 * j + 1].z * w1.z + v[2 * j + 1].w * w1.w); }
                dot = wave_sum(dot); if (lane == jj) mine = dot + bif[jj]; }
            if (lane < 8) gif[(size_t)row * 8 + lane] = mine; }
    }
}

__device__ __forceinline__ void mlstm_A(const bf16* PROJ, const float* GIF, float* MLS, float* MLN, float* MLSC, int u, unsigned char* lds, int tid) {
    const int c = u % NCH, bh = u / NCH, h = bh & 3, b = bh >> 2, lane = tid & 63, wave = tid >> 6, lc = lane & 15, g = lane >> 4;
    constexpr int QP = 264;
    bf16* kw = (bf16*)lds; bf16* vs = (bf16*)(lds + 33792); float* wsc = (float*)(lds + RING_BYTES);
    if (tid < 64) {
        const int p = 64 * c + lane - 48; float lf = 0.f, li = NEGF;
        if (p >= 0) { const int row = seq_row(b, p); li = GIF[(size_t)row * 8 + h]; lf = log_sigmoidf_(GIF[(size_t)row * 8 + 4 + h]); }
        const float bc = wave_incl_sum(lf, lane); const float bend = __shfl(bc, 63);
        const float wl = bend - bc + li; const float a = wave_max(wl);
        wsc[lane] = expf(wl - a);
        if (lane == 0) { MLSC[u] = a; MLSC[520 + u] = bend; }
    }
    __syncthreads();
#pragma unroll
    for (int j = 0; j < 4; ++j) { const int id = tid + 512 * j, r = id >> 5, cp = id & 31, p = 64 * c + r - 48;
        v4u vr = (v4u){0u, 0u, 0u, 0u}; float kv[8];
#pragma unroll
        for (int q = 0; q < 8; ++q) kv[q] = 0.f;
        if (p >= 0) { const size_t ro = (size_t)seq_row(b, p) * NPROJ + h * 256 + cp * 8; unpack8(*(const v4u*)(PROJ + ro + PC_MLK), kv); vr = *(const v4u*)(PROJ + ro + PC_MLV); const float w = wsc[r];
#pragma unroll
            for (int q = 0; q < 8; ++q) kv[q] *= w; }
        *(bf16x8v*)(kw + r * QP + cp * 8) = pack8(kv); *(v4u*)(vs + r * QP + cp * 8) = vr; }
    __syncthreads();
    bf16x8v af[2][2];
#pragma unroll
    for (int dt = 0; dt < 2; ++dt)
#pragma unroll
        for (int ks = 0; ks < 2; ++ks)
#pragma unroll
            for (int i = 0; i < 8; ++i) af[dt][ks][i] = (short)kw[(32 * ks + 8 * g + i) * QP + 32 * wave + 16 * dt + lc];
    bf16* out = (bf16*)MLS + (size_t)u * MLCT_UNIT;
    for (int et = 0; et < 17; ++et) { bf16x8v bv[2];
#pragma unroll
        for (int ks = 0; ks < 2; ++ks)
#pragma unroll
            for (int i = 0; i < 8; ++i) bv[ks][i] = (et < 16) ? (short)vs[(32 * ks + 8 * g + i) * QP + 16 * et + lc] : ((lc == 0) ? (short)0x3F80 : (short)0);
#pragma unroll
        for (int dt = 0; dt < 2; ++dt) { f32x4 acc = (f32x4){0.f, 0.f, 0.f, 0.f};
#pragma unroll
            for (int ks = 0; ks < 2; ++ks) acc = MFMA16(af[dt][ks], bv[ks], acc);
            const int d0 = 32 * wave + 16 * dt + 4 * g;
            if (et < 16) { v2u w; w.x = pk2(acc[0], acc[1]); w.y = pk2(acc[2], acc[3]);
                *(v2u*)(out + ((size_t)(et * 8 + wave) * 64 + lc + 16 * (2 * dt + (g >> 1))) * 8 + 4 * (g & 1)) = w; }
            else if (lc == 0) {
#pragma unroll
                for (int r = 0; r < 4; ++r) MLN[(size_t)u * 256 + d0 + r] = acc[r]; } } }
    __syncthreads();
}
__device__ __forceinline__ void mlstm_B(const float* MLS, const float* MLN, float* MLSC, bf16* MLCT, int unit, unsigned char* lds, int tid) {
    const int chain = unit >> 5, slice = unit & 31;
    float* alpha = (float*)lds; float* beta = alpha + 80; float* av = alpha + 160; float* bv = alpha + 240; float* mm = alpha + 320;
    if (tid < NCH) { av[tid] = MLSC[chain * NCH + tid]; bv[tid] = MLSC[520 + chain * NCH + tid]; }
    __syncthreads();
    if (tid == 0) { float m = 0.f;
        for (int c = 0; c < NCH; ++c) { mm[c] = m; m = fmaxf(bv[c] + m, av[c]); } mm[NCH] = m; }
    __syncthreads();
    if (tid < NCH) { const float m = mm[tid], mn = mm[tid + 1]; alpha[tid] = __expf(bv[tid] + m - mn); beta[tid] = __expf(av[tid] - mn); if (slice == 0) MLSC[1040 + chain * NCH + tid] = m; }
    __syncthreads();
    { const int gid = slice * 512 + tid, e = gid & 255, d4 = gid >> 8; float st[4];
#pragma unroll
      for (int i = 0; i < 4; ++i) st[i] = 0.f;
      const size_t fo = ((size_t)((e >> 4) * 8 + (d4 >> 3)) * 64 + (e & 15) + 16 * ((d4 >> 1) & 3)) * 8 + 4 * (d4 & 1);
#pragma unroll 4
      for (int c = 0; c < NCH; ++c) { const size_t uu = (size_t)chain * NCH + c; const v2u dw = *(const v2u*)((const bf16*)MLS + uu * MLCT_UNIT + fo); const float dl[4] = {bflo(dw.x), bfhi(dw.x), bflo(dw.y), bfhi(dw.y)};
          v2u w; w.x = pk2(st[0], st[1]); w.y = pk2(st[2], st[3]); *(v2u*)(MLCT + uu * MLCT_UNIT + fo) = w;
          const float al_ = alpha[c], be_ = beta[c];
#pragma unroll
          for (int i = 0; i < 4; ++i) st[i] = st[i] * al_ + dl[i] * be_; } }
    if (slice == 0) { const int ks = tid >> 6, l = tid & 63; const bool own = (l & 15) == 0; const int d0 = 32 * ks + 8 * (l >> 4); float st[8];
#pragma unroll
      for (int i = 0; i < 8; ++i) st[i] = 0.f;
#pragma unroll 5
      for (int c = 0; c < NCH; ++c) { const size_t uu = (size_t)chain * NCH + c; const f32x4 n0 = *(const f32x4*)(MLN + uu * 256 + d0), n1 = *(const f32x4*)(MLN + uu * 256 + d0 + 4);
          const float sel = own ? 1.f : 0.f; const float dl[8] = {n0.x * sel, n0.y * sel, n0.z * sel, n0.w * sel, n1.x * sel, n1.y * sel, n1.z * sel, n1.w * sel};
          *(bf16x8v*)(MLCT + uu * MLCT_UNIT + ((size_t)(16 * 8 + ks) * 64 + l) * 8) = pack8(st);
          const float al_ = alpha[c], be_ = beta[c];
#pragma unroll
          for (int i = 0; i < 8; ++i) st[i] = st[i] * al_ + dl[i] * be_; } }
    __syncthreads();
}
template <bool DEN> __device__ __forceinline__ void ml_tile(const bf16* CT, const bf16* Qs, const bf16* Sp, const bf16* Vs, const float* inter, int j, f32x4 (&acc)[4], int lane) {
    constexpr int QP = 264, SP = 72; const int lc = lane & 15, g = lane >> 4;
    bf16x8v bfr[8];
#pragma unroll
    for (int ks = 0; ks < 8; ++ks) bfr[ks] = *(const bf16x8v*)(CT + ((size_t)(j * 8 + ks) * 64 + lane) * 8);
#pragma unroll
    for (int m = 0; m < 4; ++m) acc[m] = (f32x4){0.f, 0.f, 0.f, 0.f};
#pragma unroll
    for (int ks = 0; ks < 8; ++ks) {
#pragma unroll
        for (int m = 0; m < 4; ++m) acc[m] = MFMA16(*(const bf16x8v*)(Qs + (16 * m + lc) * QP + 32 * ks + 8 * g), bfr[ks], acc[m]);
        asm volatile("" ::: "memory"); }
#pragma unroll
    for (int m = 0; m < 4; ++m)
#pragma unroll
        for (int r = 0; r < 4; ++r) acc[m][r] *= inter[16 * m + 4 * g + r];
#pragma unroll
    for (int ks = 0; ks < 2; ++ks) { bf16x8v vf;
        if (!DEN) {
#pragma unroll
            for (int i = 0; i < 8; ++i) vf[i] = (short)Vs[(32 * ks + 8 * g + i) * QP + 16 * j + lc]; }
        else {
#pragma unroll
            for (int i = 0; i < 8; ++i) vf[i] = (lc == 0) ? (short)0x3F80 : (short)0; }
#pragma unroll
        for (int m = 0; m < 4; ++m) acc[m] = MFMA16(*(const bf16x8v*)(Sp + (16 * m + lc) * SP + 32 * ks + 8 * g), vf, acc[m]);
        asm volatile("" ::: "memory"); }
}
__device__ __forceinline__ void mlstm_C(const bf16* PROJ, const float* GIF, const bf16* MLCT, const float* MLSC, const float* ml_norm, bf16* BRp, int u, unsigned char* lds, int tid) {
    const int c = u % NCH, bh = u / NCH, h = bh & 3, b = bh >> 2, lane = tid & 63, wave = tid >> 6, lc = lane & 15, g = lane >> 4;
    constexpr int QP = 264, SP = 72;
    bf16* Qs = (bf16*)lds; bf16* Ks = (bf16*)(lds + 33792); bf16* Vs = (bf16*)(lds + 67584); bf16* Sp = (bf16*)(lds + 101376);
    float* bcs = (float*)(lds + RING_BYTES); float* lis = bcs + 64; float* mout = lis + 64; float* inter = mout + 64; float* den = inter + 64; float* rstd = den + 64; float* part = rstd + 64;
    if (tid < 64) {
        const int p = 64 * c + lane - 48; float lf = 0.f, li = NEGF;
        if (p >= 0) { const int row = seq_row(b, p); li = GIF[(size_t)row * 8 + h]; lf = log_sigmoidf_(GIF[(size_t)row * 8 + 4 + h]); }
        const float bc = wave_incl_sum(lf, lane); const float pm = wave_incl_max(li - bc, lane); const float mc = MLSC[1040 + u];
        const float mo = fmaxf(bc + mc, bc + pm);
        bcs[lane] = bc; lis[lane] = li; mout[lane] = mo; inter[lane] = expf(bc + mc - mo) * 0.0625f;
    }
#pragma unroll
    for (int j = 0; j < 4; ++j) { const int id = tid + 512 * j, r = id >> 5, cp = id & 31, p = 64 * c + r - 48;
        v4u qr = (v4u){0u, 0u, 0u, 0u}, kr = qr, vr = qr;
        if (p >= 0) { const size_t ro = (size_t)seq_row(b, p) * NPROJ + h * 256 + cp * 8; qr = *(const v4u*)(PROJ + ro + PC_MLQ); kr = *(const v4u*)(PROJ + ro + PC_MLK); vr = *(const v4u*)(PROJ + ro + PC_MLV); }
        *(v4u*)(Qs + r * QP + cp * 8) = qr; *(v4u*)(Ks + r * QP + cp * 8) = kr; *(v4u*)(Vs + r * QP + cp * 8) = vr; }
    __syncthreads();
    {
        const int tr = wave >> 1;
#pragma unroll
        for (int q = 0; q < 2; ++q) { const int tc = 2 * (wave & 1) + q; f32x4 a = (f32x4){0.f, 0.f, 0.f, 0.f};
#pragma unroll
            for (int ks = 0; ks < 8; ++ks) a = MFMA16(*(const bf16x8v*)(Qs + (16 * tr + lc) * QP + 32 * ks + 8 * g), *(const bf16x8v*)(Ks + (16 * tc + lc) * QP + 32 * ks + 8 * g), a);
            const int s = 16 * tc + lc; const float bs = bcs[s], ls = lis[s];
#pragma unroll
            for (int r = 0; r < 4; ++r) { const int t = 16 * tr + 4 * g + r; float val = 0.f; if (s <= t) val = a[r] * 0.0625f * __expf(bcs[t] - bs + ls - mout[t]);
                Sp[t * SP + s] = (bf16)f2bf(val); } } }
    __syncthreads();
    const bf16* CT = MLCT + (size_t)u * MLCT_UNIT;
    if (wave == 0) { f32x4 ad[4]; ml_tile<true>(CT, Qs, Sp, Vs, inter, 16, ad, lane);
        if (lc == 0) {
#pragma unroll
            for (int m = 0; m < 4; ++m)
#pragma unroll
                for (int r = 0; r < 4; ++r) den[16 * m + 4 * g + r] = ad[m][r]; } }
    f32x4 a0[4], a1[4];
    ml_tile<false>(CT, Qs, Sp, Vs, inter, wave, a0, lane); ml_tile<false>(CT, Qs, Sp, Vs, inter, wave + 8, a1, lane);
    __syncthreads();
#pragma unroll
    for (int m = 0; m < 4; ++m)
#pragma unroll
        for (int r = 0; r < 4; ++r) { const int t = 16 * m + 4 * g + r; const float dinv = __builtin_amdgcn_rcpf(fmaxf(fabsf(den[t]), __expf(-mout[t])));
            a0[m][r] *= dinv; a1[m][r] *= dinv; float sq = a0[m][r] * a0[m][r] + a1[m][r] * a1[m][r];
            sq += __shfl_xor(sq, 1); sq += __shfl_xor(sq, 2); sq += __shfl_xor(sq, 4); sq += __shfl_xor(sq, 8);
            if (lc == 0) part[wave * 64 + t] = sq; }
    __syncthreads();
    if (tid < 64) { float sq = 0.f;
#pragma unroll
        for (int w = 0; w < 8; ++w) sq += part[w * 64 + tid];
        rstd[tid] = __builtin_amdgcn_rsqf(sq * (1.0f / 256.0f) + EPS); }
    __syncthreads();
    { const int e0 = 16 * wave + lc, e1 = e0 + 128; const float g0 = ml_norm[h * 256 + e0], g1 = ml_norm[h * 256 + e1];
#pragma unroll
      for (int m = 0; m < 4; ++m)
#pragma unroll
          for (int r = 0; r < 4; ++r) { const int t = 16 * m + 4 * g + r, p = 64 * c + t - 48;
              if (p >= 0 && (c > 0 || b == 0)) { const int row = seq_row(b, p); const bf16* op = PROJ + (size_t)row * NPROJ + PC_MLO + h * 256; bf16* bp = BRp + (size_t)row * D + h * 256;
                  bp[e0] = (bf16)f2bf(a0[m][r] * rstd[t] * g0 * sigmoidf_(bf1(op[e0]))); bp[e1] = (bf16)f2bf(a1[m][r] * rstd[t] * g1 * sigmoidf_(bf1(op[e1]))); } } }
    __syncthreads();
}

__device__ __forceinline__ void hg_cumsum(const bf16* PROJ, const float* LB, int b, int h, int c, float* bcs, float* kks, int d) {
    const float lb = LB[h * 128 + d]; float bacc = 0.f;
    for (int t = 0; t < 64; ++t) { const int p = 64 * c + t - 48; float lf = 0.f, kk = 0.f;
        if (p >= 0) { const float fp = bf1(PROJ[(size_t)seq_row(b, p) * NPROJ + PC_HGF + h * 128 + d]); const float sig = sigmoidf_(fp), nsig = sigmoidf_(-fp);
            lf = logf(lb + (1.0f - lb) * sig); kk = (1.0f - lb) * nsig; }
        bacc += lf; bcs[t * 128 + d] = bacc; kks[t * 128 + d] = kk; }
}
__device__ __forceinline__ void hg_A(const bf16* PROJ, const float* LB, float* HGS, float* HGE, int u, unsigned char* lds, int tid) {
    const int c = u % NCH, bh = u / NCH, h = bh & 7, b = bh >> 3;
    float* bcs = (float*)lds; float* kkw = bcs + 64 * 128; float* iv = kkw + 64 * 128;
    for (int id = tid; id < 2048; id += 512) { const int which = id >> 10, r = (id >> 4) & 63, cp = id & 15, p = 64 * c + r - 48; float x[8];
        if (which == 0) {
            float lf[8], kk[8];
            if (p >= 0) { unpack8(*(const v4u*)(PROJ + (size_t)seq_row(b, p) * NPROJ + PC_HGF + h * 128 + cp * 8), x);
#pragma unroll
                for (int q = 0; q < 8; ++q) { const float lb = LB[h * 128 + cp * 8 + q]; const float e = __expf(-fminf(fmaxf(x[q], -60.f), 60.f)); const float sig = __builtin_amdgcn_rcpf(1.0f + e), nsig = e * sig; lf[q] = __logf(lb + (1.0f - lb) * sig); kk[q] = (1.0f - lb) * nsig; } }
            else {
#pragma unroll
                for (int q = 0; q < 8; ++q) { lf[q] = 0.f; kk[q] = 0.f; } }
            *(f32x4*)(bcs + r * 128 + cp * 8) = (f32x4){lf[0], lf[1], lf[2], lf[3]}; *(f32x4*)(bcs + r * 128 + cp * 8 + 4) = (f32x4){lf[4], lf[5], lf[6], lf[7]};
            *(f32x4*)(kkw + r * 128 + cp * 8) = (f32x4){kk[0], kk[1], kk[2], kk[3]}; *(f32x4*)(kkw + r * 128 + cp * 8 + 4) = (f32x4){kk[4], kk[5], kk[6], kk[7]};
            continue; }
        {
            if (p >= 0) unpack8(*(const v4u*)(PROJ + (size_t)seq_row(b, p) * NPROJ + PC_HGI + h * 128 + cp * 8), x);
            else {
#pragma unroll
                for (int q = 0; q < 8; ++q) x[q] = 0.f; }
            *(f32x4*)(iv + r * 128 + cp * 8) = (f32x4){x[0], x[1], x[2], x[3]}; *(f32x4*)(iv + r * 128 + cp * 8 + 4) = (f32x4){x[4], x[5], x[6], x[7]}; } }
    __syncthreads();
    if (tid < 128) { float bacc = 0.f;
#pragma unroll 8
        for (int t = 0; t < 64; ++t) { bacc += bcs[t * 128 + tid]; bcs[t * 128 + tid] = bacc; } }
    __syncthreads();
    constexpr int DP = 136; bf16* kb = (bf16*)kkw; bf16* ib = (bf16*)iv;
    float kvv[16], ivv[16];
#pragma unroll
    for (int k = 0; k < 16; ++k) { const int idx = tid + 512 * k, d = idx & 127; kvv[k] = kkw[idx] * __expf(bcs[63 * 128 + d] - bcs[idx]); ivv[k] = iv[idx]; }
    if (tid < 128) HGE[(size_t)u * 128 + tid] = __expf(bcs[63 * 128 + tid]);
    __syncthreads();
#pragma unroll
    for (int k = 0; k < 16; ++k) { const int idx = tid + 512 * k, d = idx & 127, sr = idx >> 7; kb[sr * DP + d] = (bf16)f2bf(kvv[k]); ib[sr * DP + d] = (bf16)f2bf(ivv[k]); }
    __syncthreads();
    { const int lane = tid & 63, wave = tid >> 6, lc = lane & 15, g = lane >> 4;
      bf16x8v af[2];
#pragma unroll
      for (int ks = 0; ks < 2; ++ks)
#pragma unroll
          for (int i = 0; i < 8; ++i) af[ks][i] = (short)kb[(32 * ks + 8 * g + i) * DP + 16 * wave + lc];
      bf16* out = (bf16*)HGS + (size_t)u * 16384;
#pragma unroll 2
      for (int et = 0; et < 8; ++et) { bf16x8v bv[2];
#pragma unroll
          for (int ks = 0; ks < 2; ++ks)
#pragma unroll
              for (int i = 0; i < 8; ++i) bv[ks][i] = (short)ib[(32 * ks + 8 * g + i) * DP + 16 * et + lc];
          f32x4 acc = (f32x4){0.f, 0.f, 0.f, 0.f};
#pragma unroll
          for (int ks = 0; ks < 2; ++ks) acc = MFMA16(af[ks], bv[ks], acc);
          v2u w; w.x = pk2(acc[0], acc[1]); w.y = pk2(acc[2], acc[3]);
          *(v2u*)(out + ((size_t)(et * 4 + (wave >> 1)) * 64 + lc + 16 * ((2 * wave + (g >> 1)) & 3)) * 8 + 4 * (g & 1)) = w; } }
    __syncthreads();
}
__device__ __forceinline__ void hg_B(float* HGS, const float* HGE, int unit, int tid) {
    const int chain = unit >> 4, slice = unit & 15, x = 2 * (slice * 512 + tid), d = 32 * ((x >> 9) & 3) + 8 * ((x >> 7) & 3) + (x & 7); float s0 = 0.f, s1 = 0.f;
#pragma unroll 5
    for (int c = 0; c < NCH; ++c) { const size_t uu = (size_t)chain * NCH + c; unsigned* p = (unsigned*)((bf16*)HGS + uu * 16384 + x); const unsigned dl = *p; const float e0 = HGE[uu * 128 + d], e1 = HGE[uu * 128 + d + 1];
        *p = pk2(s0, s1); s0 = s0 * e0 + bflo(dl); s1 = s1 * e1 + bfhi(dl); }
}
__device__ __forceinline__ void hg_C(const bf16* PROJ, const float* LB, const float* HGS, const float* hg_norm, bf16* BRp, int u, unsigned char* lds, int tid) {
    const int c = u % NCH, bh = u / NCH, h = bh & 7, b = bh >> 3, lane = tid & 63, wave = tid >> 6, lc = lane & 15, g = lane >> 4;
    constexpr int DP = 136, SP = 72;
    float* bcs = (float*)lds;
    bf16* qs = (bf16*)(lds + 32768);
    bf16* kks = (bf16*)(lds + 50176);
    bf16* It = (bf16*)(lds + 67584);
    bf16* QD = (bf16*)(lds + 86016);
    bf16* KD = (bf16*)(lds + 103424);
    bf16* ATT = (bf16*)(lds + 129536);
    for (int id = tid; id < 3072; id += 512) { const int which = id >> 10, r = (id >> 4) & 63, cp = id & 15, p = 64 * c + r - 48; float x[8];
        if (p >= 0) unpack8(*(const v4u*)(PROJ + (size_t)seq_row(b, p) * NPROJ + (which == 0 ? PC_HGF : (which == 1 ? PC_HGQ : PC_HGI)) + h * 128 + cp * 8), x);
        else {
#pragma unroll
            for (int q = 0; q < 8; ++q) x[q] = 0.f; }
        if (which == 0) { float lf[8], kk[8];
#pragma unroll
            for (int q = 0; q < 8; ++q) { const float lb = LB[h * 128 + cp * 8 + q]; const float e = __expf(-fminf(fmaxf(x[q], -60.f), 60.f)); const float sig = __builtin_amdgcn_rcpf(1.0f + e), nsig = e * sig;
                lf[q] = (p >= 0) ? __logf(lb + (1.0f - lb) * sig) : 0.f; kk[q] = (p >= 0) ? (1.0f - lb) * nsig : 0.f; }
            *(f32x4*)(bcs + r * 128 + cp * 8) = (f32x4){lf[0], lf[1], lf[2], lf[3]}; *(f32x4*)(bcs + r * 128 + cp * 8 + 4) = (f32x4){lf[4], lf[5], lf[6], lf[7]};
            *(bf16x8v*)(kks + r * DP + cp * 8) = pack8(kk); }
        else if (which == 1) {
#pragma unroll
            for (int q = 0; q < 8; ++q) x[q] = x[q] * fast_sigmoid_(x[q]);
            *(bf16x8v*)(qs + r * DP + cp * 8) = pack8(x); }
        else {
#pragma unroll
            for (int q = 0; q < 8; ++q) It[(cp * 8 + q) * SP + r] = (bf16)f2bf(x[q]); } }
    __syncthreads();
    for (int i = tid; i < 64 * SP / 8; i += NTHR) *(v4u*)(ATT + i * 8) = (v4u){0u, 0u, 0u, 0u};
    if (tid < 128) { float bacc = 0.f;
#pragma unroll 8
        for (int t = 0; t < 64; ++t) { bacc += bcs[t * 128 + tid]; bcs[t * 128 + tid] = bacc; } }
    __syncthreads();
#pragma unroll 2
    for (int k = 0; k < 12; ++k) { const int idx = tid + 512 * k, t = 16 + (idx >> 7), d = idx & 127, I = t >> 4;
        QD[t * DP + d] = (bf16)f2bf(bf1(qs[t * DP + d]) * __expf(bcs[t * 128 + d] - bcs[(16 * I - 1) * 128 + d])); }
#pragma unroll 2
    for (int k = 0; k < 24; ++k) { const int idx = tid + 512 * k, row = idx >> 7, d = idx & 127; const int I = row < 16 ? 1 : (row < 48 ? 2 : 3), s = row - (I == 1 ? 0 : (I == 2 ? 16 : 48));
        KD[row * DP + d] = (bf16)f2bf(bf1(kks[s * DP + d]) * __expf(bcs[(16 * I - 1) * 128 + d] - bcs[s * 128 + d])); }
    float q2v[16], k2v[16], qev[16];
#pragma unroll
    for (int k = 0; k < 16; ++k) { const int idx = tid + 512 * k, t = idx >> 7, d = idx & 127, mid = 16 * (t >> 4) + 7; const float bt = bcs[idx], bm = bcs[mid * 128 + d], qv = bf1(qs[t * DP + d]);
        q2v[k] = qv * __expf(fminf(bt - bm, 80.f)); k2v[k] = bf1(kks[t * DP + d]) * __expf(fminf(bm - bt, 80.f)); qev[k] = qv * __expf(bt); }
    __syncthreads();
    bf16* QE = (bf16*)lds;
#pragma unroll
    for (int k = 0; k < 16; ++k) { const int idx = tid + 512 * k, t = idx >> 7, d = idx & 127; qs[t * DP + d] = (bf16)f2bf(q2v[k]); kks[t * DP + d] = (bf16)f2bf(k2v[k]); QE[t * DP + d] = (bf16)f2bf(qev[k]); }
    bf16x8v sfr[4];
    { const bf16* Sst = (const bf16*)HGS + (size_t)u * 16384;
#pragma unroll
      for (int ks = 0; ks < 4; ++ks) sfr[ks] = *(const bf16x8v*)(Sst + ((size_t)(wave * 4 + ks) * 64 + lane) * 8); }
    __syncthreads();
#pragma unroll
    for (int rep = 0; rep < 2; ++rep) { const int tl = wave + 8 * rep;
        if (tl < 6) { const int I = tl < 1 ? 1 : (tl < 3 ? 2 : 3), J = tl < 1 ? 0 : (tl < 3 ? tl - 1 : tl - 3), kb = I == 1 ? 0 : (I == 2 ? 16 : 48);
            f32x4 acc = (f32x4){0.f, 0.f, 0.f, 0.f};
#pragma unroll
            for (int ks = 0; ks < 4; ++ks) acc = MFMA16(*(const bf16x8v*)(QD + (16 * I + lc) * DP + 32 * ks + 8 * g), *(const bf16x8v*)(KD + (kb + 16 * J + lc) * DP + 32 * ks + 8 * g), acc);
#pragma unroll
            for (int r = 0; r < 4; ++r) ATT[(16 * I + 4 * g + r) * SP + 16 * J + lc] = (bf16)f2bf(acc[r]); }
        else if (tl < 10) { const int I = tl - 6; f32x4 acc = (f32x4){0.f, 0.f, 0.f, 0.f};
#pragma unroll
            for (int ks = 0; ks < 4; ++ks) acc = MFMA16(*(const bf16x8v*)(qs + (16 * I + lc) * DP + 32 * ks + 8 * g), *(const bf16x8v*)(kks + (16 * I + lc) * DP + 32 * ks + 8 * g), acc);
#pragma unroll
            for (int r = 0; r < 4; ++r) ATT[(16 * I + 4 * g + r) * SP + 16 * I + lc] = (lc <= 4 * g + r) ? (bf16)f2bf(acc[r]) : (bf16)0; } }
    __syncthreads();
    f32x4 acc[4];
#pragma unroll
    for (int m = 0; m < 4; ++m) { acc[m] = (f32x4){0.f, 0.f, 0.f, 0.f};
#pragma unroll
        for (int ks = 0; ks < 2; ++ks) acc[m] = MFMA16(*(const bf16x8v*)(ATT + (16 * m + lc) * SP + 32 * ks + 8 * g), *(const bf16x8v*)(It + (16 * wave + lc) * SP + 32 * ks + 8 * g), acc[m]);
#pragma unroll
        for (int ks = 0; ks < 4; ++ks) acc[m] = MFMA16(*(const bf16x8v*)(QE + (16 * m + lc) * DP + 32 * ks + 8 * g), sfr[ks], acc[m]); }
    float* part = bcs + 5120; float* rstd = bcs + 5120 + 512;
#pragma unroll
    for (int m = 0; m < 4; ++m)
#pragma unroll
        for (int r = 0; r < 4; ++r) { float sq = acc[m][r] * acc[m][r]; sq += __shfl_xor(sq, 1); sq += __shfl_xor(sq, 2); sq += __shfl_xor(sq, 4); sq += __shfl_xor(sq, 8);
            if (lc == 0) part[(16 * m + 4 * g + r) * 8 + wave] = sq; }
    __syncthreads();
    if (tid < 64) { float sq = 0.f;
#pragma unroll
        for (int w = 0; w < 8; ++w) sq += part[tid * 8 + w];
        rstd[tid] = __builtin_amdgcn_rsqf(sq * (1.0f / 128.0f) + EPS); }
    __syncthreads();
    { const int e = 16 * wave + lc; const float gn = hg_norm[h * 128 + e];
#pragma unroll
      for (int m = 0; m < 4; ++m)
#pragma unroll
          for (int r = 0; r < 4; ++r) { const int t = 16 * m + 4 * g + r, p = 64 * c + t - 48;
              if (p >= 0 && (c > 0 || b == 0)) { const int row = seq_row(b, p); const float og = sigmoidf_(bf1(PROJ[(size_t)row * NPROJ + PC_HGG + h * 128 + e]));
                  BRp[(size_t)row * D + 2048 + h * 128 + e] = (bf16)f2bf(acc[m][r] * rstd[t] * gn * og); } } }
    __syncthreads();
}

__device__ __forceinline__ void rg_frags(const float* wa, const float* wx, int n, int jt, int lc, int g, bf16x8v (&fa)[2], bf16x8v (&fx)[2]) {
#pragma unroll
    for (int ks = 0; ks < 2; ++ks) { float xa[8], xx[8];
#pragma unroll
        for (int q = 0; q < 8; ++q) { const int wi = (n * 64 + 32 * ks + 8 * g + q) * 64 + 16 * jt + lc; xa[q] = wa[wi]; xx[q] = wx[wi]; }
        fa[ks] = pack8(xa); fx[ks] = pack8(xx); }
}
__device__ __forceinline__ void rg_A(const bf16* PROJ, const float* conv_w, const float* conv_b, const float* wa, const float* ba, const float* wx, const float* bx, const float* lam, float* RGH, float* RGP, float* RGT, int u, unsigned char* lds, int tid) {
    const int half = u & 1, c = (u < 256) ? 1 + ((u >> 1) & 63) : 0, b = (u < 256) ? (u >> 7) : 0, ch = half * 512 + tid, p0 = 64 * c - 48;
    const int lane = tid & 63, wave = tid >> 6, lc = lane & 15, g = lane >> 4, n = half * 8 + wave;
    constexpr int XP = 520;
    bf16* xs = (bf16*)lds;
    bf16* xcb = (bf16*)(lds + 68608);
    bf16* las = (bf16*)(lds + 68608);
    bf16* us = (bf16*)lds;
    bf16x8v fa[2], fx[2]; rg_frags(wa, wx, n, 0, lc, g, fa, fx);
    for (int id = tid; id < 67 * 64; id += NTHR) { const int r = id >> 6, cp = id & 63, p = p0 - 3 + r; v4u w = (v4u){0u, 0u, 0u, 0u};
        if (p >= 0) w = *(const v4u*)(PROJ + (size_t)seq_row(b, p) * NPROJ + PC_RGX + half * 512 + cp * 8);
        *(v4u*)(xs + r * 512 + cp * 8) = w; }
    __syncthreads();
    { const float w0 = conv_w[ch], w1 = conv_w[1024 + ch], w2 = conv_w[2048 + ch], w3 = conv_w[3072 + ch], cb = conv_b[ch];
      float xm3 = bf1(xs[tid]), xm2 = bf1(xs[512 + tid]), xm1 = bf1(xs[1024 + tid]);
#pragma unroll 8
      for (int t = 0; t < 64; ++t) { const float x0 = bf1(xs[(t + 3) * 512 + tid]); xcb[t * XP + tid] = (bf16)f2bf(cb + (w0 * xm3 + w1 * xm2) + (w2 * xm1 + w3 * x0)); xm3 = xm2; xm2 = xm1; xm1 = x0; } }
    __syncthreads();
    unsigned ru[4][4][2];
    { bf16x8v af[4][2];
#pragma unroll
      for (int m = 0; m < 4; ++m)
#pragma unroll
          for (int ks = 0; ks < 2; ++ks) af[m][ks] = *(const bf16x8v*)(xcb + (16 * m + lc) * XP + 64 * wave + 32 * ks + 8 * g);
      __syncthreads();
#pragma unroll
      for (int jt = 0; jt < 4; ++jt) { bf16x8v na[2], nx[2];
          asm volatile("" ::: "memory");
          if (jt < 3) rg_frags(wa, wx, n, jt + 1, lc, g, na, nx);
          const int cg = 64 * n + 16 * jt + lc, cl = cg - half * 512;
          const float bav = ba[cg], bxv = bx[cg], spv = softplusf_(-lam[cg]), w0 = conv_w[cg], w1 = conv_w[1024 + cg], w2 = conv_w[2048 + cg], w3 = conv_w[3072 + cg], cb = conv_b[cg];
#pragma unroll
          for (int m = 0; m < 4; ++m) { f32x4 aa = (f32x4){0.f, 0.f, 0.f, 0.f}, ax = aa;
#pragma unroll
              for (int ks = 0; ks < 2; ++ks) { aa = MFMA16(af[m][ks], fa[ks], aa); ax = MFMA16(af[m][ks], fx[ks], ax); }
              float uv[4];
#pragma unroll
              for (int r = 0; r < 4; ++r) { const int t = 16 * m + 4 * g + r;
                  const float xc = cb + (w0 * bf1(xs[t * 512 + cl]) + w1 * bf1(xs[(t + 1) * 512 + cl])) + (w2 * bf1(xs[(t + 2) * 512 + cl]) + w3 * bf1(xs[(t + 3) * 512 + cl]));
                  const float rr = fast_sigmoid_(aa[r] + bav), gi = fast_sigmoid_(ax[r] + bxv); const unsigned lb16 = f2bf(-8.0f * rr * spv); const float a = __expf(__uint_as_float(lb16 << 16));
                  las[t * 512 + cl] = (bf16)lb16; uv[r] = __builtin_amdgcn_sqrtf(fmaxf(1.0f - a * a, 0.f)) * gi * xc; }
              ru[jt][m][0] = pk2(uv[0], uv[1]); ru[jt][m][1] = pk2(uv[2], uv[3]); }
          if (jt < 3) { fa[0] = na[0]; fa[1] = na[1]; fx[0] = nx[0]; fx[1] = nx[1]; } } }
    __syncthreads();
#pragma unroll
    for (int jt = 0; jt < 4; ++jt) { const int cl = 64 * wave + 16 * jt + lc;
#pragma unroll
        for (int m = 0; m < 4; ++m)
#pragma unroll
            for (int h2 = 0; h2 < 2; ++h2) { const int t = 16 * m + 4 * g + 2 * h2;
                us[t * 512 + cl] = (bf16)(ru[jt][m][h2] & 0xffffu); us[(t + 1) * 512 + cl] = (bf16)(ru[jt][m][h2] >> 16); } }
    __syncthreads();
    float hh = 0.f, P = 1.f;
    { const int tb = (c == 0 ? 48 : 0); float* ph = RGH + (size_t)seq_row(b, p0 + tb) * 1024 + ch; float* pp = RGP + (size_t)seq_row(b, p0 + tb) * 1024 + ch;
#pragma unroll 4
      for (int t = tb; t < 64; ++t) { const float a = __expf(bf1(las[t * 512 + tid])), uu = bf1(us[t * 512 + tid]);
          hh = a * hh + uu; P *= a; *ph = hh; *pp = P; ph += 1024; pp += 1024; } }
    RGT[(size_t)(0 * 2 + b) * NCH * 1024 + c * 1024 + ch] = P; RGT[(size_t)(1 * 2 + b) * NCH * 1024 + c * 1024 + ch] = hh;
    if (c == 0) { RGT[(size_t)(0 * 2 + 1) * NCH * 1024 + ch] = P; RGT[(size_t)(1 * 2 + 1) * NCH * 1024 + ch] = hh; }
    __syncthreads();
}
__device__ __forceinline__ void rg_B(float* RGT, int chain, int lane) {
    const int b = chain >> 10, ch = chain & 1023;
    float a = RGT[(size_t)(0 * 2 + b) * NCH * 1024 + lane * 1024 + ch], hv = RGT[(size_t)(1 * 2 + b) * NCH * 1024 + lane * 1024 + ch];
#pragma unroll
    for (int o = 1; o < 64; o <<= 1) { const float ap = __shfl_up(a, o), hp = __shfl_up(hv, o); if (lane >= o) { hv = a * hp + hv; a = a * ap; } }
    float* Cc = RGT + (size_t)(2 * 2 + b) * NCH * 1024 + ch;
    const float prev = __shfl_up(hv, 1);
    Cc[lane * 1024] = (lane == 0) ? 0.f : prev;
    if (lane == 63) Cc[64 * 1024] = hv;
}
__device__ __forceinline__ float gelu_tanh(float y) { const float z2 = 1.5957691216057308f * (y + 0.044715f * y * y * y); return y * __builtin_amdgcn_rcpf(1.0f + __expf(-z2)); }
__device__ __forceinline__ void rg_C(const bf16* PROJ, const float* RGH, const float* RGP, const float* RGT, bf16* BR, int gw, int NGW, int lane) {
    for (int row = gw; row < TREAL + NMETA; row += NGW) {
        const int b = row < TREAL ? (row >> 12) : 0, p = row < TREAL ? (row & 4095) + NMETA : row - TREAL, c = (p + 48) >> 6;
        const float* Cc = RGT + (size_t)(2 * 2 + b) * NCH * 1024 + c * 1024;
#pragma unroll
        for (int j = 0; j < 2; ++j) { const int ch = j * 512 + lane * 8; float y[8]; unpack8(*(const v4u*)(PROJ + (size_t)row * NPROJ + PC_RGY + ch), y); float o[8];
#pragma unroll
            for (int q = 0; q < 2; ++q) { const f32x4 hl = *(const f32x4*)(RGH + (size_t)row * 1024 + ch + 4 * q), pp = *(const f32x4*)(RGP + (size_t)row * 1024 + ch + 4 * q), cc = *(const f32x4*)(Cc + ch + 4 * q);
                const f32x4 hv = hl + pp * cc; o[4 * q] = hv.x * gelu_tanh(y[4 * q]); o[4 * q + 1] = hv.y * gelu_tanh(y[4 * q + 1]); o[4 * q + 2] = hv.z * gelu_tanh(y[4 * q + 2]); o[4 * q + 3] = hv.w * gelu_tanh(y[4 * q + 3]); }
            v4u w; w.x = pk2(o[0], o[1]); w.y = pk2(o[2], o[3]); w.z = pk2(o[4], o[5]); w.w = pk2(o[6], o[7]);
            *(v4u*)(BR + (size_t)row * D + 3072 + ch) = w; }
    }
}

__device__ __forceinline__ void sb_unit(const bf16* PROJ, const float* gq, const float* gk, bf16* BRp, int b, int h, int i, unsigned char* lds, int tid) {
    constexpr int KP = 136, VP = 72;
    bf16* Kt = (bf16*)lds; bf16* Vt = (bf16*)(lds + 17408);
    const int lane = tid & 63, wave = tid >> 6, c = lane & 15, g = lane >> 4;
    bf16* Ps = (bf16*)(lds + 35840) + wave * (16 * VP);
    bf16x8v aq[4];
    { const int pq = 128 * i - 112 + 16 * wave + c; float qv[4][8]; float ss = 0.f;
      if (pq >= 0) { const bf16* qp = PROJ + (size_t)seq_row(b, pq) * NPROJ + PC_SBQ + h * 128 + 8 * g;
#pragma unroll
          for (int ks = 0; ks < 4; ++ks) { unpack8(*(const v4u*)(qp + 32 * ks), qv[ks]);
#pragma unroll
              for (int k = 0; k < 8; ++k) ss += qv[ks][k] * qv[ks][k]; } }
      else {
#pragma unroll
          for (int ks = 0; ks < 4; ++ks)
#pragma unroll
              for (int k = 0; k < 8; ++k) qv[ks][k] = 0.f; }
      ss += __shfl_xor(ss, 16); ss += __shfl_xor(ss, 32);
      const float sc = 0.08838834764831845f * __builtin_amdgcn_rsqf(ss * (1.0f / 128.0f) + EPS);
#pragma unroll
      for (int ks = 0; ks < 4; ++ks) { const f32x4 g0 = *(const f32x4*)(gq + 32 * ks + 8 * g), g1 = *(const f32x4*)(gq + 32 * ks + 8 * g + 4);
          qv[ks][0] *= sc * g0.x; qv[ks][1] *= sc * g0.y; qv[ks][2] *= sc * g0.z; qv[ks][3] *= sc * g0.w; qv[ks][4] *= sc * g1.x; qv[ks][5] *= sc * g1.y; qv[ks][6] *= sc * g1.z; qv[ks][7] *= sc * g1.w;
          aq[ks] = pack8(qv[ks]); } }
    const int p0row = 128 * i - 112 + 16 * wave + 4 * g;
    float carry[4] = {0.f, 0.f, 0.f, 0.f};
    f32x4 acc_o[8];
#pragma unroll
    for (int n = 0; n < 8; ++n) acc_o[n] = (f32x4){0.f, 0.f, 0.f, 0.f};
    const int kt_hi = (i == 0) ? 0 : 2 * i;
    v4u pk0 = (v4u){0u, 0u, 0u, 0u}, pk1 = pk0, pv0 = pk0, pv1 = pk0;
#define SB_FETCH(kt_) do { const int pkf = 64 * (kt_) + (tid >> 3); pk0 = (v4u){0u, 0u, 0u, 0u}; pk1 = pk0; pv0 = pk0; pv1 = pk0; \
        if (pkf < 4096 + NMETA) { const bf16* rp = PROJ + (size_t)seq_row(b, pkf) * NPROJ + h * 128 + (tid & 7) * 16; \
            pk0 = *(const v4u*)(rp + PC_SBK); pk1 = *(const v4u*)(rp + PC_SBK + 8); pv0 = *(const v4u*)(rp + PC_SBV); pv1 = *(const v4u*)(rp + PC_SBV + 8); } } while (0)
    SB_FETCH(kt_hi);
    for (int kt = kt_hi; kt >= 0; --kt) {
        { const int kr = tid >> 3, sg = tid & 7; float ka[8], kb[8], va[8], vb[8]; float ss = 0.f;
          unpack8(pk0, ka); unpack8(pk1, kb); unpack8(pv0, va); unpack8(pv1, vb);
#pragma unroll
          for (int k = 0; k < 8; ++k) ss += ka[k] * ka[k] + kb[k] * kb[k];
          ss += __shfl_xor(ss, 1); ss += __shfl_xor(ss, 2); ss += __shfl_xor(ss, 4);
          const float rstd = __builtin_amdgcn_rsqf(ss * (1.0f / 128.0f) + EPS);
          const f32x4 g0 = *(const f32x4*)(gk + sg * 16), g1 = *(const f32x4*)(gk + sg * 16 + 4), g2 = *(const f32x4*)(gk + sg * 16 + 8), g3 = *(const f32x4*)(gk + sg * 16 + 12);
          ka[0] *= rstd * g0.x; ka[1] *= rstd * g0.y; ka[2] *= rstd * g0.z; ka[3] *= rstd * g0.w; ka[4] *= rstd * g1.x; ka[5] *= rstd * g1.y; ka[6] *= rstd * g1.z; ka[7] *= rstd * g1.w;
          kb[0] *= rstd * g2.x; kb[1] *= rstd * g2.y; kb[2] *= rstd * g2.z; kb[3] *= rstd * g2.w; kb[4] *= rstd * g3.x; kb[5] *= rstd * g3.y; kb[6] *= rstd * g3.z; kb[7] *= rstd * g3.w;
          *(bf16x8v*)(Kt + kr * KP + sg * 16) = pack8(ka); *(bf16x8v*)(Kt + kr * KP + sg * 16 + 8) = pack8(kb);
#pragma unroll
          for (int k = 0; k < 8; ++k) { Vt[(sg * 16 + k) * VP + kr] = (bf16)f2bf(va[k]); Vt[(sg * 16 + 8 + k) * VP + kr] = (bf16)f2bf(vb[k]); } }
        __syncthreads();
        if (kt > 0) SB_FETCH(kt - 1);
        f32x4 z[4];
#pragma unroll
        for (int j = 0; j < 4; ++j) { z[j] = (f32x4){0.f, 0.f, 0.f, 0.f};
#pragma unroll
            for (int ks = 0; ks < 4; ++ks) z[j] = MFMA16(aq[ks], *(const bf16x8v*)(Kt + (16 * j + 15 - c) * KP + 32 * ks + 8 * g), z[j]); }
        float lk[4][4], zl[4][4], inc[4][4];
#pragma unroll
        for (int j = 0; j < 4; ++j)
#pragma unroll
            for (int r = 0; r < 4; ++r) { const bool vis = (64 * kt + 16 * j + 15 - c) < (p0row + r); const float zz = z[j][r];
                const float sp = fmaxf(zz, 0.f) + __logf(1.0f + __expf(-fabsf(zz)));
                lk[j][r] = vis ? -sp : 0.f; zl[j][r] = vis ? (zz - sp) : -1e30f; inc[j][r] = lk[j][r]; }
#pragma unroll
        for (int j = 0; j < 4; ++j)
#pragma unroll
            for (int r = 0; r < 4; ++r) { float v = inc[j][r]; v += dpp_shr16<1>(v); v += dpp_shr16<2>(v); v += dpp_shr16<4>(v); v += dpp_shr16<8>(v); inc[j][r] = v; }
#pragma unroll
        for (int r = 0; r < 4; ++r) { float off = carry[r];
#pragma unroll
            for (int j = 3; j >= 0; --j) { const float tot = __shfl(inc[j][r], 15, 16); const float a = __expf(zl[j][r] + off + inc[j][r] - lk[j][r]);
                Ps[(4 * g + r) * VP + 16 * j + 15 - c] = (bf16)f2bf(a); off += tot; }
            carry[r] = off; }
#pragma unroll
        for (int ks = 0; ks < 2; ++ks) { const bf16x8v pf = *(const bf16x8v*)(Ps + c * VP + 32 * ks + 8 * g);
#pragma unroll
            for (int n = 0; n < 8; ++n) acc_o[n] = MFMA16(pf, *(const bf16x8v*)(Vt + (16 * n + c) * VP + 32 * ks + 8 * g), acc_o[n]); }
        { volatile unsigned* flg = (volatile unsigned*)(lds + RING_BYTES) + (kt & 1) * 8;
          bool dn = true;
#pragma unroll
          for (int r = 0; r < 4; ++r) dn = dn && ((p0row + r) < 0 || carry[r] < -104.0f);
          const int alldone = __all(dn ? 1 : 0);
          if (lane == 0) flg[wave] = alldone ? 1u : 0u;
          __syncthreads();
          unsigned d = 1u;
#pragma unroll
          for (int w = 0; w < NWAVES; ++w) d &= flg[w];
          if (d) break; }
    }
#pragma unroll
    for (int r = 0; r < 4; ++r) { const int p = p0row + r; if (p >= 0 && (i > 0 || b == 0)) { bf16* op = BRp + (size_t)seq_row(b, p) * D + 1024 + h * 128 + c;
#pragma unroll
            for (int n = 0; n < 8; ++n) op[16 * n] = (bf16)f2bf(acc_o[n][r]); } }
    __syncthreads();
}

#undef SB_FETCH
template <int MODE> __device__ __forceinline__ void skinny_phase(const bf16* A, int lda, const bf16* Bt, int ldb, int N, int K, float* hmeta, bf16* MGm, const bf16* Gm, unsigned char* lds, int tid, int bx, int G) {
    const int lane = tid & 63, wave = tid >> 6, lc = lane & 15, g = lane >> 4, kw = K / 8, nst = kw / 32;
    f32x4* red = (f32x4*)lds;
    for (int nu = bx; nu < N / 16; nu += G) {
        const bf16* ap = A + (size_t)lc * lda + wave * kw + 8 * g; const bf16* bp = Bt + (size_t)(16 * nu + lc) * ldb + wave * kw + 8 * g;
        f32x4 acc = (f32x4){0.f, 0.f, 0.f, 0.f}; int st = 0;
        for (; st + 8 <= nst; st += 8) { bf16x8v af[8], bv[8];
#pragma unroll
            for (int i = 0; i < 8; ++i) { af[i] = *(const bf16x8v*)(ap + 32 * (st + i)); bv[i] = *(const bf16x8v*)(bp + 32 * (st + i)); }
#pragma unroll
            for (int i = 0; i < 8; ++i) acc = MFMA16(af[i], bv[i], acc); }
        for (; st < nst; ++st) acc = MFMA16(*(const bf16x8v*)(ap + 32 * st), *(const bf16x8v*)(bp + 32 * st), acc);
        red[wave * 64 + lane] = acc;
        __syncthreads();
        if (wave == 0) { const int n = 16 * nu + lc;
            if (MODE == 0) { f32x4 v = red[lane];
#pragma unroll
                for (int w = 1; w < 8; ++w) v += red[w * 64 + lane];
#pragma unroll
                for (int r = 0; r < 4; ++r) hmeta[(size_t)(4 * g + r) * D + n] += v[r]; }
            else { f32x4 mg = (f32x4){0.f, 0.f, 0.f, 0.f};
#pragma unroll
                for (int k = 0; k < 4; ++k) { const f32x4 uk = red[(2 * k) * 64 + lane] + red[(2 * k + 1) * 64 + lane];
#pragma unroll
                    for (int r = 0; r < 4; ++r) mg[r] += uk[r] * __builtin_amdgcn_rcpf(bf1(Gm[(size_t)(4 * g + r) * NPROJ + k * 4096 + n])); }
#pragma unroll
                for (int r = 0; r < 4; ++r) MGm[(size_t)(4 * g + r) * D + n] = (bf16)f2bf(mg[r]); } }
        __syncthreads();
    }
}

__device__ __forceinline__ void skinny_swiglu(const bf16* A, const bf16* Bt, bf16* ACTm, unsigned char* lds, int tid, int bx, int G) {
    const int lane = tid & 63, wave = tid >> 6, lc = lane & 15, g = lane >> 4; constexpr int kw = D / 8, nst = kw / 32;
    f32x4* red = (f32x4*)lds;
    for (int nu = bx; nu < DFF / 16; nu += G) { const int j = 16 * nu + lc, brow = (j >> 7) * 256 + (j & 127);
        const bf16* ap = A + (size_t)lc * D + wave * kw + 8 * g; const bf16* bg = Bt + (size_t)brow * D + wave * kw + 8 * g; const bf16* bu = bg + (size_t)128 * D;
        f32x4 ag = (f32x4){0.f, 0.f, 0.f, 0.f}, au = ag;
#pragma unroll
        for (int h2 = 0; h2 < 2; ++h2) { bf16x8v af[8], gv[8], uv[8];
#pragma unroll
            for (int i = 0; i < 8; ++i) { af[i] = *(const bf16x8v*)(ap + 32 * (8 * h2 + i)); gv[i] = *(const bf16x8v*)(bg + 32 * (8 * h2 + i)); uv[i] = *(const bf16x8v*)(bu + 32 * (8 * h2 + i)); }
#pragma unroll
            for (int i = 0; i < 8; ++i) { ag = MFMA16(af[i], gv[i], ag); au = MFMA16(af[i], uv[i], au); } }
        static_assert(nst == 16, "two batches of 8 k-steps");
        red[wave * 64 + lane] = ag; red[512 + wave * 64 + lane] = au;
        __syncthreads();
        if (wave == 0) { f32x4 vg = red[lane], vu = red[512 + lane];
#pragma unroll
            for (int w = 1; w < 8; ++w) { vg += red[w * 64 + lane]; vu += red[512 + w * 64 + lane]; }
#pragma unroll
            for (int r = 0; r < 4; ++r) ACTm[(size_t)(4 * g + r) * DFF + j] = (bf16)f2bf(vg[r] * fast_sigmoid_(vg[r]) * vu[r]); }
        __syncthreads();
    }
}
#ifndef REP_P0
#define REP_P0 1
#endif
#ifndef REP_A
#define REP_A 1
#endif
#ifndef REP_C
#define REP_C 1
#endif
#ifndef REP_G1
#define REP_G1 1
#endif
#ifndef REP_G8
#define REP_G8 1
#endif
#ifndef PG8_ALIGN_RES
#define PG8_ALIGN_RES true
#endif
#ifndef PG8_ALIGNV
#define PG8_ALIGNV true
#endif
#ifndef PG8_SP2V
#define PG8_SP2V true
#endif
#ifndef MK_N_LAUNCHES
#define MK_N_LAUNCHES 1
#endif
constexpr int N_PHASES = 1 + 10 * NLAYER;
struct Args { const float* in[23]; float* out; unsigned char* ws; int ph_lo, ph_hi; };
static_assert(sizeof(Args) == 23 * 8 + 8 + 8 + 8, "Args has no padding bytes");

template <int LO, int HI> __global__ void __launch_bounds__(NTHR, 2) fwd_kernel(Args args) {
    extern __shared__ __attribute__((aligned(16))) unsigned char lds[];
    const int tid = threadIdx.x;
    const int G = gridDim.x, bx = blockIdx.x;
    const int vcu = (G % 8 == 0) ? (bx % 8) * (G / 8) + bx / 8 : bx;
    const int NGW = G * NWAVES, NGT = G * NTHR;
    unsigned char* ws = args.ws;
    unsigned* ctl = (unsigned*)(ws + WS_CTL);
    volatile LAS unsigned* MISC = (volatile LAS unsigned*)((LAS unsigned char*)lds + MISC_OFF);
    for (int u = tid; u < (LDS_BYTES - LDSCTL_OFF) / 4; u += NTHR) ((LAS unsigned*)((LAS unsigned char*)lds + LDSCTL_OFF))[u] = 0u;
    __syncthreads();
    constexpr bool use_bar = (HI - LO) > 1;
    XcdBarrier bar; bar.bar = ctl + CW_BAR; bar.x = 0; bar.st = nullptr;
    if constexpr (use_bar) bar = xcd_barrier_post(ctl + CW_BAR, MISC + 8);
#define IN(k) (LO <= (k) && (k) < HI)
#define PHASE_VARS int tid_ = tid; asm volatile("" : "+v"(tid_)); const int lane_ = tid_ & 63, wave_ = __builtin_amdgcn_readfirstlane(tid_ >> 6), gw_ = vcu * NWAVES + wave_, gtid_ = bx * NTHR + tid_; (void)lane_; (void)wave_; (void)gw_; (void)gtid_;
#if defined(PROBE_DOUBLE_BAR)
#define SEAM(k) do { if constexpr (IN(k) && IN((k) + 1)) { xcd_barrier(bar); xcd_barrier(bar); } } while (0)
#else
#define SEAM(k) do { if constexpr (IN(k) && IN((k) + 1)) xcd_barrier(bar); } while (0)
#endif

#define PROJ ((bf16*)(ws + WS_PROJ))
#define ACT ((bf16*)(ws + WS_ACT))
#define XN ((bf16*)(ws + WS_XN))
#define BR ((bf16*)(ws + WS_BR))
#define MG ((bf16*)(ws + WS_MG))
#define HMETA ((float*)(ws + WS_HMETA))
#define GIF ((float*)(ws + WS_GIF))
#define WIF ((const float*)(ws + WS_WIF))
#define LBp ((const float*)(ws + WS_LB))
#define MLS ((float*)(ws + WS_MLS))
#define MLN ((float*)(ws + WS_MLN))
#define MLSC ((float*)(ws + WS_MLSC))
#define MLCT ((bf16*)(ws + WS_MLCT))
#define HGS ((float*)(ws + WS_HGS))
#define HGE ((float*)(ws + WS_HGE))
#define RGH ((float*)(ws + WS_RGH))
#define RGP ((float*)(ws + WS_RGP))
#define RGT ((float*)(ws + WS_RGT))
#define HBp ((bf16*)(ws + WS_HB))
#define x (args.in[0])
#define out (args.out)

#if defined(PROBE_SPIN_US)
    if constexpr (IN(0)) { const unsigned long long t0 = __builtin_amdgcn_s_memrealtime(); while (__builtin_amdgcn_s_memrealtime() - t0 < (unsigned long long)PROBE_SPIN_US * 100ull) __builtin_amdgcn_s_sleep(8); }
#endif
    if constexpr (IN(0)) { PHASE_VARS p0_prologue(args.in, ws, lds, bx, G, wave_, lane_, gtid_, NGT); }
#if defined(PROBE_REP_P0)
    if constexpr (IN(0)) { PHASE_VARS p0_prologue(args.in, ws, lds, bx, G, wave_, lane_, gtid_, NGT); }
#endif
    SEAM(0);

    {
        constexpr int l = 0;
        constexpr int pb = 1 + 10 * l;
        constexpr bool lastl = (l == NLAYER - 1);
        constexpr int Mtail = lastl ? TREAL : MROWS;
        constexpr int Mg = TREAL;
        const void* hsrc = (l == 0) ? (const void*)x : (const void*)HBp;
        if constexpr (IN(pb + 0)) { PHASE_VARS norm_rows<true, (l != 0)>(hsrc, HMETA, args.in[2] + l * D, XN, MROWS, WIF + (size_t)l * 8 * D, args.in[5] + (size_t)l * NIN + 4096, GIF, gw_, NGW, lane_, lds, tid_); }
#if defined(PROBE_REP_NORM)
            if constexpr (IN(pb + 0)) { PHASE_VARS norm_rows<true, (l != 0)>(hsrc, HMETA, args.in[2] + l * D, XN, MROWS, WIF + (size_t)l * 8 * D, args.in[5] + (size_t)l * NIN + 4096, GIF, gw_, NGW, lane_, lds, tid_); }
#endif
        SEAM(pb + 0);
        if constexpr (IN(pb + 1)) { PHASE_VARS pg8::Gemm g{XN, (const bf16*)(ws + WS_WIN + (size_t)l * SZ_WIN), MROWS, NPROJ, D, D, D}; pg8::StaticOrder S; S.init(MROWS, NPROJ, G, bx);
            pg8::EpiProj E{PROJ, NPROJ, args.in[5] + (size_t)l * NIN, 4096, 8, PC_GATE};
            pg8::gemm_phase<pg8::EpiProj, pg8::StaticOrder, PG8_ALIGNV, PG8_SP2V>((PG8_LAS unsigned char*)lds, g, S, E, tid_); }
#if defined(PROBE_REP_G1)
        if constexpr (IN(pb + 1)) { PHASE_VARS pg8::Gemm g{XN, (const bf16*)(ws + WS_WIN + (size_t)l * SZ_WIN), MROWS, NPROJ, D, D, D}; pg8::StaticOrder S; S.init(MROWS, NPROJ, G, bx);
            pg8::EpiProj E{PROJ, NPROJ, args.in[5] + (size_t)l * NIN, 4096, 8, PC_GATE};
            pg8::gemm_phase<pg8::EpiProj, pg8::StaticOrder, PG8_ALIGNV, PG8_SP2V>((PG8_LAS unsigned char*)lds, g, S, E, tid_); }
#endif
        SEAM(pb + 1);
        if constexpr (IN(pb + 2)) { PHASE_VARS
            for (int w_ = bx; w_ < 520; w_ += G) { const int u = (w_ < 512) ? (w_ >> 6) * NCH + 1 + (w_ & 63) : (w_ - 512) * NCH; mlstm_A(PROJ, GIF, MLS, MLN, MLSC, u, lds, tid_); }
#if defined(PROBE_REP_MLA)
            for (int w_ = bx; w_ < 520; w_ += G) { const int u = (w_ < 512) ? (w_ >> 6) * NCH + 1 + (w_ & 63) : (w_ - 512) * NCH; mlstm_A(PROJ, GIF, MLS, MLN, MLSC, u, lds, tid_); }
#endif
            for (int w_ = (bx + G - 8) % G; w_ < 1040; w_ += G) { const int u = (w_ < 1024) ? (w_ >> 6) * NCH + 1 + (w_ & 63) : (w_ - 1024) * NCH; hg_A(PROJ, LBp + l * 1024, HGS, HGE, u, lds, tid_); }
#if defined(PROBE_REP_HGA)
            for (int w_ = (bx + G - 8) % G; w_ < 1040; w_ += G) { const int u = (w_ < 1024) ? (w_ >> 6) * NCH + 1 + (w_ & 63) : (w_ - 1024) * NCH; hg_A(PROJ, LBp + l * 1024, HGS, HGE, u, lds, tid_); }
#endif
            for (int u = (bx + G - 24) % G; u < 258; u += G) rg_A(PROJ, args.in[11] + l * 4096, args.in[12] + l * 1024, args.in[13] + l * 65536, args.in[14] + l * 1024, args.in[15] + l * 65536, args.in[16] + l * 1024, args.in[17] + l * 1024, RGH, RGP, RGT, u, lds, tid_);
#if defined(PROBE_REP_RGA)
            for (int u = (bx + G - 24) % G; u < 258; u += G) rg_A(PROJ, args.in[11] + l * 4096, args.in[12] + l * 1024, args.in[13] + l * 65536, args.in[14] + l * 1024, args.in[15] + l * 65536, args.in[16] + l * 1024, args.in[17] + l * 1024, RGH, RGP, RGT, u, lds, tid_);
#endif
            for (int r = 0;; ++r) { const int bs = (r == 2) ? (bx + G - 28) % G : bx; const int idx = r * G + ((r & 1) ? (G - 1 - bs) : bs); if (r * G >= (lastl ? 512 : 520)) break; if (idx >= (lastl ? 512 : 520)) continue;
                int b, h, i; if (idx < 512) { i = 32 - (idx >> 4); b = (idx >> 3) & 1; h = idx & 7; } else { i = 0; b = 0; h = idx - 512; }
                sb_unit(PROJ, args.in[7] + l * 128, args.in[8] + l * 128, BR, b, h, i, lds, tid_); }
#if defined(PROBE_REP_SB)
            for (int r = 0;; ++r) { const int bs = (r == 2) ? (bx + G - 28) % G : bx; const int idx = r * G + ((r & 1) ? (G - 1 - bs) : bs); if (r * G >= (lastl ? 512 : 520)) break; if (idx >= (lastl ? 512 : 520)) continue;
                int b, h, i; if (idx < 512) { i = 32 - (idx >> 4); b = (idx >> 3) & 1; h = idx & 7; } else { i = 0; b = 0; h = idx - 512; }
                sb_unit(PROJ, args.in[7] + l * 128, args.in[8] + l * 128, BR, b, h, i, lds, tid_); }
#endif
        }
        SEAM(pb + 2);
        if constexpr (IN(pb + 3)) { PHASE_VARS
            for (int u = bx; u < 256; u += G) mlstm_B(MLS, MLN, MLSC, MLCT, u, lds, tid_);
#if defined(PROBE_REP_MLB)
            for (int u = bx; u < 256; u += G) mlstm_B(MLS, MLN, MLSC, MLCT, u, lds, tid_);
#endif
            for (int u = bx; u < 256; u += G) hg_B(HGS, HGE, u, tid_);
            for (int ch_ = gw_; ch_ < 2048; ch_ += NGW) rg_B(RGT, ch_, lane_);
        }
        SEAM(pb + 3);
        if constexpr (IN(pb + 4)) { PHASE_VARS
            for (int w_ = (bx + G - 64) % G; w_ < (lastl ? 512 : 520); w_ += G) { const int u = (w_ < 512) ? (w_ >> 6) * NCH + 1 + (w_ & 63) : (w_ - 512) * NCH; mlstm_C(PROJ, GIF, MLCT, MLSC, args.in[6] + l * 1024, BR, u, lds, tid_); }
#if defined(PROBE_REP_MLC)
            for (int w_ = (bx + G - 64) % G; w_ < (lastl ? 512 : 520); w_ += G) { const int u = (w_ < 512) ? (w_ >> 6) * NCH + 1 + (w_ & 63) : (w_ - 512) * NCH; mlstm_C(PROJ, GIF, MLCT, MLSC, args.in[6] + l * 1024, BR, u, lds, tid_); }
#endif
            for (int w_ = (bx + G - 72) % G; w_ < (lastl ? 1024 : 1040); w_ += G) { const int u = (w_ < 1024) ? (w_ >> 6) * NCH + 1 + (w_ & 63) : (w_ - 1024) * NCH; hg_C(PROJ, LBp + l * 1024, HGS, args.in[10] + l * 1024, BR, u, lds, tid_); }
#if defined(PROBE_REP_HGC)
            for (int w_ = (bx + G - 72) % G; w_ < (lastl ? 1024 : 1040); w_ += G) { const int u = (w_ < 1024) ? (w_ >> 6) * NCH + 1 + (w_ & 63) : (w_ - 1024) * NCH; hg_C(PROJ, LBp + l * 1024, HGS, args.in[10] + l * 1024, BR, u, lds, tid_); }
#endif
            rg_C(PROJ, RGH, RGP, RGT, BR, gw_, NGW, lane_);
#if defined(PROBE_REP_RGC)
            rg_C(PROJ, RGH, RGP, RGT, BR, gw_, NGW, lane_);
#endif
        }
        SEAM(pb + 4);
        if constexpr (IN(pb + 5)) { PHASE_VARS pg8::Gemm g{BR, (const bf16*)(ws + WS_WUP + (size_t)l * SZ_WSQ), Mg, D, D, D, D}; pg8::StaticOrder S; S.init(Mg, D, G, bx);
            pg8::EpiUpGate E{MG, D, PROJ + PC_GATE, NPROJ};
            pg8::gemm_phase<pg8::EpiUpGate, pg8::StaticOrder, PG8_ALIGN_RES, PG8_SP2V>((PG8_LAS unsigned char*)lds, g, S, E, tid_);
            if constexpr (!lastl) { int tid2_ = tid; asm volatile("" : "+v"(tid2_)); skinny_phase<1>(BR + (size_t)METAROW * D, D, (const bf16*)(ws + WS_WUP + (size_t)l * SZ_WSQ), D, D, D, nullptr, MG + (size_t)METAROW * D, PROJ + (size_t)METAROW * NPROJ + PC_GATE, lds, tid2_, bx, G); } }
#if defined(PROBE_REP_G5)
        if constexpr (IN(pb + 5)) { PHASE_VARS pg8::Gemm g{BR, (const bf16*)(ws + WS_WUP + (size_t)l * SZ_WSQ), Mg, D, D, D, D}; pg8::StaticOrder S; S.init(Mg, D, G, bx);
            pg8::EpiUpGate E{MG, D, PROJ + PC_GATE, NPROJ};
            pg8::gemm_phase<pg8::EpiUpGate, pg8::StaticOrder, PG8_ALIGN_RES, PG8_SP2V>((PG8_LAS unsigned char*)lds, g, S, E, tid_);
            if constexpr (!lastl) { int tid2_ = tid; asm volatile("" : "+v"(tid2_)); skinny_phase<1>(BR + (size_t)METAROW * D, D, (const bf16*)(ws + WS_WUP + (size_t)l * SZ_WSQ), D, D, D, nullptr, MG + (size_t)METAROW * D, PROJ + (size_t)METAROW * NPROJ + PC_GATE, lds, tid2_, bx, G); } }
#endif
        SEAM(pb + 5);
        if constexpr (IN(pb + 6)) { PHASE_VARS pg8::Gemm g{MG, (const bf16*)(ws + WS_WOUT + (size_t)l * SZ_WSQ), Mg, D, D, D, D}; pg8::StaticOrder S; S.init(Mg, D, G, bx);
            pg8::EpiResid<(l != 0), true> E{hsrc, HBp};
            pg8::gemm_phase<pg8::EpiResid<(l != 0), true>, pg8::StaticOrder, PG8_ALIGN_RES, PG8_SP2V>((PG8_LAS unsigned char*)lds, g, S, E, tid_);
            if constexpr (!lastl) { int tid2_ = tid; asm volatile("" : "+v"(tid2_)); skinny_phase<0>(MG + (size_t)METAROW * D, D, (const bf16*)(ws + WS_WOUT + (size_t)l * SZ_WSQ), D, D, D, HMETA, nullptr, nullptr, lds, tid2_, bx, G); } }
        SEAM(pb + 6);
        if constexpr (IN(pb + 7)) { PHASE_VARS norm_rows<false, true>(HBp, HMETA, args.in[3] + l * D, XN, Mtail, nullptr, nullptr, nullptr, gw_, NGW, lane_, lds, tid_); }
#if defined(PROBE_REP_NORM)
            if constexpr (IN(pb + 7)) { PHASE_VARS norm_rows<false, true>(HBp, HMETA, args.in[3] + l * D, XN, Mtail, nullptr, nullptr, nullptr, gw_, NGW, lane_, lds, tid_); }
#endif
        SEAM(pb + 7);
        if constexpr (IN(pb + 8)) { PHASE_VARS pg8::Gemm g{XN, (const bf16*)(ws + WS_WGU + (size_t)l * SZ_WGU), Mg, NGU, D, D, D}; pg8::StaticOrder S; S.init(Mg, NGU, G, bx);
            pg8::EpiSwiGLU E{ACT, DFF};
            pg8::gemm_phase<pg8::EpiSwiGLU, pg8::StaticOrder, PG8_ALIGNV, PG8_SP2V>((PG8_LAS unsigned char*)lds, g, S, E, tid_);
            if constexpr (!lastl) { int tid2_ = tid; asm volatile("" : "+v"(tid2_)); skinny_swiglu(XN + (size_t)METAROW * D, (const bf16*)(ws + WS_WGU + (size_t)l * SZ_WGU), ACT + (size_t)METAROW * DFF, lds, tid2_, bx, G); } }
#if defined(PROBE_REP_G8)
        if constexpr (IN(pb + 8)) { PHASE_VARS pg8::Gemm g{XN, (const bf16*)(ws + WS_WGU + (size_t)l * SZ_WGU), Mg, NGU, D, D, D}; pg8::StaticOrder S; S.init(Mg, NGU, G, bx);
            pg8::EpiSwiGLU E{ACT, DFF};
            pg8::gemm_phase<pg8::EpiSwiGLU, pg8::StaticOrder, PG8_ALIGNV, PG8_SP2V>((PG8_LAS unsigned char*)lds, g, S, E, tid_);
            if constexpr (!lastl) { int tid2_ = tid; asm volatile("" : "+v"(tid2_)); skinny_swiglu(XN + (size_t)METAROW * D, (const bf16*)(ws + WS_WGU + (size_t)l * SZ_WGU), ACT + (size_t)METAROW * DFF, lds, tid2_, bx, G); } }
#endif
        SEAM(pb + 8);
        if constexpr (IN(pb + 9)) { PHASE_VARS pg8::Gemm g{ACT, (const bf16*)(ws + WS_WD + (size_t)l * SZ_WD), Mg, D, DFF, DFF, DFF}; pg8::StaticOrder S; S.init(Mg, D, G, bx);
            pg8::EpiResid<true, !lastl> E{HBp, lastl ? (void*)out : (void*)HBp};
            pg8::gemm_phase<pg8::EpiResid<true, !lastl>, pg8::StaticOrder, PG8_ALIGN_RES, PG8_SP2V>((PG8_LAS unsigned char*)lds, g, S, E, tid_);
            if constexpr (!lastl) { int tid2_ = tid; asm volatile("" : "+v"(tid2_)); skinny_phase<0>(ACT + (size_t)METAROW * DFF, DFF, (const bf16*)(ws + WS_WD + (size_t)l * SZ_WD), DFF, D, DFF, HMETA, nullptr, nullptr, lds, tid2_, bx, G); } }
        SEAM(pb + 9);
    }
    {
        constexpr int l = 1;
        constexpr int pb = 1 + 10 * l;
        constexpr bool lastl = (l == NLAYER - 1);
        constexpr int Mtail = lastl ? TREAL : MROWS;
        constexpr int Mg = TREAL;
        const void* hsrc = (l == 0) ? (const void*)x : (const void*)HBp;
        if constexpr (IN(pb + 0)) { PHASE_VARS norm_rows<true, (l != 0)>(hsrc, HMETA, args.in[2] + l * D, XN, MROWS, WIF + (size_t)l * 8 * D, args.in[5] + (size_t)l * NIN + 4096, GIF, gw_, NGW, lane_, lds, tid_); }
#if defined(PROBE_REP_NORM)
            if constexpr (IN(pb + 0)) { PHASE_VARS norm_rows<true, (l != 0)>(hsrc, HMETA, args.in[2] + l * D, XN, MROWS, WIF + (size_t)l * 8 * D, args.in[5] + (size_t)l * NIN + 4096, GIF, gw_, NGW, lane_, lds, tid_); }
#endif
        SEAM(pb + 0);
        if constexpr (IN(pb + 1)) { PHASE_VARS pg8::Gemm g{XN, (const bf16*)(ws + WS_WIN + (size_t)l * SZ_WIN), MROWS, NPROJ, D, D, D}; pg8::StaticOrder S; S.init(MROWS, NPROJ, G, bx);
            pg8::EpiProj E{PROJ, NPROJ, args.in[5] + (size_t)l * NIN, 4096, 8, PC_GATE};
            pg8::gemm_phase<pg8::EpiProj, pg8::StaticOrder, PG8_ALIGNV, PG8_SP2V>((PG8_LAS unsigned char*)lds, g, S, E, tid_); }
#if defined(PROBE_REP_G1)
        if constexpr (IN(pb + 1)) { PHASE_VARS pg8::Gemm g{XN, (const bf16*)(ws + WS_WIN + (size_t)l * SZ_WIN), MROWS, NPROJ, D, D, D}; pg8::StaticOrder S; S.init(MROWS, NPROJ, G, bx);
            pg8::EpiProj E{PROJ, NPROJ, args.in[5] + (size_t)l * NIN, 4096, 8, PC_GATE};
            pg8::gemm_phase<pg8::EpiProj, pg8::StaticOrder, PG8_ALIGNV, PG8_SP2V>((PG8_LAS unsigned char*)lds, g, S, E, tid_); }
#endif
        SEAM(pb + 1);
        if constexpr (IN(pb + 2)) { PHASE_VARS
            for (int w_ = bx; w_ < 520; w_ += G) { const int u = (w_ < 512) ? (w_ >> 6) * NCH + 1 + (w_ & 63) : (w_ - 512) * NCH; mlstm_A(PROJ, GIF, MLS, MLN, MLSC, u, lds, tid_); }
#if defined(PROBE_REP_MLA)
            for (int w_ = bx; w_ < 520; w_ += G) { const int u = (w_ < 512) ? (w_ >> 6) * NCH + 1 + (w_ & 63) : (w_ - 512) * NCH; mlstm_A(PROJ, GIF, MLS, MLN, MLSC, u, lds, tid_); }
#endif
            for (int w_ = (bx + G - 8) % G; w_ < 1040; w_ += G) { const int u = (w_ < 1024) ? (w_ >> 6) * NCH + 1 + (w_ & 63) : (w_ - 1024) * NCH; hg_A(PROJ, LBp + l * 1024, HGS, HGE, u, lds, tid_); }
#if defined(PROBE_REP_HGA)
            for (int w_ = (bx + G - 8) % G; w_ < 1040; w_ += G) { const int u = (w_ < 1024) ? (w_ >> 6) * NCH + 1 + (w_ & 63) : (w_ - 1024) * NCH; hg_A(PROJ, LBp + l * 1024, HGS, HGE, u, lds, tid_); }
#endif
            for (int u = (bx + G - 24) % G; u < 258; u += G) rg_A(PROJ, args.in[11] + l * 4096, args.in[12] + l * 1024, args.in[13] + l * 65536, args.in[14] + l * 1024, args.in[15] + l * 65536, args.in[16] + l * 1024, args.in[17] + l * 1024, RGH, RGP, RGT, u, lds, tid_);
#if defined(PROBE_REP_RGA)
            for (int u = (bx + G - 24) % G; u < 258; u += G) rg_A(PROJ, args.in[11] + l * 4096, args.in[12] + l * 1024, args.in[13] + l * 65536, args.in[14] + l * 1024, args.in[15] + l * 65536, args.in[16] + l * 1024, args.in[17] + l * 1024, RGH, RGP, RGT, u, lds, tid_);
#endif
            for (int r = 0;; ++r) { const int bs = (r == 2) ? (bx + G - 28) % G : bx; const int idx = r * G + ((r & 1) ? (G - 1 - bs) : bs); if (r * G >= (lastl ? 512 : 520)) break; if (idx >= (lastl ? 512 : 520)) continue;
                int b, h, i; if (idx < 512) { i = 32 - (idx >> 4); b = (idx >> 3) & 1; h = idx & 7; } else { i = 0; b = 0; h = idx - 512; }
                sb_unit(PROJ, args.in[7] + l * 128, args.in[8] + l * 128, BR, b, h, i, lds, tid_); }
#if defined(PROBE_REP_SB)
            for (int r = 0;; ++r) { const int bs = (r == 2) ? (bx + G - 28) % G : bx; const int idx = r * G + ((r & 1) ? (G - 1 - bs) : bs); if (r * G >= (lastl ? 512 : 520)) break; if (idx >= (lastl ? 512 : 520)) continue;
                int b, h, i; if (idx < 512) { i = 32 - (idx >> 4); b = (idx >> 3) & 1; h = idx & 7; } else { i = 0; b = 0; h = idx - 512; }
                sb_unit(PROJ, args.in[7] + l * 128, args.in[8] + l * 128, BR, b, h, i, lds, tid_); }
#endif
        }
        SEAM(pb + 2);
        if constexpr (IN(pb + 3)) { PHASE_VARS
            for (int u = bx; u < 256; u += G) mlstm_B(MLS, MLN, MLSC, MLCT, u, lds, tid_);
#if defined(PROBE_REP_MLB)
            for (int u = bx; u < 256; u += G) mlstm_B(MLS, MLN, MLSC, MLCT, u, lds, tid_);
#endif
            for (int u = bx; u < 256; u += G) hg_B(HGS, HGE, u, tid_);
            for (int ch_ = gw_; ch_ < 2048; ch_ += NGW) rg_B(RGT, ch_, lane_);
        }
        SEAM(pb + 3);
        if constexpr (IN(pb + 4)) { PHASE_VARS
            for (int w_ = (bx + G - 64) % G; w_ < (lastl ? 512 : 520); w_ += G) { const int u = (w_ < 512) ? (w_ >> 6) * NCH + 1 + (w_ & 63) : (w_ - 512) * NCH; mlstm_C(PROJ, GIF, MLCT, MLSC, args.in[6] + l * 1024, BR, u, lds, tid_); }
#if defined(PROBE_REP_MLC)
            for (int w_ = (bx + G - 64) % G; w_ < (lastl ? 512 : 520); w_ += G) { const int u = (w_ < 512) ? (w_ >> 6) * NCH + 1 + (w_ & 63) : (w_ - 512) * NCH; mlstm_C(PROJ, GIF, MLCT, MLSC, args.in[6] + l * 1024, BR, u, lds, tid_); }
#endif
            for (int w_ = (bx + G - 72) % G; w_ < (lastl ? 1024 : 1040); w_ += G) { const int u = (w_ < 1024) ? (w_ >> 6) * NCH + 1 + (w_ & 63) : (w_ - 1024) * NCH; hg_C(PROJ, LBp + l * 1024, HGS, args.in[10] + l * 1024, BR, u, lds, tid_); }
#if defined(PROBE_REP_HGC)
            for (int w_ = (bx + G - 72) % G; w_ < (lastl ? 1024 : 1040); w_ += G) { const int u = (w_ < 1024) ? (w_ >> 6) * NCH + 1 + (w_ & 63) : (w_ - 1024) * NCH; hg_C(PROJ, LBp + l * 1024, HGS, args.in[10] + l * 1024, BR, u, lds, tid_); }
#endif
            rg_C(PROJ, RGH, RGP, RGT, BR, gw_, NGW, lane_);
#if defined(PROBE_REP_RGC)
            rg_C(PROJ, RGH, RGP, RGT, BR, gw_, NGW, lane_);
#endif
        }
        SEAM(pb + 4);
        if constexpr (IN(pb + 5)) { PHASE_VARS pg8::Gemm g{BR, (const bf16*)(ws + WS_WUP + (size_t)l * SZ_WSQ), Mg, D, D, D, D}; pg8::StaticOrder S; S.init(Mg, D, G, bx);
            pg8::EpiUpGate E{MG, D, PROJ + PC_GATE, NPROJ};
            pg8::gemm_phase<pg8::EpiUpGate, pg8::StaticOrder, PG8_ALIGN_RES, PG8_SP2V>((PG8_LAS unsigned char*)lds, g, S, E, tid_);
            if constexpr (!lastl) { int tid2_ = tid; asm volatile("" : "+v"(tid2_)); skinny_phase<1>(BR + (size_t)METAROW * D, D, (const bf16*)(ws + WS_WUP + (size_t)l * SZ_WSQ), D, D, D, nullptr, MG + (size_t)METAROW * D, PROJ + (size_t)METAROW * NPROJ + PC_GATE, lds, tid2_, bx, G); } }
#if defined(PROBE_REP_G5)
        if constexpr (IN(pb + 5)) { PHASE_VARS pg8::Gemm g{BR, (const bf16*)(ws + WS_WUP + (size_t)l * SZ_WSQ), Mg, D, D, D, D}; pg8::StaticOrder S; S.init(Mg, D, G, bx);
            pg8::EpiUpGate E{MG, D, PROJ + PC_GATE, NPROJ};
            pg8::gemm_phase<pg8::EpiUpGate, pg8::StaticOrder, PG8_ALIGN_RES, PG8_SP2V>((PG8_LAS unsigned char*)lds, g, S, E, tid_);
            if constexpr (!lastl) { int tid2_ = tid; asm volatile("" : "+v"(tid2_)); skinny_phase<1>(BR + (size_t)METAROW * D, D, (const bf16*)(ws + WS_WUP + (size_t)l * SZ_WSQ), D, D, D, nullptr, MG + (size_t)METAROW * D, PROJ + (size_t)METAROW * NPROJ + PC_GATE, lds, tid2_, bx, G); } }
#endif
        SEAM(pb + 5);
        if constexpr (IN(pb + 6)) { PHASE_VARS pg8::Gemm g{MG, (const bf16*)(ws + WS_WOUT + (size_t)l * SZ_WSQ), Mg, D, D, D, D}; pg8::StaticOrder S; S.init(Mg, D, G, bx);
            pg8::EpiResid<(l != 0), true> E{hsrc, HBp};
            pg8::gemm_phase<pg8::EpiResid<(l != 0), true>, pg8::StaticOrder, PG8_ALIGN_RES, PG8_SP2V>((PG8_LAS unsigned char*)lds, g, S, E, tid_);
            if constexpr (!lastl) { int tid2_ = tid; asm volatile("" : "+v"(tid2_)); skinny_phase<0>(MG + (size_t)METAROW * D, D, (const bf16*)(ws + WS_WOUT + (size_t)l * SZ_WSQ), D, D, D, HMETA, nullptr, nullptr, lds, tid2_, bx, G); } }
        SEAM(pb + 6);
        if constexpr (IN(pb + 7)) { PHASE_VARS norm_rows<false, true>(HBp, HMETA, args.in[3] + l * D, XN, Mtail, nullptr, nullptr, nullptr, gw_, NGW, lane_, lds, tid_); }
#if defined(PROBE_REP_NORM)
            if constexpr (IN(pb + 7)) { PHASE_VARS norm_rows<false, true>(HBp, HMETA, args.in[3] + l * D, XN, Mtail, nullptr, nullptr, nullptr, gw_, NGW, lane_, lds, tid_); }
#endif
        SEAM(pb + 7);
        if constexpr (IN(pb + 8)) { PHASE_VARS pg8::Gemm g{XN, (const bf16*)(ws + WS_WGU + (size_t)l * SZ_WGU), Mg, NGU, D, D, D}; pg8::StaticOrder S; S.init(Mg, NGU, G, bx);
            pg8::EpiSwiGLU E{ACT, DFF};
            pg8::gemm_phase<pg8::EpiSwiGLU, pg8::StaticOrder, PG8_ALIGNV, PG8_SP2V>((PG8_LAS unsigned char*)lds, g, S, E, tid_);
            if constexpr (!lastl) { int tid2_ = tid; asm volatile("" : "+v"(tid2_)); skinny_swiglu(XN + (size_t)METAROW * D, (const bf16*)(ws + WS_WGU + (size_t)l * SZ_WGU), ACT + (size_t)METAROW * DFF, lds, tid2_, bx, G); } }
#if defined(PROBE_REP_G8)
        if constexpr (IN(pb + 8)) { PHASE_VARS pg8::Gemm g{XN, (const bf16*)(ws + WS_WGU + (size_t)l * SZ_WGU), Mg, NGU, D, D, D}; pg8::StaticOrder S; S.init(Mg, NGU, G, bx);
            pg8::EpiSwiGLU E{ACT, DFF};
            pg8::gemm_phase<pg8::EpiSwiGLU, pg8::StaticOrder, PG8_ALIGNV, PG8_SP2V>((PG8_LAS unsigned char*)lds, g, S, E, tid_);
            if constexpr (!lastl) { int tid2_ = tid; asm volatile("" : "+v"(tid2_)); skinny_swiglu(XN + (size_t)METAROW * D, (const bf16*)(ws + WS_WGU + (size_t)l * SZ_WGU), ACT + (size_t)METAROW * DFF, lds, tid2_, bx, G); } }
#endif
        SEAM(pb + 8);
        if constexpr (IN(pb + 9)) { PHASE_VARS pg8::Gemm g{ACT, (const bf16*)(ws + WS_WD + (size_t)l * SZ_WD), Mg, D, DFF, DFF, DFF}; pg8::StaticOrder S; S.init(Mg, D, G, bx);
            pg8::EpiResid<true, !lastl> E{HBp, lastl ? (void*)out : (void*)HBp};
            pg8::gemm_phase<pg8::EpiResid<true, !lastl>, pg8::StaticOrder, PG8_ALIGN_RES, PG8_SP2V>((PG8_LAS unsigned char*)lds, g, S, E, tid_);
            if constexpr (!lastl) { int tid2_ = tid; asm volatile("" : "+v"(tid2_)); skinny_phase<0>(ACT + (size_t)METAROW * DFF, DFF, (const bf16*)(ws + WS_WD + (size_t)l * SZ_WD), DFF, D, DFF, HMETA, nullptr, nullptr, lds, tid2_, bx, G); } }
        SEAM(pb + 9);
    }

#undef IN
#undef SEAM
#undef PHASE_VARS
#undef PROJ
#undef ACT
#undef XN
#undef BR
#undef MG
#undef HMETA
#undef GIF
#undef WIF
#undef LBp
#undef MLS
#undef MLN
#undef MLSC
#undef MLCT
#undef HGS
#undef HGE
#undef RGH
#undef RGP
#undef RGT
#undef HBp
#undef x
#undef out
}


#if MK_N_LAUNCHES == 1
template <class F> static void for_each_kernel(F&& f) { f((const void*)fwd_kernel<0, N_PHASES>); }
static void launch_all(const Args& a, int grid, hipStream_t stream) { hipLaunchKernelGGL((fwd_kernel<0, N_PHASES>), dim3(grid), dim3(NTHR), LDS_BYTES, stream, a); }
#else
template <int K> struct PhaseLaunch {
    template <class F> static void each(F&& f) { f((const void*)fwd_kernel<K, K + 1>); PhaseLaunch<K + 1>::each(f); }
    static void go(const Args& a, int grid, hipStream_t stream) { hipLaunchKernelGGL((fwd_kernel<K, K + 1>), dim3(grid), dim3(NTHR), LDS_BYTES, stream, a); PhaseLaunch<K + 1>::go(a, grid, stream); }
};
template <> struct PhaseLaunch<N_PHASES> { template <class F> static void each(F&&) {} static void go(const Args&, int, hipStream_t) {} };
template <class F> static void for_each_kernel(F&& f) { PhaseLaunch<0>::each(f); }
static void launch_all(const Args& a, int grid, hipStream_t stream) { PhaseLaunch<0>::go(a, grid, stream); }
#endif
extern "C" void kernel_launch(void* const* d_in, const int* in_sizes, int n_in, void* d_out, int out_size, void* d_ws, size_t ws_size, hipStream_t stream) {
    static int grid = 0;
    if (grid == 0) {
        if (n_in != 23 || out_size != TREAL * D || ws_size < WS_END) { fprintf(stderr, "kernel_launch: unexpected shapes (n_in %d, out %d, ws %zu < %zu); nothing launched\n", n_in, out_size, ws_size, (size_t)WS_END); grid = -1; return; }
        int dev = 0, cus = 0, per_cu = 0;
        if (hipGetDevice(&dev) != hipSuccess || hipDeviceGetAttribute(&cus, hipDeviceAttributeMultiprocessorCount, dev) != hipSuccess) { grid = -1; return; }
        bool ok = true;
        for_each_kernel([&](const void* f) { if (hipFuncSetAttribute(f, hipFuncAttributeMaxDynamicSharedMemorySize, LDS_BYTES) != hipSuccess) ok = false; });
        if (!ok) { fprintf(stderr, "kernel_launch: hipFuncSetAttribute failed\n"); grid = -1; return; }
        (void)per_cu; (void)hipGetLastError();
        grid = cus;
    }
    if (grid < 0) return;
    (void)in_sizes;
    if (hipMemsetAsync((char*)d_ws + WS_CTL, 0, CTL_ZERO_BYTES, stream) != hipSuccess) return;
    Args a{};
    for (int i = 0; i < 23; ++i) a.in[i] = (const float*)d_in[i];
    a.out = (float*)d_out; a.ws = (unsigned char*)d_ws; a.ph_lo = 0; a.ph_hi = N_PHASES;
    launch_all(a, grid, stream);
}
```

```cpp
#include <hip/hip_runtime.h>
#include <cstdio>
#include <cstdint>
#define MK_N_LAUNCHES 1
#ifndef PG8_WGM
#define PG8_WGM 8
#endif
namespace pg8 {
#define PG8_LAS __attribute__((address_space(3)))
typedef unsigned short bf16_t;
typedef short bf16x8 __attribute__((ext_vector_type(8)));
typedef float f32x4 __attribute__((ext_vector_type(4)));
typedef unsigned u32x4 __attribute__((ext_vector_type(4)));
constexpr int BM = 256, BK = 64, HALF = 128, HTB = HALF * BK * 2  , STAGE_BYTES = 8 * HTB, NXCD = 8, WGM = PG8_WGM;

__host__ __device__ __forceinline__ int lds_byte(int r, int c) { const int st = (r >> 4) * 2 + (c >> 5), rr = r & 15, cc = c & 31, ob = rr * 64 + cc * 2; return st * 1024 + (ob ^ (((ob >> 9) & 1) << 5)); }
__host__ __device__ __forceinline__ void stage_rc(int b, int& R, int& C) { const int st = b / 1024, sb = b % 1024, swz = sb ^ (((sb >> 9) & 1) << 5); R = (st >> 1) * 16 + swz / 64; C = (st & 1) * 32 + (swz % 64) / 2; }
__host__ __device__ __forceinline__ int perm32(int rho) { const int n = rho >> 4, i = rho & 15; return 8 * (i >> 2) + 4 * n + (i & 3); }

struct Unit { int pm, pn; };
struct Gemm { const bf16_t* A; const bf16_t* Bt; int M, N, K, lda, ldb; };

struct StaticOrder {
    int nM, nN, nwg, G, c;
    __host__ __device__ void init(int M, int N, int G_, int c_) { nM = M / BM; nN = N / BM; nwg = nM * nN; G = G_; c = c_; }
    __host__ __device__ bool next(int i, Unit& u) const {
        const long L = (long)i * G + c; if (L >= nwg) return false;
        int wgid = (int)L;
#if !defined(PG8_NO_XCD_REMAP)
        { const int q = nwg / NXCD, r = nwg % NXCD, xcd = wgid % NXCD, off = wgid / NXCD; wgid = (xcd < r ? xcd * (q + 1) : r * (q + 1) + (xcd - r) * q) + off; }
#endif
        const int nig = WGM * nN, gid = wgid / nig, fm = gid * WGM, gsz = (nM - fm) < WGM ? (nM - fm) : WGM;
        u.pm = fm + ((wgid % nig) % gsz); u.pn = (wgid % nig) / gsz; return true;
    }
    __device__ __forceinline__ void a_ready(const Unit&) const {}
    __device__ __forceinline__ void done(const Unit&) const {}
};

__device__ __forceinline__ unsigned cvt_pk_bf16(float lo, float hi) { unsigned r; asm volatile("v_cvt_pk_bf16_f32 %0, %1, %2" : "=v"(r) : "v"(lo), "v"(hi)); return r; }
typedef float f32x2 __attribute__((ext_vector_type(2)));
typedef float f32x2 __attribute__((ext_vector_type(2)));
__device__ __forceinline__ float bf_lo(unsigned w) { return __uint_as_float(w << 16); }
__device__ __forceinline__ float bf_hi(unsigned w) { return __uint_as_float(w & 0xffff0000u); }
__device__ __forceinline__ float fast_sigmoid(float x) { return __builtin_amdgcn_rcpf(1.0f + __expf(-x)); }

struct EpiProj {
    static constexpr bool PERM = true, WIDE = true, AFTER_DRAIN = false, MID = false; static constexpr int SEG = 16;
    bf16_t* O; int ldc; const float* bias; int shift_from, bias_shift, gate_from;
    __device__ __forceinline__ void operator()(const f32x4 (&acc)[2][2][4][2], const Unit& u, int wr, int wc, int fr, int fq) const {
        const int row0 = u.pm * BM + wr * 64 + fr; const int colt = u.pn * BM;
        const int col0 = colt + wc * 64 + 8 * fq; const float* bp = bias + col0 + (colt >= shift_from ? bias_shift : 0);
        const bool isg = colt >= gate_from;
        f32x4 bv[2][2];
#pragma unroll
        for (int bj = 0; bj < 2; ++bj)
#pragma unroll
            for (int n = 0; n < 2; ++n) bv[bj][n] = *(const f32x4*)(bp + bj * 32 + 4 * n);
#pragma unroll
        for (int ai = 0; ai < 2; ++ai)
#pragma unroll
            for (int m = 0; m < 4; ++m) { bf16_t* rowp = O + (size_t)(row0 + ai * HALF + m * 16) * ldc + col0;
#pragma unroll
                for (int bj = 0; bj < 2; ++bj) { f32x4 v0 = acc[ai][bj][m][0] + bv[bj][0], v1 = acc[ai][bj][m][1] + bv[bj][1];
                    if (isg) {
#pragma unroll
                        for (int j = 0; j < 4; ++j) { v0[j] = 1.0f + __expf(-fmaxf(v0[j], -60.f)); v1[j] = 1.0f + __expf(-fmaxf(v1[j], -60.f)); } }
                    u32x4 w; w.x = cvt_pk_bf16(v0[0], v0[1]); w.y = cvt_pk_bf16(v0[2], v0[3]); w.z = cvt_pk_bf16(v1[0], v1[1]); w.w = cvt_pk_bf16(v1[2], v1[3]);
                    *(u32x4*)(rowp + bj * 32) = w; } }
    }
};

struct EpiUpGate {
    static constexpr bool PERM = true, WIDE = true, AFTER_DRAIN = false, MID = true; static constexpr int SEG = 16;
    bf16_t* O; int ldc; const bf16_t* G; int ldg;
    __device__ __forceinline__ void mid(f32x4 (&acc)[2][2][4][2], const Unit& u, int seg, int wr, int wc, int fr, int fq) const {
        const int row0 = u.pm * BM + wr * 64 + fr; const int col0 = u.pn * BM + wc * 64 + 8 * fq;
#pragma unroll
        for (int ai = 0; ai < 2; ++ai) { u32x4 ga[4][2], gb[4][2];
#pragma unroll
            for (int m = 0; m < 4; ++m) { const bf16_t* gp = G + (size_t)(row0 + ai * HALF + m * 16) * ldg + seg * 4096 + col0;
#pragma unroll
                for (int bj = 0; bj < 2; ++bj) { ga[m][bj] = *(const u32x4*)(gp + bj * 32); gb[m][bj] = *(const u32x4*)(gp + 4096 + bj * 32); } }
#pragma unroll
            for (int m = 0; m < 4; ++m)
#pragma unroll
                for (int bj = 0; bj < 2; ++bj) { const u32x4 a = ga[m][bj], b = gb[m][bj];
                    const unsigned aw[4] = {a.x, a.y, a.z, a.w}, bw[4] = {b.x, b.y, b.z, b.w};
#pragma unroll
                    for (int j = 0; j < 4; ++j) {
                        const float rl = bf_lo(bw[j]) * __builtin_amdgcn_rcpf(bf_lo(aw[j])), rh = bf_hi(bw[j]) * __builtin_amdgcn_rcpf(bf_hi(aw[j]));
                        acc[ai][bj][m][j >> 1][(j & 1) * 2] *= rl; acc[ai][bj][m][j >> 1][(j & 1) * 2 + 1] *= rh; } }
            asm volatile("" ::: "memory"); }
    }
    __device__ __forceinline__ void operator()(const f32x4 (&acc)[2][2][4][2], const Unit& u, int wr, int wc, int fr, int fq) const {
        const int row0 = u.pm * BM + wr * 64 + fr; const int col0 = u.pn * BM + wc * 64 + 8 * fq;
        u32x4 ga[2][4][2];
#pragma unroll
        for (int ai = 0; ai < 2; ++ai)
#pragma unroll
            for (int m = 0; m < 4; ++m) { const bf16_t* gp = G + (size_t)(row0 + ai * HALF + m * 16) * ldg + 3 * 4096 + col0;
#pragma unroll
                for (int bj = 0; bj < 2; ++bj) ga[ai][m][bj] = *(const u32x4*)(gp + bj * 32); }
#pragma unroll
        for (int ai = 0; ai < 2; ++ai)
#pragma unroll
            for (int m = 0; m < 4; ++m) { const int row = row0 + ai * HALF + m * 16; bf16_t* rowp = O + (size_t)row * ldc + col0;
#pragma unroll
                for (int bj = 0; bj < 2; ++bj) { const u32x4 a = ga[ai][m][bj]; const unsigned aw[4] = {a.x, a.y, a.z, a.w}; float o[8];
#pragma unroll
                    for (int j = 0; j < 4; ++j) { const float gl = __builtin_amdgcn_rcpf(bf_lo(aw[j])), gh = __builtin_amdgcn_rcpf(bf_hi(aw[j]));
                        o[2 * j] = acc[ai][bj][m][j >> 1][(j & 1) * 2] * gl; o[2 * j + 1] = acc[ai][bj][m][j >> 1][(j & 1) * 2 + 1] * gh; }
                    u32x4 w; w.x = cvt_pk_bf16(o[0], o[1]); w.y = cvt_pk_bf16(o[2], o[3]); w.z = cvt_pk_bf16(o[4], o[5]); w.w = cvt_pk_bf16(o[6], o[7]);
                    *(u32x4*)(rowp + bj * 32) = w; } }
    }
};

template <bool SB, bool DB> struct EpiResid {
    static constexpr bool PERM = true, WIDE = true, AFTER_DRAIN = false, MID = false; static constexpr int SEG = 16;
    const void* src; void* dst;
    __device__ __forceinline__ void operator()(const f32x4 (&acc)[2][2][4][2], const Unit& u, int wr, int wc, int fr, int fq) const {
        const int row0 = u.pm * BM + wr * 64 + fr, col0 = u.pn * BM + wc * 64 + 8 * fq;
        if constexpr (SB) {
            u32x4 rs[2][4][2];
#pragma unroll
            for (int ai = 0; ai < 2; ++ai)
#pragma unroll
                for (int m = 0; m < 4; ++m)
#pragma unroll
                    for (int bj = 0; bj < 2; ++bj) rs[ai][m][bj] = *(const u32x4*)((const bf16_t*)src + (size_t)(row0 + ai * HALF + m * 16) * 4096 + col0 + bj * 32);
#pragma unroll
            for (int ai = 0; ai < 2; ++ai)
#pragma unroll
                for (int m = 0; m < 4; ++m) { const size_t off = (size_t)(row0 + ai * HALF + m * 16) * 4096 + col0;
#pragma unroll
                    for (int bj = 0; bj < 2; ++bj) { const u32x4 a = rs[ai][m][bj];
                        const f32x4 v0 = (f32x4){bf_lo(a.x), bf_hi(a.x), bf_lo(a.y), bf_hi(a.y)} + acc[ai][bj][m][0], v1 = (f32x4){bf_lo(a.z), bf_hi(a.z), bf_lo(a.w), bf_hi(a.w)} + acc[ai][bj][m][1];
                        if constexpr (DB) { u32x4 w; w.x = cvt_pk_bf16(v0[0], v0[1]); w.y = cvt_pk_bf16(v0[2], v0[3]); w.z = cvt_pk_bf16(v1[0], v1[1]); w.w = cvt_pk_bf16(v1[2], v1[3]);
                            *(u32x4*)((bf16_t*)dst + off + bj * 32) = w; }
                        else { *(f32x4*)((float*)dst + off + bj * 32) = v0; *(f32x4*)((float*)dst + off + bj * 32 + 4) = v1; } } }
        } else {
#pragma unroll
            for (int ai = 0; ai < 2; ++ai) { f32x4 rs[4][2][2];
#pragma unroll
                for (int m = 0; m < 4; ++m)
#pragma unroll
                    for (int bj = 0; bj < 2; ++bj) { const float* sp = (const float*)src + (size_t)(row0 + ai * HALF + m * 16) * 4096 + col0 + bj * 32; rs[m][bj][0] = *(const f32x4*)sp; rs[m][bj][1] = *(const f32x4*)(sp + 4); }
#pragma unroll
                for (int m = 0; m < 4; ++m) { const size_t off = (size_t)(row0 + ai * HALF + m * 16) * 4096 + col0;
#pragma unroll
                    for (int bj = 0; bj < 2; ++bj) { const f32x4 v0 = rs[m][bj][0] + acc[ai][bj][m][0], v1 = rs[m][bj][1] + acc[ai][bj][m][1];
                        if constexpr (DB) { u32x4 w; w.x = cvt_pk_bf16(v0[0], v0[1]); w.y = cvt_pk_bf16(v0[2], v0[3]); w.z = cvt_pk_bf16(v1[0], v1[1]); w.w = cvt_pk_bf16(v1[2], v1[3]);
                            *(u32x4*)((bf16_t*)dst + off + bj * 32) = w; }
                        else { *(f32x4*)((float*)dst + off + bj * 32) = v0; *(f32x4*)((float*)dst + off + bj * 32 + 4) = v1; } } }
                asm volatile("" ::: "memory"); }
        }
    }
};

struct EpiSwiGLU {
    static constexpr bool PERM = true, WIDE = false, AFTER_DRAIN = false, MID = false; static constexpr int SEG = 16;
    bf16_t* O; int ldc;
    __device__ __forceinline__ void operator()(const f32x4 (&acc)[2][2][4][2], const Unit& u, int wr, int wc, int fr, int fq) const {
        const int row0 = u.pm * BM + wr * 64 + fr; const int col0 = u.pn * HALF + wc * 32 + 8 * fq;
#pragma unroll
        for (int ai = 0; ai < 2; ++ai)
#pragma unroll
            for (int m = 0; m < 4; ++m) { float o[8];
#pragma unroll
                for (int n = 0; n < 2; ++n)
#pragma unroll
                    for (int j = 0; j < 4; ++j) { const float gv = acc[ai][0][m][n][j], uv = acc[ai][1][m][n][j]; o[4 * n + j] = gv * fast_sigmoid(gv) * uv; }
                u32x4 w; w.x = cvt_pk_bf16(o[0], o[1]); w.y = cvt_pk_bf16(o[2], o[3]); w.z = cvt_pk_bf16(o[4], o[5]); w.w = cvt_pk_bf16(o[6], o[7]);
                *(u32x4*)(O + (size_t)(row0 + ai * HALF + m * 16) * ldc + col0) = w; }
    }
};
template <class Epi, class Sched, bool ALIGN_EPI = false, bool SP2 = false>
__device__ __forceinline__ void gemm_phase(PG8_LAS unsigned char* lds, const Gemm g, const Sched& S, const Epi& E, const int tid) {
    const int wid = __builtin_amdgcn_readfirstlane(tid >> 6), lane = tid & 63, wr = wid >> 2, wc = wid & 3, fr = lane & 15, fq = lane >> 4;
    const int K = g.K, nt = K / BK;
    unsigned voffA[2], voffB[2];
#pragma unroll
    for (int i = 0; i < 2; ++i) { int R, C; stage_rc(tid * 16 + i * 8192, R, C); const int Rb = Epi::PERM ? (Epi::WIDE ? ((R >> 5) * 64 + perm32(R & 31)) : ((R & ~31) + perm32(R & 31))) : R;
        voffA[i] = (unsigned)(R * g.lda + C) * 2u; voffB[i] = (unsigned)(Rb * g.ldb + C) * 2u; }
    const size_t kstep = (size_t)(BK * 2);
    const size_t hstepA = (size_t)HALF * g.lda * 2, hstepB = (size_t)(Epi::WIDE ? 32 : HALF) * g.ldb * 2;
    const size_t tstepA = 2 * hstepA, tstepB = (size_t)BM * g.ldb * 2;
    const unsigned ldsw = (unsigned)wid * 1024u;
    const int aoff = lds_byte(wr * 64 + fr, fq * 8), boff = lds_byte(wc * 32 + fr, fq * 8);
#define PG8_SA(b, h) (((b) * 2 + (h)) * HTB)
#define PG8_SB(b, h) ((4 + (b) * 2 + (h)) * HTB)
#define PG8_STAGE(bufoff, gbase, voff) do { _Pragma("unroll") for (int _i = 0; _i < 2; ++_i) \
        __builtin_amdgcn_global_load_lds((const unsigned*)((const char*)(gbase) + (voff)[_i]), (PG8_LAS unsigned*)(lds + (bufoff) + ldsw + _i * 8192), 16, 0, 0); } while (0)
#define PG8_LDA(dst, b, h) do { _Pragma("unroll") for (int m = 0; m < 4; ++m) _Pragma("unroll") for (int k = 0; k < 2; ++k) dst[m][k] = *(const PG8_LAS bf16x8*)(lds + PG8_SA(b, h) + aoff + m * 2048 + k * 1024); } while (0)
#define PG8_LDB(dst, b, h) do { _Pragma("unroll") for (int n = 0; n < 2; ++n) _Pragma("unroll") for (int k = 0; k < 2; ++k) dst[n][k] = *(const PG8_LAS bf16x8*)(lds + PG8_SB(b, h) + boff + n * 2048 + k * 1024); } while (0)
#define PG8_MMA(ai, bj, At, Bt) do { __builtin_amdgcn_s_setprio(1); _Pragma("unroll") for (int m = 0; m < 4; ++m) _Pragma("unroll") for (int n = 0; n < 2; ++n) _Pragma("unroll") for (int k = 0; k < 2; ++k) \
        acc[ai][bj][m][n] = __builtin_amdgcn_mfma_f32_16x16x32_bf16(Bt[n][k], At[m][k], acc[ai][bj][m][n], 0, 0, 0); __builtin_amdgcn_s_setprio(0); } while (0)
#define PG8_WAIT_V(n) asm volatile("s_waitcnt vmcnt(" #n ")" ::: "memory")
#define PG8_WAIT_L(n) asm volatile("s_waitcnt lgkmcnt(" #n ")" ::: "memory")
#define PG8_BAR __builtin_amdgcn_s_barrier()
#define PG8_SCHED __builtin_amdgcn_sched_barrier(0)
    Unit cur, nxt; int ui = 0;
    if (!S.next(0, cur)) return;
    f32x4 acc[2][2][4][2];
#pragma unroll
    for (int a = 0; a < 2; ++a)
#pragma unroll
        for (int b = 0; b < 2; ++b)
#pragma unroll
            for (int m = 0; m < 4; ++m)
#pragma unroll
                for (int n = 0; n < 2; ++n) acc[a][b][m][n] = (f32x4){0.f, 0.f, 0.f, 0.f};
    bf16x8 At[4][2], B0[2][2], B1[2][2];
    const char* cA = (const char*)g.A + (size_t)cur.pm * tstepA; const char* cB = (const char*)g.Bt + (size_t)cur.pn * tstepB;
    S.a_ready(cur);
    if constexpr (SP2) {
        PG8_STAGE(PG8_SB(0, 0), cB, voffB); PG8_STAGE(PG8_SB(0, 1), cB + hstepB, voffB); PG8_STAGE(PG8_SA(0, 0), cA, voffA); PG8_STAGE(PG8_SA(0, 1), cA + hstepA, voffA);
        if (wr == 1) PG8_BAR;
        PG8_WAIT_V(2); PG8_BAR;
        PG8_STAGE(PG8_SB(1, 0), cB + kstep, voffB); PG8_STAGE(PG8_SA(1, 0), cA + kstep, voffA); PG8_STAGE(PG8_SB(1, 1), cB + hstepB + kstep, voffB);
        PG8_WAIT_V(6); PG8_BAR;
    } else {
        PG8_STAGE(PG8_SB(0, 0), cB, voffB); PG8_STAGE(PG8_SA(0, 0), cA, voffA); PG8_STAGE(PG8_SB(0, 1), cB + hstepB, voffB); PG8_STAGE(PG8_SA(0, 1), cA + hstepA, voffA);
        if (wr == 1) PG8_BAR;
        PG8_WAIT_V(4); PG8_BAR;
        PG8_STAGE(PG8_SB(1, 0), cB + kstep, voffB); PG8_STAGE(PG8_SA(1, 0), cA + kstep, voffA); PG8_STAGE(PG8_SB(1, 1), cB + hstepB + kstep, voffB);
        PG8_WAIT_V(6); PG8_BAR;
    }
    for (;;) {
        const bool has_next = S.next(ui + 1, nxt);
        const char* nA = has_next ? (const char*)g.A + (size_t)nxt.pm * tstepA : cA; const char* nB = has_next ? (const char*)g.Bt + (size_t)nxt.pn * tstepB : cB;
        for (int t = 0; t < nt; t += 2) {
            const bool last = (t == nt - 2);
            const char* a1 = cA + (size_t)(t + 1) * kstep;
            const char* a2 = last ? nA : cA + (size_t)(t + 2) * kstep; const char* b2 = last ? nB : cB + (size_t)(t + 2) * kstep;
            const char* a3 = a2 + kstep; const char* b3 = b2 + kstep;
            if (last && has_next) S.a_ready(nxt);
            if constexpr (SP2) {
            PG8_LDB(B0, 0, 0); PG8_LDB(B1, 0, 1); PG8_SCHED; PG8_LDA(At, 0, 0); PG8_STAGE(PG8_SA(1, 1), a1 + hstepA, voffA);
            PG8_WAIT_V(8); PG8_WAIT_L(0); PG8_BAR; PG8_MMA(0, 0, At, B0); PG8_MMA(0, 1, At, B1); PG8_BAR; PG8_SCHED;
            PG8_LDA(At, 0, 1); PG8_STAGE(PG8_SB(0, 0), b2, voffB); PG8_STAGE(PG8_SB(0, 1), b2 + hstepB, voffB); PG8_STAGE(PG8_SA(0, 0), a2, voffA);
            PG8_WAIT_V(8); PG8_WAIT_L(0); PG8_BAR; PG8_MMA(1, 0, At, B0); PG8_MMA(1, 1, At, B1); PG8_BAR; PG8_SCHED;
            PG8_LDB(B0, 1, 0); PG8_LDB(B1, 1, 1); PG8_SCHED; PG8_LDA(At, 1, 0); PG8_STAGE(PG8_SA(0, 1), a2 + hstepA, voffA);
            PG8_WAIT_V(8); PG8_WAIT_L(0); PG8_BAR; PG8_MMA(0, 0, At, B0); PG8_MMA(0, 1, At, B1); PG8_BAR; PG8_SCHED;
            PG8_LDA(At, 1, 1); PG8_STAGE(PG8_SB(1, 0), b3, voffB); PG8_STAGE(PG8_SB(1, 1), b3 + hstepB, voffB); PG8_STAGE(PG8_SA(1, 0), a3, voffA);
            PG8_WAIT_V(8); PG8_WAIT_L(0); PG8_BAR; PG8_MMA(1, 0, At, B0); PG8_MMA(1, 1, At, B1); PG8_BAR; PG8_SCHED;
            } else {
            PG8_LDB(B0, 0, 0); PG8_SCHED; PG8_LDA(At, 0, 0); PG8_STAGE(PG8_SA(1, 1), a1 + hstepA, voffA);
            PG8_WAIT_L(8); PG8_BAR; PG8_WAIT_L(0); PG8_MMA(0, 0, At, B0); PG8_BAR; PG8_SCHED;
            PG8_LDB(B1, 0, 1); PG8_STAGE(PG8_SB(0, 0), b2, voffB);
            PG8_BAR; PG8_WAIT_L(0); PG8_MMA(0, 1, At, B1); PG8_BAR;
            PG8_LDA(At, 0, 1); PG8_STAGE(PG8_SA(0, 0), a2, voffA);
            PG8_BAR; PG8_WAIT_L(0); PG8_MMA(1, 0, At, B0); PG8_BAR; PG8_SCHED;
            PG8_STAGE(PG8_SB(0, 1), b2 + hstepB, voffB);
            PG8_WAIT_V(6); PG8_BAR; PG8_MMA(1, 1, At, B1); PG8_BAR;
            PG8_LDB(B0, 1, 0); PG8_SCHED; PG8_LDA(At, 1, 0); PG8_STAGE(PG8_SA(0, 1), a2 + hstepA, voffA);
            PG8_WAIT_L(8); PG8_BAR; PG8_WAIT_L(0); PG8_MMA(0, 0, At, B0); PG8_BAR; PG8_SCHED;
            PG8_LDB(B1, 1, 1); PG8_STAGE(PG8_SB(1, 0), b3, voffB);
            PG8_BAR; PG8_WAIT_L(0); PG8_MMA(0, 1, At, B1); PG8_BAR;
            PG8_LDA(At, 1, 1); PG8_STAGE(PG8_SA(1, 0), a3, voffA);
            PG8_BAR; PG8_WAIT_L(0); PG8_MMA(1, 0, At, B0); PG8_BAR; PG8_SCHED;
            PG8_STAGE(PG8_SB(1, 1), b3 + hstepB, voffB);
            PG8_WAIT_V(6); PG8_BAR; PG8_MMA(1, 1, At, B1); PG8_BAR;
            }
            if constexpr (Epi::MID) { if (!last && ((t + 2) % Epi::SEG) == 0) E.mid(acc, cur, (t + 2) / Epi::SEG - 1, wr, wc, fr, fq); }
        }
        if constexpr (ALIGN_EPI) { if (wr == 0) PG8_BAR; }
        if constexpr (!Epi::AFTER_DRAIN) { E(acc, cur, wr, wc, fr, fq); S.done(cur); }
        if (!has_next) break;
#pragma unroll
        for (int a = 0; a < 2; ++a)
#pragma unroll
            for (int b = 0; b < 2; ++b)
#pragma unroll
                for (int m = 0; m < 4; ++m)
#pragma unroll
                    for (int n = 0; n < 2; ++n) acc[a][b][m][n] = (f32x4){0.f, 0.f, 0.f, 0.f};
        cur = nxt; cA = nA; cB = nB; ++ui;
        if constexpr (ALIGN_EPI) { if (wr == 1) PG8_BAR; }
    }
    PG8_WAIT_V(0);
    if constexpr (!ALIGN_EPI) { if (wr == 0) PG8_BAR; }
    PG8_BAR;
    if constexpr (Epi::AFTER_DRAIN) { E.fused(acc, cur, wr, wc, fr, fq, lds, wid, lane); S.done(cur); }
#undef PG8_SA
#undef PG8_SB
#undef PG8_STAGE
#undef PG8_LDA
#undef PG8_LDB
#undef PG8_MMA
#undef PG8_WAIT_V
#undef PG8_WAIT_L
#undef PG8_BAR
#undef PG8_SCHED
}
}
constexpr int D = 4096, TREAL = 8192, NMETA = 16, MROWS = 8448, METAROW = 8192;
constexpr int MIXW = 1024, NPROJ = 29696, NIN = 29704, DFF = 11008, NGU = 22016, NLAYER = 2;
constexpr int PC_MLQ = 0, PC_MLK = 1024, PC_MLV = 2048, PC_MLO = 3072, PC_SBQ = 4096, PC_SBK = 5120, PC_SBV = 6144, PC_HGQ = 7168, PC_HGF = 8192, PC_HGI = 9216, PC_HGG = 10240, PC_RGX = 11264, PC_RGY = 12288, PC_GATE = 13312;
constexpr int NCH = 65;
constexpr float EPS = 1e-6f, NEGF = -1e30f;
constexpr int NWAVES = 8, NTHR = 512;

constexpr size_t MiB = 1u << 20;
constexpr size_t al(size_t x) { return (x + MiB - 1) / MiB * MiB; }
constexpr size_t WS_CTL = 0, CTL_ZERO_BYTES = 1 * MiB;
constexpr size_t SZ_WIN = (size_t)NPROJ * D * 2, SZ_WSQ = (size_t)D * D * 2, SZ_WGU = (size_t)NGU * D * 2, SZ_WD = (size_t)D * DFF * 2;
constexpr size_t WS_WIN = 1 * MiB;
constexpr size_t WS_WUP = WS_WIN + al(2 * SZ_WIN);
constexpr size_t WS_WOUT = WS_WUP + al(2 * SZ_WSQ);
constexpr size_t WS_WGU = WS_WOUT + al(2 * SZ_WSQ);
constexpr size_t WS_WD = WS_WGU + al(2 * SZ_WGU);
constexpr size_t WS_PROJ = WS_WD + al(2 * SZ_WD);
constexpr size_t WS_ACT = WS_PROJ;
constexpr size_t WS_XN = WS_PROJ + al((size_t)MROWS * NPROJ * 2);
constexpr size_t WS_BR = WS_XN + al((size_t)MROWS * D * 2);
constexpr size_t WS_MG = WS_BR + al((size_t)MROWS * D * 2);
constexpr size_t WS_HMETA = WS_MG + al((size_t)MROWS * D * 2);
constexpr size_t WS_GIF = WS_HMETA + al((size_t)256 * D * 4);
constexpr size_t WS_WIF = WS_GIF + al((size_t)MROWS * 8 * 4);
constexpr size_t WS_LB = WS_WIF + al((size_t)2 * 8 * D * 4);
constexpr size_t WS_MLS = WS_LB + MiB;
constexpr size_t WS_MLN = WS_MLS + al((size_t)520 * 65536 * 4);
constexpr size_t WS_MLSC = WS_MLN + al((size_t)520 * 256 * 4);
constexpr size_t WS_HGS = WS_MLSC + MiB;
constexpr size_t WS_HGE = WS_HGS + al((size_t)1040 * 16384 * 4);
constexpr size_t WS_RGH = WS_HGE + al((size_t)1040 * 128 * 4);
constexpr size_t WS_RGP = WS_RGH + al((size_t)MROWS * 1024 * 4);
constexpr size_t WS_RGT = WS_RGP + al((size_t)MROWS * 1024 * 4);
constexpr size_t WS_MLCT = WS_RGT + al((size_t)3 * 2 * 65 * 1024 * 4);
constexpr size_t MLCT_UNIT = (size_t)17 * 8 * 64 * 8;
constexpr size_t WS_HB = WS_MLCT + al((size_t)520 * MLCT_UNIT * 2);
constexpr size_t WS_END = WS_HB + al((size_t)TREAL * D * 2);
static_assert(WS_END <= (size_t)2300 * MiB, "workspace map");
constexpr int CW_BAR = 4096;

constexpr int RING_BYTES = 131072;
constexpr int LDSCTL_OFF = RING_BYTES + 8192, MISC_OFF = LDSCTL_OFF + 320;
constexpr int LDS_BYTES = 147456;
static_assert(MISC_OFF + 128 <= LDS_BYTES, "LDS map");

#define GAS __attribute__((address_space(1)))
#define LAS __attribute__((address_space(3)))
typedef unsigned short bf16;
typedef unsigned v4u __attribute__((ext_vector_type(4)));
typedef unsigned v2u __attribute__((ext_vector_type(2)));
typedef float f32x4 __attribute__((ext_vector_type(4)));
typedef float f32x2 __attribute__((ext_vector_type(2)));
typedef GAS unsigned gu32;
#define RLX_AGENT __ATOMIC_RELAXED, __HIP_MEMORY_SCOPE_AGENT
#define LDS_WAIT() asm volatile("s_waitcnt lgkmcnt(0)" ::: "memory")
#define VM_WAIT() asm volatile("s_waitcnt vmcnt(0)" ::: "memory")
typedef float f32x2c_ __attribute__((ext_vector_type(2)));
typedef __bf16 bf16x2c_ __attribute__((ext_vector_type(2)));
__device__ __forceinline__ unsigned pk2(float lo, float hi) { const f32x2c_ v = {lo, hi}; const bf16x2c_ b = __builtin_convertvector(v, bf16x2c_); return __builtin_bit_cast(unsigned, b); }
__device__ __forceinline__ unsigned f2bf(float f) { const __bf16 b = (__bf16)f; return (unsigned)__builtin_bit_cast(unsigned short, b); }
__device__ __forceinline__ float bflo(unsigned w) { return __uint_as_float(w << 16); }
__device__ __forceinline__ float bfhi(unsigned w) { return __uint_as_float(w & 0xffff0000u); }
__device__ __forceinline__ float bf1(bf16 b) { return __uint_as_float(((unsigned)b) << 16); }
__device__ __forceinline__ void unpack8(const v4u w, float (&o)[8]) { o[0] = bflo(w.x); o[1] = bfhi(w.x); o[2] = bflo(w.y); o[3] = bfhi(w.y); o[4] = bflo(w.z); o[5] = bfhi(w.z); o[6] = bflo(w.w); o[7] = bfhi(w.w); }
__device__ __forceinline__ float wave_sum(float v) {
#pragma unroll
    for (int o = 1; o < 64; o <<= 1) v += __shfl_xor(v, o);
    return v;
}
__device__ __forceinline__ float wave_max(float v) {
#pragma unroll
    for (int o = 1; o < 64; o <<= 1) v = fmaxf(v, __shfl_xor(v, o));
    return v;
}
__device__ __forceinline__ float wave_incl_sum(float v, int lane) {
#pragma unroll
    for (int o = 1; o < 64; o <<= 1) { const float t = __shfl_up(v, o); if (lane >= o) v += t; }
    return v;
}
__device__ __forceinline__ float wave_incl_max(float v, int lane) {
#pragma unroll
    for (int o = 1; o < 64; o <<= 1) { const float t = __shfl_up(v, o); if (lane >= o) v = fmaxf(v, t); }
    return v;
}
__device__ __forceinline__ float sigmoidf_(float x) { return __builtin_amdgcn_rcpf(1.0f + __expf(-x)); }
__device__ __forceinline__ float log_sigmoidf_(float x) { return fminf(x, 0.f) - log1pf(expf(-fabsf(x))); }
__device__ __forceinline__ float softplusf_(float x) { return fmaxf(x, 0.f) + log1pf(expf(-fabsf(x))); }
__device__ __forceinline__ int seq_row(int b, int p) { return p < NMETA ? METAROW + p : b * 4096 + p - NMETA; }
#define XB_TMO      128
#define XB_XCNT(j)  (256  + 64 * (j))
#define XB_XSUB(j)  (1280 + 64 * (j))
#define XB_XGEN(j)  (2304 + 64 * (j))
#define XB_TOP      3328
#define XB_TOPGEN   3392
#define XCD_BAR_WORDS 3456
#define XB_SPIN_CAP (1u << 18)

__device__ __forceinline__ unsigned xb_ld(unsigned* p)              { return __hip_atomic_load(p, __ATOMIC_RELAXED, __HIP_MEMORY_SCOPE_AGENT); }
__device__ __forceinline__ unsigned xb_add(unsigned* p, unsigned v) { return __hip_atomic_fetch_add(p, v, __ATOMIC_RELAXED, __HIP_MEMORY_SCOPE_AGENT); }
__device__ __forceinline__ unsigned xb_xcc_id() { return (unsigned)__builtin_amdgcn_s_getreg((3 << 11) | 20) & 0xFu; }
#define XB_SPIN(cond, bar) do { unsigned _sp = 0; while (cond) { __builtin_amdgcn_s_sleep(1); \
    if ((++_sp & 255u) == 0u) { if (xb_ld(&(bar)[XB_TMO])) break; if (_sp > XB_SPIN_CAP) { atomicAdd(&(bar)[XB_TMO], 1u); break; } } } } while (0)

struct XcdBarrier {
    unsigned* bar; unsigned x;
    volatile LAS unsigned* st;
};

__device__ __forceinline__ XcdBarrier xcd_barrier_post(unsigned* bar, volatile LAS unsigned* st) {
    XcdBarrier b; b.bar = bar; b.x = xb_xcc_id(); b.st = st;
    if (threadIdx.x == 0) (void)xb_add(&bar[XB_XCNT(b.x)], 1u);
    return b;
}
__device__ __forceinline__ void xcd_barrier_complete(unsigned* bar, unsigned x, unsigned& nloc, unsigned& nx) {
    const unsigned G = gridDim.x * gridDim.y * gridDim.z;
    unsigned sum, cnt, mine, sp = 0u;
    for (;;) {
        sum = 0u; cnt = 0u; mine = 0u;
#pragma unroll
        for (unsigned j = 0; j < 16; ++j) { const unsigned c = xb_ld(&bar[XB_XCNT(j)]); sum += c; cnt += (c > 0u) ? 1u : 0u; mine = (j == x) ? c : mine; }
        if (sum == G) break;
        __builtin_amdgcn_s_sleep(1);
        if ((++sp & 255u) == 0u) { if (xb_ld(&bar[XB_TMO])) break; if (sp > XB_SPIN_CAP) { atomicAdd(&bar[XB_TMO], 1u); break; } }
    }
    nloc = mine > 0u ? mine : 1u; nx = cnt > 0u ? cnt : 1u;
}

__device__ __forceinline__ void xcd_barrier(const XcdBarrier& b) {
    asm volatile("s_waitcnt vmcnt(0)" ::: "memory");
    __syncthreads();
    if (threadIdx.x == 0) {
        unsigned* bar = b.bar;
        __builtin_amdgcn_s_waitcnt(0);
        unsigned nloc = b.st[0], nx = b.st[1];
        if (nloc == 0u) { xcd_barrier_complete(bar, b.x, nloc, nx); b.st[0] = nloc; b.st[1] = nx; }
        const unsigned old = xb_add(&bar[XB_XSUB(b.x)], 1u);
        const unsigned gen = old / nloc;
        if (old + 1u == (gen + 1u) * nloc) {
            __builtin_amdgcn_fence(__ATOMIC_RELEASE, "agent");
            asm volatile("s_waitcnt vmcnt(0)" ::: "memory");
            const unsigned og = xb_add(&bar[XB_TOP], 1u);
            const unsigned tg = og / nx;
            if (og + 1u == (tg + 1u) * nx) xb_add(&bar[XB_TOPGEN], 1u);
            else XB_SPIN(xb_ld(&bar[XB_TOPGEN]) == tg, bar);
            __builtin_amdgcn_fence(__ATOMIC_ACQUIRE, "agent");
            xb_add(&bar[XB_XGEN(b.x)], 1u);
            asm volatile("s_waitcnt vmcnt(0)" ::: "memory");
        } else {
            XB_SPIN(xb_ld(&bar[XB_XGEN(b.x)]) == gen, bar);
            __builtin_amdgcn_fence(__ATOMIC_ACQUIRE, "agent");
            asm volatile("s_waitcnt vmcnt(0)" ::: "memory");
        }
    }
    __syncthreads();
}
template <int N> __device__ __forceinline__ float dpp_shr16(float v) { return __builtin_bit_cast(float, __builtin_amdgcn_update_dpp(0, __builtin_bit_cast(int, v), 0x110 + N, 0xf, 0xf, true)); }
typedef __bf16 bf16x2v __attribute__((ext_vector_type(2)));
__device__ __forceinline__ float dot2bf(unsigned a, unsigned b, float acc) { return __builtin_amdgcn_fdot2_f32_bf16(__builtin_bit_cast(bf16x2v, a), __builtin_bit_cast(bf16x2v, b), acc, false); }
typedef short bf16x8v __attribute__((ext_vector_type(8)));
#define MFMA16(a, b, c) __builtin_amdgcn_mfma_f32_16x16x32_bf16(a, b, c, 0, 0, 0)
__device__ __forceinline__ bf16x8v pack8(const float (&x)[8]) { v4u w; w.x = pk2(x[0], x[1]); w.y = pk2(x[2], x[3]); w.z = pk2(x[4], x[5]); w.w = pk2(x[6], x[7]); return __builtin_bit_cast(bf16x8v, w); }
__device__ __forceinline__ float fast_sigmoid_(float x) { return __builtin_amdgcn_rcpf(1.0f + __expf(-x)); }
struct P0Item { const float* src; bf16* dst; int ldw, K; };
struct P0Strip { const float* src0; bf16* dst0; int ldw, K, kb_lo, kb_n; };
constexpr int NSTRIP_DN = 2 * NLAYER * 64, NSTRIP_L = 464 + 344 + 64 + 64, NSTRIP = NSTRIP_DN + NLAYER * NSTRIP_L;
__device__ __forceinline__ P0Strip p0_strip(const float* const* in, unsigned char* ws, int s) {
    P0Strip o;
    if (s < NSTRIP_DN) { const int l = s >> 7, rem = s & 127, nb = rem >> 1, half = rem & 1;
        o.ldw = D; o.K = DFF; o.src0 = in[22] + (size_t)l * DFF * D + 64 * nb; o.dst0 = (bf16*)(ws + WS_WD + (size_t)l * SZ_WD) + (size_t)(64 * nb) * DFF; o.kb_lo = 86 * half; o.kb_n = 86; return o; }
    s -= NSTRIP_DN; const int l = s / NSTRIP_L; int r = s - l * NSTRIP_L; o.K = D; o.kb_lo = 0; o.kb_n = 64;
    if (r < 464) { o.ldw = NIN; o.src0 = in[4] + (size_t)l * D * NIN + 64 * r + (r >= 64 ? 8 : 0); o.dst0 = (bf16*)(ws + WS_WIN + (size_t)l * SZ_WIN) + (size_t)(64 * r) * D; return o; } r -= 464;
    if (r < 344) { const int which = r / 172, nb = r % 172, n0 = 64 * nb; o.ldw = DFF; o.src0 = in[20 + which] + (size_t)l * D * DFF + n0; o.dst0 = (bf16*)(ws + WS_WGU + (size_t)l * SZ_WGU) + (size_t)((n0 >> 7) * 256 + which * 128 + (n0 & 127)) * D; return o; } r -= 344;
    if (r < 64) { o.ldw = D; o.src0 = in[18] + (size_t)l * D * D + 64 * r; o.dst0 = (bf16*)(ws + WS_WUP + (size_t)l * SZ_WSQ) + (size_t)(64 * r) * D; return o; } r -= 64;
    { o.ldw = D; o.src0 = in[19] + (size_t)l * D * D + 64 * r; o.dst0 = (bf16*)(ws + WS_WOUT + (size_t)l * SZ_WSQ) + (size_t)(64 * r) * D; return o; }
}
__device__ __forceinline__ P0Item p0_item(const P0Strip& S, int kb) { P0Item o; o.src = S.src0 + (size_t)(64 * kb) * S.ldw; o.dst = S.dst0 + 64 * kb; o.ldw = S.ldw; o.K = S.K; return o; }
__device__ __forceinline__ void p0_load(const P0Item& I, f32x4 (&v)[16], int lane) {
    const float* p = I.src + (size_t)(2 * (lane >> 4)) * I.ldw + 4 * (lane & 15);
#pragma unroll
#if defined(P0_NT)
    for (int j = 0; j < 16; ++j) v[j] = __builtin_nontemporal_load((const f32x4*)(p + (size_t)(8 * (j >> 1) + (j & 1)) * I.ldw));
#else
    for (int j = 0; j < 16; ++j) v[j] = *(const f32x4*)(p + (size_t)(8 * (j >> 1) + (j & 1)) * I.ldw);
#endif
}
__device__ __forceinline__ void p0_store(const P0Item& I, const f32x4 (&v)[16], unsigned* scr, int lane) {
    const int l15 = lane & 15, l4 = lane >> 4;
#pragma unroll
    for (int m = 0; m < 8; ++m)
#pragma unroll
        for (int i = 0; i < 4; ++i) scr[(4 * l15 + i) * 33 + 4 * m + l4] = pk2(v[2 * m][i], v[2 * m + 1][i]);
    LDS_WAIT(); asm volatile("" ::: "memory");
    const int c = lane & 7;
#pragma unroll
    for (int j = 0; j < 8; ++j) { const int n = (lane >> 3) + 8 * j; const unsigned* s = scr + n * 33 + 4 * c;
        v4u o; o.x = s[0]; o.y = s[1]; o.z = s[2]; o.w = s[3];
        *(v4u*)(I.dst + (size_t)n * I.K + 8 * c) = o; }
    LDS_WAIT(); asm volatile("" ::: "memory");
}
__device__ __forceinline__ void p0_prologue(const float* const* in, unsigned char* ws, unsigned char* lds, int bxp, int Gp, int wave, int lane, int gtid, int NGT) {
    unsigned* scr = (unsigned*)(lds + wave * 16384);
    const float* w_in = in[4];
#if defined(PROBE_P0_STORES)
    for (int sidx = bxp; sidx < NSTRIP; sidx += Gp) { const P0Strip S = p0_strip(in, ws, sidx); const int hi = S.kb_lo + S.kb_n;
        for (int kb = S.kb_lo + wave; kb < hi; kb += NWAVES) { const P0Item I = p0_item(S, kb); const int c = lane & 7;
#pragma unroll
            for (int j = 0; j < 8; ++j) { const int n = (lane >> 3) + 8 * j; *(v4u*)(I.dst + (size_t)n * I.K + 8 * c) = (v4u){(unsigned)kb, (unsigned)j, 0u, 0u}; } } }
    VM_WAIT(); __syncthreads();
#endif
#if defined(PROBE_P0_LOADS)
    for (int sidx = bxp; sidx < NSTRIP; sidx += Gp) { const P0Strip S = p0_strip(in, ws, sidx); const int hi = S.kb_lo + S.kb_n; f32x4 va[16];
        for (int kb = S.kb_lo + wave; kb < hi; kb += NWAVES) { p0_load(p0_item(S, kb), va, lane);
#pragma unroll
            for (int j = 0; j < 16; ++j) asm volatile("" :: "v"(va[j])); } }
    VM_WAIT(); __syncthreads();
#endif
    for (int sidx = bxp; sidx < NSTRIP; sidx += Gp) {
        const P0Strip S = p0_strip(in, ws, sidx); const int hi = S.kb_lo + S.kb_n; int kb = S.kb_lo + wave; f32x4 va[16], vb[16];
        if (kb < hi) p0_load(p0_item(S, kb), va, lane);
        while (kb < hi) {
            const int k1 = kb + NWAVES; if (k1 < hi) p0_load(p0_item(S, k1), vb, lane);
            p0_store(p0_item(S, kb), va, scr, lane);
            if (k1 >= hi) break;
            const int k2 = k1 + NWAVES; if (k2 < hi) p0_load(p0_item(S, k2), va, lane);
            p0_store(p0_item(S, k1), vb, scr, lane);
            kb = k2; }
    }
    { float* hm = (float*)(ws + WS_HMETA); const float* meta = in[1];
      for (int i = gtid; i < 256 * D; i += NGT) hm[i] = (i < NMETA * D) ? meta[i] : 0.f; }
    { unsigned* brp = (unsigned*)(ws + WS_BR + (size_t)(TREAL + NMETA) * D * 2);
      for (int i = gtid; i < (MROWS - TREAL - NMETA) * D / 2; i += NGT) brp[i] = 0u; }
    { float* wif = (float*)(ws + WS_WIF);
      for (int it = bxp * NWAVES + wave; it < NLAYER * 64; it += Gp * NWAVES) { const int l = it >> 6, k = 64 * (it & 63) + lane;
          const float* p = w_in + ((size_t)l * D + k) * NIN + 4096; const f32x4 a = *(const f32x4*)p, b = *(const f32x4*)(p + 4);
          float* wq = wif + (size_t)l * 8 * D + k;
          wq[0] = a.x; wq[D] = a.y; wq[2 * D] = a.z; wq[3 * D] = a.w; wq[4 * D] = b.x; wq[5 * D] = b.y; wq[6 * D] = b.z; wq[7 * D] = b.w; } }
    { float* lb = (float*)(ws + WS_LB); const float* hl = in[9];
      for (int i = gtid; i < 1024; i += NGT) { const float a0 = hl[i], a1 = hl[1024 + i], mx = fmaxf(a0, a1), e0 = expf(a0 - mx), e1 = expf(a1 - mx); const float p1 = e1 / (e0 + e1);
          lb[i] = 0.f; lb[1024 + i] = fminf(fmaxf(p1, 0.f), 0.999f); } }
}

template <bool GATES, bool HBF> __device__ __forceinline__ void norm_rows(const void* hreal, const float* hmeta, const float* gain, bf16* XN, int nrows, const float* wif_g, const float* bif, float* gif, int gw, int NGW, int lane, unsigned char* lds, int tid) {
    const float* wif = (const float*)lds;
    if (GATES) {
        for (int i = tid; i < 8 * D / 4; i += NTHR) *(f32x4*)(lds + (size_t)i * 16) = *(const f32x4*)(wif_g + (size_t)i * 4);
        __syncthreads(); }
    for (int row = gw; row < nrows; row += NGW) {
        f32x4 v[16]; float ss = 0.f;
        const bool real_bf = HBF && row < TREAL;
        const float* hr = row < TREAL ? (const float*)hreal + (size_t)row * D : hmeta + (size_t)(row - TREAL) * D;
        const bf16* hb = (const bf16*)hreal + (size_t)row * D;
#pragma unroll
        for (int j = 0; j < 8; ++j) {
            if (real_bf) { const v4u a = *(const v4u*)(hb + 512 * j + 8 * lane); v[2 * j] = (f32x4){bflo(a.x), bfhi(a.x), bflo(a.y), bfhi(a.y)}; v[2 * j + 1] = (f32x4){bflo(a.z), bfhi(a.z), bflo(a.w), bfhi(a.w)}; }
            else { const float* p = hr + 512 * j + 8 * lane; v[2 * j] = *(const f32x4*)p; v[2 * j + 1] = *(const f32x4*)(p + 4); }
            ss += (v[2 * j].x * v[2 * j].x + v[2 * j].y * v[2 * j].y) + (v[2 * j].z * v[2 * j].z + v[2 * j].w * v[2 * j].w) + (v[2 * j + 1].x * v[2 * j + 1].x + v[2 * j + 1].y * v[2 * j + 1].y) + (v[2 * j + 1].z * v[2 * j + 1].z + v[2 * j + 1].w * v[2 * j + 1].w); }
        const float rstd = __builtin_amdgcn_rsqf(wave_sum(ss) * (1.0f / D) + EPS);
#pragma unroll
        for (int j = 0; j < 8; ++j) { const float* gp = gain + 512 * j + 8 * lane; const f32x4 g0 = *(const f32x4*)gp, g1 = *(const f32x4*)(gp + 4);
            v[2 * j] = v[2 * j] * rstd * g0; v[2 * j + 1] = v[2 * j + 1] * rstd * g1;
            v4u o; o.x = pk2(v[2 * j].x, v[2 * j].y); o.y = pk2(v[2 * j].z, v[2 * j].w); o.z = pk2(v[2 * j + 1].x, v[2 * j + 1].y); o.w = pk2(v[2 * j + 1].z, v[2 * j + 1].w);
            *(v4u*)(XN + (size_t)row * D + 512 * j + 8 * lane) = o; }
        if (GATES) { float mine = 0.f;
#pragma unroll 1
            for (int jj = 0; jj < 8; ++jj) { float dot = 0.f; const float* wp = wif + jj * D + 8 * lane;
#pragma unroll
                for (int j = 0; j < 8; ++j) { const f32x4 w0 = *(const f32x4*)(wp + 512 * j), w1 = *(const f32x4*)(wp + 512 * j + 4);
                    dot += (v[2 * j].x * w0.x + v[2 * j].y * w0.y) + (v[2 * j].z * w0.z + v[2 * j].w * w0.w) + (v[2 * j + 1].x * w1.x + v[2 * j + 1].y * w1.y) + (v[2 * j + 1].z * w1.z + v[2 * j + 1].w * w1.w); }
                dot = wave_sum(dot); if (lane == jj) mine = dot + bif[jj]; }
            if (lane < 8) gif[(size_t)row * 8 + lane] = mine; }
    }
}

__device__ __forceinline__ void mlstm_A(const bf16* PROJ, const float* GIF, float* MLS, float* MLN, float* MLSC, int u, unsigned char* lds, int tid) {
    const int c = u % NCH, bh = u / NCH, h = bh & 3, b = bh >> 2, lane = tid & 63, wave = tid >> 6, lc = lane & 15, g = lane >> 4;
    constexpr int QP = 264;
    bf16* kw = (bf16*)lds; bf16* vs = (bf16*)(lds + 33792); float* wsc = (float*)(lds + RING_BYTES);
    if (tid < 64) {
        const int p = 64 * c + lane - 48; float lf = 0.f, li = NEGF;
        if (p >= 0) { const int row = seq_row(b, p); li = GIF[(size_t)row * 8 + h]; lf = log_sigmoidf_(GIF[(size_t)row * 8 + 4 + h]); }
        const float bc = wave_incl_sum(lf, lane); const float bend = __shfl(bc, 63);
        const float wl = bend - bc + li; const float a = wave_max(wl);
        wsc[lane] = expf(wl - a);
        if (lane == 0) { MLSC[u] = a; MLSC[520 + u] = bend; }
    }
    __syncthreads();
#pragma unroll
    for (int j = 0; j < 4; ++j) { const int id = tid + 512 * j, r = id >> 5, cp = id & 31, p = 64 * c + r - 48;
        v4u vr = (v4u){0u, 0u, 0u, 0u}; float kv[8];
#pragma unroll
        for (int q = 0; q < 8; ++q) kv[q] = 0.f;
        if (p >= 0) { const size_t ro = (size_t)seq_row(b, p) * NPROJ + h * 256 + cp * 8; unpack8(*(const v4u*)(PROJ + ro + PC_MLK), kv); vr = *(const v4u*)(PROJ + ro + PC_MLV); const float w = wsc[r];
#pragma unroll
            for (int q = 0; q < 8; ++q) kv[q] *= w; }
        *(bf16x8v*)(kw + r * QP + cp * 8) = pack8(kv); *(v4u*)(vs + r * QP + cp * 8) = vr; }
    __syncthreads();
    bf16x8v af[2][2];
#pragma unroll
    for (int dt = 0; dt < 2; ++dt)
#pragma unroll
        for (int ks = 0; ks < 2; ++ks)
#pragma unroll
            for (int i = 0; i < 8; ++i) af[dt][ks][i] = (short)kw[(32 * ks + 8 * g + i) * QP + 32 * wave + 16 * dt + lc];
    bf16* out = (bf16*)MLS + (size_t)u * MLCT_UNIT;
    for (int et = 0; et < 17; ++et) { bf16x8v bv[2];
#pragma unroll
        for (int ks = 0; ks < 2; ++ks)
#pragma unroll
            for (int i = 0; i < 8; ++i) bv[ks][i] = (et < 16) ? (short)vs[(32 * ks + 8 * g + i) * QP + 16 * et + lc] : ((lc == 0) ? (short)0x3F80 : (short)0);
#pragma unroll
        for (int dt = 0; dt < 2; ++dt) { f32x4 acc = (f32x4){0.f, 0.f, 0.f, 0.f};
#pragma unroll
            for (int ks = 0; ks < 2; ++ks) acc = MFMA16(af[dt][ks], bv[ks], acc);
            const int d0 = 32 * wave + 16 * dt + 4 * g;
            if (et < 16) { v2u w; w.x = pk2(acc[0], acc[1]); w.y = pk2(acc[2], acc[3]);
                *(v2u*)(out + ((size_t)(et * 8 + wave) * 64 + lc + 16 * (2 * dt + (g >> 1))) * 8 + 4 * (g & 1)) = w; }
            else if (lc == 0) {
#pragma unroll
                for (int r = 0; r < 4; ++r) MLN[(size_t)u * 256 + d0 + r] = acc[r]; } } }
    __syncthreads();
}
__device__ __forceinline__ void mlstm_B(const float* MLS, const float* MLN, float* MLSC, bf16* MLCT, int unit, unsigned char* lds, int tid) {
    const int chain = unit >> 5, slice = unit & 31;
    float* alpha = (float*)lds; float* beta = alpha + 80; float* av = alpha + 160; float* bv = alpha + 240; float* mm = alpha + 320;
    if (tid < NCH) { av[tid] = MLSC[chain * NCH + tid]; bv[tid] = MLSC[520 + chain * NCH + tid]; }
    __syncthreads();
    if (tid == 0) { float m = 0.f;
        for (int c = 0; c < NCH; ++c) { mm[c] = m; m = fmaxf(bv[c] + m, av[c]); } mm[NCH] = m; }
    __syncthreads();
    if (tid < NCH) { const float m = mm[tid], mn = mm[tid + 1]; alpha[tid] = __expf(bv[tid] + m - mn); beta[tid] = __expf(av[tid] - mn); if (slice == 0) MLSC[1040 + chain * NCH + tid] = m; }
    __syncthreads();
    { const int gid = slice * 512 + tid, e = gid & 255, d4 = gid >> 8; float st[4];
#pragma unroll
      for (int i = 0; i < 4; ++i) st[i] = 0.f;
      const size_t fo = ((size_t)((e >> 4) * 8 + (d4 >> 3)) * 64 + (e & 15) + 16 * ((d4 >> 1) & 3)) * 8 + 4 * (d4 & 1);
#pragma unroll 4
      for (int c = 0; c < NCH; ++c) { const size_t uu = (size_t)chain * NCH + c; const v2u dw = *(const v2u*)((const bf16*)MLS + uu * MLCT_UNIT + fo); const float dl[4] = {bflo(dw.x), bfhi(dw.x), bflo(dw.y), bfhi(dw.y)};
          v2u w; w.x = pk2(st[0], st[1]); w.y = pk2(st[2], st[3]); *(v2u*)(MLCT + uu * MLCT_UNIT + fo) = w;
          const float al_ = alpha[c], be_ = beta[c];
#pragma unroll
          for (int i = 0; i < 4; ++i) st[i] = st[i] * al_ + dl[i] * be_; } }
    if (slice == 0) { const int ks = tid >> 6, l = tid & 63; const bool own = (l & 15) == 0; const int d0 = 32 * ks + 8 * (l >> 4); float st[8];
#pragma unroll
      for (int i = 0; i < 8; ++i) st[i] = 0.f;
#pragma unroll 5
      for (int c = 0; c < NCH; ++c) { const size_t uu = (size_t)chain * NCH + c; const f32x4 n0 = *(const f32x4*)(MLN + uu * 256 + d0), n1 = *(const f32x4*)(MLN + uu * 256 + d0 + 4);
          const float sel = own ? 1.f : 0.f; const float dl[8] = {n0.x * sel, n0.y * sel, n0.z * sel, n0.w * sel, n1.x * sel, n1.y * sel, n1.z * sel, n1.w * sel};
          *(bf16x8v*)(MLCT + uu * MLCT_UNIT + ((size_t)(16 * 8 + ks) * 64 + l) * 8) = pack8(st);
          const float al_ = alpha[c], be_ = beta[c];
#pragma unroll
          for (int i = 0; i < 8; ++i) st[i] = st[i] * al_ + dl[i] * be_; } }
    __syncthreads();
}
template <bool DEN> __device__ __forceinline__ void ml_tile(const bf16* CT, const bf16* Qs, const bf16* Sp, const bf16* Vs, const float* inter, int j, f32x4 (&acc)[4], int lane) {
    constexpr int QP = 264, SP = 72; const int lc = lane & 15, g = lane >> 4;
    bf16x8v bfr[8];
#pragma unroll
    for (int ks = 0; ks < 8; ++ks) bfr[ks] = *(const bf16x8v*)(CT + ((size_t)(j * 8 + ks) * 64 + lane) * 8);
#pragma unroll
    for (int m = 0; m < 4; ++m) acc[m] = (f32x4){0.f, 0.f, 0.f, 0.f};
#pragma unroll
    for (int ks = 0; ks < 8; ++ks) {
#pragma unroll
        for (int m = 0; m < 4; ++m) acc[m] = MFMA16(*(const bf16x8v*)(Qs + (16 * m + lc) * QP + 32 * ks + 8 * g), bfr[ks], acc[m]);
        asm volatile("" ::: "memory"); }
#pragma unroll
    for (int m = 0; m < 4; ++m)
#pragma unroll
        for (int r = 0; r < 4; ++r) acc[m][r] *= inter[16 * m + 4 * g + r];
#pragma unroll
    for (int ks = 0; ks < 2; ++ks) { bf16x8v vf;
        if (!DEN) {
#pragma unroll
            for (int i = 0; i < 8; ++i) vf[i] = (short)Vs[(32 * ks + 8 * g + i) * QP + 16 * j + lc]; }
        else {
#pragma unroll
            for (int i = 0; i < 8; ++i) vf[i] = (lc == 0) ? (short)0x3F80 : (short)0; }
#pragma unroll
        for (int m = 0; m < 4; ++m) acc[m] = MFMA16(*(const bf16x8v*)(Sp + (16 * m + lc) * SP + 32 * ks + 8 * g), vf, acc[m]);
        asm volatile("" ::: "memory"); }
}
__device__ __forceinline__ void mlstm_C(const bf16* PROJ, const float* GIF, const bf16* MLCT, const float* MLSC, const float* ml_norm, bf16* BRp, int u, unsigned char* lds, int tid) {
    const int c = u % NCH, bh = u / NCH, h = bh & 3, b = bh >> 2, lane = tid & 63, wave = tid >> 6, lc = lane & 15, g = lane >> 4;
    constexpr int QP = 264, SP = 72;
    bf16* Qs = (bf16*)lds; bf16* Ks = (bf16*)(lds + 33792); bf16* Vs = (bf16*)(lds + 67584); bf16* Sp = (bf16*)(lds + 101376);
    float* bcs = (float*)(lds + RING_BYTES); float* lis = bcs + 64; float* mout = lis + 64; float* inter = mout + 64; float* den = inter + 64; float* rstd = den + 64; float* part = rstd + 64;
    if (tid < 64) {
        const int p = 64 * c + lane - 48; float lf = 0.f, li = NEGF;
        if (p >= 0) { const int row = seq_row(b, p); li = GIF[(size_t)row * 8 + h]; lf = log_sigmoidf_(GIF[(size_t)row * 8 + 4 + h]); }
        const float bc = wave_incl_sum(lf, lane); const float pm = wave_incl_max(li - bc, lane); const float mc = MLSC[1040 + u];
        const float mo = fmaxf(bc + mc, bc + pm);
        bcs[lane] = bc; lis[lane] = li; mout[lane] = mo; inter[lane] = expf(bc + mc - mo) * 0.0625f;
    }
#pragma unroll
    for (int j = 0; j < 4; ++j) { const int id = tid + 512 * j, r = id >> 5, cp = id & 31, p = 64 * c + r - 48;
        v4u qr = (v4u){0u, 0u, 0u, 0u}, kr = qr, vr = qr;
        if (p >= 0) { const size_t ro = (size_t)seq_row(b, p) * NPROJ + h * 256 + cp * 8; qr = *(const v4u*)(PROJ + ro + PC_MLQ); kr = *(const v4u*)(PROJ + ro + PC_MLK); vr = *(const v4u*)(PROJ + ro + PC_MLV); }
        *(v4u*)(Qs + r * QP + cp * 8) = qr; *(v4u*)(Ks + r * QP + cp * 8) = kr; *(v4u*)(Vs + r * QP + cp * 8) = vr; }
    __syncthreads();
    {
        const int tr = wave >> 1;
#pragma unroll
        for (int q = 0; q < 2; ++q) { const int tc = 2 * (wave & 1) + q; f32x4 a = (f32x4){0.f, 0.f, 0.f, 0.f};
#pragma unroll
            for (int ks = 0; ks < 8; ++ks) a = MFMA16(*(const bf16x8v*)(Qs + (16 * tr + lc) * QP + 32 * ks + 8 * g), *(const bf16x8v*)(Ks + (16 * tc + lc) * QP + 32 * ks + 8 * g), a);
            const int s = 16 * tc + lc; const float bs = bcs[s], ls = lis[s];
#pragma unroll
            for (int r = 0; r < 4; ++r) { const int t = 16 * tr + 4 * g + r; float val = 0.f; if (s <= t) val = a[r] * 0.0625f * __expf(bcs[t] - bs + ls - mout[t]);
                Sp[t * SP + s] = (bf16)f2bf(val); } } }
    __syncthreads();
    const bf16* CT = MLCT + (size_t)u * MLCT_UNIT;
    if (wave == 0) { f32x4 ad[4]; ml_tile<true>(CT, Qs, Sp, Vs, inter, 16, ad, lane);
        if (lc == 0) {
#pragma unroll
            for (int m = 0; m < 4; ++m)
#pragma unroll
                for (int r = 0; r < 4; ++r) den[16 * m + 4 * g + r] = ad[m][r]; } }
    f32x4 a0[4], a1[4];
    ml_tile<false>(CT, Qs, Sp, Vs, inter, wave, a0, lane); ml_tile<false>(CT, Qs, Sp, Vs, inter, wave + 8, a1, lane);
    __syncthreads();
#pragma unroll
    for (int m = 0; m < 4; ++m)
#pragma unroll
        for (int r = 0; r < 4; ++r) { const int t = 16 * m + 4 * g + r; const float dinv = __builtin_amdgcn_rcpf(fmaxf(fabsf(den[t]), __expf(-mout[t])));
            a0[m][r] *= dinv; a1[m][r] *= dinv; float sq = a0[m][r] * a0[m][r] + a1[m][r] * a1[m][r];
            sq += __shfl_xor(sq, 1); sq += __shfl_xor(sq, 2); sq += __shfl_xor(sq, 4); sq += __shfl_xor(sq, 8);
            if (lc == 0) part[wave * 64 + t] = sq; }
    __syncthreads();
    if (tid < 64) { float sq = 0.f;
#pragma unroll
        for (int w = 0; w < 8; ++w) sq += part[w * 64 + tid];
        rstd[tid] = __builtin_amdgcn_rsqf(sq * (1.0f / 256.0f) + EPS); }
    __syncthreads();
    { const int e0 = 16 * wave + lc, e1 = e0 + 128; const float g0 = ml_norm[h * 256 + e0], g1 = ml_norm[h * 256 + e1];
#pragma unroll
      for (int m = 0; m < 4; ++m)
#pragma unroll
          for (int r = 0; r < 4; ++r) { const int t = 16 * m + 4 * g + r, p = 64 * c + t - 48;
              if (p >= 0 && (c > 0 || b == 0)) { const int row = seq_row(b, p); const bf16* op = PROJ + (size_t)row * NPROJ + PC_MLO + h * 256; bf16* bp = BRp + (size_t)row * D + h * 256;
                  bp[e0] = (bf16)f2bf(a0[m][r] * rstd[t] * g0 * sigmoidf_(bf1(op[e0]))); bp[e1] = (bf16)f2bf(a1[m][r] * rstd[t] * g1 * sigmoidf_(bf1(op[e1]))); } } }
    __syncthreads();
}

__device__ __forceinline__ void hg_cumsum(const bf16* PROJ, const float* LB, int b, int h, int c, float* bcs, float* kks, int d) {
    const float lb = LB[h * 128 + d]; float bacc = 0.f;
    for (int t = 0; t < 64; ++t) { const int p = 64 * c + t - 48; float lf = 0.f, kk = 0.f;
        if (p >= 0) { const float fp = bf1(PROJ[(size_t)seq_row(b, p) * NPROJ + PC_HGF + h * 128 + d]); const float sig = sigmoidf_(fp), nsig = sigmoidf_(-fp);
            lf = logf(lb + (1.0f - lb) * sig); kk = (1.0f - lb) * nsig; }
        bacc += lf; bcs[t * 128 + d] = bacc; kks[t * 128 + d] = kk; }
}
__device__ __forceinline__ void hg_A(const bf16* PROJ, const float* LB, float* HGS, float* HGE, int u, unsigned char* lds, int tid) {
    const int c = u % NCH, bh = u / NCH, h = bh & 7, b = bh >> 3;
    float* bcs = (float*)lds; float* kkw = bcs + 64 * 128; float* iv = kkw + 64 * 128;
    for (int id = tid; id < 2048; id += 512) { const int which = id >> 10, r = (id >> 4) & 63, cp = id & 15, p = 64 * c + r - 48; float x[8];
        if (which == 0) {
            float lf[8], kk[8];
            if (p >= 0) { unpack8(*(const v4u*)(PROJ + (size_t)seq_row(b, p) * NPROJ + PC_HGF + h * 128 + cp * 8), x);
#pragma unroll
                for (int q = 0; q < 8; ++q) { const float lb = LB[h * 128 + cp * 8 + q]; const float e = __expf(-fminf(fmaxf(x[q], -60.f), 60.f)); const float sig = __builtin_amdgcn_rcpf(1.0f + e), nsig = e * sig; lf[q] = __logf(lb + (1.0f - lb) * sig); kk[q] = (1.0f - lb) * nsig; } }
            else {
#pragma unroll
                for (int q = 0; q < 8; ++q) { lf[q] = 0.f; kk[q] = 0.f; } }
            *(f32x4*)(bcs + r * 128 + cp * 8) = (f32x4){lf[0], lf[1], lf[2], lf[3]}; *(f32x4*)(bcs + r * 128 + cp * 8 + 4) = (f32x4){lf[4], lf[5], lf[6], lf[7]};
            *(f32x4*)(kkw + r * 128 + cp * 8) = (f32x4){kk[0], kk[1], kk[2], kk[3]}; *(f32x4*)(kkw + r * 128 + cp * 8 + 4) = (f32x4){kk[4], kk[5], kk[6], kk[7]};
            continue; }
        {
            if (p >= 0) unpack8(*(const v4u*)(PROJ + (size_t)seq_row(b, p) * NPROJ + PC_HGI + h * 128 + cp * 8), x);
            else {
#pragma unroll
                for (int q = 0; q < 8; ++q) x[q] = 0.f; }
            *(f32x4*)(iv + r * 128 + cp * 8) = (f32x4){x[0], x[1], x[2], x[3]}; *(f32x4*)(iv + r * 128 + cp * 8 + 4) = (f32x4){x[4], x[5], x[6], x[7]}; } }
    __syncthreads();
    if (tid < 128) { float bacc = 0.f;
#pragma unroll 8
        for (int t = 0; t < 64; ++t) { bacc += bcs[t * 128 + tid]; bcs[t * 128 + tid] = bacc; } }
    __syncthreads();
    constexpr int DP = 136; bf16* kb = (bf16*)kkw; bf16* ib = (bf16*)iv;
    float kvv[16], ivv[16];
#pragma unroll
    for (int k = 0; k < 16; ++k) { const int idx = tid + 512 * k, d = idx & 127; kvv[k] = kkw[idx] * __expf(bcs[63 * 128 + d] - bcs[idx]); ivv[k] = iv[idx]; }
    if (tid < 128) HGE[(size_t)u * 128 + tid] = __expf(bcs[63 * 128 + tid]);
    __syncthreads();
#pragma unroll
    for (int k = 0; k < 16; ++k) { const int idx = tid + 512 * k, d = idx & 127, sr = idx >> 7; kb[sr * DP + d] = (bf16)f2bf(kvv[k]); ib[sr * DP + d] = (bf16)f2bf(ivv[k]); }
    __syncthreads();
    { const int lane = tid & 63, wave = tid >> 6, lc = lane & 15, g = lane >> 4;
      bf16x8v af[2];
#pragma unroll
      for (int ks = 0; ks < 2; ++ks)
#pragma unroll
          for (int i = 0; i < 8; ++i) af[ks][i] = (short)kb[(32 * ks + 8 * g + i) * DP + 16 * wave + lc];
      bf16* out = (bf16*)HGS + (size_t)u * 16384;
#pragma unroll 2
      for (int et = 0; et < 8; ++et) { bf16x8v bv[2];
#pragma unroll
          for (int ks = 0; ks < 2; ++ks)
#pragma unroll
              for (int i = 0; i < 8; ++i) bv[ks][i] = (short)ib[(32 * ks + 8 * g + i) * DP + 16 * et + lc];
          f32x4 acc = (f32x4){0.f, 0.f, 0.f, 0.f};
#pragma unroll
          for (int ks = 0; ks < 2; ++ks) acc = MFMA16(af[ks], bv[ks], acc);
          v2u w; w.x = pk2(acc[0], acc[1]); w.y = pk2(acc[2], acc[3]);
          *(v2u*)(out + ((size_t)(et * 4 + (wave >> 1)) * 64 + lc + 16 * ((2 * wave + (g >> 1)) & 3)) * 8 + 4 * (g & 1)) = w; } }
    __syncthreads();
}
__device__ __forceinline__ void hg_B(float* HGS, const float* HGE, int unit, int tid) {
    const int chain = unit >> 4, slice = unit & 15, x = 2 * (slice * 512 + tid), d = 32 * ((x >> 9) & 3) + 8 * ((x >> 7) & 3) + (x & 7); float s0 = 0.f, s1 = 0.f;
#pragma unroll 5
    for (int c = 0; c < NCH; ++c) { const size_t uu = (size_t)chain * NCH + c; unsigned* p = (unsigned*)((bf16*)HGS + uu * 16384 + x); const unsigned dl = *p; const float e0 = HGE[uu * 128 + d], e1 = HGE[uu * 128 + d + 1];
        *p = pk2(s0, s1); s0 = s0 * e0 + bflo(dl); s1 = s1 * e1 + bfhi(dl); }
}
__device__ __forceinline__ void hg_C(const bf16* PROJ, const float* LB, const float* HGS, const float* hg_norm, bf16* BRp, int u, unsigned char* lds, int tid) {
    const int c = u % NCH, bh = u / NCH, h = bh & 7, b = bh >> 3, lane = tid & 63, wave = tid >> 6, lc = lane & 15, g = lane >> 4;
    constexpr int DP = 136, SP = 72;
    float* bcs = (float*)lds;
    bf16* qs = (bf16*)(lds + 32768);
    bf16* kks = (bf16*)(lds + 50176);
    bf16* It = (bf16*)(lds + 67584);
    bf16* QD = (bf16*)(lds + 86016);
    bf16* KD = (bf16*)(lds + 103424);
    bf16* ATT = (bf16*)(lds + 129536);
    for (int id = tid; id < 3072; id += 512) { const int which = id >> 10, r = (id >> 4) & 63, cp = id & 15, p = 64 * c + r - 48; float x[8];
        if (p >= 0) unpack8(*(const v4u*)(PROJ + (size_t)seq_row(b, p) * NPROJ + (which == 0 ? PC_HGF : (which == 1 ? PC_HGQ : PC_HGI)) + h * 128 + cp * 8), x);
        else {
#pragma unroll
            for (int q = 0; q < 8; ++q) x[q] = 0.f; }
        if (which == 0) { float lf[8], kk[8];
#pragma unroll
            for (int q = 0; q < 8; ++q) { const float lb = LB[h * 128 + cp * 8 + q]; const float e = __expf(-fminf(fmaxf(x[q], -60.f), 60.f)); const float sig = __builtin_amdgcn_rcpf(1.0f + e), nsig = e * sig;
                lf[q] = (p >= 0) ? __logf(lb + (1.0f - lb) * sig) : 0.f; kk[q] = (p >= 0) ? (1.0f - lb) * nsig : 0.f; }
            *(f32x4*)(bcs + r * 128 + cp * 8) = (f32x4){lf[0], lf[1], lf[2], lf[3]}; *(f32x4*)(bcs + r * 128 + cp * 8 + 4) = (f32x4){lf[4], lf[5], lf[6], lf[7]};
            *(bf16x8v*)(kks + r * DP + cp * 8) = pack8(kk); }
        else if (which == 1) {
#pragma unroll
            for (int q = 0; q < 8; ++q) x[q] = x[q] * fast_sigmoid_(x[q]);
            *(bf16x8v*)(qs + r * DP + cp * 8) = pack8(x); }
        else {
#pragma unroll
            for (int q = 0; q < 8; ++q) It[(cp * 8 + q) * SP + r] = (bf16)f2bf(x[q]); } }
    __syncthreads();
    for (int i = tid; i < 64 * SP / 8; i += NTHR) *(v4u*)(ATT + i * 8) = (v4u){0u, 0u, 0u, 0u};
    if (tid < 128) { float bacc = 0.f;
#pragma unroll 8
        for (int t = 0; t < 64; ++t) { bacc += bcs[t * 128 + tid]; bcs[t * 128 + tid] = bacc; } }
    __syncthreads();
#pragma unroll 2
    for (int k = 0; k < 12; ++k) { const int idx = tid + 512 * k, t = 16 + (idx >> 7), d = idx & 127, I = t >> 4;
        QD[t * DP + d] = (bf16)f2bf(bf1(qs[t * DP + d]) * __expf(bcs[t * 128 + d] - bcs[(16 * I - 1) * 128 + d])); }
#pragma unroll 2
    for (int k = 0; k < 24; ++k) { const int idx = tid + 512 * k, row = idx >> 7, d = idx & 127; const int I = row < 16 ? 1 : (row < 48 ? 2 : 3), s = row - (I == 1 ? 0 : (I == 2 ? 16 : 48));
        KD[row * DP + d] = (bf16)f2bf(bf1(kks[s * DP + d]) * __expf(bcs[(16 * I - 1) * 128 + d] - bcs[s * 128 + d])); }
    float q2v[16], k2v[16], qev[16];
#pragma unroll
    for (int k = 0; k < 16; ++k) { const int idx = tid + 512 * k, t = idx >> 7, d = idx & 127, mid = 16 * (t >> 4) + 7; const float bt = bcs[idx], bm = bcs[mid * 128 + d], qv = bf1(qs[t * DP + d]);
        q2v[k] = qv * __expf(fminf(bt - bm, 80.f)); k2v[k] = bf1(kks[t * DP + d]) * __expf(fminf(bm - bt, 80.f)); qev[k] = qv * __expf(bt); }
    __syncthreads();
    bf16* QE = (bf16*)lds;
#pragma unroll
    for (int k = 0; k < 16; ++k) { const int idx = tid + 512 * k, t = idx >> 7, d = idx & 127; qs[t * DP + d] = (bf16)f2bf(q2v[k]); kks[t * DP + d] = (bf16)f2bf(k2v[k]); QE[t * DP + d] = (bf16)f2bf(qev[k]); }
    bf16x8v sfr[4];
    { const bf16* Sst = (const bf16*)HGS + (size_t)u * 16384;
#pragma unroll
      for (int ks = 0; ks < 4; ++ks) sfr[ks] = *(const bf16x8v*)(Sst + ((size_t)(wave * 4 + ks) * 64 + lane) * 8); }
    __syncthreads();
#pragma unroll
    for (int rep = 0; rep < 2; ++rep) { const int tl = wave + 8 * rep;
        if (tl < 6) { const int I = tl < 1 ? 1 : (tl < 3 ? 2 : 3), J = tl < 1 ? 0 : (tl < 3 ? tl - 1 : tl - 3), kb = I == 1 ? 0 : (I == 2 ? 16 : 48);
            f32x4 acc = (f32x4){0.f, 0.f, 0.f, 0.f};
#pragma unroll
            for (int ks = 0; ks < 4; ++ks) acc = MFMA16(*(const bf16x8v*)(QD + (16 * I + lc) * DP + 32 * ks + 8 * g), *(const bf16x8v*)(KD + (kb + 16 * J + lc) * DP + 32 * ks + 8 * g), acc);
#pragma unroll
            for (int r = 0; r < 4; ++r) ATT[(16 * I + 4 * g + r) * SP + 16 * J + lc] = (bf16)f2bf(acc[r]); }
        else if (tl < 10) { const int I = tl - 6; f32x4 acc = (f32x4){0.f, 0.f, 0.f, 0.f};
#pragma unroll
            for (int ks = 0; ks < 4; ++ks) acc = MFMA16(*(const bf16x8v*)(qs + (16 * I + lc) * DP + 32 * ks + 8 * g), *(const bf16x8v*)(kks + (16 * I + lc) * DP + 32 * ks + 8 * g), acc);
#pragma unroll
            for (int r = 0; r < 4; ++r) ATT[(16 * I + 4 * g + r) * SP + 16 * I + lc] = (lc <= 4 * g + r) ? (bf16)f2bf(acc[r]) : (bf16)0; } }
    __syncthreads();
    f32x4 acc[4];
#pragma unroll
    for (int m = 0; m < 4; ++m) { acc[m] = (f32x4){0.f, 0.f, 0.f, 0.f};
#pragma unroll
        for (int ks = 0; ks < 2; ++ks) acc[m] = MFMA16(*(const bf16x8v*)(ATT + (16 * m + lc) * SP + 32 * ks + 8 * g), *(const bf16x8v*)(It + (16 * wave + lc) * SP + 32 * ks + 8 * g), acc[m]);
#pragma unroll
        for (int ks = 0; ks < 4; ++ks) acc[m] = MFMA16(*(const bf16x8v*)(QE + (16 * m + lc) * DP + 32 * ks + 8 * g), sfr[ks], acc[m]); }
    float* part = bcs + 5120; float* rstd = bcs + 5120 + 512;
#pragma unroll
    for (int m = 0; m < 4; ++m)
#pragma unroll
        for (int r = 0; r < 4; ++r) { float sq = acc[m][r] * acc[m][r]; sq += __shfl_xor(sq, 1); sq += __shfl_xor(sq, 2); sq += __shfl_xor(sq, 4); sq += __shfl_xor(sq, 8);
            if (lc == 0) part[(16 * m + 4 * g + r) * 8 + wave] = sq; }
    __syncthreads();
    if (tid < 64) { float sq = 0.f;
#pragma unroll
        for (int w = 0; w < 8; ++w) sq += part[tid * 8 + w];
        rstd[tid] = __builtin_amdgcn_rsqf(sq * (1.0f / 128.0f) + EPS); }
    __syncthreads();
    { const int e = 16 * wave + lc; const float gn = hg_norm[h * 128 + e];
#pragma unroll
      for (int m = 0; m < 4; ++m)
#pragma unroll
          for (int r = 0; r < 4; ++r) { const int t = 16 * m + 4 * g + r, p = 64 * c + t - 48;
              if (p >= 0 && (c > 0 || b == 0)) { const int row = seq_row(b, p); const float og = sigmoidf_(bf1(PROJ[(size_t)row * NPROJ + PC_HGG + h * 128 + e]));
                  BRp[(size_t)row * D + 2048 + h * 128 + e] = (bf16)f2bf(acc[m][r] * rstd[t] * gn * og); } } }
    __syncthreads();
}

__device__ __forceinline__ void rg_frags(const float* wa, const float* wx, int n, int jt, int lc, int g, bf16x8v (&fa)[2], bf16x8v (&fx)[2]) {
#pragma unroll
    for (int ks = 0; ks < 2; ++ks) { float xa[8], xx[8];
#pragma unroll
        for (int q = 0; q < 8; ++q) { const int wi = (n * 64 + 32 * ks + 8 * g + q) * 64 + 16 * jt + lc; xa[q] = wa[wi]; xx[q] = wx[wi]; }
        fa[ks] = pack8(xa); fx[ks] = pack8(xx); }
}
__device__ __forceinline__ void rg_A(const bf16* PROJ, const float* conv_w, const float* conv_b, const float* wa, const float* ba, const float* wx, const float* bx, const float* lam, float* RGH, float* RGP, float* RGT, int u, unsigned char* lds, int tid) {
    const int half = u & 1, c = (u < 256) ? 1 + ((u >> 1) & 63) : 0, b = (u < 256) ? (u >> 7) : 0, ch = half * 512 + tid, p0 = 64 * c - 48;
    const int lane = tid & 63, wave = tid >> 6, lc = lane & 15, g = lane >> 4, n = half * 8 + wave;
    constexpr int XP = 520;
    bf16* xs = (bf16*)lds;
    bf16* xcb = (bf16*)(lds + 68608);
    bf16* las = (bf16*)(lds + 68608);
    bf16* us = (bf16*)lds;
    bf16x8v fa[2], fx[2]; rg_frags(wa, wx, n, 0, lc, g, fa, fx);
    for (int id = tid; id < 67 * 64; id += NTHR) { const int r = id >> 6, cp = id & 63, p = p0 - 3 + r; v4u w = (v4u){0u, 0u, 0u, 0u};
        if (p >= 0) w = *(const v4u*)(PROJ + (size_t)seq_row(b, p) * NPROJ + PC_RGX + half * 512 + cp * 8);
        *(v4u*)(xs + r * 512 + cp * 8) = w; }
    __syncthreads();
    { const float w0 = conv_w[ch], w1 = conv_w[1024 + ch], w2 = conv_w[2048 + ch], w3 = conv_w[3072 + ch], cb = conv_b[ch];
      float xm3 = bf1(xs[tid]), xm2 = bf1(xs[512 + tid]), xm1 = bf1(xs[1024 + tid]);
#pragma unroll 8
      for (int t = 0; t < 64; ++t) { const float x0 = bf1(xs[(t + 3) * 512 + tid]); xcb[t * XP + tid] = (bf16)f2bf(cb + (w0 * xm3 + w1 * xm2) + (w2 * xm1 + w3 * x0)); xm3 = xm2; xm2 = xm1; xm1 = x0; } }
    __syncthreads();
    unsigned ru[4][4][2];
    { bf16x8v af[4][2];
#pragma unroll
      for (int m = 0; m < 4; ++m)
#pragma unroll
          for (int ks = 0; ks < 2; ++ks) af[m][ks] = *(const bf16x8v*)(xcb + (16 * m + lc) * XP + 64 * wave + 32 * ks + 8 * g);
      __syncthreads();
#pragma unroll
      for (int jt = 0; jt < 4; ++jt) { bf16x8v na[2], nx[2];
          asm volatile("" ::: "memory");
          if (jt < 3) rg_frags(wa, wx, n, jt + 1, lc, g, na, nx);
          const int cg = 64 * n + 16 * jt + lc, cl = cg - half * 512;
          const float bav = ba[cg], bxv = bx[cg], spv = softplusf_(-lam[cg]), w0 = conv_w[cg], w1 = conv_w[1024 + cg], w2 = conv_w[2048 + cg], w3 = conv_w[3072 + cg], cb = conv_b[cg];
#pragma unroll
          for (int m = 0; m < 4; ++m) { f32x4 aa = (f32x4){0.f, 0.f, 0.f, 0.f}, ax = aa;
#pragma unroll
              for (int ks = 0; ks < 2; ++ks) { aa = MFMA16(af[m][ks], fa[ks], aa); ax = MFMA16(af[m][ks], fx[ks], ax); }
              float uv[4];
#pragma unroll
              for (int r = 0; r < 4; ++r) { const int t = 16 * m + 4 * g + r;
                  const float xc = cb + (w0 * bf1(xs[t * 512 + cl]) + w1 * bf1(xs[(t + 1) * 512 + cl])) + (w2 * bf1(xs[(t + 2) * 512 + cl]) + w3 * bf1(xs[(t + 3) * 512 + cl]));
                  const float rr = fast_sigmoid_(aa[r] + bav), gi = fast_sigmoid_(ax[r] + bxv); const unsigned lb16 = f2bf(-8.0f * rr * spv); const float a = __expf(__uint_as_float(lb16 << 16));
                  las[t * 512 + cl] = (bf16)lb16; uv[r] = __builtin_amdgcn_sqrtf(fmaxf(1.0f - a * a, 0.f)) * gi * xc; }
              ru[jt][m][0] = pk2(uv[0], uv[1]); ru[jt][m][1] = pk2(uv[2], uv[3]); }
          if (jt < 3) { fa[0] = na[0]; fa[1] = na[1]; fx[0] = nx[0]; fx[1] = nx[1]; } } }
    __syncthreads();
#pragma unroll
    for (int jt = 0; jt < 4; ++jt) { const int cl = 64 * wave + 16 * jt + lc;
#pragma unroll
        for (int m = 0; m < 4; ++m)
#pragma unroll
            for (int h2 = 0; h2 < 2; ++h2) { const int t = 16 * m + 4 * g + 2 * h2;
                us[t * 512 + cl] = (bf16)(ru[jt][m][h2] & 0xffffu); us[(t + 1) * 512 + cl] = (bf16)(ru[jt][m][h2] >> 16); } }
    __syncthreads();
    float hh = 0.f, P = 1.f;
    { const int tb = (c == 0 ? 48 : 0); float* ph = RGH + (size_t)seq_row(b, p0 + tb) * 1024 + ch; float* pp = RGP + (size_t)seq_row(b, p0 + tb) * 1024 + ch;
#pragma unroll 4
      for (int t = tb; t < 64; ++t) { const float a = __expf(bf1(las[t * 512 + tid])), uu = bf1(us[t * 512 + tid]);
          hh = a * hh + uu; P *= a; *ph = hh; *pp = P; ph += 1024; pp += 1024; } }
    RGT[(size_t)(0 * 2 + b) * NCH * 1024 + c * 1024 + ch] = P; RGT[(size_t)(1 * 2 + b) * NCH * 1024 + c * 1024 + ch] = hh;
    if (c == 0) { RGT[(size_t)(0 * 2 + 1) * NCH * 1024 + ch] = P; RGT[(size_t)(1 * 2 + 1) * NCH * 1024 + ch] = hh; }
    __syncthreads();
}
__device__ __forceinline__ void rg_B(float* RGT, int chain, int lane) {
    const int b = chain >> 10, ch = chain & 1023;
    float a = RGT[(size_t)(0 * 2 + b) * NCH * 1024 + lane * 1024 + ch], hv = RGT[(size_t)(1 * 2 + b) * NCH * 1024 + lane * 1024 + ch];
#pragma unroll
    for (int o = 1; o < 64; o <<= 1) { const float ap = __shfl_up(a, o), hp = __shfl_up(hv, o); if (lane >= o) { hv = a * hp + hv; a = a * ap; } }
    float* Cc = RGT + (size_t)(2 * 2 + b) * NCH * 1024 + ch;
    const float prev = __shfl_up(hv, 1);
    Cc[lane * 1024] = (lane == 0) ? 0.f : prev;
    if (lane == 63) Cc[64 * 1024] = hv;
}
__device__ __forceinline__ float gelu_tanh(float y) { const float z2 = 1.5957691216057308f * (y + 0.044715f * y * y * y); return y * __builtin_amdgcn_rcpf(1.0f + __expf(-z2)); }
__device__ __forceinline__ void rg_C(const bf16* PROJ, const float* RGH, const float* RGP, const float* RGT, bf16* BR, int gw, int NGW, int lane) {
    for (int row = gw; row < TREAL + NMETA; row += NGW) {
        const int b = row < TREAL ? (row >> 12) : 0, p = row < TREAL ? (row & 4095) + NMETA : row - TREAL, c = (p + 48) >> 6;
        const float* Cc = RGT + (size_t)(2 * 2 + b) * NCH * 1024 + c * 1024;
#pragma unroll
        for (int j = 0; j < 2; ++j) { const int ch = j * 512 + lane * 8; float y[8]; unpack8(*(const v4u*)(PROJ + (size_t)row * NPROJ + PC_RGY + ch), y); float o[8];
#pragma unroll
            for (int q = 0; q < 2; ++q) { const f32x4 hl = *(const f32x4*)(RGH + (size_t)row * 1024 + ch + 4 * q), pp = *(const f32x4*)(RGP + (size_t)row * 1024 + ch + 4 * q), cc = *(const f32x4*)(Cc + ch + 4 * q);
                const f32x4 hv = hl + pp * cc; o[4 * q] = hv.x * gelu_tanh(y[4 * q]); o[4 * q + 1] = hv.y * gelu_tanh(y[4 * q + 1]); o[4 * q + 2] = hv.z * gelu_tanh(y[4 * q + 2]); o[4 * q + 3] = hv.w * gelu_tanh(y[4 * q + 3]); }
            v4u w; w.x = pk2(o[0], o[1]); w.y = pk2(o[2], o[3]); w.z = pk2(o[4], o[5]); w.w = pk2(o[6], o[7]);
            *(v4u*)(BR + (size_t)row * D + 3072 + ch) = w; }
    }
}

__device__ __forceinline__ void sb_unit(const bf16* PROJ, const float* gq, const float* gk, bf16* BRp, int b, int h, int i, unsigned char* lds, int tid) {
    constexpr int KP = 136, VP = 72;
    bf16* Kt = (bf16*)lds; bf16* Vt = (bf16*)(lds + 17408);
    const int lane = tid & 63, wave = tid >> 6, c = lane & 15, g = lane >> 4;
    bf16* Ps = (bf16*)(lds + 35840) + wave * (16 * VP);
    bf16x8v aq[4];
    { const int pq = 128 * i - 112 + 16 * wave + c; float qv[4][8]; float ss = 0.f;
      if (pq >= 0) { const bf16* qp = PROJ + (size_t)seq_row(b, pq) * NPROJ + PC_SBQ + h * 128 + 8 * g;
#pragma unroll
          for (int ks = 0; ks < 4; ++ks) { unpack8(*(const v4u*)(qp + 32 * ks), qv[ks]);
#pragma unroll
              for (int k = 0; k < 8; ++k) ss += qv[ks][k] * qv[ks][k]; } }
      else {
#pragma unroll
          for (int ks = 0; ks < 4; ++ks)
#pragma unroll
              for (int k = 0; k < 8; ++k) qv[ks][k] = 0.f; }
      ss += __shfl_xor(ss, 16); ss += __shfl_xor(ss, 32);
      const float sc = 0.08838834764831845f * __builtin_amdgcn_rsqf(ss * (1.0f / 128.0f) + EPS);
#pragma unroll
      for (int ks = 0; ks < 4; ++ks) { const f32x4 g0 = *(const f32x4*)(gq + 32 * ks + 8 * g), g1 = *(const f32x4*)(gq + 32 * ks + 8 * g + 4);
          qv[ks][0] *= sc * g0.x; qv[ks][1] *= sc * g0.y; qv[ks][2] *= sc * g0.z; qv[ks][3] *= sc * g0.w; qv[ks][4] *= sc * g1.x; qv[ks][5] *= sc * g1.y; qv[ks][6] *= sc * g1.z; qv[ks][7] *= sc * g1.w;
          aq[ks] = pack8(qv[ks]); } }
    const int p0row = 128 * i - 112 + 16 * wave + 4 * g;
    float carry[4] = {0.f, 0.f, 0.f, 0.f};
    f32x4 acc_o[8];
#pragma unroll
    for (int n = 0; n < 8; ++n) acc_o[n] = (f32x4){0.f, 0.f, 0.f, 0.f};
    const int kt_hi = (i == 0) ? 0 : 2 * i;
    v4u pk0 = (v4u){0u, 0u, 0u, 0u}, pk1 = pk0, pv0 = pk0, pv1 = pk0;
#define SB_FETCH(kt_) do { const int pkf = 64 * (kt_) + (tid >> 3); pk0 = (v4u){0u, 0u, 0u, 0u}; pk1 = pk0; pv0 = pk0; pv1 = pk0; \
        if (pkf < 4096 + NMETA) { const bf16* rp = PROJ + (size_t)seq_row(b, pkf) * NPROJ + h * 128 + (tid & 7) * 16; \
            pk0 = *(const v4u*)(rp + PC_SBK); pk1 = *(const v4u*)(rp + PC_SBK + 8); pv0 = *(const v4u*)(rp + PC_SBV); pv1 = *(const v4u*)(rp + PC_SBV + 8); } } while (0)
    SB_FETCH(kt_hi);
    for (int kt = kt_hi; kt >= 0; --kt) {
        { const int kr = tid >> 3, sg = tid & 7; float ka[8], kb[8], va[8], vb[8]; float ss = 0.f;
          unpack8(pk0, ka); unpack8(pk1, kb); unpack8(pv0, va); unpack8(pv1, vb);
#pragma unroll
          for (int k = 0; k < 8; ++k) ss += ka[k] * ka[k] + kb[k] * kb[k];
          ss += __shfl_xor(ss, 1); ss += __shfl_xor(ss, 2); ss += __shfl_xor(ss, 4);
          const float rstd = __builtin_amdgcn_rsqf(ss * (1.0f / 128.0f) + EPS);
          const f32x4 g0 = *(const f32x4*)(gk + sg * 16), g1 = *(const f32x4*)(gk + sg * 16 + 4), g2 = *(const f32x4*)(gk + sg * 16 + 8), g3 = *(const f32x4*)(gk + sg * 16 + 12);
          ka[0] *= rstd * g0.x; ka[1] *= rstd * g0.y; ka[2] *= rstd * g0.z; ka[3] *= rstd * g0.w; ka[4] *= rstd * g1.x; ka[5] *= rstd * g1.y; ka[6] *= rstd * g1.z; ka[7] *= rstd * g1.w;
          kb[0] *= rstd * g2.x; kb[1] *= rstd * g2.y; kb[2] *= rstd * g2.z; kb[3] *= rstd * g2.w; kb[4] *= rstd * g3.x; kb[5] *= rstd * g3.y; kb[6] *= rstd * g3.z; kb[7] *= rstd * g3.w;
          *(bf16x8v*)(Kt + kr * KP + sg * 16) = pack8(ka); *(bf16x8v*)(Kt + kr * KP + sg * 16 + 8) = pack8(kb);
#pragma unroll
          for (int k = 0; k < 8; ++k) { Vt[(sg * 16 + k) * VP + kr] = (bf16)f2bf(va[k]); Vt[(sg * 16 + 8 + k) * VP + kr] = (bf16)f2bf(vb[k]); } }
        __syncthreads();
        if (kt > 0) SB_FETCH(kt - 1);
        f32x4 z[4];
#pragma unroll
        for (int j = 0; j < 4; ++j) { z[j] = (f32x4){0.f, 0.f, 0.f, 0.f};
#pragma unroll
            for (int ks = 0; ks < 4; ++ks) z[j] = MFMA16(aq[ks], *(const bf16x8v*)(Kt + (16 * j + 15 - c) * KP + 32 * ks + 8 * g), z[j]); }
        float lk[4][4], zl[4][4], inc[4][4];
#pragma unroll
        for (int j = 0; j < 4; ++j)
#pragma unroll
            for (int r = 0; r < 4; ++r) { const bool vis = (64 * kt + 16 * j + 15 - c) < (p0row + r); const float zz = z[j][r];
                const float sp = fmaxf(zz, 0.f) + __logf(1.0f + __expf(-fabsf(zz)));
                lk[j][r] = vis ? -sp : 0.f; zl[j][r] = vis ? (zz - sp) : -1e30f; inc[j][r] = lk[j][r]; }
#pragma unroll
        for (int j = 0; j < 4; ++j)
#pragma unroll
            for (int r = 0; r < 4; ++r) { float v = inc[j][r]; v += dpp_shr16<1>(v); v += dpp_shr16<2>(v); v += dpp_shr16<4>(v); v += dpp_shr16<8>(v); inc[j][r] = v; }
#pragma unroll
        for (int r = 0; r < 4; ++r) { float off = carry[r];
#pragma unroll
            for (int j = 3; j >= 0; --j) { const float tot = __shfl(inc[j][r], 15, 16); const float a = __expf(zl[j][r] + off + inc[j][r] - lk[j][r]);
                Ps[(4 * g + r) * VP + 16 * j + 15 - c] = (bf16)f2bf(a); off += tot; }
            carry[r] = off; }
#pragma unroll
        for (int ks = 0; ks < 2; ++ks) { const bf16x8v pf = *(const bf16x8v*)(Ps + c * VP + 32 * ks + 8 * g);
#pragma unroll
            for (int n = 0; n < 8; ++n) acc_o[n] = MFMA16(pf, *(const bf16x8v*)(Vt + (16 * n + c) * VP + 32 * ks + 8 * g), acc_o[n]); }
        { volatile unsigned* flg = (volatile unsigned*)(lds + RING_BYTES) + (kt & 1) * 8;
          bool dn = true;
#pragma unroll
          for (int r = 0; r < 4; ++r) dn = dn && ((p0row + r) < 0 || carry[r] < -104.0f);
          const int alldone = __all(dn ? 1 : 0);
          if (lane == 0) flg[wave] = alldone ? 1u : 0u;
          __syncthreads();
          unsigned d = 1u;
#pragma unroll
          for (int w = 0; w < NWAVES; ++w) d &= flg[w];
          if (d) break; }
    }
#pragma unroll
    for (int r = 0; r < 4; ++r) { const int p = p0row + r; if (p >= 0 && (i > 0 || b == 0)) { bf16* op = BRp + (size_t)seq_row(b, p) * D + 1024 + h * 128 + c;
#pragma unroll
            for (int n = 0; n < 8; ++n) op[16 * n] = (bf16)f2bf(acc_o[n][r]); } }
    __syncthreads();
}

#undef SB_FETCH
template <int MODE> __device__ __forceinline__ void skinny_phase(const bf16* A, int lda, const bf16* Bt, int ldb, int N, int K, float* hmeta, bf16* MGm, const bf16* Gm, unsigned char* lds, int tid, int bx, int G) {
    const int lane = tid & 63, wave = tid >> 6, lc = lane & 15, g = lane >> 4, kw = K / 8, nst = kw / 32;
    f32x4* red = (f32x4*)lds;
    for (int nu = bx; nu < N / 16; nu += G) {
        const bf16* ap = A + (size_t)lc * lda + wave * kw + 8 * g; const bf16* bp = Bt + (size_t)(16 * nu + lc) * ldb + wave * kw + 8 * g;
        f32x4 acc = (f32x4){0.f, 0.f, 0.f, 0.f}; int st = 0;
        for (; st + 8 <= nst; st += 8) { bf16x8v af[8], bv[8];
#pragma unroll
            for (int i = 0; i < 8; ++i) { af[i] = *(const bf16x8v*)(ap + 32 * (st + i)); bv[i] = *(const bf16x8v*)(bp + 32 * (st + i)); }
#pragma unroll
            for (int i = 0; i < 8; ++i) acc = MFMA16(af[i], bv[i], acc); }
        for (; st < nst; ++st) acc = MFMA16(*(const bf16x8v*)(ap + 32 * st), *(const bf16x8v*)(bp + 32 * st), acc);
        red[wave * 64 + lane] = acc;
        __syncthreads();
        if (wave == 0) { const int n = 16 * nu + lc;
            if (MODE == 0) { f32x4 v = red[lane];
#pragma unroll
                for (int w = 1; w < 8; ++w) v += red[w * 64 + lane];
#pragma unroll
                for (int r = 0; r < 4; ++r) hmeta[(size_t)(4 * g + r) * D + n] += v[r]; }
            else { f32x4 mg = (f32x4){0.f, 0.f, 0.f, 0.f};
#pragma unroll
                for (int k = 0; k < 4; ++k) { const f32x4 uk = red[(2 * k) * 64 + lane] + red[(2 * k + 1) * 64 + lane];
#pragma unroll
                    for (int r = 0; r < 4; ++r) mg[r] += uk[r] * __builtin_amdgcn_rcpf(bf1(Gm[(size_t)(4 * g + r) * NPROJ + k * 4096 + n])); }
#pragma unroll
                for (int r = 0; r < 4; ++r) MGm[(size_t)(4 * g + r) * D + n] = (bf16)f2bf(mg[r]); } }
        __syncthreads();
    }
}

__device__ __forceinline__ void skinny_swiglu(const bf16* A, const bf16* Bt, bf16* ACTm, unsigned char* lds, int tid, int bx, int G) {
    const int lane = tid & 63, wave = tid >> 6, lc = lane & 15, g = lane >> 4; constexpr int kw = D / 8, nst = kw / 32;
    f32x4* red = (f32x4*)lds;
    for (int nu = bx; nu < DFF / 16; nu += G) { const int j = 16 * nu + lc, brow = (j >> 7) * 256 + (j & 127);
        const bf16* ap = A + (size_t)lc * D + wave * kw + 8 * g; const bf16* bg = Bt + (size_t)brow * D + wave * kw + 8 * g; const bf16* bu = bg + (size_t)128 * D;
        f32x4 ag = (f32x4){0.f, 0.f, 0.f, 0.f}, au = ag;
#pragma unroll
        for (int h2 = 0; h2 < 2; ++h2) { bf16x8v af[8], gv[8], uv[8];
#pragma unroll
            for (int i = 0; i < 8; ++i) { af[i] = *(const bf16x8v*)(ap + 32 * (8 * h2 + i)); gv[i] = *(const bf16x8v*)(bg + 32 * (8 * h2 + i)); uv[i] = *(const bf16x8v*)(bu + 32 * (8 * h2 + i)); }
#pragma unroll
            for (int i = 0; i < 8; ++i) { ag = MFMA16(af[i], gv[i], ag); au = MFMA16(af[i], uv[i], au); } }
        static_assert(nst == 16, "two batches of 8 k-steps");
        red[wave * 64 + lane] = ag; red[512 + wave * 64 + lane] = au;
        __syncthreads();
        if (wave == 0) { f32x4 vg = red[lane], vu = red[512 + lane];
#pragma unroll
            for (int w = 1; w < 8; ++w) { vg += red[w * 64 + lane]; vu += red[512 + w * 64 + lane]; }
#pragma unroll
            for (int r = 0; r < 4; ++r) ACTm[(size_t)(4 * g + r) * DFF + j] = (bf16)f2bf(vg[r] * fast_sigmoid_(vg[r]) * vu[r]); }
        __syncthreads();
    }
}
#ifndef REP_P0
#define REP_P0 1
#endif
#ifndef REP_A
#define REP_A 1
#endif
#ifndef REP_C
#define REP_C 1
#endif
#ifndef REP_G1
#define REP_G1 1
#endif
#ifndef REP_G8
#define REP_G8 1
#endif
#ifndef PG8_ALIGN_RES
#define PG8_ALIGN_RES true
#endif
#ifndef PG8_ALIGNV
#define PG8_ALIGNV true
#endif
#ifndef PG8_SP2V
#define PG8_SP2V true
#endif
#ifndef MK_N_LAUNCHES
#define MK_N_LAUNCHES 1
#endif
constexpr int N_PHASES = 1 + 10 * NLAYER;
struct Args { const float* in[23]; float* out; unsigned char* ws; int ph_lo, ph_hi; };
static_assert(sizeof(Args) == 23 * 8 + 8 + 8 + 8, "Args has no padding bytes");

template <int LO, int HI> __global__ void __launch_bounds__(NTHR, 2) fwd_kernel(Args args) {
    extern __shared__ __attribute__((aligned(16))) unsigned char lds[];
    const int tid = threadIdx.x;
    const int G = gridDim.x, bx = blockIdx.x;
    const int vcu = (G % 8 == 0) ? (bx % 8) * (G / 8) + bx / 8 : bx;
    const int NGW = G * NWAVES, NGT = G * NTHR;
    unsigned char* ws = args.ws;
    unsigned* ctl = (unsigned*)(ws + WS_CTL);
    volatile LAS unsigned* MISC = (volatile LAS unsigned*)((LAS unsigned char*)lds + MISC_OFF);
    for (int u = tid; u < (LDS_BYTES - LDSCTL_OFF) / 4; u += NTHR) ((LAS unsigned*)((LAS unsigned char*)lds + LDSCTL_OFF))[u] = 0u;
    __syncthreads();
    constexpr bool use_bar = (HI - LO) > 1;
    XcdBarrier bar; bar.bar = ctl + CW_BAR; bar.x = 0; bar.st = nullptr;
    if constexpr (use_bar) bar = xcd_barrier_post(ctl + CW_BAR, MISC + 8);
#define IN(k) (LO <= (k) && (k) < HI)
#define PHASE_VARS int tid_ = tid; asm volatile("" : "+v"(tid_)); const int lane_ = tid_ & 63, wave_ = __builtin_amdgcn_readfirstlane(tid_ >> 6), gw_ = vcu * NWAVES + wave_, gtid_ = bx * NTHR + tid_; (void)lane_; (void)wave_; (void)gw_; (void)gtid_;
#if defined(PROBE_DOUBLE_BAR)
#define SEAM(k) do { if constexpr (IN(k) && IN((k) + 1)) { xcd_barrier(bar); xcd_barrier(bar); } } while (0)
#else
#define SEAM(k) do { if constexpr (IN(k) && IN((k) + 1)) xcd_barrier(bar); } while (0)
#endif

#define PROJ ((bf16*)(ws + WS_PROJ))
#define ACT ((bf16*)(ws + WS_ACT))
#define XN ((bf16*)(ws + WS_XN))
#define BR ((bf16*)(ws + WS_BR))
#define MG ((bf16*)(ws + WS_MG))
#define HMETA ((float*)(ws + WS_HMETA))
#define GIF ((float*)(ws + WS_GIF))
#define WIF ((const float*)(ws + WS_WIF))
#define LBp ((const float*)(ws + WS_LB))
#define MLS ((float*)(ws + WS_MLS))
#define MLN ((float*)(ws + WS_MLN))
#define MLSC ((float*)(ws + WS_MLSC))
#define MLCT ((bf16*)(ws + WS_MLCT))
#define HGS ((float*)(ws + WS_HGS))
#define HGE ((float*)(ws + WS_HGE))
#define RGH ((float*)(ws + WS_RGH))
#define RGP ((float*)(ws + WS_RGP))
#define RGT ((float*)(ws + WS_RGT))
#define HBp ((bf16*)(ws + WS_HB))
#define x (args.in[0])
#define out (args.out)

#if defined(PROBE_SPIN_US)
    if constexpr (IN(0)) { const unsigned long long t0 = __builtin_amdgcn_s_memrealtime(); while (__builtin_amdgcn_s_memrealtime() - t0 < (unsigned long long)PROBE_SPIN_US * 100ull) __builtin_amdgcn_s_sleep(8); }
#endif
    if constexpr (IN(0)) { PHASE_VARS p0_prologue(args.in, ws, lds, bx, G, wave_, lane_, gtid_, NGT); }
#if defined(PROBE_REP_P0)
    if constexpr (IN(0)) { PHASE_VARS p0_prologue(args.in, ws, lds, bx, G, wave_, lane_, gtid_, NGT); }
#endif
    SEAM(0);

    {
        constexpr int l = 0;
        constexpr int pb = 1 + 10 * l;
        constexpr bool lastl = (l == NLAYER - 1);
        constexpr int Mtail = lastl ? TREAL : MROWS;
        constexpr int Mg = TREAL;
        const void* hsrc = (l == 0) ? (const void*)x : (const void*)HBp;
        if constexpr (IN(pb + 0)) { PHASE_VARS norm_rows<true, (l != 0)>(hsrc, HMETA, args.in[2] + l * D, XN, MROWS, WIF + (size_t)l * 8 * D, args.in[5] + (size_t)l * NIN + 4096, GIF, gw_, NGW, lane_, lds, tid_); }
#if defined(PROBE_REP_NORM)
            if constexpr (IN(pb + 0)) { PHASE_VARS norm_rows<true, (l != 0)>(hsrc, HMETA, args.in[2] + l * D, XN, MROWS, WIF + (size_t)l * 8 * D, args.in[5] + (size_t)l * NIN + 4096, GIF, gw_, NGW, lane_, lds, tid_); }
#endif
        SEAM(pb + 0);
        if constexpr (IN(pb + 1)) { PHASE_VARS pg8::Gemm g{XN, (const bf16*)(ws + WS_WIN + (size_t)l * SZ_WIN), MROWS, NPROJ, D, D, D}; pg8::StaticOrder S; S.init(MROWS, NPROJ, G, bx);
            pg8::EpiProj E{PROJ, NPROJ, args.in[5] + (size_t)l * NIN, 4096, 8, PC_GATE};
            pg8::gemm_phase<pg8::EpiProj, pg8::StaticOrder, PG8_ALIGNV, PG8_SP2V>((PG8_LAS unsigned char*)lds, g, S, E, tid_); }
#if defined(PROBE_REP_G1)
        if constexpr (IN(pb + 1)) { PHASE_VARS pg8::Gemm g{XN, (const bf16*)(ws + WS_WIN + (size_t)l * SZ_WIN), MROWS, NPROJ, D, D, D}; pg8::StaticOrder S; S.init(MROWS, NPROJ, G, bx);
            pg8::EpiProj E{PROJ, NPROJ, args.in[5] + (size_t)l * NIN, 4096, 8, PC_GATE};
            pg8::gemm_phase<pg8::EpiProj, pg8::StaticOrder, PG8_ALIGNV, PG8_SP2V>((PG8_LAS unsigned char*)lds, g, S, E, tid_); }
#endif
        SEAM(pb + 1);
        if constexpr (IN(pb + 2)) { PHASE_VARS
            for (int w_ = bx; w_ < 520; w_ += G) { const int u = (w_ < 512) ? (w_ >> 6) * NCH + 1 + (w_ & 63) : (w_ - 512) * NCH; mlstm_A(PROJ, GIF, MLS, MLN, MLSC, u, lds, tid_); }
#if defined(PROBE_REP_MLA)
            for (int w_ = bx; w_ < 520; w_ += G) { const int u = (w_ < 512) ? (w_ >> 6) * NCH + 1 + (w_ & 63) : (w_ - 512) * NCH; mlstm_A(PROJ, GIF, MLS, MLN, MLSC, u, lds, tid_); }
#endif
            for (int w_ = (bx + G - 8) % G; w_ < 1040; w_ += G) { const int u = (w_ < 1024) ? (w_ >> 6) * NCH + 1 + (w_ & 63) : (w_ - 1024) * NCH; hg_A(PROJ, LBp + l * 1024, HGS, HGE, u, lds, tid_); }
#if defined(PROBE_REP_HGA)
            for (int w_ = (bx + G - 8) % G; w_ < 1040; w_ += G) { const int u = (w_ < 1024) ? (w_ >> 6) * NCH + 1 + (w_ & 63) : (w_ - 1024) * NCH; hg_A(PROJ, LBp + l * 1024, HGS, HGE, u, lds, tid_); }
#endif
            for (int u = (bx + G - 24) % G; u < 258; u += G) rg_A(PROJ, args.in[11] + l * 4096, args.in[12] + l * 1024, args.in[13] + l * 65536, args.in[14] + l * 1024, args.in[15] + l * 65536, args.in[16] + l * 1024, args.in[17] + l * 1024, RGH, RGP, RGT, u, lds, tid_);
#if defined(PROBE_REP_RGA)
            for (int u = (bx + G - 24) % G; u < 258; u += G) rg_A(PROJ, args.in[11] + l * 4096, args.in[12] + l * 1024, args.in[13] + l * 65536, args.in[14] + l * 1024, args.in[15] + l * 65536, args.in[16] + l * 1024, args.in[17] + l * 1024, RGH, RGP, RGT, u, lds, tid_);
#endif
            for (int r = 0;; ++r) { const int bs = (r == 2) ? (bx + G - 28) % G : bx; const int idx = r * G + ((r & 1) ? (G - 1 - bs) : bs); if (r * G >= (lastl ? 512 : 520)) break; if (idx >= (lastl ? 512 : 520)) continue;
                int b, h, i; if (idx < 512) { i = 32 - (idx >> 4); b = (idx >> 3) & 1; h = idx & 7; } else { i = 0; b = 0; h = idx - 512; }
                sb_unit(PROJ, args.in[7] + l * 128, args.in[8] + l * 128, BR, b, h, i, lds, tid_); }
#if defined(PROBE_REP_SB)
            for (int r = 0;; ++r) { const int bs = (r == 2) ? (bx + G - 28) % G : bx; const int idx = r * G + ((r & 1) ? (G - 1 - bs) : bs); if (r * G >= (lastl ? 512 : 520)) break; if (idx >= (lastl ? 512 : 520)) continue;
                int b, h, i; if (idx < 512) { i = 32 - (idx >> 4); b = (idx >> 3) & 1; h = idx & 7; } else { i = 0; b = 0; h = idx - 512; }
                sb_unit(PROJ, args.in[7] + l * 128, args.in[8] + l * 128, BR, b, h, i, lds, tid_); }
#endif
        }
        SEAM(pb + 2);
        if constexpr (IN(pb + 3)) { PHASE_VARS
            for (int u = bx; u < 256; u += G) mlstm_B(MLS, MLN, MLSC, MLCT, u, lds, tid_);
#if defined(PROBE_REP_MLB)
            for (int u = bx; u < 256; u += G) mlstm_B(MLS, MLN, MLSC, MLCT, u, lds, tid_);
#endif
            for (int u = bx; u < 256; u += G) hg_B(HGS, HGE, u, tid_);
            for (int ch_ = gw_; ch_ < 2048; ch_ += NGW) rg_B(RGT, ch_, lane_);
        }
        SEAM(pb + 3);
        if constexpr (IN(pb + 4)) { PHASE_VARS
            for (int w_ = (bx + G - 64) % G; w_ < (lastl ? 512 : 520); w_ += G) { const int u = (w_ < 512) ? (w_ >> 6) * NCH + 1 + (w_ & 63) : (w_ - 512) * NCH; mlstm_C(PROJ, GIF, MLCT, MLSC, args.in[6] + l * 1024, BR, u, lds, tid_); }
#if defined(PROBE_REP_MLC)
            for (int w_ = (bx + G - 64) % G; w_ < (lastl ? 512 : 520); w_ += G) { const int u = (w_ < 512) ? (w_ >> 6) * NCH + 1 + (w_ & 63) : (w_ - 512) * NCH; mlstm_C(PROJ, GIF, MLCT, MLSC, args.in[6] + l * 1024, BR, u, lds, tid_); }
#endif
            for (int w_ = (bx + G - 72) % G; w_ < (lastl ? 1024 : 1040); w_ += G) { const int u = (w_ < 1024) ? (w_ >> 6) * NCH + 1 + (w_ & 63) : (w_ - 1024) * NCH; hg_C(PROJ, LBp + l * 1024, HGS, args.in[10] + l * 1024, BR, u, lds, tid_); }
#if defined(PROBE_REP_HGC)
            for (int w_ = (bx + G - 72) % G; w_ < (lastl ? 1024 : 1040); w_ += G) { const int u = (w_ < 1024) ? (w_ >> 6) * NCH + 1 + (w_ & 63) : (w_ - 1024) * NCH; hg_C(PROJ, LBp + l * 1024, HGS, args.in[10] + l * 1024, BR, u, lds, tid_); }
#endif
            rg_C(PROJ, RGH, RGP, RGT, BR, gw_, NGW, lane_);
#if defined(PROBE_REP_RGC)
            rg_C(PROJ, RGH, RGP, RGT, BR, gw_, NGW, lane_);
#endif
        }
        SEAM(pb + 4);
        if constexpr (IN(pb + 5)) { PHASE_VARS pg8::Gemm g{BR, (const bf16*)(ws + WS_WUP + (size_t)l * SZ_WSQ), Mg, D, D, D, D}; pg8::StaticOrder S; S.init(Mg, D, G, bx);
            pg8::EpiUpGate E{MG, D, PROJ + PC_GATE, NPROJ};
            pg8::gemm_phase<pg8::EpiUpGate, pg8::StaticOrder, PG8_ALIGN_RES, PG8_SP2V>((PG8_LAS unsigned char*)lds, g, S, E, tid_);
            if constexpr (!lastl) { int tid2_ = tid; asm volatile("" : "+v"(tid2_)); skinny_phase<1>(BR + (size_t)METAROW * D, D, (const bf16*)(ws + WS_WUP + (size_t)l * SZ_WSQ), D, D, D, nullptr, MG + (size_t)METAROW * D, PROJ + (size_t)METAROW * NPROJ + PC_GATE, lds, tid2_, bx, G); } }
#if defined(PROBE_REP_G5)
        if constexpr (IN(pb + 5)) { PHASE_VARS pg8::Gemm g{BR, (const bf16*)(ws + WS_WUP + (size_t)l * SZ_WSQ), Mg, D, D, D, D}; pg8::StaticOrder S; S.init(Mg, D, G, bx);
            pg8::EpiUpGate E{MG, D, PROJ + PC_GATE, NPROJ};
            pg8::gemm_phase<pg8::EpiUpGate, pg8::StaticOrder, PG8_ALIGN_RES, PG8_SP2V>((PG8_LAS unsigned char*)lds, g, S, E, tid_);
            if constexpr (!lastl) { int tid2_ = tid; asm volatile("" : "+v"(tid2_)); skinny_phase<1>(BR + (size_t)METAROW * D, D, (const bf16*)(ws + WS_WUP + (size_t)l * SZ_WSQ), D, D, D, nullptr, MG + (size_t)METAROW * D, PROJ + (size_t)METAROW * NPROJ + PC_GATE, lds, tid2_, bx, G); } }
#endif
        SEAM(pb + 5);
        if constexpr (IN(pb + 6)) { PHASE_VARS pg8::Gemm g{MG, (const bf16*)(ws + WS_WOUT + (size_t)l * SZ_WSQ), Mg, D, D, D, D}; pg8::StaticOrder S; S.init(Mg, D, G, bx);
            pg8::EpiResid<(l != 0), true> E{hsrc, HBp};
            pg8::gemm_phase<pg8::EpiResid<(l != 0), true>, pg8::StaticOrder, PG8_ALIGN_RES, PG8_SP2V>((PG8_LAS unsigned char*)lds, g, S, E, tid_);
            if constexpr (!lastl) { int tid2_ = tid; asm volatile("" : "+v"(tid2_)); skinny_phase<0>(MG + (size_t)METAROW * D, D, (const bf16*)(ws + WS_WOUT + (size_t)l * SZ_WSQ), D, D, D, HMETA, nullptr, nullptr, lds, tid2_, bx, G); } }
        SEAM(pb + 6);
        if constexpr (IN(pb + 7)) { PHASE_VARS norm_rows<false, true>(HBp, HMETA, args.in[3] + l * D, XN, Mtail, nullptr, nullptr, nullptr, gw_, NGW, lane_, lds, tid_); }
#if defined(PROBE_REP_NORM)
            if constexpr (IN(pb + 7)) { PHASE_VARS norm_rows<false, true>(HBp, HMETA, args.in[3] + l * D, XN, Mtail, nullptr, nullptr, nullptr, gw_, NGW, lane_, lds, tid_); }
#endif
        SEAM(pb + 7);
        if constexpr (IN(pb + 8)) { PHASE_VARS pg8::Gemm g{XN, (const bf16*)(ws + WS_WGU + (size_t)l * SZ_WGU), Mg, NGU, D, D, D}; pg8::StaticOrder S; S.init(Mg, NGU, G, bx);
            pg8::EpiSwiGLU E{ACT, DFF};
            pg8::gemm_phase<pg8::EpiSwiGLU, pg8::StaticOrder, PG8_ALIGNV, PG8_SP2V>((PG8_LAS unsigned char*)lds, g, S, E, tid_);
            if constexpr (!lastl) { int tid2_ = tid; asm volatile("" : "+v"(tid2_)); skinny_swiglu(XN + (size_t)METAROW * D, (const bf16*)(ws + WS_WGU + (size_t)l * SZ_WGU), ACT + (size_t)METAROW * DFF, lds, tid2_, bx, G); } }
#if defined(PROBE_REP_G8)
        if constexpr (IN(pb + 8)) { PHASE_VARS pg8::Gemm g{XN, (const bf16*)(ws + WS_WGU + (size_t)l * SZ_WGU), Mg, NGU, D, D, D}; pg8::StaticOrder S; S.init(Mg, NGU, G, bx);
            pg8::EpiSwiGLU E{ACT, DFF};
            pg8::gemm_phase<pg8::EpiSwiGLU, pg8::StaticOrder, PG8_ALIGNV, PG8_SP2V>((PG8_LAS unsigned char*)lds, g, S, E, tid_);
            if constexpr (!lastl) { int tid2_ = tid; asm volatile("" : "+v"(tid2_)); skinny_swiglu(XN + (size_t)METAROW * D, (const bf16*)(ws + WS_WGU + (size_t)l * SZ_WGU), ACT + (size_t)METAROW * DFF, lds, tid2_, bx, G); } }
#endif
        SEAM(pb + 8);
        if constexpr (IN(pb + 9)) { PHASE_VARS pg8::Gemm g{ACT, (const bf16*)(ws + WS_WD + (size_t)l * SZ_WD), Mg, D, DFF, DFF, DFF}; pg8::StaticOrder S; S.init(Mg, D, G, bx);
            pg8::EpiResid<true, !lastl> E{HBp, lastl ? (void*)out : (void*)HBp};
            pg8::gemm_phase<pg8::EpiResid<true, !lastl>, pg8::StaticOrder, PG8_ALIGN_RES, PG8_SP2V>((PG8_LAS unsigned char*)lds, g, S, E, tid_);
            if constexpr (!lastl) { int tid2_ = tid; asm volatile("" : "+v"(tid2_)); skinny_phase<0>(ACT + (size_t)METAROW * DFF, DFF, (const bf16*)(ws + WS_WD + (size_t)l * SZ_WD), DFF, D, DFF, HMETA, nullptr, nullptr, lds, tid2_, bx, G); } }
        SEAM(pb + 9);
    }
    {
        constexpr int l = 1;
        constexpr int pb = 1 + 10 * l;
        constexpr bool lastl = (l == NLAYER - 1);
        constexpr int Mtail = lastl ? TREAL : MROWS;
        constexpr int Mg = TREAL;
        const void* hsrc = (l == 0) ? (const void*)x : (const void*)HBp;
        if constexpr (IN(pb + 0)) { PHASE_VARS norm_rows<true, (l != 0)>(hsrc, HMETA, args.in[2] + l * D, XN, MROWS, WIF + (size_t)l * 8 * D, args.in[5] + (size_t)l * NIN + 4096, GIF, gw_, NGW, lane_, lds, tid_); }
#if defined(PROBE_REP_NORM)
            if constexpr (IN(pb + 0)) { PHASE_VARS norm_rows<true, (l != 0)>(hsrc, HMETA, args.in[2] + l * D, XN, MROWS, WIF + (size_t)l * 8 * D, args.in[5] + (size_t)l * NIN + 4096, GIF, gw_, NGW, lane_, lds, tid_); }
#endif
        SEAM(pb + 0);
        if constexpr (IN(pb + 1)) { PHASE_VARS pg8::Gemm g{XN, (const bf16*)(ws + WS_WIN + (size_t)l * SZ_WIN), MROWS, NPROJ, D, D, D}; pg8::StaticOrder S; S.init(MROWS, NPROJ, G, bx);
            pg8::EpiProj E{PROJ, NPROJ, args.in[5] + (size_t)l * NIN, 4096, 8, PC_GATE};
            pg8::gemm_phase<pg8::EpiProj, pg8::StaticOrder, PG8_ALIGNV, PG8_SP2V>((PG8_LAS unsigned char*)lds, g, S, E, tid_); }
#if defined(PROBE_REP_G1)
        if constexpr (IN(pb + 1)) { PHASE_VARS pg8::Gemm g{XN, (const bf16*)(ws + WS_WIN + (size_t)l * SZ_WIN), MROWS, NPROJ, D, D, D}; pg8::StaticOrder S; S.init(MROWS, NPROJ, G, bx);
            pg8::EpiProj E{PROJ, NPROJ, args.in[5] + (size_t)l * NIN, 4096, 8, PC_GATE};
            pg8::gemm_phase<pg8::EpiProj, pg8::StaticOrder, PG8_ALIGNV, PG8_SP2V>((PG8_LAS unsigned char*)lds, g, S, E, tid_); }
#endif
        SEAM(pb + 1);
        if constexpr (IN(pb + 2)) { PHASE_VARS
            for (int w_ = bx; w_ < 520; w_ += G) { const int u = (w_ < 512) ? (w_ >> 6) * NCH + 1 + (w_ & 63) : (w_ - 512) * NCH; mlstm_A(PROJ, GIF, MLS, MLN, MLSC, u, lds, tid_); }
#if defined(PROBE_REP_MLA)
            for (int w_ = bx; w_ < 520; w_ += G) { const int u = (w_ < 512) ? (w_ >> 6) * NCH + 1 + (w_ & 63) : (w_ - 512) * NCH; mlstm_A(PROJ, GIF, MLS, MLN, MLSC, u, lds, tid_); }
#endif
            for (int w_ = (bx + G - 8) % G; w_ < 1040; w_ += G) { const int u = (w_ < 1024) ? (w_ >> 6) * NCH + 1 + (w_ & 63) : (w_ - 1024) * NCH; hg_A(PROJ, LBp + l * 1024, HGS, HGE, u, lds, tid_); }
#if defined(PROBE_REP_HGA)
            for (int w_ = (bx + G - 8) % G; w_ < 1040; w_ += G) { const int u = (w_ < 1024) ? (w_ >> 6) * NCH + 1 + (w_ & 63) : (w_ - 1024) * NCH; hg_A(PROJ, LBp + l * 1024, HGS, HGE, u, lds, tid_); }
#endif
            for (int u = (bx + G - 24) % G; u < 258; u += G) rg_A(PROJ, args.in[11] + l * 4096, args.in[12] + l * 1024, args.in[13] + l * 65536, args.in[14] + l * 1024, args.in[15] + l * 65536, args.in[16] + l * 1024, args.in[17] + l * 1024, RGH, RGP, RGT, u, lds, tid_);
#if defined(PROBE_REP_RGA)
            for (int u = (bx + G - 24) % G; u < 258; u += G) rg_A(PROJ, args.in[11] + l * 4096, args.in[12] + l * 1024, args.in[13] + l * 65536, args.in[14] + l * 1024, args.in[15] + l * 65536, args.in[16] + l * 1024, args.in[17] + l * 1024, RGH, RGP, RGT, u, lds, tid_);
#endif
            for (int r = 0;; ++r) { const int bs = (r == 2) ? (bx + G - 28) % G : bx; const int idx = r * G + ((r & 1) ? (G - 1 - bs) : bs); if (r * G >= (lastl ? 512 : 520)) break; if (idx >= (lastl ? 512 : 520)) continue;
                int b, h, i; if (idx < 512) { i = 32 - (idx >> 4); b = (idx >> 3) & 1; h = idx & 7; } else { i = 0; b = 0; h = idx - 512; }
                sb_unit(PROJ, args.in[7] + l * 128, args.in[8] + l * 128, BR, b, h, i, lds, tid_); }
#if defined(PROBE_REP_SB)
            for (int r = 0;; ++r) { const int bs = (r == 2) ? (bx + G - 28) % G : bx; const int idx = r * G + ((r & 1) ? (G - 1 - bs) : bs); if (r * G >= (lastl ? 512 : 520)) break; if (idx >= (lastl ? 512 : 520)) continue;
                int b, h, i; if (idx < 512) { i = 32 - (idx >> 4); b = (idx >> 3) & 1; h = idx & 7; } else { i = 0; b = 0; h = idx - 512; }
                sb_unit(PROJ, args.in[7] + l * 128, args.in[8] + l * 128, BR, b, h, i, lds, tid_); }
#endif
        }
        SEAM(pb + 2);
        if constexpr (IN(pb + 3)) { PHASE_VARS
            for (int u = bx; u < 256; u += G) mlstm_B(MLS, MLN, MLSC, MLCT, u, lds, tid_);
#if defined(PROBE_REP_MLB)
            for (int u = bx; u < 256; u += G) mlstm_B(MLS, MLN, MLSC, MLCT, u, lds, tid_);
#endif
            for (int u = bx; u < 256; u += G) hg_B(HGS, HGE, u, tid_);
            for (int ch_ = gw_; ch_ < 2048; ch_ += NGW) rg_B(RGT, ch_, lane_);
        }
        SEAM(pb + 3);
        if constexpr (IN(pb + 4)) { PHASE_VARS
            for (int w_ = (bx + G - 64) % G; w_ < (lastl ? 512 : 520); w_ += G) { const int u = (w_ < 512) ? (w_ >> 6) * NCH + 1 + (w_ & 63) : (w_ - 512) * NCH; mlstm_C(PROJ, GIF, MLCT, MLSC, args.in[6] + l * 1024, BR, u, lds, tid_); }
#if defined(PROBE_REP_MLC)
            for (int w_ = (bx + G - 64) % G; w_ < (lastl ? 512 : 520); w_ += G) { const int u = (w_ < 512) ? (w_ >> 6) * NCH + 1 + (w_ & 63) : (w_ - 512) * NCH; mlstm_C(PROJ, GIF, MLCT, MLSC, args.in[6] + l * 1024, BR, u, lds, tid_); }
#endif
            for (int w_ = (bx + G - 72) % G; w_ < (lastl ? 1024 : 1040); w_ += G) { const int u = (w_ < 1024) ? (w_ >> 6) * NCH + 1 + (w_ & 63) : (w_ - 1024) * NCH; hg_C(PROJ, LBp + l * 1024, HGS, args.in[10] + l * 1024, BR, u, lds, tid_); }
#if defined(PROBE_REP_HGC)
            for (int w_ = (bx + G - 72) % G; w_ < (lastl ? 1024 : 1040); w_ += G) { const int u = (w_ < 1024) ? (w_ >> 6) * NCH + 1 + (w_ & 63) : (w_ - 1024) * NCH; hg_C(PROJ, LBp + l * 1024, HGS, args.in[10] + l * 1024, BR, u, lds, tid_); }
#endif
            rg_C(PROJ, RGH, RGP, RGT, BR, gw_, NGW, lane_);
#if defined(PROBE_REP_RGC)
            rg_C(PROJ, RGH, RGP, RGT, BR, gw_, NGW, lane_);
#endif
        }
        SEAM(pb + 4);
        if constexpr (IN(pb + 5)) { PHASE_VARS pg8::Gemm g{BR, (const bf16*)(ws + WS_WUP + (size_t)l * SZ_WSQ), Mg, D, D, D, D}; pg8::StaticOrder S; S.init(Mg, D, G, bx);
            pg8::EpiUpGate E{MG, D, PROJ + PC_GATE, NPROJ};
            pg8::gemm_phase<pg8::EpiUpGate, pg8::StaticOrder, PG8_ALIGN_RES, PG8_SP2V>((PG8_LAS unsigned char*)lds, g, S, E, tid_);
            if constexpr (!lastl) { int tid2_ = tid; asm volatile("" : "+v"(tid2_)); skinny_phase<1>(BR + (size_t)METAROW * D, D, (const bf16*)(ws + WS_WUP + (size_t)l * SZ_WSQ), D, D, D, nullptr, MG + (size_t)METAROW * D, PROJ + (size_t)METAROW * NPROJ + PC_GATE, lds, tid2_, bx, G); } }
#if defined(PROBE_REP_G5)
        if constexpr (IN(pb + 5)) { PHASE_VARS pg8::Gemm g{BR, (const bf16*)(ws + WS_WUP + (size_t)l * SZ_WSQ), Mg, D, D, D, D}; pg8::StaticOrder S; S.init(Mg, D, G, bx);
            pg8::EpiUpGate E{MG, D, PROJ + PC_GATE, NPROJ};
            pg8::gemm_phase<pg8::EpiUpGate, pg8::StaticOrder, PG8_ALIGN_RES, PG8_SP2V>((PG8_LAS unsigned char*)lds, g, S, E, tid_);
            if constexpr (!lastl) { int tid2_ = tid; asm volatile("" : "+v"(tid2_)); skinny_phase<1>(BR + (size_t)METAROW * D, D, (const bf16*)(ws + WS_WUP + (size_t)l * SZ_WSQ), D, D, D, nullptr, MG + (size_t)METAROW * D, PROJ + (size_t)METAROW * NPROJ + PC_GATE, lds, tid2_, bx, G); } }
#endif
        SEAM(pb + 5);
        if constexpr (IN(pb + 6)) { PHASE_VARS pg8::Gemm g{MG, (const bf16*)(ws + WS_WOUT + (size_t)l * SZ_WSQ), Mg, D, D, D, D}; pg8::StaticOrder S; S.init(Mg, D, G, bx);
            pg8::EpiResid<(l != 0), true> E{hsrc, HBp};
            pg8::gemm_phase<pg8::EpiResid<(l != 0), true>, pg8::StaticOrder, PG8_ALIGN_RES, PG8_SP2V>((PG8_LAS unsigned char*)lds, g, S, E, tid_);
            if constexpr (!lastl) { int tid2_ = tid; asm volatile("" : "+v"(tid2_)); skinny_phase<0>(MG + (size_t)METAROW * D, D, (const bf16*)(ws + WS_WOUT + (size_t)l * SZ_WSQ), D, D, D, HMETA, nullptr, nullptr, lds, tid2_, bx, G); } }
        SEAM(pb + 6);
        if constexpr (IN(pb + 7)) { PHASE_VARS norm_rows<false, true>(HBp, HMETA, args.in[3] + l * D, XN, Mtail, nullptr, nullptr, nullptr, gw_, NGW, lane_, lds, tid_); }
#if defined(PROBE_REP_NORM)
            if constexpr (IN(pb + 7)) { PHASE_VARS norm_rows<false, true>(HBp, HMETA, args.in[3] + l * D, XN, Mtail, nullptr, nullptr, nullptr, gw_, NGW, lane_, lds, tid_); }
#endif
        SEAM(pb + 7);
        if constexpr (IN(pb + 8)) { PHASE_VARS pg8::Gemm g{XN, (const bf16*)(ws + WS_WGU + (size_t)l * SZ_WGU), Mg, NGU, D, D, D}; pg8::StaticOrder S; S.init(Mg, NGU, G, bx);
            pg8::EpiSwiGLU E{ACT, DFF};
            pg8::gemm_phase<pg8::EpiSwiGLU, pg8::StaticOrder, PG8_ALIGNV, PG8_SP2V>((PG8_LAS unsigned char*)lds, g, S, E, tid_);
            if constexpr (!lastl) { int tid2_ = tid; asm volatile("" : "+v"(tid2_)); skinny_swiglu(XN + (size_t)METAROW * D, (const bf16*)(ws + WS_WGU + (size_t)l * SZ_WGU), ACT + (size_t)METAROW * DFF, lds, tid2_, bx, G); } }
#if defined(PROBE_REP_G8)
        if constexpr (IN(pb + 8)) { PHASE_VARS pg8::Gemm g{XN, (const bf16*)(ws + WS_WGU + (size_t)l * SZ_WGU), Mg, NGU, D, D, D}; pg8::StaticOrder S; S.init(Mg, NGU, G, bx);
            pg8::EpiSwiGLU E{ACT, DFF};
            pg8::gemm_phase<pg8::EpiSwiGLU, pg8::StaticOrder, PG8_ALIGNV, PG8_SP2V>((PG8_LAS unsigned char*)lds, g, S, E, tid_);
            if constexpr (!lastl) { int tid2_ = tid; asm volatile("" : "+v"(tid2_)); skinny_swiglu(XN + (size_t)METAROW * D, (const bf16*)(ws + WS_WGU + (size_t)l * SZ_WGU), ACT + (size_t)METAROW * DFF, lds, tid2_, bx, G); } }
#endif
        SEAM(pb + 8);
        if constexpr (IN(pb + 9)) { PHASE_VARS pg8::Gemm g{ACT, (const bf16*)(ws + WS_WD + (size_t)l * SZ_WD), Mg, D, DFF, DFF, DFF}; pg8::StaticOrder S; S.init(Mg, D, G, bx);
            pg8::EpiResid<true, !lastl> E{HBp, lastl ? (void*)out : (void*)HBp};
            pg8::gemm_phase<pg8::EpiResid<true, !lastl>, pg8::StaticOrder, PG8_ALIGN_RES, PG8_SP2V>((PG8_LAS unsigned char*)lds, g, S, E, tid_);
            if constexpr (!lastl) { int tid2_ = tid; asm volatile("" : "+v"(tid2_)); skinny_phase<0>(ACT + (size_t)METAROW * DFF, DFF, (const bf16*)(ws + WS_WD + (size_t)l * SZ_WD), DFF, D, DFF, HMETA, nullptr, nullptr, lds, tid2_, bx, G); } }
        SEAM(pb + 9);
    }

#undef IN
#undef SEAM
#undef PHASE_VARS
#undef PROJ
#undef ACT
#undef XN
#undef BR
#undef MG
#undef HMETA
#undef GIF
#undef WIF
#undef LBp
#undef MLS
#undef MLN
#undef MLSC
#undef MLCT
#undef HGS
#undef HGE
#undef RGH
#undef RGP
#undef RGT
#undef HBp
#undef x
#undef out
}


#if MK_N_LAUNCHES == 1
template <class F> static void for_each_kernel(F&& f) { f((const void*)fwd_kernel<0, N_PHASES>); }
static void launch_all(const Args& a, int grid, hipStream_t stream) { hipLaunchKernelGGL((fwd_kernel<0, N_PHASES>), dim3(grid), dim3(NTHR), LDS_BYTES, stream, a); }
#else
template <int K> struct PhaseLaunch {
    template <class F> static void each(F&& f) { f((const void*)fwd_kernel<K, K + 1>); PhaseLaunch<K + 1>::each(f); }
    static void go(const Args& a, int grid, hipStream_t stream) { hipLaunchKernelGGL((fwd_kernel<K, K + 1>), dim3(grid), dim3(NTHR), LDS_BYTES, stream, a); PhaseLaunch<K + 1>::go(a, grid, stream); }
};
template <> struct PhaseLaunch<N_PHASES> { template <class F> static void each(F&&) {} static void go(const Args&, int, hipStream_t) {} };
template <class F> static void for_each_kernel(F&& f) { PhaseLaunch<0>::each(f); }
static void launch_all(const Args& a, int grid, hipStream_t stream) { PhaseLaunch<0>::go(a, grid, stream); }
#endif
extern "C" void kernel_launch(void* const* d_in, const int* in_sizes, int n_in, void* d_out, int out_size, void* d_ws, size_t ws_size, hipStream_t stream) {
    static int grid = 0;
    if (grid == 0) {
        if (n_in != 23 || out_size != TREAL * D || ws_size < WS_END) { fprintf(stderr, "kernel_launch: unexpected shapes (n_in %d, out %d, ws %zu < %zu); nothing launched\n", n_in, out_size, ws_size, (size_t)WS_END); grid = -1; return; }
        int dev = 0, cus = 0, per_cu = 0;
        if (hipGetDevice(&dev) != hipSuccess || hipDeviceGetAttribute(&cus, hipDeviceAttributeMultiprocessorCount, dev) != hipSuccess) { grid = -1; return; }
        bool ok = true;
        for_each_kernel([&](const void* f) { if (hipFuncSetAttribute(f, hipFuncAttributeMaxDynamicSharedMemorySize, LDS_BYTES) != hipSuccess) ok = false; });
        if (!ok) { fprintf(stderr, "kernel_launch: hipFuncSetAttribute failed\n"); grid = -1; return; }
        (void)per_cu; (void)hipGetLastError();
        grid = cus;
    }
    if (grid < 0) return;
    (void)in_sizes;
    if (hipMemsetAsync((char*)d_ws + WS_CTL, 0, CTL_ZERO_BYTES, stream) != hipSuccess) return;
    Args a{};
    for (int i = 0; i < 23; ++i) a.in[i] = (const float*)d_in[i];
    a.out = (float*)d_out; a.ws = (unsigned char*)d_ws; a.ph_lo = 0; a.ph_hi = N_PHASES;
    launch_all(a, grid, stream);
}
```

```cpp
#include <hip/hip_runtime.h>
#include <cstdio>
#include <cstdint>
#define MK_N_LAUNCHES 1
#ifndef PG8_WGM
#define PG8_WGM 8
#endif
namespace pg8 {
#define PG8_LAS __attribute__((address_space(3)))
typedef unsigned short bf16_t;
typedef short bf16x8 __attribute__((ext_vector_type(8)));
typedef float f32x4 __attribute__((ext_vector_type(4)));
typedef unsigned u32x4 __attribute__((ext_vector_type(4)));
constexpr int BM = 256, BK = 64, HALF = 128, HTB = HALF * BK * 2  , STAGE_BYTES = 8 * HTB, NXCD = 8, WGM = PG8_WGM;

__host__ __device__ __forceinline__ int lds_byte(int r, int c) { const int st = (r >> 4) * 2 + (c >> 5), rr = r & 15, cc = c & 31, ob = rr * 64 + cc * 2; return st * 1024 + (ob ^ (((ob >> 9) & 1) << 5)); }
__host__ __device__ __forceinline__ void stage_rc(int b, int& R, int& C) { const int st = b / 1024, sb = b % 1024, swz = sb ^ (((sb >> 9) & 1) << 5); R = (st >> 1) * 16 + swz / 64; C = (st & 1) * 32 + (swz % 64) / 2; }
__host__ __device__ __forceinline__ int perm32(int rho) { const int n = rho >> 4, i = rho & 15; return 8 * (i >> 2) + 4 * n + (i & 3); }

struct Unit { int pm, pn; };
struct Gemm { const bf16_t* A; const bf16_t* Bt; int M, N, K, lda, ldb; };

struct StaticOrder {
    int nM, nN, nwg, G, c;
    __host__ __device__ void init(int M, int N, int G_, int c_) { nM = M / BM; nN = N / BM; nwg = nM * nN; G = G_; c = c_; }
    __host__ __device__ bool next(int i, Unit& u) const {
        const long L = (long)i * G + c; if (L >= nwg) return false;
        int wgid = (int)L;
#if !defined(PG8_NO_XCD_REMAP)
        { const int q = nwg / NXCD, r = nwg % NXCD, xcd = wgid % NXCD, off = wgid / NXCD; wgid = (xcd < r ? xcd * (q + 1) : r * (q + 1) + (xcd - r) * q) + off; }
#endif
        const int nig = WGM * nN, gid = wgid / nig, fm = gid * WGM, gsz = (nM - fm) < WGM ? (nM - fm) : WGM;
        u.pm = fm + ((wgid % nig) % gsz); u.pn = (wgid % nig) / gsz; return true;
    }
    __device__ __forceinline__ void a_ready(const Unit&) const {}
    __device__ __forceinline__ void done(const Unit&) const {}
};

__device__ __forceinline__ unsigned cvt_pk_bf16(float lo, float hi) { unsigned r; asm volatile("v_cvt_pk_bf16_f32 %0, %1, %2" : "=v"(r) : "v"(lo), "v"(hi)); return r; }
typedef float f32x2 __attribute__((ext_vector_type(2)));
typedef float f32x2 __attribute__((ext_vector_type(2)));
__device__ __forceinline__ float bf_lo(unsigned w) { return __uint_as_float(w << 16); }
__device__ __forceinline__ float bf_hi(unsigned w) { return __uint_as_float(w & 0xffff0000u); }
__device__ __forceinline__ float fast_sigmoid(float x) { return __builtin_amdgcn_rcpf(1.0f + __expf(-x)); }

struct EpiProj {
    static constexpr bool PERM = true, AFTER_DRAIN = false, MID = false; static constexpr int SEG = 16;
    bf16_t* O; int ldc; const float* bias; int shift_from, bias_shift, gate_from;
    __device__ __forceinline__ void operator()(const f32x4 (&acc)[2][2][4][2], const Unit& u, int wr, int wc, int fr, int fq) const {
        const int row0 = u.pm * BM + wr * 64 + fr; const int colt = u.pn * BM;
        const int col0 = colt + wc * 32 + 8 * fq; const float* bp = bias + col0 + (colt >= shift_from ? bias_shift : 0);
        const bool isg = colt >= gate_from;
        f32x4 bv[2][2];
#pragma unroll
        for (int bj = 0; bj < 2; ++bj)
#pragma unroll
            for (int n = 0; n < 2; ++n) bv[bj][n] = *(const f32x4*)(bp + bj * HALF + 4 * n);
#pragma unroll
        for (int ai = 0; ai < 2; ++ai)
#pragma unroll
            for (int m = 0; m < 4; ++m) { bf16_t* rowp = O + (size_t)(row0 + ai * HALF + m * 16) * ldc + col0;
#pragma unroll
                for (int bj = 0; bj < 2; ++bj) { f32x4 v0 = acc[ai][bj][m][0] + bv[bj][0], v1 = acc[ai][bj][m][1] + bv[bj][1];
                    if (isg) {
#pragma unroll
                        for (int j = 0; j < 4; ++j) { v0[j] = 1.0f + __expf(-fmaxf(v0[j], -60.f)); v1[j] = 1.0f + __expf(-fmaxf(v1[j], -60.f)); } }
                    u32x4 w; w.x = cvt_pk_bf16(v0[0], v0[1]); w.y = cvt_pk_bf16(v0[2], v0[3]); w.z = cvt_pk_bf16(v1[0], v1[1]); w.w = cvt_pk_bf16(v1[2], v1[3]);
                    *(u32x4*)(rowp + bj * HALF) = w; } }
    }
};

struct EpiUpGate {
    static constexpr bool PERM = true, AFTER_DRAIN = false, MID = true; static constexpr int SEG = 16;
    bf16_t* O; int ldc; const bf16_t* G; int ldg;
    __device__ __forceinline__ void mid(f32x4 (&acc)[2][2][4][2], const Unit& u, int seg, int wr, int wc, int fr, int fq) const {
        const int row0 = u.pm * BM + wr * 64 + fr; const int col0 = u.pn * BM + wc * 32 + 8 * fq;
#pragma unroll
        for (int ai = 0; ai < 2; ++ai) { u32x4 ga[4][2], gb[4][2];
#pragma unroll
            for (int m = 0; m < 4; ++m) { const bf16_t* gp = G + (size_t)(row0 + ai * HALF + m * 16) * ldg + seg * 4096 + col0;
#pragma unroll
                for (int bj = 0; bj < 2; ++bj) { ga[m][bj] = *(const u32x4*)(gp + bj * HALF); gb[m][bj] = *(const u32x4*)(gp + 4096 + bj * HALF); } }
#pragma unroll
            for (int m = 0; m < 4; ++m)
#pragma unroll
                for (int bj = 0; bj < 2; ++bj) { const u32x4 a = ga[m][bj], b = gb[m][bj];
                    const unsigned aw[4] = {a.x, a.y, a.z, a.w}, bw[4] = {b.x, b.y, b.z, b.w};
#pragma unroll
                    for (int j = 0; j < 4; ++j) {
                        const float rl = bf_lo(bw[j]) * __builtin_amdgcn_rcpf(bf_lo(aw[j])), rh = bf_hi(bw[j]) * __builtin_amdgcn_rcpf(bf_hi(aw[j]));
                        acc[ai][bj][m][j >> 1][(j & 1) * 2] *= rl; acc[ai][bj][m][j >> 1][(j & 1) * 2 + 1] *= rh; } }
            asm volatile("" ::: "memory"); }
    }
    __device__ __forceinline__ void operator()(const f32x4 (&acc)[2][2][4][2], const Unit& u, int wr, int wc, int fr, int fq) const {
        const int row0 = u.pm * BM + wr * 64 + fr; const int col0 = u.pn * BM + wc * 32 + 8 * fq;
        u32x4 ga[2][4][2];
#pragma unroll
        for (int ai = 0; ai < 2; ++ai)
#pragma unroll
            for (int m = 0; m < 4; ++m) { const bf16_t* gp = G + (size_t)(row0 + ai * HALF + m * 16) * ldg + 3 * 4096 + col0;
#pragma unroll
                for (int bj = 0; bj < 2; ++bj) ga[ai][m][bj] = *(const u32x4*)(gp + bj * HALF); }
#pragma unroll
        for (int ai = 0; ai < 2; ++ai)
#pragma unroll
            for (int m = 0; m < 4; ++m) { const int row = row0 + ai * HALF + m * 16; bf16_t* rowp = O + (size_t)row * ldc + col0;
#pragma unroll
                for (int bj = 0; bj < 2; ++bj) { const u32x4 a = ga[ai][m][bj]; const unsigned aw[4] = {a.x, a.y, a.z, a.w}; float o[8];
#pragma unroll
                    for (int j = 0; j < 4; ++j) { const float gl = __builtin_amdgcn_rcpf(bf_lo(aw[j])), gh = __builtin_amdgcn_rcpf(bf_hi(aw[j]));
                        o[2 * j] = acc[ai][bj][m][j >> 1][(j & 1) * 2] * gl; o[2 * j + 1] = acc[ai][bj][m][j >> 1][(j & 1) * 2 + 1] * gh; }
                    u32x4 w; w.x = cvt_pk_bf16(o[0], o[1]); w.y = cvt_pk_bf16(o[2], o[3]); w.z = cvt_pk_bf16(o[4], o[5]); w.w = cvt_pk_bf16(o[6], o[7]);
                    *(u32x4*)(rowp + bj * HALF) = w; } }
    }
};

template <bool SB, bool DB> struct EpiResid {
    static constexpr bool PERM = true, AFTER_DRAIN = false, MID = false; static constexpr int SEG = 16;
    const void* src; void* dst;
    __device__ __forceinline__ void operator()(const f32x4 (&acc)[2][2][4][2], const Unit& u, int wr, int wc, int fr, int fq) const {
        const int row0 = u.pm * BM + wr * 64 + fr, col0 = u.pn * BM + wc * 32 + 8 * fq;
        if constexpr (SB) {
            u32x4 rs[2][4][2];
#pragma unroll
            for (int ai = 0; ai < 2; ++ai)
#pragma unroll
                for (int m = 0; m < 4; ++m)
#pragma unroll
                    for (int bj = 0; bj < 2; ++bj) rs[ai][m][bj] = *(const u32x4*)((const bf16_t*)src + (size_t)(row0 + ai * HALF + m * 16) * 4096 + col0 + bj * HALF);
#pragma unroll
            for (int ai = 0; ai < 2; ++ai)
#pragma unroll
                for (int m = 0; m < 4; ++m) { const size_t off = (size_t)(row0 + ai * HALF + m * 16) * 4096 + col0;
#pragma unroll
                    for (int bj = 0; bj < 2; ++bj) { const u32x4 a = rs[ai][m][bj];
                        const f32x4 v0 = (f32x4){bf_lo(a.x), bf_hi(a.x), bf_lo(a.y), bf_hi(a.y)} + acc[ai][bj][m][0], v1 = (f32x4){bf_lo(a.z), bf_hi(a.z), bf_lo(a.w), bf_hi(a.w)} + acc[ai][bj][m][1];
                        if constexpr (DB) { u32x4 w; w.x = cvt_pk_bf16(v0[0], v0[1]); w.y = cvt_pk_bf16(v0[2], v0[3]); w.z = cvt_pk_bf16(v1[0], v1[1]); w.w = cvt_pk_bf16(v1[2], v1[3]);
                            *(u32x4*)((bf16_t*)dst + off + bj * HALF) = w; }
                        else { *(f32x4*)((float*)dst + off + bj * HALF) = v0; *(f32x4*)((float*)dst + off + bj * HALF + 4) = v1; } } }
        } else {
#pragma unroll
            for (int ai = 0; ai < 2; ++ai) { f32x4 rs[4][2][2];
#pragma unroll
                for (int m = 0; m < 4; ++m)
#pragma unroll
                    for (int bj = 0; bj < 2; ++bj) { const float* sp = (const float*)src + (size_t)(row0 + ai * HALF + m * 16) * 4096 + col0 + bj * HALF; rs[m][bj][0] = *(const f32x4*)sp; rs[m][bj][1] = *(const f32x4*)(sp + 4); }
#pragma unroll
                for (int m = 0; m < 4; ++m) { const size_t off = (size_t)(row0 + ai * HALF + m * 16) * 4096 + col0;
#pragma unroll
                    for (int bj = 0; bj < 2; ++bj) { const f32x4 v0 = rs[m][bj][0] + acc[ai][bj][m][0], v1 = rs[m][bj][1] + acc[ai][bj][m][1];
                        if constexpr (DB) { u32x4 w; w.x = cvt_pk_bf16(v0[0], v0[1]); w.y = cvt_pk_bf16(v0[2], v0[3]); w.z = cvt_pk_bf16(v1[0], v1[1]); w.w = cvt_pk_bf16(v1[2], v1[3]);
                            *(u32x4*)((bf16_t*)dst + off + bj * HALF) = w; }
                        else { *(f32x4*)((float*)dst + off + bj * HALF) = v0; *(f32x4*)((float*)dst + off + bj * HALF + 4) = v1; } } }
                asm volatile("" ::: "memory"); }
        }
    }
};

struct EpiSwiGLU {
    static constexpr bool PERM = true, AFTER_DRAIN = false, MID = false; static constexpr int SEG = 16;
    bf16_t* O; int ldc;
    __device__ __forceinline__ void operator()(const f32x4 (&acc)[2][2][4][2], const Unit& u, int wr, int wc, int fr, int fq) const {
        const int row0 = u.pm * BM + wr * 64 + fr; const int col0 = u.pn * HALF + wc * 32 + 8 * fq;
#pragma unroll
        for (int ai = 0; ai < 2; ++ai)
#pragma unroll
            for (int m = 0; m < 4; ++m) { float o[8];
#pragma unroll
                for (int n = 0; n < 2; ++n)
#pragma unroll
                    for (int j = 0; j < 4; ++j) { const float gv = acc[ai][0][m][n][j], uv = acc[ai][1][m][n][j]; o[4 * n + j] = gv * fast_sigmoid(gv) * uv; }
                u32x4 w; w.x = cvt_pk_bf16(o[0], o[1]); w.y = cvt_pk_bf16(o[2], o[3]); w.z = cvt_pk_bf16(o[4], o[5]); w.w = cvt_pk_bf16(o[6], o[7]);
                *(u32x4*)(O + (size_t)(row0 + ai * HALF + m * 16) * ldc + col0) = w; }
    }
};
template <class Epi, class Sched, bool ALIGN_EPI = false, bool SP2 = false>
__device__ __forceinline__ void gemm_phase(PG8_LAS unsigned char* lds, const Gemm g, const Sched& S, const Epi& E, const int tid) {
    const int wid = __builtin_amdgcn_readfirstlane(tid >> 6), lane = tid & 63, wr = wid >> 2, wc = wid & 3, fr = lane & 15, fq = lane >> 4;
    const int K = g.K, nt = K / BK;
    unsigned voffA[2], voffB[2];
#pragma unroll
    for (int i = 0; i < 2; ++i) { int R, C; stage_rc(tid * 16 + i * 8192, R, C); const int Rb = Epi::PERM ? ((R & ~31) + perm32(R & 31)) : R;
        voffA[i] = (unsigned)(R * g.lda + C) * 2u; voffB[i] = (unsigned)(Rb * g.ldb + C) * 2u; }
    const size_t kstep = (size_t)(BK * 2);
    const size_t hstepA = (size_t)HALF * g.lda * 2, hstepB = (size_t)HALF * g.ldb * 2;
    const size_t tstepA = 2 * hstepA, tstepB = 2 * hstepB;
    const unsigned ldsw = (unsigned)wid * 1024u;
    const int aoff = lds_byte(wr * 64 + fr, fq * 8), boff = lds_byte(wc * 32 + fr, fq * 8);
#define PG8_SA(b, h) (((b) * 2 + (h)) * HTB)
#define PG8_SB(b, h) ((4 + (b) * 2 + (h)) * HTB)
#define PG8_STAGE(bufoff, gbase, voff) do { _Pragma("unroll") for (int _i = 0; _i < 2; ++_i) \
        __builtin_amdgcn_global_load_lds((const unsigned*)((const char*)(gbase) + (voff)[_i]), (PG8_LAS unsigned*)(lds + (bufoff) + ldsw + _i * 8192), 16, 0, 0); } while (0)
#define PG8_LDA(dst, b, h) do { _Pragma("unroll") for (int m = 0; m < 4; ++m) _Pragma("unroll") for (int k = 0; k < 2; ++k) dst[m][k] = *(const PG8_LAS bf16x8*)(lds + PG8_SA(b, h) + aoff + m * 2048 + k * 1024); } while (0)
#define PG8_LDB(dst, b, h) do { _Pragma("unroll") for (int n = 0; n < 2; ++n) _Pragma("unroll") for (int k = 0; k < 2; ++k) dst[n][k] = *(const PG8_LAS bf16x8*)(lds + PG8_SB(b, h) + boff + n * 2048 + k * 1024); } while (0)
#define PG8_MMA(ai, bj, At, Bt) do { __builtin_amdgcn_s_setprio(1); _Pragma("unroll") for (int m = 0; m < 4; ++m) _Pragma("unroll") for (int n = 0; n < 2; ++n) _Pragma("unroll") for (int k = 0; k < 2; ++k) \
        acc[ai][bj][m][n] = __builtin_amdgcn_mfma_f32_16x16x32_bf16(Bt[n][k], At[m][k], acc[ai][bj][m][n], 0, 0, 0); __builtin_amdgcn_s_setprio(0); } while (0)
#define PG8_WAIT_V(n) asm volatile("s_waitcnt vmcnt(" #n ")" ::: "memory")
#define PG8_WAIT_L(n) asm volatile("s_waitcnt lgkmcnt(" #n ")" ::: "memory")
#define PG8_BAR __builtin_amdgcn_s_barrier()
#define PG8_SCHED __builtin_amdgcn_sched_barrier(0)
    Unit cur, nxt; int ui = 0;
    if (!S.next(0, cur)) return;
    f32x4 acc[2][2][4][2];
#pragma unroll
    for (int a = 0; a < 2; ++a)
#pragma unroll
        for (int b = 0; b < 2; ++b)
#pragma unroll
            for (int m = 0; m < 4; ++m)
#pragma unroll
                for (int n = 0; n < 2; ++n) acc[a][b][m][n] = (f32x4){0.f, 0.f, 0.f, 0.f};
    bf16x8 At[4][2], B0[2][2], B1[2][2];
    const char* cA = (const char*)g.A + (size_t)cur.pm * tstepA; const char* cB = (const char*)g.Bt + (size_t)cur.pn * tstepB;
    S.a_ready(cur);
    if constexpr (SP2) {
        PG8_STAGE(PG8_SB(0, 0), cB, voffB); PG8_STAGE(PG8_SB(0, 1), cB + hstepB, voffB); PG8_STAGE(PG8_SA(0, 0), cA, voffA); PG8_STAGE(PG8_SA(0, 1), cA + hstepA, voffA);
        if (wr == 1) PG8_BAR;
        PG8_WAIT_V(2); PG8_BAR;
        PG8_STAGE(PG8_SB(1, 0), cB + kstep, voffB); PG8_STAGE(PG8_SA(1, 0), cA + kstep, voffA); PG8_STAGE(PG8_SB(1, 1), cB + hstepB + kstep, voffB);
        PG8_WAIT_V(6); PG8_BAR;
    } else {
        PG8_STAGE(PG8_SB(0, 0), cB, voffB); PG8_STAGE(PG8_SA(0, 0), cA, voffA); PG8_STAGE(PG8_SB(0, 1), cB + hstepB, voffB); PG8_STAGE(PG8_SA(0, 1), cA + hstepA, voffA);
        if (wr == 1) PG8_BAR;
        PG8_WAIT_V(4); PG8_BAR;
        PG8_STAGE(PG8_SB(1, 0), cB + kstep, voffB); PG8_STAGE(PG8_SA(1, 0), cA + kstep, voffA); PG8_STAGE(PG8_SB(1, 1), cB + hstepB + kstep, voffB);
        PG8_WAIT_V(6); PG8_BAR;
    }
    for (;;) {
        const bool has_next = S.next(ui + 1, nxt);
        const char* nA = has_next ? (const char*)g.A + (size_t)nxt.pm * tstepA : cA; const char* nB = has_next ? (const char*)g.Bt + (size_t)nxt.pn * tstepB : cB;
        for (int t = 0; t < nt; t += 2) {
            const bool last = (t == nt - 2);
            const char* a1 = cA + (size_t)(t + 1) * kstep;
            const char* a2 = last ? nA : cA + (size_t)(t + 2) * kstep; const char* b2 = last ? nB : cB + (size_t)(t + 2) * kstep;
            const char* a3 = a2 + kstep; const char* b3 = b2 + kstep;
            if (last && has_next) S.a_ready(nxt);
            if constexpr (SP2) {
            PG8_LDB(B0, 0, 0); PG8_LDB(B1, 0, 1); PG8_SCHED; PG8_LDA(At, 0, 0); PG8_STAGE(PG8_SA(1, 1), a1 + hstepA, voffA);
            PG8_WAIT_V(8); PG8_WAIT_L(0); PG8_BAR; PG8_MMA(0, 0, At, B0); PG8_MMA(0, 1, At, B1); PG8_BAR; PG8_SCHED;
            PG8_LDA(At, 0, 1); PG8_STAGE(PG8_SB(0, 0), b2, voffB); PG8_STAGE(PG8_SB(0, 1), b2 + hstepB, voffB); PG8_STAGE(PG8_SA(0, 0), a2, voffA);
            PG8_WAIT_V(8); PG8_WAIT_L(0); PG8_BAR; PG8_MMA(1, 0, At, B0); PG8_MMA(1, 1, At, B1); PG8_BAR; PG8_SCHED;
            PG8_LDB(B0, 1, 0); PG8_LDB(B1, 1, 1); PG8_SCHED; PG8_LDA(At, 1, 0); PG8_STAGE(PG8_SA(0, 1), a2 + hstepA, voffA);
            PG8_WAIT_V(8); PG8_WAIT_L(0); PG8_BAR; PG8_MMA(0, 0, At, B0); PG8_MMA(0, 1, At, B1); PG8_BAR; PG8_SCHED;
            PG8_LDA(At, 1, 1); PG8_STAGE(PG8_SB(1, 0), b3, voffB); PG8_STAGE(PG8_SB(1, 1), b3 + hstepB, voffB); PG8_STAGE(PG8_SA(1, 0), a3, voffA);
            PG8_WAIT_V(8); PG8_WAIT_L(0); PG8_BAR; PG8_MMA(1, 0, At, B0); PG8_MMA(1, 1, At, B1); PG8_BAR; PG8_SCHED;
            } else {
            PG8_LDB(B0, 0, 0); PG8_SCHED; PG8_LDA(At, 0, 0); PG8_STAGE(PG8_SA(1, 1), a1 + hstepA, voffA);
            PG8_WAIT_L(8); PG8_BAR; PG8_WAIT_L(0); PG8_MMA(0, 0, At, B0); PG8_BAR; PG8_SCHED;
            PG8_LDB(B1, 0, 1); PG8_STAGE(PG8_SB(0, 0), b2, voffB);
            PG8_BAR; PG8_WAIT_L(0); PG8_MMA(0, 1, At, B1); PG8_BAR;
            PG8_LDA(At, 0, 1); PG8_STAGE(PG8_SA(0, 0), a2, voffA);
            PG8_BAR; PG8_WAIT_L(0); PG8_MMA(1, 0, At, B0); PG8_BAR; PG8_SCHED;
            PG8_STAGE(PG8_SB(0, 1), b2 + hstepB, voffB);
            PG8_WAIT_V(6); PG8_BAR; PG8_MMA(1, 1, At, B1); PG8_BAR;
            PG8_LDB(B0, 1, 0); PG8_SCHED; PG8_LDA(At, 1, 0); PG8_STAGE(PG8_SA(0, 1), a2 + hstepA, voffA);
            PG8_WAIT_L(8); PG8_BAR; PG8_WAIT_L(0); PG8_MMA(0, 0, At, B0); PG8_BAR; PG8_SCHED;
            PG8_LDB(B1, 1, 1); PG8_STAGE(PG8_SB(1, 0), b3, voffB);
            PG8_BAR; PG8_WAIT_L(0); PG8_MMA(0, 1, At, B1); PG8_BAR;
            PG8_LDA(At, 1, 1); PG8_STAGE(PG8_SA(1, 0), a3, voffA);
            PG8_BAR; PG8_WAIT_L(0); PG8_MMA(1, 0, At, B0); PG8_BAR; PG8_SCHED;
            PG8_STAGE(PG8_SB(1, 1), b3 + hstepB, voffB);
            PG8_WAIT_V(6); PG8_BAR; PG8_MMA(1, 1, At, B1); PG8_BAR;
            }
            if constexpr (Epi::MID) { if (!last && ((t + 2) % Epi::SEG) == 0) E.mid(acc, cur, (t + 2) / Epi::SEG - 1, wr, wc, fr, fq); }
        }
        if constexpr (ALIGN_EPI) { if (wr == 0) PG8_BAR; }
        if constexpr (!Epi::AFTER_DRAIN) { E(acc, cur, wr, wc, fr, fq); S.done(cur); }
        if (!has_next) break;
#pragma unroll
        for (int a = 0; a < 2; ++a)
#pragma unroll
            for (int b = 0; b < 2; ++b)
#pragma unroll
                for (int m = 0; m < 4; ++m)
#pragma unroll
                    for (int n = 0; n < 2; ++n) acc[a][b][m][n] = (f32x4){0.f, 0.f, 0.f, 0.f};
        cur = nxt; cA = nA; cB = nB; ++ui;
        if constexpr (ALIGN_EPI) { if (wr == 1) PG8_BAR; }
    }
    PG8_WAIT_V(0);
    if constexpr (!ALIGN_EPI) { if (wr == 0) PG8_BAR; }
    PG8_BAR;
    if constexpr (Epi::AFTER_DRAIN) { E.fused(acc, cur, wr, wc, fr, fq, lds, wid, lane); S.done(cur); }
#undef PG8_SA
#undef PG8_SB
#undef PG8_STAGE
#undef PG8_LDA
#undef PG8_LDB
#undef PG8_MMA
#undef PG8_WAIT_V
#undef PG8_WAIT_L
#undef PG8_BAR
#undef PG8_SCHED
}
}
constexpr int D = 4096, TREAL = 8192, NMETA = 16, MROWS = 8448, METAROW = 8192;
constexpr int MIXW = 1024, NPROJ = 29696, NIN = 29704, DFF = 11008, NGU = 22016, NLAYER = 2;
constexpr int PC_MLQ = 0, PC_MLK = 1024, PC_MLV = 2048, PC_MLO = 3072, PC_SBQ = 4096, PC_SBK = 5120, PC_SBV = 6144, PC_HGQ = 7168, PC_HGF = 8192, PC_HGI = 9216, PC_HGG = 10240, PC_RGX = 11264, PC_RGY = 12288, PC_GATE = 13312;
constexpr int NCH = 65;
constexpr float EPS = 1e-6f, NEGF = -1e30f;
constexpr int NWAVES = 8, NTHR = 512;

constexpr size_t MiB = 1u << 20;
constexpr size_t al(size_t x) { return (x + MiB - 1) / MiB * MiB; }
constexpr size_t WS_CTL = 0, CTL_ZERO_BYTES = 1 * MiB;
constexpr size_t SZ_WIN = (size_t)NPROJ * D * 2, SZ_WSQ = (size_t)D * D * 2, SZ_WGU = (size_t)NGU * D * 2, SZ_WD = (size_t)D * DFF * 2;
constexpr size_t WS_WIN = 1 * MiB;
constexpr size_t WS_WUP = WS_WIN + al(2 * SZ_WIN);
constexpr size_t WS_WOUT = WS_WUP + al(2 * SZ_WSQ);
constexpr size_t WS_WGU = WS_WOUT + al(2 * SZ_WSQ);
constexpr size_t WS_WD = WS_WGU + al(2 * SZ_WGU);
constexpr size_t WS_PROJ = WS_WD + al(2 * SZ_WD);
constexpr size_t WS_ACT = WS_PROJ;
constexpr size_t WS_XN = WS_PROJ + al((size_t)MROWS * NPROJ * 2);
constexpr size_t WS_BR = WS_XN + al((size_t)MROWS * D * 2);
constexpr size_t WS_MG = WS_BR + al((size_t)MROWS * D * 2);
constexpr size_t WS_HMETA = WS_MG + al((size_t)MROWS * D * 2);
constexpr size_t WS_GIF = WS_HMETA + al((size_t)256 * D * 4);
constexpr size_t WS_WIF = WS_GIF + al((size_t)MROWS * 8 * 4);
constexpr size_t WS_LB = WS_WIF + al((size_t)2 * 8 * D * 4);
constexpr size_t WS_MLS = WS_LB + MiB;
constexpr size_t WS_MLN = WS_MLS + al((size_t)520 * 65536 * 4);
constexpr size_t WS_MLSC = WS_MLN + al((size_t)520 * 256 * 4);
constexpr size_t WS_HGS = WS_MLSC + MiB;
constexpr size_t WS_HGE = WS_HGS + al((size_t)1040 * 16384 * 4);
constexpr size_t WS_RGH = WS_HGE + al((size_t)1040 * 128 * 4);
constexpr size_t WS_RGP = WS_RGH + al((size_t)MROWS * 1024 * 4);
constexpr size_t WS_RGT = WS_RGP + al((size_t)MROWS * 1024 * 4);
constexpr size_t WS_MLCT = WS_RGT + al((size_t)3 * 2 * 65 * 1024 * 4);
constexpr size_t MLCT_UNIT = (size_t)17 * 8 * 64 * 8;
constexpr size_t WS_HB = WS_MLCT + al((size_t)520 * MLCT_UNIT * 2);
constexpr size_t WS_END = WS_HB + al((size_t)TREAL * D * 2);
static_assert(WS_END <= (size_t)2300 * MiB, "workspace map");
constexpr int CW_BAR = 4096;

constexpr int RING_BYTES = 131072;
constexpr int LDSCTL_OFF = RING_BYTES + 8192, MISC_OFF = LDSCTL_OFF + 320;
constexpr int LDS_BYTES = 147456;
static_assert(MISC_OFF + 128 <= LDS_BYTES, "LDS map");

#define GAS __attribute__((address_space(1)))
#define LAS __attribute__((address_space(3)))
typedef unsigned short bf16;
typedef unsigned v4u __attribute__((ext_vector_type(4)));
typedef unsigned v2u __attribute__((ext_vector_type(2)));
typedef float f32x4 __attribute__((ext_vector_type(4)));
typedef float f32x2 __attribute__((ext_vector_type(2)));
typedef GAS unsigned gu32;
#define RLX_AGENT __ATOMIC_RELAXED, __HIP_MEMORY_SCOPE_AGENT
#define LDS_WAIT() asm volatile("s_waitcnt lgkmcnt(0)" ::: "memory")
#define VM_WAIT() asm volatile("s_waitcnt vmcnt(0)" ::: "memory")
typedef float f32x2c_ __attribute__((ext_vector_type(2)));
typedef __bf16 bf16x2c_ __attribute__((ext_vector_type(2)));
__device__ __forceinline__ unsigned pk2(float lo, float hi) { const f32x2c_ v = {lo, hi}; const bf16x2c_ b = __builtin_convertvector(v, bf16x2c_); return __builtin_bit_cast(unsigned, b); }
__device__ __forceinline__ unsigned f2bf(float f) { const __bf16 b = (__bf16)f; return (unsigned)__builtin_bit_cast(unsigned short, b); }
__device__ __forceinline__ float bflo(unsigned w) { return __uint_as_float(w << 16); }
__device__ __forceinline__ float bfhi(unsigned w) { return __uint_as_float(w & 0xffff0000u); }
__device__ __forceinline__ float bf1(bf16 b) { return __uint_as_float(((unsigned)b) << 16); }
__device__ __forceinline__ void unpack8(const v4u w, float (&o)[8]) { o[0] = bflo(w.x); o[1] = bfhi(w.x); o[2] = bflo(w.y); o[3] = bfhi(w.y); o[4] = bflo(w.z); o[5] = bfhi(w.z); o[6] = bflo(w.w); o[7] = bfhi(w.w); }
__device__ __forceinline__ float wave_sum(float v) {
#pragma unroll
    for (int o = 1; o < 64; o <<= 1) v += __shfl_xor(v, o);
    return v;
}
__device__ __forceinline__ float wave_max(float v) {
#pragma unroll
    for (int o = 1; o < 64; o <<= 1) v = fmaxf(v, __shfl_xor(v, o));
    return v;
}
__device__ __forceinline__ float wave_incl_sum(float v, int lane) {
#pragma unroll
    for (int o = 1; o < 64; o <<= 1) { const float t = __shfl_up(v, o); if (lane >= o) v += t; }
    return v;
}
__device__ __forceinline__ float wave_incl_max(float v, int lane) {
#pragma unroll
    for (int o = 1; o < 64; o <<= 1) { const float t = __shfl_up(v, o); if (lane >= o) v = fmaxf(v, t); }
    return v;
}
__device__ __forceinline__ float sigmoidf_(float x) { return __builtin_amdgcn_rcpf(1.0f + __expf(-x)); }
__device__ __forceinline__ float log_sigmoidf_(float x) { return fminf(x, 0.f) - log1pf(expf(-fabsf(x))); }
__device__ __forceinline__ float softplusf_(float x) { return fmaxf(x, 0.f) + log1pf(expf(-fabsf(x))); }
__device__ __forceinline__ int seq_row(int b, int p) { return p < NMETA ? METAROW + p : b * 4096 + p - NMETA; }
#define XB_TMO      128
#define XB_XCNT(j)  (256  + 64 * (j))
#define XB_XSUB(j)  (1280 + 64 * (j))
#define XB_XGEN(j)  (2304 + 64 * (j))
#define XB_TOP      3328
#define XB_TOPGEN   3392
#define XCD_BAR_WORDS 3456
#define XB_SPIN_CAP (1u << 18)

__device__ __forceinline__ unsigned xb_ld(unsigned* p)              { return __hip_atomic_load(p, __ATOMIC_RELAXED, __HIP_MEMORY_SCOPE_AGENT); }
__device__ __forceinline__ unsigned xb_add(unsigned* p, unsigned v) { return __hip_atomic_fetch_add(p, v, __ATOMIC_RELAXED, __HIP_MEMORY_SCOPE_AGENT); }
__device__ __forceinline__ unsigned xb_xcc_id() { return (unsigned)__builtin_amdgcn_s_getreg((3 << 11) | 20) & 0xFu; }
#define XB_SPIN(cond, bar) do { unsigned _sp = 0; while (cond) { __builtin_amdgcn_s_sleep(1); \
    if ((++_sp & 255u) == 0u) { if (xb_ld(&(bar)[XB_TMO])) break; if (_sp > XB_SPIN_CAP) { atomicAdd(&(bar)[XB_TMO], 1u); break; } } } } while (0)

struct XcdBarrier {
    unsigned* bar; unsigned x;
    volatile LAS unsigned* st;
};

__device__ __forceinline__ XcdBarrier xcd_barrier_post(unsigned* bar, volatile LAS unsigned* st) {
    XcdBarrier b; b.bar = bar; b.x = xb_xcc_id(); b.st = st;
    if (threadIdx.x == 0) (void)xb_add(&bar[XB_XCNT(b.x)], 1u);
    return b;
}
__device__ __forceinline__ void xcd_barrier_complete(unsigned* bar, unsigned x, unsigned& nloc, unsigned& nx) {
    const unsigned G = gridDim.x * gridDim.y * gridDim.z;
    unsigned sum, cnt, mine, sp = 0u;
    for (;;) {
        sum = 0u; cnt = 0u; mine = 0u;
#pragma unroll
        for (unsigned j = 0; j < 16; ++j) { const unsigned c = xb_ld(&bar[XB_XCNT(j)]); sum += c; cnt += (c > 0u) ? 1u : 0u; mine = (j == x) ? c : mine; }
        if (sum == G) break;
        __builtin_amdgcn_s_sleep(1);
        if ((++sp & 255u) == 0u) { if (xb_ld(&bar[XB_TMO])) break; if (sp > XB_SPIN_CAP) { atomicAdd(&bar[XB_TMO], 1u); break; } }
    }
    nloc = mine > 0u ? mine : 1u; nx = cnt > 0u ? cnt : 1u;
}

__device__ __forceinline__ void xcd_barrier(const XcdBarrier& b) {
    asm volatile("s_waitcnt vmcnt(0)" ::: "memory");
    __syncthreads();
    if (threadIdx.x == 0) {
        unsigned* bar = b.bar;
        __builtin_amdgcn_s_waitcnt(0);
        unsigned nloc = b.st[0], nx = b.st[1];
        if (nloc == 0u) { xcd_barrier_complete(bar, b.x, nloc, nx); b.st[0] = nloc; b.st[1] = nx; }
        const unsigned old = xb_add(&bar[XB_XSUB(b.x)], 1u);
        const unsigned gen = old / nloc;
        if (old + 1u == (gen + 1u) * nloc) {
            __builtin_amdgcn_fence(__ATOMIC_RELEASE, "agent");
            asm volatile("s_waitcnt vmcnt(0)" ::: "memory");
            const unsigned og = xb_add(&bar[XB_TOP], 1u);
            const unsigned tg = og / nx;
            if (og + 1u == (tg + 1u) * nx) xb_add(&bar[XB_TOPGEN], 1u);
            else XB_SPIN(xb_ld(&bar[XB_TOPGEN]) == tg, bar);
            __builtin_amdgcn_fence(__ATOMIC_ACQUIRE, "agent");
            xb_add(&bar[XB_XGEN(b.x)], 1u);
            asm volatile("s_waitcnt vmcnt(0)" ::: "memory");
        } else {
            XB_SPIN(xb_ld(&bar[XB_XGEN(b.x)]) == gen, bar);
            __builtin_amdgcn_fence(__ATOMIC_ACQUIRE, "agent");
            asm volatile("s_waitcnt vmcnt(0)" ::: "memory");
        }
    }
    __syncthreads();
}
template <int N> __device__ __forceinline__ float dpp_shr16(float v) { return __builtin_bit_cast(float, __builtin_amdgcn_update_dpp(0, __builtin_bit_cast(int, v), 0x110 + N, 0xf, 0xf, true)); }
typedef __bf16 bf16x2v __attribute__((ext_vector_type(2)));
__device__ __forceinline__ float dot2bf(unsigned a, unsigned b, float acc) { return __builtin_amdgcn_fdot2_f32_bf16(__builtin_bit_cast(bf16x2v, a), __builtin_bit_cast(bf16x2v, b), acc, false); }
typedef short bf16x8v __attribute__((ext_vector_type(8)));
#define MFMA16(a, b, c) __builtin_amdgcn_mfma_f32_16x16x32_bf16(a, b, c, 0, 0, 0)
__device__ __forceinline__ bf16x8v pack8(const float (&x)[8]) { v4u w; w.x = pk2(x[0], x[1]); w.y = pk2(x[2], x[3]); w.z = pk2(x[4], x[5]); w.w = pk2(x[6], x[7]); return __builtin_bit_cast(bf16x8v, w); }
__device__ __forceinline__ float fast_sigmoid_(float x) { return __builtin_amdgcn_rcpf(1.0f + __expf(-x)); }
struct P0Item { const float* src; bf16* dst; int ldw, K; };
struct P0Strip { const float* src0; bf16* dst0; int ldw, K, kb_lo, kb_n; };
constexpr int NSTRIP_DN = 2 * NLAYER * 64, NSTRIP_L = 464 + 344 + 64 + 64, NSTRIP = NSTRIP_DN + NLAYER * NSTRIP_L;
__device__ __forceinline__ P0Strip p0_strip(const float* const* in, unsigned char* ws, int s) {
    P0Strip o;
    if (s < NSTRIP_DN) { const int l = s >> 7, rem = s & 127, nb = rem >> 1, half = rem & 1;
        o.ldw = D; o.K = DFF; o.src0 = in[22] + (size_t)l * DFF * D + 64 * nb; o.dst0 = (bf16*)(ws + WS_WD + (size_t)l * SZ_WD) + (size_t)(64 * nb) * DFF; o.kb_lo = 86 * half; o.kb_n = 86; return o; }
    s -= NSTRIP_DN; const int l = s / NSTRIP_L; int r = s - l * NSTRIP_L; o.K = D; o.kb_lo = 0; o.kb_n = 64;
    if (r < 464) { o.ldw = NIN; o.src0 = in[4] + (size_t)l * D * NIN + 64 * r + (r >= 64 ? 8 : 0); o.dst0 = (bf16*)(ws + WS_WIN + (size_t)l * SZ_WIN) + (size_t)(64 * r) * D; return o; } r -= 464;
    if (r < 344) { const int which = r / 172, nb = r % 172, n0 = 64 * nb; o.ldw = DFF; o.src0 = in[20 + which] + (size_t)l * D * DFF + n0; o.dst0 = (bf16*)(ws + WS_WGU + (size_t)l * SZ_WGU) + (size_t)((n0 >> 7) * 256 + which * 128 + (n0 & 127)) * D; return o; } r -= 344;
    if (r < 64) { o.ldw = D; o.src0 = in[18] + (size_t)l * D * D + 64 * r; o.dst0 = (bf16*)(ws + WS_WUP + (size_t)l * SZ_WSQ) + (size_t)(64 * r) * D; return o; } r -= 64;
    { o.ldw = D; o.src0 = in[19] + (size_t)l * D * D + 64 * r; o.dst0 = (bf16*)(ws + WS_WOUT + (size_t)l * SZ_WSQ) + (size_t)(64 * r) * D; return o; }
}
__device__ __forceinline__ P0Item p0_item(const P0Strip& S, int kb) { P0Item o; o.src = S.src0 + (size_t)(64 * kb) * S.ldw; o.dst = S.dst0 + 64 * kb; o.ldw = S.ldw; o.K = S.K; return o; }
__device__ __forceinline__ void p0_load(const P0Item& I, f32x4 (&v)[16], int lane) {
    const float* p = I.src + (size_t)(2 * (lane >> 4)) * I.ldw + 4 * (lane & 15);
#pragma unroll
#if defined(P0_NT)
    for (int j = 0; j < 16; ++j) v[j] = __builtin_nontemporal_load((const f32x4*)(p + (size_t)(8 * (j >> 1) + (j & 1)) * I.ldw));
#else
    for (int j = 0; j < 16; ++j) v[j] = *(const f32x4*)(p + (size_t)(8 * (j >> 1) + (j & 1)) * I.ldw);
#endif
}
__device__ __forceinline__ void p0_store(const P0Item& I, const f32x4 (&v)[16], unsigned* scr, int lane) {
    const int l15 = lane & 15, l4 = lane >> 4;
#pragma unroll
    for (int m = 0; m < 8; ++m)
#pragma unroll
        for (int i = 0; i < 4; ++i) scr[(4 * l15 + i) * 33 + 4 * m + l4] = pk2(v[2 * m][i], v[2 * m + 1][i]);
    LDS_WAIT(); asm volatile("" ::: "memory");
    const int c = lane & 7;
#pragma unroll
    for (int j = 0; j < 8; ++j) { const int n = (lane >> 3) + 8 * j; const unsigned* s = scr + n * 33 + 4 * c;
        v4u o; o.x = s[0]; o.y = s[1]; o.z = s[2]; o.w = s[3];
        __builtin_nontemporal_store(o, (v4u*)(I.dst + (size_t)n * I.K + 8 * c)); }
    LDS_WAIT(); asm volatile("" ::: "memory");
}
__device__ __forceinline__ void p0_prologue(const float* const* in, unsigned char* ws, unsigned char* lds, int bxp, int Gp, int wave, int lane, int gtid, int NGT) {
    unsigned* scr = (unsigned*)(lds + wave * 16384);
    const float* w_in = in[4];
#if defined(PROBE_P0_STORES)
    for (int sidx = bxp; sidx < NSTRIP; sidx += Gp) { const P0Strip S = p0_strip(in, ws, sidx); const int hi = S.kb_lo + S.kb_n;
        for (int kb = S.kb_lo + wave; kb < hi; kb += NWAVES) { const P0Item I = p0_item(S, kb); const int c = lane & 7;
#pragma unroll
            for (int j = 0; j < 8; ++j) { const int n = (lane >> 3) + 8 * j; *(v4u*)(I.dst + (size_t)n * I.K + 8 * c) = (v4u){(unsigned)kb, (unsigned)j, 0u, 0u}; } } }
    VM_WAIT(); __syncthreads();
#endif
#if defined(PROBE_P0_LOADS)
    for (int sidx = bxp; sidx < NSTRIP; sidx += Gp) { const P0Strip S = p0_strip(in, ws, sidx); const int hi = S.kb_lo + S.kb_n; f32x4 va[16];
        for (int kb = S.kb_lo + wave; kb < hi; kb += NWAVES) { p0_load(p0_item(S, kb), va, lane);
#pragma unroll
            for (int j = 0; j < 16; ++j) asm volatile("" :: "v"(va[j])); } }
    VM_WAIT(); __syncthreads();
#endif
    for (int sidx = bxp; sidx < NSTRIP; sidx += Gp) {
        const P0Strip S = p0_strip(in, ws, sidx); const int hi = S.kb_lo + S.kb_n; int kb = S.kb_lo + wave; f32x4 va[16], vb[16];
        if (kb < hi) p0_load(p0_item(S, kb), va, lane);
        while (kb < hi) {
            const int k1 = kb + NWAVES; if (k1 < hi) p0_load(p0_item(S, k1), vb, lane);
            p0_store(p0_item(S, kb), va, scr, lane);
            if (k1 >= hi) break;
            const int k2 = k1 + NWAVES; if (k2 < hi) p0_load(p0_item(S, k2), va, lane);
            p0_store(p0_item(S, k1), vb, scr, lane);
            kb = k2; }
    }
    { float* hm = (float*)(ws + WS_HMETA); const float* meta = in[1];
      for (int i = gtid; i < 256 * D; i += NGT) hm[i] = (i < NMETA * D) ? meta[i] : 0.f; }
    { unsigned* brp = (unsigned*)(ws + WS_BR + (size_t)(TREAL + NMETA) * D * 2);
      for (int i = gtid; i < (MROWS - TREAL - NMETA) * D / 2; i += NGT) brp[i] = 0u; }
    { float* wif = (float*)(ws + WS_WIF);
      for (int it = bxp * NWAVES + wave; it < NLAYER * 64; it += Gp * NWAVES) { const int l = it >> 6, k = 64 * (it & 63) + lane;
          const float* p = w_in + ((size_t)l * D + k) * NIN + 4096; const f32x4 a = *(const f32x4*)p, b = *(const f32x4*)(p + 4);
          float* wq = wif + (size_t)l * 8 * D + k;
          wq[0] = a.x; wq[D] = a.y; wq[2 * D] = a.z; wq[3 * D] = a.w; wq[4 * D] = b.x; wq[5 * D] = b.y; wq[6 * D] = b.z; wq[7 * D] = b.w; } }
    { float* lb = (float*)(ws + WS_LB); const float* hl = in[9];
      for (int i = gtid; i < 1024; i += NGT) { const float a0 = hl[i], a1 = hl[1024 + i], mx = fmaxf(a0, a1), e0 = expf(a0 - mx), e1 = expf(a1 - mx); const float p1 = e1 / (e0 + e1);
          lb[i] = 0.f; lb[1024 + i] = fminf(fmaxf(p1, 0.f), 0.999f); } }
}

template <bool GATES, bool HBF> __device__ __forceinline__ void norm_rows(const void* hreal, const float* hmeta, const float* gain, bf16* XN, int nrows, const float* wif_g, const float* bif, float* gif, int gw, int NGW, int lane, unsigned char* lds, int tid) {
    const float* wif = (const float*)lds;
    if (GATES) {
        for (int i = tid; i < 8 * D / 4; i += NTHR) *(f32x4*)(lds + (size_t)i * 16) = *(const f32x4*)(wif_g + (size_t)i * 4);
        __syncthreads(); }
    for (int row = gw; row < nrows; row += NGW) {
        f32x4 v[16]; float ss = 0.f;
        const bool real_bf = HBF && row < TREAL;
        const float* hr = row < TREAL ? (const float*)hreal + (size_t)row * D : hmeta + (size_t)(row - TREAL) * D;
        const bf16* hb = (const bf16*)hreal + (size_t)row * D;
#pragma unroll
        for (int j = 0; j < 8; ++j) {
            if (real_bf) { const v4u a = *(const v4u*)(hb + 512 * j + 8 * lane); v[2 * j] = (f32x4){bflo(a.x), bfhi(a.x), bflo(a.y), bfhi(a.y)}; v[2 * j + 1] = (f32x4){bflo(a.z), bfhi(a.z), bflo(a.w), bfhi(a.w)}; }
            else { const float* p = hr + 512 * j + 8 * lane; v[2 * j] = *(const f32x4*)p; v[2 * j + 1] = *(const f32x4*)(p + 4); }
            ss += (v[2 * j].x * v[2 * j].x + v[2 * j].y * v[2 * j].y) + (v[2 * j].z * v[2 * j].z + v[2 * j].w * v[2 * j].w) + (v[2 * j + 1].x * v[2 * j + 1].x + v[2 * j + 1].y * v[2 * j + 1].y) + (v[2 * j + 1].z * v[2 * j + 1].z + v[2 * j + 1].w * v[2 * j + 1].w); }
        const float rstd = __builtin_amdgcn_rsqf(wave_sum(ss) * (1.0f / D) + EPS);
#pragma unroll
        for (int j = 0; j < 8; ++j) { const float* gp = gain + 512 * j + 8 * lane; const f32x4 g0 = *(const f32x4*)gp, g1 = *(const f32x4*)(gp + 4);
            v[2 * j] = v[2 * j] * rstd * g0; v[2 * j + 1] = v[2 * j + 1] * rstd * g1;
            v4u o; o.x = pk2(v[2 * j].x, v[2 * j].y); o.y = pk2(v[2 * j].z, v[2 * j].w); o.z = pk2(v[2 * j + 1].x, v[2 * j + 1].y); o.w = pk2(v[2 * j + 1].z, v[2 * j + 1].w);
            *(v4u*)(XN + (size_t)row * D + 512 * j + 8 * lane) = o; }
        if (GATES) { float mine = 0.f;
#pragma unroll 1
            for (int jj = 0; jj < 8; ++jj) { float dot = 0.f; const float* wp = wif + jj * D + 8 * lane;
#pragma unroll
                for (int j = 0; j < 8; ++j) { const f32x4 w0 = *(const f32x4*)(wp + 512 * j), w1 = *(const f32x4*)(wp + 512 * j + 4);
                    dot += (v[2 * j].x * w0.x + v[2 * j].y * w0.y) + (v[2 * j].z * w0.z + v[2 * j].w * w0.w) + (v[2 * j + 1].x * w1.x + v[2 * j + 1].y * w1.y) + (v[2 * j + 1].z * w1.z + v[2 * j + 1].w * w1.w); }
                dot = wave_sum(dot); if (lane == jj) mine = dot + bif[jj]; }
            if (lane < 8) gif[(size_t)row * 8 + lane] = mine; }
    }
}

__device__ __forceinline__ void mlstm_A(const bf16* PROJ, const float* GIF, float* MLS, float* MLN, float* MLSC, int u, unsigned char* lds, int tid) {
    const int c = u % NCH, bh = u / NCH, h = bh & 3, b = bh >> 2, lane = tid & 63, wave = tid >> 6, lc = lane & 15, g = lane >> 4;
    constexpr int QP = 264;
    bf16* kw = (bf16*)lds; bf16* vs = (bf16*)(lds + 33792); float* wsc = (float*)(lds + RING_BYTES);
    if (tid < 64) {
        const int p = 64 * c + lane - 48; float lf = 0.f, li = NEGF;
        if (p >= 0) { const int row = seq_row(b, p); li = GIF[(size_t)row * 8 + h]; lf = log_sigmoidf_(GIF[(size_t)row * 8 + 4 + h]); }
        const float bc = wave_incl_sum(lf, lane); const float bend = __shfl(bc, 63);
        const float wl = bend - bc + li; const float a = wave_max(wl);
        wsc[lane] = expf(wl - a);
        if (lane == 0) { MLSC[u] = a; MLSC[520 + u] = bend; }
    }
    __syncthreads();
#pragma unroll
    for (int j = 0; j < 4; ++j) { const int id = tid + 512 * j, r = id >> 5, cp = id & 31, p = 64 * c + r - 48;
        v4u vr = (v4u){0u, 0u, 0u, 0u}; float kv[8];
#pragma unroll
        for (int q = 0; q < 8; ++q) kv[q] = 0.f;
        if (p >= 0) { const size_t ro = (size_t)seq_row(b, p) * NPROJ + h * 256 + cp * 8; unpack8(*(const v4u*)(PROJ + ro + PC_MLK), kv); vr = *(const v4u*)(PROJ + ro + PC_MLV); const float w = wsc[r];
#pragma unroll
            for (int q = 0; q < 8; ++q) kv[q] *= w; }
        *(bf16x8v*)(kw + r * QP + cp * 8) = pack8(kv); *(v4u*)(vs + r * QP + cp * 8) = vr; }
    __syncthreads();
    bf16x8v af[2][2];
#pragma unroll
    for (int dt = 0; dt < 2; ++dt)
#pragma unroll
        for (int ks = 0; ks < 2; ++ks)
#pragma unroll
            for (int i = 0; i < 8; ++i) af[dt][ks][i] = (short)kw[(32 * ks + 8 * g + i) * QP + 32 * wave + 16 * dt + lc];
    bf16* out = (bf16*)MLS + (size_t)u * MLCT_UNIT;
    for (int et = 0; et < 17; ++et) { bf16x8v bv[2];
#pragma unroll
        for (int ks = 0; ks < 2; ++ks)
#pragma unroll
            for (int i = 0; i < 8; ++i) bv[ks][i] = (et < 16) ? (short)vs[(32 * ks + 8 * g + i) * QP + 16 * et + lc] : ((lc == 0) ? (short)0x3F80 : (short)0);
#pragma unroll
        for (int dt = 0; dt < 2; ++dt) { f32x4 acc = (f32x4){0.f, 0.f, 0.f, 0.f};
#pragma unroll
            for (int ks = 0; ks < 2; ++ks) acc = MFMA16(af[dt][ks], bv[ks], acc);
            const int d0 = 32 * wave + 16 * dt + 4 * g;
            if (et < 16) { v2u w; w.x = pk2(acc[0], acc[1]); w.y = pk2(acc[2], acc[3]);
                *(v2u*)(out + ((size_t)(et * 8 + wave) * 64 + lc + 16 * (2 * dt + (g >> 1))) * 8 + 4 * (g & 1)) = w; }
            else if (lc == 0) {
#pragma unroll
                for (int r = 0; r < 4; ++r) MLN[(size_t)u * 256 + d0 + r] = acc[r]; } } }
    __syncthreads();
}
__device__ __forceinline__ void mlstm_B(const float* MLS, const float* MLN, float* MLSC, bf16* MLCT, int unit, unsigned char* lds, int tid) {
    const int chain = unit >> 5, slice = unit & 31;
    float* alpha = (float*)lds; float* beta = alpha + 80; float* av = alpha + 160; float* bv = alpha + 240; float* mm = alpha + 320;
    if (tid < NCH) { av[tid] = MLSC[chain * NCH + tid]; bv[tid] = MLSC[520 + chain * NCH + tid]; }
    __syncthreads();
    if (tid == 0) { float m = 0.f;
        for (int c = 0; c < NCH; ++c) { mm[c] = m; m = fmaxf(bv[c] + m, av[c]); } mm[NCH] = m; }
    __syncthreads();
    if (tid < NCH) { const float m = mm[tid], mn = mm[tid + 1]; alpha[tid] = __expf(bv[tid] + m - mn); beta[tid] = __expf(av[tid] - mn); if (slice == 0) MLSC[1040 + chain * NCH + tid] = m; }
    __syncthreads();
    { const int gid = slice * 512 + tid, e = gid & 255, d4 = gid >> 8; float st[4];
#pragma unroll
      for (int i = 0; i < 4; ++i) st[i] = 0.f;
      const size_t fo = ((size_t)((e >> 4) * 8 + (d4 >> 3)) * 64 + (e & 15) + 16 * ((d4 >> 1) & 3)) * 8 + 4 * (d4 & 1);
#pragma unroll 4
      for (int c = 0; c < NCH; ++c) { const size_t uu = (size_t)chain * NCH + c; const v2u dw = *(const v2u*)((const bf16*)MLS + uu * MLCT_UNIT + fo); const float dl[4] = {bflo(dw.x), bfhi(dw.x), bflo(dw.y), bfhi(dw.y)};
          v2u w; w.x = pk2(st[0], st[1]); w.y = pk2(st[2], st[3]); *(v2u*)(MLCT + uu * MLCT_UNIT + fo) = w;
          const float al_ = alpha[c], be_ = beta[c];
#pragma unroll
          for (int i = 0; i < 4; ++i) st[i] = st[i] * al_ + dl[i] * be_; } }
    if (slice == 0) { const int ks = tid >> 6, l = tid & 63; const bool own = (l & 15) == 0; const int d0 = 32 * ks + 8 * (l >> 4); float st[8];
#pragma unroll
      for (int i = 0; i < 8; ++i) st[i] = 0.f;
#pragma unroll 5
      for (int c = 0; c < NCH; ++c) { const size_t uu = (size_t)chain * NCH + c; const f32x4 n0 = *(const f32x4*)(MLN + uu * 256 + d0), n1 = *(const f32x4*)(MLN + uu * 256 + d0 + 4);
          const float sel = own ? 1.f : 0.f; const float dl[8] = {n0.x * sel, n0.y * sel, n0.z * sel, n0.w * sel, n1.x * sel, n1.y * sel, n1.z * sel, n1.w * sel};
          *(bf16x8v*)(MLCT + uu * MLCT_UNIT + ((size_t)(16 * 8 + ks) * 64 + l) * 8) = pack8(st);
          const float al_ = alpha[c], be_ = beta[c];
#pragma unroll
          for (int i = 0; i < 8; ++i) st[i] = st[i] * al_ + dl[i] * be_; } }
    __syncthreads();
}
template <bool DEN> __device__ __forceinline__ void ml_tile(const bf16* CT, const bf16* Qs, const bf16* Sp, const bf16* Vs, const float* inter, int j, f32x4 (&acc)[4], int lane) {
    constexpr int QP = 264, SP = 72; const int lc = lane & 15, g = lane >> 4;
    bf16x8v bfr[8];
#pragma unroll
    for (int ks = 0; ks < 8; ++ks) bfr[ks] = *(const bf16x8v*)(CT + ((size_t)(j * 8 + ks) * 64 + lane) * 8);
#pragma unroll
    for (int m = 0; m < 4; ++m) acc[m] = (f32x4){0.f, 0.f, 0.f, 0.f};
#pragma unroll
    for (int ks = 0; ks < 8; ++ks) {
#pragma unroll
        for (int m = 0; m < 4; ++m) acc[m] = MFMA16(*(const bf16x8v*)(Qs + (16 * m + lc) * QP + 32 * ks + 8 * g), bfr[ks], acc[m]);
        asm volatile("" ::: "memory"); }
#pragma unroll
    for (int m = 0; m < 4; ++m)
#pragma unroll
        for (int r = 0; r < 4; ++r) acc[m][r] *= inter[16 * m + 4 * g + r];
#pragma unroll
    for (int ks = 0; ks < 2; ++ks) { bf16x8v vf;
        if (!DEN) {
#pragma unroll
            for (int i = 0; i < 8; ++i) vf[i] = (short)Vs[(32 * ks + 8 * g + i) * QP + 16 * j + lc]; }
        else {
#pragma unroll
            for (int i = 0; i < 8; ++i) vf[i] = (lc == 0) ? (short)0x3F80 : (short)0; }
#pragma unroll
        for (int m = 0; m < 4; ++m) acc[m] = MFMA16(*(const bf16x8v*)(Sp + (16 * m + lc) * SP + 32 * ks + 8 * g), vf, acc[m]);
        asm volatile("" ::: "memory"); }
}
__device__ __forceinline__ void mlstm_C(const bf16* PROJ, const float* GIF, const bf16* MLCT, const float* MLSC, const float* ml_norm, bf16* BRp, int u, unsigned char* lds, int tid) {
    const int c = u % NCH, bh = u / NCH, h = bh & 3, b = bh >> 2, lane = tid & 63, wave = tid >> 6, lc = lane & 15, g = lane >> 4;
    constexpr int QP = 264, SP = 72;
    bf16* Qs = (bf16*)lds; bf16* Ks = (bf16*)(lds + 33792); bf16* Vs = (bf16*)(lds + 67584); bf16* Sp = (bf16*)(lds + 101376);
    float* bcs = (float*)(lds + RING_BYTES); float* lis = bcs + 64; float* mout = lis + 64; float* inter = mout + 64; float* den = inter + 64; float* rstd = den + 64; float* part = rstd + 64;
    if (tid < 64) {
        const int p = 64 * c + lane - 48; float lf = 0.f, li = NEGF;
        if (p >= 0) { const int row = seq_row(b, p); li = GIF[(size_t)row * 8 + h]; lf = log_sigmoidf_(GIF[(size_t)row * 8 + 4 + h]); }
        const float bc = wave_incl_sum(lf, lane); const float pm = wave_incl_max(li - bc, lane); const float mc = MLSC[1040 + u];
        const float mo = fmaxf(bc + mc, bc + pm);
        bcs[lane] = bc; lis[lane] = li; mout[lane] = mo; inter[lane] = expf(bc + mc - mo) * 0.0625f;
    }
#pragma unroll
    for (int j = 0; j < 4; ++j) { const int id = tid + 512 * j, r = id >> 5, cp = id & 31, p = 64 * c + r - 48;
        v4u qr = (v4u){0u, 0u, 0u, 0u}, kr = qr, vr = qr;
        if (p >= 0) { const size_t ro = (size_t)seq_row(b, p) * NPROJ + h * 256 + cp * 8; qr = *(const v4u*)(PROJ + ro + PC_MLQ); kr = *(const v4u*)(PROJ + ro + PC_MLK); vr = *(const v4u*)(PROJ + ro + PC_MLV); }
        *(v4u*)(Qs + r * QP + cp * 8) = qr; *(v4u*)(Ks + r * QP + cp * 8) = kr; *(v4u*)(Vs + r * QP + cp * 8) = vr; }
    __syncthreads();
    {
        const int tr = wave >> 1;
#pragma unroll
        for (int q = 0; q < 2; ++q) { const int tc = 2 * (wave & 1) + q; f32x4 a = (f32x4){0.f, 0.f, 0.f, 0.f};
#pragma unroll
            for (int ks = 0; ks < 8; ++ks) a = MFMA16(*(const bf16x8v*)(Qs + (16 * tr + lc) * QP + 32 * ks + 8 * g), *(const bf16x8v*)(Ks + (16 * tc + lc) * QP + 32 * ks + 8 * g), a);
            const int s = 16 * tc + lc; const float bs = bcs[s], ls = lis[s];
#pragma unroll
            for (int r = 0; r < 4; ++r) { const int t = 16 * tr + 4 * g + r; float val = 0.f; if (s <= t) val = a[r] * 0.0625f * __expf(bcs[t] - bs + ls - mout[t]);
                Sp[t * SP + s] = (bf16)f2bf(val); } } }
    __syncthreads();
    const bf16* CT = MLCT + (size_t)u * MLCT_UNIT;
    if (wave == 0) { f32x4 ad[4]; ml_tile<true>(CT, Qs, Sp, Vs, inter, 16, ad, lane);
        if (lc == 0) {
#pragma unroll
            for (int m = 0; m < 4; ++m)
#pragma unroll
                for (int r = 0; r < 4; ++r) den[16 * m + 4 * g + r] = ad[m][r]; } }
    f32x4 a0[4], a1[4];
    ml_tile<false>(CT, Qs, Sp, Vs, inter, wave, a0, lane); ml_tile<false>(CT, Qs, Sp, Vs, inter, wave + 8, a1, lane);
    __syncthreads();
#pragma unroll
    for (int m = 0; m < 4; ++m)
#pragma unroll
        for (int r = 0; r < 4; ++r) { const int t = 16 * m + 4 * g + r; const float dinv = __builtin_amdgcn_rcpf(fmaxf(fabsf(den[t]), __expf(-mout[t])));
            a0[m][r] *= dinv; a1[m][r] *= dinv; float sq = a0[m][r] * a0[m][r] + a1[m][r] * a1[m][r];
            sq += __shfl_xor(sq, 1); sq += __shfl_xor(sq, 2); sq += __shfl_xor(sq, 4); sq += __shfl_xor(sq, 8);
            if (lc == 0) part[wave * 64 + t] = sq; }
    __syncthreads();
    if (tid < 64) { float sq = 0.f;
#pragma unroll
        for (int w = 0; w < 8; ++w) sq += part[w * 64 + tid];
        rstd[tid] = __builtin_amdgcn_rsqf(sq * (1.0f / 256.0f) + EPS); }
    __syncthreads();
    { const int e0 = 16 * wave + lc, e1 = e0 + 128; const float g0 = ml_norm[h * 256 + e0], g1 = ml_norm[h * 256 + e1];
#pragma unroll
      for (int m = 0; m < 4; ++m)
#pragma unroll
          for (int r = 0; r < 4; ++r) { const int t = 16 * m + 4 * g + r, p = 64 * c + t - 48;
              if (p >= 0 && (c > 0 || b == 0)) { const int row = seq_row(b, p); const bf16* op = PROJ + (size_t)row * NPROJ + PC_MLO + h * 256; bf16* bp = BRp + (size_t)row * D + h * 256;
                  bp[e0] = (bf16)f2bf(a0[m][r] * rstd[t] * g0 * sigmoidf_(bf1(op[e0]))); bp[e1] = (bf16)f2bf(a1[m][r] * rstd[t] * g1 * sigmoidf_(bf1(op[e1]))); } } }
    __syncthreads();
}

__device__ __forceinline__ void hg_cumsum(const bf16* PROJ, const float* LB, int b, int h, int c, float* bcs, float* kks, int d) {
    const float lb = LB[h * 128 + d]; float bacc = 0.f;
    for (int t = 0; t < 64; ++t) { const int p = 64 * c + t - 48; float lf = 0.f, kk = 0.f;
        if (p >= 0) { const float fp = bf1(PROJ[(size_t)seq_row(b, p) * NPROJ + PC_HGF + h * 128 + d]); const float sig = sigmoidf_(fp), nsig = sigmoidf_(-fp);
            lf = logf(lb + (1.0f - lb) * sig); kk = (1.0f - lb) * nsig; }
        bacc += lf; bcs[t * 128 + d] = bacc; kks[t * 128 + d] = kk; }
}
__device__ __forceinline__ void hg_A(const bf16* PROJ, const float* LB, float* HGS, float* HGE, int u, unsigned char* lds, int tid) {
    const int c = u % NCH, bh = u / NCH, h = bh & 7, b = bh >> 3;
    float* bcs = (float*)lds; float* kkw = bcs + 64 * 128; float* iv = kkw + 64 * 128;
    for (int id = tid; id < 2048; id += 512) { const int which = id >> 10, r = (id >> 4) & 63, cp = id & 15, p = 64 * c + r - 48; float x[8];
        if (which == 0) {
            float lf[8], kk[8];
            if (p >= 0) { unpack8(*(const v4u*)(PROJ + (size_t)seq_row(b, p) * NPROJ + PC_HGF + h * 128 + cp * 8), x);
#pragma unroll
                for (int q = 0; q < 8; ++q) { const float lb = LB[h * 128 + cp * 8 + q]; const float e = __expf(-fminf(fmaxf(x[q], -60.f), 60.f)); const float sig = __builtin_amdgcn_rcpf(1.0f + e), nsig = e * sig; lf[q] = __logf(lb + (1.0f - lb) * sig); kk[q] = (1.0f - lb) * nsig; } }
            else {
#pragma unroll
                for (int q = 0; q < 8; ++q) { lf[q] = 0.f; kk[q] = 0.f; } }
            *(f32x4*)(bcs + r * 128 + cp * 8) = (f32x4){lf[0], lf[1], lf[2], lf[3]}; *(f32x4*)(bcs + r * 128 + cp * 8 + 4) = (f32x4){lf[4], lf[5], lf[6], lf[7]};
            *(f32x4*)(kkw + r * 128 + cp * 8) = (f32x4){kk[0], kk[1], kk[2], kk[3]}; *(f32x4*)(kkw + r * 128 + cp * 8 + 4) = (f32x4){kk[4], kk[5], kk[6], kk[7]};
            continue; }
        {
            if (p >= 0) unpack8(*(const v4u*)(PROJ + (size_t)seq_row(b, p) * NPROJ + PC_HGI + h * 128 + cp * 8), x);
            else {
#pragma unroll
                for (int q = 0; q < 8; ++q) x[q] = 0.f; }
            *(f32x4*)(iv + r * 128 + cp * 8) = (f32x4){x[0], x[1], x[2], x[3]}; *(f32x4*)(iv + r * 128 + cp * 8 + 4) = (f32x4){x[4], x[5], x[6], x[7]}; } }
    __syncthreads();
    if (tid < 128) { float bacc = 0.f;
#pragma unroll 8
        for (int t = 0; t < 64; ++t) { bacc += bcs[t * 128 + tid]; bcs[t * 128 + tid] = bacc; } }
    __syncthreads();
    constexpr int DP = 136; bf16* kb = (bf16*)kkw; bf16* ib = (bf16*)iv;
    float kvv[16], ivv[16];
#pragma unroll
    for (int k = 0; k < 16; ++k) { const int idx = tid + 512 * k, d = idx & 127; kvv[k] = kkw[idx] * __expf(bcs[63 * 128 + d] - bcs[idx]); ivv[k] = iv[idx]; }
    if (tid < 128) HGE[(size_t)u * 128 + tid] = __expf(bcs[63 * 128 + tid]);
    __syncthreads();
#pragma unroll
    for (int k = 0; k < 16; ++k) { const int idx = tid + 512 * k, d = idx & 127, sr = idx >> 7; kb[sr * DP + d] = (bf16)f2bf(kvv[k]); ib[sr * DP + d] = (bf16)f2bf(ivv[k]); }
    __syncthreads();
    { const int lane = tid & 63, wave = tid >> 6, lc = lane & 15, g = lane >> 4;
      bf16x8v af[2];
#pragma unroll
      for (int ks = 0; ks < 2; ++ks)
#pragma unroll
          for (int i = 0; i < 8; ++i) af[ks][i] = (short)kb[(32 * ks + 8 * g + i) * DP + 16 * wave + lc];
      bf16* out = (bf16*)HGS + (size_t)u * 16384;
#pragma unroll 2
      for (int et = 0; et < 8; ++et) { bf16x8v bv[2];
#pragma unroll
          for (int ks = 0; ks < 2; ++ks)
#pragma unroll
              for (int i = 0; i < 8; ++i) bv[ks][i] = (short)ib[(32 * ks + 8 * g + i) * DP + 16 * et + lc];
          f32x4 acc = (f32x4){0.f, 0.f, 0.f, 0.f};
#pragma unroll
          for (int ks = 0; ks < 2; ++ks) acc = MFMA16(af[ks], bv[ks], acc);
          v2u w; w.x = pk2(acc[0], acc[1]); w.y = pk2(acc[2], acc[3]);
          *(v2u*)(out + ((size_t)(et * 4 + (wave >> 1)) * 64 + lc + 16 * ((2 * wave + (g >> 1)) & 3)) * 8 + 4 * (g & 1)) = w; } }
    __syncthreads();
}
__device__ __forceinline__ void hg_B(float* HGS, const float* HGE, int unit, int tid) {
    const int chain = unit >> 4, slice = unit & 15, x = 2 * (slice * 512 + tid), d = 32 * ((x >> 9) & 3) + 8 * ((x >> 7) & 3) + (x & 7); float s0 = 0.f, s1 = 0.f;
#pragma unroll 5
    for (int c = 0; c < NCH; ++c) { const size_t uu = (size_t)chain * NCH + c; unsigned* p = (unsigned*)((bf16*)HGS + uu * 16384 + x); const unsigned dl = *p; const float e0 = HGE[uu * 128 + d], e1 = HGE[uu * 128 + d + 1];
        *p = pk2(s0, s1); s0 = s0 * e0 + bflo(dl); s1 = s1 * e1 + bfhi(dl); }
}
__device__ __forceinline__ void hg_C(const bf16* PROJ, const float* LB, const float* HGS, const float* hg_norm, bf16* BRp, int u, unsigned char* lds, int tid) {
    const int c = u % NCH, bh = u / NCH, h = bh & 7, b = bh >> 3, lane = tid & 63, wave = tid >> 6, lc = lane & 15, g = lane >> 4;
    constexpr int DP = 136, SP = 72;
    float* bcs = (float*)lds;
    bf16* qs = (bf16*)(lds + 32768);
    bf16* kks = (bf16*)(lds + 50176);
    bf16* It = (bf16*)(lds + 67584);
    bf16* QD = (bf16*)(lds + 86016);
    bf16* KD = (bf16*)(lds + 103424);
    bf16* ATT = (bf16*)(lds + 129536);
    for (int id = tid; id < 3072; id += 512) { const int which = id >> 10, r = (id >> 4) & 63, cp = id & 15, p = 64 * c + r - 48; float x[8];
        if (p >= 0) unpack8(*(const v4u*)(PROJ + (size_t)seq_row(b, p) * NPROJ + (which == 0 ? PC_HGF : (which == 1 ? PC_HGQ : PC_HGI)) + h * 128 + cp * 8), x);
        else {
#pragma unroll
            for (int q = 0; q < 8; ++q) x[q] = 0.f; }
        if (which == 0) { float lf[8], kk[8];
#pragma unroll
            for (int q = 0; q < 8; ++q) { const float lb = LB[h * 128 + cp * 8 + q]; const float e = __expf(-fminf(fmaxf(x[q], -60.f), 60.f)); const float sig = __builtin_amdgcn_rcpf(1.0f + e), nsig = e * sig;
                lf[q] = (p >= 0) ? __logf(lb + (1.0f - lb) * sig) : 0.f; kk[q] = (p >= 0) ? (1.0f - lb) * nsig : 0.f; }
            *(f32x4*)(bcs + r * 128 + cp * 8) = (f32x4){lf[0], lf[1], lf[2], lf[3]}; *(f32x4*)(bcs + r * 128 + cp * 8 + 4) = (f32x4){lf[4], lf[5], lf[6], lf[7]};
            *(bf16x8v*)(kks + r * DP + cp * 8) = pack8(kk); }
        else if (which == 1) {
#pragma unroll
            for (int q = 0; q < 8; ++q) x[q] = x[q] * fast_sigmoid_(x[q]);
            *(bf16x8v*)(qs + r * DP + cp * 8) = pack8(x); }
        else {
#pragma unroll
            for (int q = 0; q < 8; ++q) It[(cp * 8 + q) * SP + r] = (bf16)f2bf(x[q]); } }
    __syncthreads();
    for (int i = tid; i < 64 * SP / 8; i += NTHR) *(v4u*)(ATT + i * 8) = (v4u){0u, 0u, 0u, 0u};
    if (tid < 128) { float bacc = 0.f;
#pragma unroll 8
        for (int t = 0; t < 64; ++t) { bacc += bcs[t * 128 + tid]; bcs[t * 128 + tid] = bacc; } }
    __syncthreads();
#pragma unroll 2
    for (int k = 0; k < 12; ++k) { const int idx = tid + 512 * k, t = 16 + (idx >> 7), d = idx & 127, I = t >> 4;
        QD[t * DP + d] = (bf16)f2bf(bf1(qs[t * DP + d]) * __expf(bcs[t * 128 + d] - bcs[(16 * I - 1) * 128 + d])); }
#pragma unroll 2
    for (int k = 0; k < 24; ++k) { const int idx = tid + 512 * k, row = idx >> 7, d = idx & 127; const int I = row < 16 ? 1 : (row < 48 ? 2 : 3), s = row - (I == 1 ? 0 : (I == 2 ? 16 : 48));
        KD[row * DP + d] = (bf16)f2bf(bf1(kks[s * DP + d]) * __expf(bcs[(16 * I - 1) * 128 + d] - bcs[s * 128 + d])); }
    float q2v[16], k2v[16], qev[16];
#pragma unroll
    for (int k = 0; k < 16; ++k) { const int idx = tid + 512 * k, t = idx >> 7, d = idx & 127, mid = 16 * (t >> 4) + 7; const float bt = bcs[idx], bm = bcs[mid * 128 + d], qv = bf1(qs[t * DP + d]);
        q2v[k] = qv * __expf(fminf(bt - bm, 80.f)); k2v[k] = bf1(kks[t * DP + d]) * __expf(fminf(bm - bt, 80.f)); qev[k] = qv * __expf(bt); }
    __syncthreads();
    bf16* QE = (bf16*)lds;
#pragma unroll
    for (int k = 0; k < 16; ++k) { const int idx = tid + 512 * k, t = idx >> 7, d = idx & 127; qs[t * DP + d] = (bf16)f2bf(q2v[k]); kks[t * DP + d] = (bf16)f2bf(k2v[k]); QE[t * DP + d] = (bf16)f2bf(qev[k]); }
    bf16x8v sfr[4];
    { const bf16* Sst = (const bf16*)HGS + (size_t)u * 16384;
#pragma unroll
      for (int ks = 0; ks < 4; ++ks) sfr[ks] = *(const bf16x8v*)(Sst + ((size_t)(wave * 4 + ks) * 64 + lane) * 8); }
    __syncthreads();
#pragma unroll
    for (int rep = 0; rep < 2; ++rep) { const int tl = wave + 8 * rep;
        if (tl < 6) { const int I = tl < 1 ? 1 : (tl < 3 ? 2 : 3), J = tl < 1 ? 0 : (tl < 3 ? tl - 1 : tl - 3), kb = I == 1 ? 0 : (I == 2 ? 16 : 48);
            f32x4 acc = (f32x4){0.f, 0.f, 0.f, 0.f};
#pragma unroll
            for (int ks = 0; ks < 4; ++ks) acc = MFMA16(*(const bf16x8v*)(QD + (16 * I + lc) * DP + 32 * ks + 8 * g), *(const bf16x8v*)(KD + (kb + 16 * J + lc) * DP + 32 * ks + 8 * g), acc);
#pragma unroll
            for (int r = 0; r < 4; ++r) ATT[(16 * I + 4 * g + r) * SP + 16 * J + lc] = (bf16)f2bf(acc[r]); }
        else if (tl < 10) { const int I = tl - 6; f32x4 acc = (f32x4){0.f, 0.f, 0.f, 0.f};
#pragma unroll
            for (int ks = 0; ks < 4; ++ks) acc = MFMA16(*(const bf16x8v*)(qs + (16 * I + lc) * DP + 32 * ks + 8 * g), *(const bf16x8v*)(kks + (16 * I + lc) * DP + 32 * ks + 8 * g), acc);
#pragma unroll
            for (int r = 0; r < 4; ++r) ATT[(16 * I + 4 * g + r) * SP + 16 * I + lc] = (lc <= 4 * g + r) ? (bf16)f2bf(acc[r]) : (bf16)0; } }
    __syncthreads();
    f32x4 acc[4];
#pragma unroll
    for (int m = 0; m < 4; ++m) { acc[m] = (f32x4){0.f, 0.f, 0.f, 0.f};
#pragma unroll
        for (int ks = 0; ks < 2; ++ks) acc[m] = MFMA16(*(const bf16x8v*)(ATT + (16 * m + lc) * SP + 32 * ks + 8 * g), *(const bf16x8v*)(It + (16 * wave + lc) * SP + 32 * ks + 8 * g), acc[m]);
#pragma unroll
        for (int ks = 0; ks < 4; ++ks) acc[m] = MFMA16(*(const bf16x8v*)(QE + (16 * m + lc) * DP + 32 * ks + 8 * g), sfr[ks], acc[m]); }
    float* part = bcs + 5120; float* rstd = bcs + 5120 + 512;
#pragma unroll
    for (int m = 0; m < 4; ++m)
#pragma unroll
        for (int r = 0; r < 4; ++r) { float sq = acc[m][r] * acc[m][r]; sq += __shfl_xor(sq, 1); sq += __shfl_xor(sq, 2); sq += __shfl_xor(sq, 4); sq += __shfl_xor(sq, 8);
            if (lc == 0) part[(16 * m + 4 * g + r) * 8 + wave] = sq; }
    __syncthreads();
    if (tid < 64) { float sq = 0.f;
#pragma unroll
        for (int w = 0; w < 8; ++w) sq += part[tid * 8 + w];
        rstd[tid] = __builtin_amdgcn_rsqf(sq * (1.0f / 128.0f) + EPS); }
    __syncthreads();
    { const int e = 16 * wave + lc; const float gn = hg_norm[h * 128 + e];
#pragma unroll
      for (int m = 0; m < 4; ++m)
#pragma unroll
          for (int r = 0; r < 4; ++r) { const int t = 16 * m + 4 * g + r, p = 64 * c + t - 48;
              if (p >= 0 && (c > 0 || b == 0)) { const int row = seq_row(b, p); const float og = sigmoidf_(bf1(PROJ[(size_t)row * NPROJ + PC_HGG + h * 128 + e]));
                  BRp[(size_t)row * D + 2048 + h * 128 + e] = (bf16)f2bf(acc[m][r] * rstd[t] * gn * og); } } }
    __syncthreads();
}

__device__ __forceinline__ void rg_frags(const float* wa, const float* wx, int n, int jt, int lc, int g, bf16x8v (&fa)[2], bf16x8v (&fx)[2]) {
#pragma unroll
    for (int ks = 0; ks < 2; ++ks) { float xa[8], xx[8];
#pragma unroll
        for (int q = 0; q < 8; ++q) { const int wi = (n * 64 + 32 * ks + 8 * g + q) * 64 + 16 * jt + lc; xa[q] = wa[wi]; xx[q] = wx[wi]; }
        fa[ks] = pack8(xa); fx[ks] = pack8(xx); }
}
__device__ __forceinline__ void rg_A(const bf16* PROJ, const float* conv_w, const float* conv_b, const float* wa, const float* ba, const float* wx, const float* bx, const float* lam, float* RGH, float* RGP, float* RGT, int u, unsigned char* lds, int tid) {
    const int half = u & 1, c = (u < 256) ? 1 + ((u >> 1) & 63) : 0, b = (u < 256) ? (u >> 7) : 0, ch = half * 512 + tid, p0 = 64 * c - 48;
    const int lane = tid & 63, wave = tid >> 6, lc = lane & 15, g = lane >> 4, n = half * 8 + wave;
    constexpr int XP = 520;
    bf16* xs = (bf16*)lds;
    bf16* xcb = (bf16*)(lds + 68608);
    bf16* las = (bf16*)(lds + 68608);
    bf16* us = (bf16*)lds;
    bf16x8v fa[2], fx[2]; rg_frags(wa, wx, n, 0, lc, g, fa, fx);
    for (int id = tid; id < 67 * 64; id += NTHR) { const int r = id >> 6, cp = id & 63, p = p0 - 3 + r; v4u w = (v4u){0u, 0u, 0u, 0u};
        if (p >= 0) w = *(const v4u*)(PROJ + (size_t)seq_row(b, p) * NPROJ + PC_RGX + half * 512 + cp * 8);
        *(v4u*)(xs + r * 512 + cp * 8) = w; }
    __syncthreads();
    { const float w0 = conv_w[ch], w1 = conv_w[1024 + ch], w2 = conv_w[2048 + ch], w3 = conv_w[3072 + ch], cb = conv_b[ch];
      float xm3 = bf1(xs[tid]), xm2 = bf1(xs[512 + tid]), xm1 = bf1(xs[1024 + tid]);
#pragma unroll 8
      for (int t = 0; t < 64; ++t) { const float x0 = bf1(xs[(t + 3) * 512 + tid]); xcb[t * XP + tid] = (bf16)f2bf(cb + (w0 * xm3 + w1 * xm2) + (w2 * xm1 + w3 * x0)); xm3 = xm2; xm2 = xm1; xm1 = x0; } }
    __syncthreads();
    unsigned ru[4][4][2];
    { bf16x8v af[4][2];
#pragma unroll
      for (int m = 0; m < 4; ++m)
#pragma unroll
          for (int ks = 0; ks < 2; ++ks) af[m][ks] = *(const bf16x8v*)(xcb + (16 * m + lc) * XP + 64 * wave + 32 * ks + 8 * g);
      __syncthreads();
#pragma unroll
      for (int jt = 0; jt < 4; ++jt) { bf16x8v na[2], nx[2];
          asm volatile("" ::: "memory");
          if (jt < 3) rg_frags(wa, wx, n, jt + 1, lc, g, na, nx);
          const int cg = 64 * n + 16 * jt + lc, cl = cg - half * 512;
          const float bav = ba[cg], bxv = bx[cg], spv = softplusf_(-lam[cg]), w0 = conv_w[cg], w1 = conv_w[1024 + cg], w2 = conv_w[2048 + cg], w3 = conv_w[3072 + cg], cb = conv_b[cg];
#pragma unroll
          for (int m = 0; m < 4; ++m) { f32x4 aa = (f32x4){0.f, 0.f, 0.f, 0.f}, ax = aa;
#pragma unroll
              for (int ks = 0; ks < 2; ++ks) { aa = MFMA16(af[m][ks], fa[ks], aa); ax = MFMA16(af[m][ks], fx[ks], ax); }
              float uv[4];
#pragma unroll
              for (int r = 0; r < 4; ++r) { const int t = 16 * m + 4 * g + r;
                  const float xc = cb + (w0 * bf1(xs[t * 512 + cl]) + w1 * bf1(xs[(t + 1) * 512 + cl])) + (w2 * bf1(xs[(t + 2) * 512 + cl]) + w3 * bf1(xs[(t + 3) * 512 + cl]));
                  const float rr = fast_sigmoid_(aa[r] + bav), gi = fast_sigmoid_(ax[r] + bxv); const unsigned lb16 = f2bf(-8.0f * rr * spv); const float a = __expf(__uint_as_float(lb16 << 16));
                  las[t * 512 + cl] = (bf16)lb16; uv[r] = __builtin_amdgcn_sqrtf(fmaxf(1.0f - a * a, 0.f)) * gi * xc; }
              ru[jt][m][0] = pk2(uv[0], uv[1]); ru[jt][m][1] = pk2(uv[2], uv[3]); }
          if (jt < 3) { fa[0] = na[0]; fa[1] = na[1]; fx[0] = nx[0]; fx[1] = nx[1]; } } }
    __syncthreads();
#pragma unroll
    for (int jt = 0; jt < 4; ++jt) { const int cl = 64 * wave + 16 * jt + lc;
#pragma unroll
        for (int m = 0; m < 4; ++m)
#pragma unroll
            for (int h2 = 0; h2 < 2; ++h2) { const int t = 16 * m + 4 * g + 2 * h2;
                us[t * 512 + cl] = (bf16)(ru[jt][m][h2] & 0xffffu); us[(t + 1) * 512 + cl] = (bf16)(ru[jt][m][h2] >> 16); } }
    __syncthreads();
    float hh = 0.f, P = 1.f;
    { const int tb = (c == 0 ? 48 : 0); float* ph = RGH + (size_t)seq_row(b, p0 + tb) * 1024 + ch; float* pp = RGP + (size_t)seq_row(b, p0 + tb) * 1024 + ch;
#pragma unroll 4
      for (int t = tb; t < 64; ++t) { const float a = __expf(bf1(las[t * 512 + tid])), uu = bf1(us[t * 512 + tid]);
          hh = a * hh + uu; P *= a; *ph = hh; *pp = P; ph += 1024; pp += 1024; } }
    RGT[(size_t)(0 * 2 + b) * NCH * 1024 + c * 1024 + ch] = P; RGT[(size_t)(1 * 2 + b) * NCH * 1024 + c * 1024 + ch] = hh;
    if (c == 0) { RGT[(size_t)(0 * 2 + 1) * NCH * 1024 + ch] = P; RGT[(size_t)(1 * 2 + 1) * NCH * 1024 + ch] = hh; }
    __syncthreads();
}
__device__ __forceinline__ void rg_B(float* RGT, int chain, int lane) {
    const int b = chain >> 10, ch = chain & 1023;
    float a = RGT[(size_t)(0 * 2 + b) * NCH * 1024 + lane * 1024 + ch], hv = RGT[(size_t)(1 * 2 + b) * NCH * 1024 + lane * 1024 + ch];
#pragma unroll
    for (int o = 1; o < 64; o <<= 1) { const float ap = __shfl_up(a, o), hp = __shfl_up(hv, o); if (lane >= o) { hv = a * hp + hv; a = a * ap; } }
    float* Cc = RGT + (size_t)(2 * 2 + b) * NCH * 1024 + ch;
    const float prev = __shfl_up(hv, 1);
    Cc[lane * 1024] = (lane == 0) ? 0.f : prev;
    if (lane == 63) Cc[64 * 1024] = hv;
}
__device__ __forceinline__ float gelu_tanh(float y) { const float z2 = 1.5957691216057308f * (y + 0.044715f * y * y * y); return y * __builtin_amdgcn_rcpf(1.0f + __expf(-z2)); }
__device__ __forceinline__ void rg_C(const bf16* PROJ, const float* RGH, const float* RGP, const float* RGT, bf16* BR, int gw, int NGW, int lane) {
    for (int row = gw; row < TREAL + NMETA; row += NGW) {
        const int b = row < TREAL ? (row >> 12) : 0, p = row < TREAL ? (row & 4095) + NMETA : row - TREAL, c = (p + 48) >> 6;
        const float* Cc = RGT + (size_t)(2 * 2 + b) * NCH * 1024 + c * 1024;
#pragma unroll
        for (int j = 0; j < 2; ++j) { const int ch = j * 512 + lane * 8; float y[8]; unpack8(*(const v4u*)(PROJ + (size_t)row * NPROJ + PC_RGY + ch), y); float o[8];
#pragma unroll
            for (int q = 0; q < 2; ++q) { const f32x4 hl = *(const f32x4*)(RGH + (size_t)row * 1024 + ch + 4 * q), pp = *(const f32x4*)(RGP + (size_t)row * 1024 + ch + 4 * q), cc = *(const f32x4*)(Cc + ch + 4 * q);
                const f32x4 hv = hl + pp * cc; o[4 * q] = hv.x * gelu_tanh(y[4 * q]); o[4 * q + 1] = hv.y * gelu_tanh(y[4 * q + 1]); o[4 * q + 2] = hv.z * gelu_tanh(y[4 * q + 2]); o[4 * q + 3] = hv.w * gelu_tanh(y[4 * q + 3]); }
            v4u w; w.x = pk2(o[0], o[1]); w.y = pk2(o[2], o[3]); w.z = pk2(o[4], o[5]); w.w = pk2(o[6], o[7]);
            *(v4u*)(BR + (size_t)row * D + 3072 + ch) = w; }
    }
}

__device__ __forceinline__ void sb_unit(const bf16* PROJ, const float* gq, const float* gk, bf16* BRp, int b, int h, int i, unsigned char* lds, int tid) {
    constexpr int KP = 136, VP = 72;
    bf16* Kt = (bf16*)lds; bf16* Vt = (bf16*)(lds + 17408);
    const int lane = tid & 63, wave = tid >> 6, c = lane & 15, g = lane >> 4;
    bf16* Ps = (bf16*)(lds + 35840) + wave * (16 * VP);
    bf16x8v aq[4];
    { const int pq = 128 * i - 112 + 16 * wave + c; float qv[4][8]; float ss = 0.f;
      if (pq >= 0) { const bf16* qp = PROJ + (size_t)seq_row(b, pq) * NPROJ + PC_SBQ + h * 128 + 8 * g;
#pragma unroll
          for (int ks = 0; ks < 4; ++ks) { unpack8(*(const v4u*)(qp + 32 * ks), qv[ks]);
#pragma unroll
              for (int k = 0; k < 8; ++k) ss += qv[ks][k] * qv[ks][k]; } }
      else {
#pragma unroll
          for (int ks = 0; ks < 4; ++ks)
#pragma unroll
              for (int k = 0; k < 8; ++k) qv[ks][k] = 0.f; }
      ss += __shfl_xor(ss, 16); ss += __shfl_xor(ss, 32);
      const float sc = 0.08838834764831845f * __builtin_amdgcn_rsqf(ss * (1.0f / 128.0f) + EPS);
#pragma unroll
      for (int ks = 0; ks < 4; ++ks) { const f32x4 g0 = *(const f32x4*)(gq + 32 * ks + 8 * g), g1 = *(const f32x4*)(gq + 32 * ks + 8 * g + 4);
          qv[ks][0] *= sc * g0.x; qv[ks][1] *= sc * g0.y; qv[ks][2] *= sc * g0.z; qv[ks][3] *= sc * g0.w; qv[ks][4] *= sc * g1.x; qv[ks][5] *= sc * g1.y; qv[ks][6] *= sc * g1.z; qv[ks][7] *= sc * g1.w;
          aq[ks] = pack8(qv[ks]); } }
    const int p0row = 128 * i - 112 + 16 * wave + 4 * g;
    float carry[4] = {0.f, 0.f, 0.f, 0.f};
    f32x4 acc_o[8];
#pragma unroll
    for (int n = 0; n < 8; ++n) acc_o[n] = (f32x4){0.f, 0.f, 0.f, 0.f};
    const int kt_hi = (i == 0) ? 0 : 2 * i;
    v4u pk0 = (v4u){0u, 0u, 0u, 0u}, pk1 = pk0, pv0 = pk0, pv1 = pk0;
#define SB_FETCH(kt_) do { const int pkf = 64 * (kt_) + (tid >> 3); pk0 = (v4u){0u, 0u, 0u, 0u}; pk1 = pk0; pv0 = pk0; pv1 = pk0; \
        if (pkf < 4096 + NMETA) { const bf16* rp = PROJ + (size_t)seq_row(b, pkf) * NPROJ + h * 128 + (tid & 7) * 16; \
            pk0 = *(const v4u*)(rp + PC_SBK); pk1 = *(const v4u*)(rp + PC_SBK + 8); pv0 = *(const v4u*)(rp + PC_SBV); pv1 = *(const v4u*)(rp + PC_SBV + 8); } } while (0)
    SB_FETCH(kt_hi);
    for (int kt = kt_hi; kt >= 0; --kt) {
        { const int kr = tid >> 3, sg = tid & 7; float ka[8], kb[8], va[8], vb[8]; float ss = 0.f;
          unpack8(pk0, ka); unpack8(pk1, kb); unpack8(pv0, va); unpack8(pv1, vb);
#pragma unroll
          for (int k = 0; k < 8; ++k) ss += ka[k] * ka[k] + kb[k] * kb[k];
          ss += __shfl_xor(ss, 1); ss += __shfl_xor(ss, 2); ss += __shfl_xor(ss, 4);
          const float rstd = __builtin_amdgcn_rsqf(ss * (1.0f / 128.0f) + EPS);
          const f32x4 g0 = *(const f32x4*)(gk + sg * 16), g1 = *(const f32x4*)(gk + sg * 16 + 4), g2 = *(const f32x4*)(gk + sg * 16 + 8), g3 = *(const f32x4*)(gk + sg * 16 + 12);
          ka[0] *= rstd * g0.x; ka[1] *= rstd * g0.y; ka[2] *= rstd * g0.z; ka[3] *= rstd * g0.w; ka[4] *= rstd * g1.x; ka[5] *= rstd * g1.y; ka[6] *= rstd * g1.z; ka[7] *= rstd * g1.w;
          kb[0] *= rstd * g2.x; kb[1] *= rstd * g2.y; kb[2] *= rstd * g2.z; kb[3] *= rstd * g2.w; kb[4] *= rstd * g3.x; kb[5] *= rstd * g3.y; kb[6] *= rstd * g3.z; kb[7] *= rstd * g3.w;
          *(bf16x8v*)(Kt + kr * KP + sg * 16) = pack8(ka); *(bf16x8v*)(Kt + kr * KP + sg * 16 + 8) = pack8(kb);
#pragma unroll
          for (int k = 0; k < 8; ++k) { Vt[(sg * 16 + k) * VP + kr] = (bf16)f2bf(va[k]); Vt[(sg * 16 + 8 + k) * VP + kr] = (bf16)f2bf(vb[k]); } }
        __syncthreads();
        if (kt > 0) SB_FETCH(kt - 1);
        f32x4 z[4];
#pragma unroll
        for (int j = 0; j < 4; ++j) { z[j] = (f32x4){0.f, 0.f, 0.f, 0.f};
#pragma unroll
            for (int ks = 0; ks < 4; ++ks) z[j] = MFMA16(aq[ks], *(const bf16x8v*)(Kt + (16 * j + 15 - c) * KP + 32 * ks + 8 * g), z[j]); }
        float lk[4][4], zl[4][4], inc[4][4];
#pragma unroll
        for (int j = 0; j < 4; ++j)
#pragma unroll
            for (int r = 0; r < 4; ++r) { const bool vis = (64 * kt + 16 * j + 15 - c) < (p0row + r); const float zz = z[j][r];
                const float sp = fmaxf(zz, 0.f) + __logf(1.0f + __expf(-fabsf(zz)));
                lk[j][r] = vis ? -sp : 0.f; zl[j][r] = vis ? (zz - sp) : -1e30f; inc[j][r] = lk[j][r]; }
#pragma unroll
        for (int j = 0; j < 4; ++j)
#pragma unroll
            for (int r = 0; r < 4; ++r) { float v = inc[j][r]; v += dpp_shr16<1>(v); v += dpp_shr16<2>(v); v += dpp_shr16<4>(v); v += dpp_shr16<8>(v); inc[j][r] = v; }
#pragma unroll
        for (int r = 0; r < 4; ++r) { float off = carry[r];
#pragma unroll
            for (int j = 3; j >= 0; --j) { const float tot = __shfl(inc[j][r], 15, 16); const float a = __expf(zl[j][r] + off + inc[j][r] - lk[j][r]);
                Ps[(4 * g + r) * VP + 16 * j + 15 - c] = (bf16)f2bf(a); off += tot; }
            carry[r] = off; }
#pragma unroll
        for (int ks = 0; ks < 2; ++ks) { const bf16x8v pf = *(const bf16x8v*)(Ps + c * VP + 32 * ks + 8 * g);
#pragma unroll
            for (int n = 0; n < 8; ++n) acc_o[n] = MFMA16(pf, *(const bf16x8v*)(Vt + (16 * n + c) * VP + 32 * ks + 8 * g), acc_o[n]); }
        { volatile unsigned* flg = (volatile unsigned*)(lds + RING_BYTES) + (kt & 1) * 8;
          bool dn = true;
#pragma unroll
          for (int r = 0; r < 4; ++r) dn = dn && ((p0row + r) < 0 || carry[r] < -104.0f);
          const int alldone = __all(dn ? 1 : 0);
          if (lane == 0) flg[wave] = alldone ? 1u : 0u;
          __syncthreads();
          unsigned d = 1u;
#pragma unroll
          for (int w = 0; w < NWAVES; ++w) d &= flg[w];
          if (d) break; }
    }
#pragma unroll
    for (int r = 0; r < 4; ++r) { const int p = p0row + r; if (p >= 0 && (i > 0 || b == 0)) { bf16* op = BRp + (size_t)seq_row(b, p) * D + 1024 + h * 128 + c;
#pragma unroll
            for (int n = 0; n < 8; ++n) op[16 * n] = (bf16)f2bf(acc_o[n][r]); } }
    __syncthreads();
}

#undef SB_FETCH
template <int MODE> __device__ __forceinline__ void skinny_phase(const bf16* A, int lda, const bf16* Bt, int ldb, int N, int K, float* hmeta, bf16* MGm, const bf16* Gm, unsigned char* lds, int tid, int bx, int G) {
    const int lane = tid & 63, wave = tid >> 6, lc = lane & 15, g = lane >> 4, kw = K / 8, nst = kw / 32;
    f32x4* red = (f32x4*)lds;
    for (int nu = bx; nu < N / 16; nu += G) {
        const bf16* ap = A + (size_t)lc * lda + wave * kw + 8 * g; const bf16* bp = Bt + (size_t)(16 * nu + lc) * ldb + wave * kw + 8 * g;
        f32x4 acc = (f32x4){0.f, 0.f, 0.f, 0.f}; int st = 0;
        for (; st + 8 <= nst; st += 8) { bf16x8v af[8], bv[8];
#pragma unroll
            for (int i = 0; i < 8; ++i) { af[i] = *(const bf16x8v*)(ap + 32 * (st + i)); bv[i] = *(const bf16x8v*)(bp + 32 * (st + i)); }
#pragma unroll
            for (int i = 0; i < 8; ++i) acc = MFMA16(af[i], bv[i], acc); }
        for (; st < nst; ++st) acc = MFMA16(*(const bf16x8v*)(ap + 32 * st), *(const bf16x8v*)(bp + 32 * st), acc);
        red[wave * 64 + lane] = acc;
        __syncthreads();
        if (wave == 0) { const int n = 16 * nu + lc;
            if (MODE == 0) { f32x4 v = red[lane];
#pragma unroll
                for (int w = 1; w < 8; ++w) v += red[w * 64 + lane];
#pragma unroll
                for (int r = 0; r < 4; ++r) hmeta[(size_t)(4 * g + r) * D + n] += v[r]; }
            else { f32x4 mg = (f32x4){0.f, 0.f, 0.f, 0.f};
#pragma unroll
                for (int k = 0; k < 4; ++k) { const f32x4 uk = red[(2 * k) * 64 + lane] + red[(2 * k + 1) * 64 + lane];
#pragma unroll
                    for (int r = 0; r < 4; ++r) mg[r] += uk[r] * __builtin_amdgcn_rcpf(bf1(Gm[(size_t)(4 * g + r) * NPROJ + k * 4096 + n])); }
#pragma unroll
                for (int r = 0; r < 4; ++r) MGm[(size_t)(4 * g + r) * D + n] = (bf16)f2bf(mg[r]); } }
        __syncthreads();
    }
}

__device__ __forceinline__ void skinny_swiglu(const bf16* A, const bf16* Bt, bf16* ACTm, unsigned char* lds, int tid, int bx, int G) {
    const int lane = tid & 63, wave = tid >> 6, lc = lane & 15, g = lane >> 4; constexpr int kw = D / 8, nst = kw / 32;
    f32x4* red = (f32x4*)lds;
    for (int nu = bx; nu < DFF / 16; nu += G) { const int j = 16 * nu + lc, brow = (j >> 7) * 256 + (j & 127);
        const bf16* ap = A + (size_t)lc * D + wave * kw + 8 * g; const bf16* bg = Bt + (size_t)brow * D + wave * kw + 8 * g; const bf16* bu = bg + (size_t)128 * D;
        f32x4 ag = (f32x4){0.f, 0.f, 0.f, 0.f}, au = ag;
#pragma unroll
        for (int h2 = 0; h2 < 2; ++h2) { bf16x8v af[8], gv[8], uv[8];
#pragma unroll
            for (int i = 0; i < 8; ++i) { af[i] = *(const bf16x8v*)(ap + 32 * (8 * h2 + i)); gv[i] = *(const bf16x8v*)(bg + 32 * (8 * h2 + i)); uv[i] = *(const bf16x8v*)(bu + 32 * (8 * h2 + i)); }
#pragma unroll
            for (int i = 0; i < 8; ++i) { ag = MFMA16(af[i], gv[i], ag); au = MFMA16(af[i], uv[i], au); } }
        static_assert(nst == 16, "two batches of 8 k-steps");
        red[wave * 64 + lane] = ag; red[512 + wave * 64 + lane] = au;
        __syncthreads();
        if (wave == 0) { f32x4 vg = red[lane], vu = red[512 + lane];
#pragma unroll
            for (int w = 1; w < 8; ++w) { vg += red[w * 64 + lane]; vu += red[512 + w * 64 + lane]; }
#pragma unroll
            for (int r = 0; r < 4; ++r) ACTm[(size_t)(4 * g + r) * DFF + j] = (bf16)f2bf(vg[r] * fast_sigmoid_(vg[r]) * vu[r]); }
        __syncthreads();
    }
}
#ifndef REP_P0
#define REP_P0 1
#endif
#ifndef REP_A
#define REP_A 1
#endif
#ifndef REP_C
#define REP_C 1
#endif
#ifndef REP_G1
#define REP_G1 1
#endif
#ifndef REP_G8
#define REP_G8 1
#endif
#ifndef PG8_ALIGN_RES
#define PG8_ALIGN_RES true
#endif
#ifndef PG8_ALIGNV
#define PG8_ALIGNV true
#endif
#ifndef PG8_SP2V
#define PG8_SP2V true
#endif
#ifndef MK_N_LAUNCHES
#define MK_N_LAUNCHES 1
#endif
constexpr int N_PHASES = 1 + 10 * NLAYER;
struct Args { const float* in[23]; float* out; unsigned char* ws; int ph_lo, ph_hi; };
static_assert(sizeof(Args) == 23 * 8 + 8 + 8 + 8, "Args has no padding bytes");

template <int LO, int HI> __global__ void __launch_bounds__(NTHR, 2) fwd_kernel(Args args) {
    extern __shared__ __attribute__((aligned(16))) unsigned char lds[];
    const int tid = threadIdx.x;
    const int G = gridDim.x, bx = blockIdx.x;
    const int vcu = (G % 8 == 0) ? (bx % 8) * (G / 8) + bx / 8 : bx;
    const int NGW = G * NWAVES, NGT = G * NTHR;
    unsigned char* ws = args.ws;
    unsigned* ctl = (unsigned*)(ws + WS_CTL);
    volatile LAS unsigned* MISC = (volatile LAS unsigned*)((LAS unsigned char*)lds + MISC_OFF);
    for (int u = tid; u < (LDS_BYTES - LDSCTL_OFF) / 4; u += NTHR) ((LAS unsigned*)((LAS unsigned char*)lds + LDSCTL_OFF))[u] = 0u;
    __syncthreads();
    constexpr bool use_bar = (HI - LO) > 1;
    XcdBarrier bar; bar.bar = ctl + CW_BAR; bar.x = 0; bar.st = nullptr;
    if constexpr (use_bar) bar = xcd_barrier_post(ctl + CW_BAR, MISC + 8);
#define IN(k) (LO <= (k) && (k) < HI)
#define PHASE_VARS int tid_ = tid; asm volatile("" : "+v"(tid_)); const int lane_ = tid_ & 63, wave_ = __builtin_amdgcn_readfirstlane(tid_ >> 6), gw_ = vcu * NWAVES + wave_, gtid_ = bx * NTHR + tid_; (void)lane_; (void)wave_; (void)gw_; (void)gtid_;
#if defined(PROBE_DOUBLE_BAR)
#define SEAM(k) do { if constexpr (IN(k) && IN((k) + 1)) { xcd_barrier(bar); xcd_barrier(bar); } } while (0)
#else
#define SEAM(k) do { if constexpr (IN(k) && IN((k) + 1)) xcd_barrier(bar); } while (0)
#endif

#define PROJ ((bf16*)(ws + WS_PROJ))
#define ACT ((bf16*)(ws + WS_ACT))
#define XN ((bf16*)(ws + WS_XN))
#define BR ((bf16*)(ws + WS_BR))
#define MG ((bf16*)(ws + WS_MG))
#define HMETA ((float*)(ws + WS_HMETA))
#define GIF ((float*)(ws + WS_GIF))
#define WIF ((const float*)(ws + WS_WIF))
#define LBp ((const float*)(ws + WS_LB))
#define MLS ((float*)(ws + WS_MLS))
#define MLN ((float*)(ws + WS_MLN))
#define MLSC ((float*)(ws + WS_MLSC))
#define MLCT ((bf16*)(ws + WS_MLCT))
#define HGS ((float*)(ws + WS_HGS))
#define HGE ((float*)(ws + WS_HGE))
#define RGH ((float*)(ws + WS_RGH))
#define RGP ((float*)(ws + WS_RGP))
#define RGT ((float*)(ws + WS_RGT))
#define HBp ((bf16*)(ws + WS_HB))
#define x (args.in[0])
#define out (args.out)

#if defined(PROBE_SPIN_US)
    if constexpr (IN(0)) { const unsigned long long t0 = __builtin_amdgcn_s_memrealtime(); while (__builtin_amdgcn_s_memrealtime() - t0 < (unsigned long long)PROBE_SPIN_US * 100ull) __builtin_amdgcn_s_sleep(8); }
#endif
    if constexpr (IN(0)) { PHASE_VARS p0_prologue(args.in, ws, lds, bx, G, wave_, lane_, gtid_, NGT); }
#if defined(PROBE_REP_P0)
    if constexpr (IN(0)) { PHASE_VARS p0_prologue(args.in, ws, lds, bx, G, wave_, lane_, gtid_, NGT); }
#endif
    SEAM(0);

    {
        constexpr int l = 0;
        constexpr int pb = 1 + 10 * l;
        constexpr bool lastl = (l == NLAYER - 1);
        constexpr int Mtail = lastl ? TREAL : MROWS;
        constexpr int Mg = TREAL;
        const void* hsrc = (l == 0) ? (const void*)x : (const void*)HBp;
        if constexpr (IN(pb + 0)) { PHASE_VARS norm_rows<true, (l != 0)>(hsrc, HMETA, args.in[2] + l * D, XN, MROWS, WIF + (size_t)l * 8 * D, args.in[5] + (size_t)l * NIN + 4096, GIF, gw_, NGW, lane_, lds, tid_); }
#if defined(PROBE_REP_NORM)
            if constexpr (IN(pb + 0)) { PHASE_VARS norm_rows<true, (l != 0)>(hsrc, HMETA, args.in[2] + l * D, XN, MROWS, WIF + (size_t)l * 8 * D, args.in[5] + (size_t)l * NIN + 4096, GIF, gw_, NGW, lane_, lds, tid_); }
#endif
        SEAM(pb + 0);
        if constexpr (IN(pb + 1)) { PHASE_VARS pg8::Gemm g{XN, (const bf16*)(ws + WS_WIN + (size_t)l * SZ_WIN), MROWS, NPROJ, D, D, D}; pg8::StaticOrder S; S.init(MROWS, NPROJ, G, bx);
            pg8::EpiProj E{PROJ, NPROJ, args.in[5] + (size_t)l * NIN, 4096, 8, PC_GATE};
            pg8::gemm_phase<pg8::EpiProj, pg8::StaticOrder, PG8_ALIGNV, PG8_SP2V>((PG8_LAS unsigned char*)lds, g, S, E, tid_); }
#if defined(PROBE_REP_G1)
        if constexpr (IN(pb + 1)) { PHASE_VARS pg8::Gemm g{XN, (const bf16*)(ws + WS_WIN + (size_t)l * SZ_WIN), MROWS, NPROJ, D, D, D}; pg8::StaticOrder S; S.init(MROWS, NPROJ, G, bx);
            pg8::EpiProj E{PROJ, NPROJ, args.in[5] + (size_t)l * NIN, 4096, 8, PC_GATE};
            pg8::gemm_phase<pg8::EpiProj, pg8::StaticOrder, PG8_ALIGNV, PG8_SP2V>((PG8_LAS unsigned char*)lds, g, S, E, tid_); }
#endif
        SEAM(pb + 1);
        if constexpr (IN(pb + 2)) { PHASE_VARS
            for (int w_ = bx; w_ < 520; w_ += G) { const int u = (w_ < 512) ? (w_ >> 6) * NCH + 1 + (w_ & 63) : (w_ - 512) * NCH; mlstm_A(PROJ, GIF, MLS, MLN, MLSC, u, lds, tid_); }
#if defined(PROBE_REP_MLA)
            for (int w_ = bx; w_ < 520; w_ += G) { const int u = (w_ < 512) ? (w_ >> 6) * NCH + 1 + (w_ & 63) : (w_ - 512) * NCH; mlstm_A(PROJ, GIF, MLS, MLN, MLSC, u, lds, tid_); }
#endif
            for (int w_ = (bx + G - 8) % G; w_ < 1040; w_ += G) { const int u = (w_ < 1024) ? (w_ >> 6) * NCH + 1 + (w_ & 63) : (w_ - 1024) * NCH; hg_A(PROJ, LBp + l * 1024, HGS, HGE, u, lds, tid_); }
#if defined(PROBE_REP_HGA)
            for (int w_ = (bx + G - 8) % G; w_ < 1040; w_ += G) { const int u = (w_ < 1024) ? (w_ >> 6) * NCH + 1 + (w_ & 63) : (w_ - 1024) * NCH; hg_A(PROJ, LBp + l * 1024, HGS, HGE, u, lds, tid_); }
#endif
            for (int u = (bx + G - 24) % G; u < 258; u += G) rg_A(PROJ, args.in[11] + l * 4096, args.in[12] + l * 1024, args.in[13] + l * 65536, args.in[14] + l * 1024, args.in[15] + l * 65536, args.in[16] + l * 1024, args.in[17] + l * 1024, RGH, RGP, RGT, u, lds, tid_);
#if defined(PROBE_REP_RGA)
            for (int u = (bx + G - 24) % G; u < 258; u += G) rg_A(PROJ, args.in[11] + l * 4096, args.in[12] + l * 1024, args.in[13] + l * 65536, args.in[14] + l * 1024, args.in[15] + l * 65536, args.in[16] + l * 1024, args.in[17] + l * 1024, RGH, RGP, RGT, u, lds, tid_);
#endif
            for (int r = 0;; ++r) { const int bs = (r == 2) ? (bx + G - 28) % G : bx; const int idx = r * G + ((r & 1) ? (G - 1 - bs) : bs); if (r * G >= (lastl ? 512 : 520)) break; if (idx >= (lastl ? 512 : 520)) continue;
                int b, h, i; if (idx < 512) { i = 32 - (idx >> 4); b = (idx >> 3) & 1; h = idx & 7; } else { i = 0; b = 0; h = idx - 512; }
                sb_unit(PROJ, args.in[7] + l * 128, args.in[8] + l * 128, BR, b, h, i, lds, tid_); }
#if defined(PROBE_REP_SB)
            for (int r = 0;; ++r) { const int bs = (r == 2) ? (bx + G - 28) % G : bx; const int idx = r * G + ((r & 1) ? (G - 1 - bs) : bs); if (r * G >= (lastl ? 512 : 520)) break; if (idx >= (lastl ? 512 : 520)) continue;
                int b, h, i; if (idx < 512) { i = 32 - (idx >> 4); b = (idx >> 3) & 1; h = idx & 7; } else { i = 0; b = 0; h = idx - 512; }
                sb_unit(PROJ, args.in[7] + l * 128, args.in[8] + l * 128, BR, b, h, i, lds, tid_); }
#endif
        }
        SEAM(pb + 2);
        if constexpr (IN(pb + 3)) { PHASE_VARS
            for (int u = bx; u < 256; u += G) mlstm_B(MLS, MLN, MLSC, MLCT, u, lds, tid_);
#if defined(PROBE_REP_MLB)
            for (int u = bx; u < 256; u += G) mlstm_B(MLS, MLN, MLSC, MLCT, u, lds, tid_);
#endif
            for (int u = bx; u < 256; u += G) hg_B(HGS, HGE, u, tid_);
            for (int ch_ = gw_; ch_ < 2048; ch_ += NGW) rg_B(RGT, ch_, lane_);
        }
        SEAM(pb + 3);
        if constexpr (IN(pb + 4)) { PHASE_VARS
            for (int w_ = (bx + G - 64) % G; w_ < (lastl ? 512 : 520); w_ += G) { const int u = (w_ < 512) ? (w_ >> 6) * NCH + 1 + (w_ & 63) : (w_ - 512) * NCH; mlstm_C(PROJ, GIF, MLCT, MLSC, args.in[6] + l * 1024, BR, u, lds, tid_); }
#if defined(PROBE_REP_MLC)
            for (int w_ = (bx + G - 64) % G; w_ < (lastl ? 512 : 520); w_ += G) { const int u = (w_ < 512) ? (w_ >> 6) * NCH + 1 + (w_ & 63) : (w_ - 512) * NCH; mlstm_C(PROJ, GIF, MLCT, MLSC, args.in[6] + l * 1024, BR, u, lds, tid_); }
#endif
            for (int w_ = (bx + G - 72) % G; w_ < (lastl ? 1024 : 1040); w_ += G) { const int u = (w_ < 1024) ? (w_ >> 6) * NCH + 1 + (w_ & 63) : (w_ - 1024) * NCH; hg_C(PROJ, LBp + l * 1024, HGS, args.in[10] + l * 1024, BR, u, lds, tid_); }
#if defined(PROBE_REP_HGC)
            for (int w_ = (bx + G - 72) % G; w_ < (lastl ? 1024 : 1040); w_ += G) { const int u = (w_ < 1024) ? (w_ >> 6) * NCH + 1 + (w_ & 63) : (w_ - 1024) * NCH; hg_C(PROJ, LBp + l * 1024, HGS, args.in[10] + l * 1024, BR, u, lds, tid_); }
#endif
            rg_C(PROJ, RGH, RGP, RGT, BR, gw_, NGW, lane_);
#if defined(PROBE_REP_RGC)
            rg_C(PROJ, RGH, RGP, RGT, BR, gw_, NGW, lane_);
#endif
        }
        SEAM(pb + 4);
        if constexpr (IN(pb + 5)) { PHASE_VARS pg8::Gemm g{BR, (const bf16*)(ws + WS_WUP + (size_t)l * SZ_WSQ), Mg, D, D, D, D}; pg8::StaticOrder S; S.init(Mg, D, G, bx);
            pg8::EpiUpGate E{MG, D, PROJ + PC_GATE, NPROJ};
            pg8::gemm_phase<pg8::EpiUpGate, pg8::StaticOrder, PG8_ALIGN_RES, PG8_SP2V>((PG8_LAS unsigned char*)lds, g, S, E, tid_);
            if constexpr (!lastl) { int tid2_ = tid; asm volatile("" : "+v"(tid2_)); skinny_phase<1>(BR + (size_t)METAROW * D, D, (const bf16*)(ws + WS_WUP + (size_t)l * SZ_WSQ), D, D, D, nullptr, MG + (size_t)METAROW * D, PROJ + (size_t)METAROW * NPROJ + PC_GATE, lds, tid2_, bx, G); } }
#if defined(PROBE_REP_G5)
        if constexpr (IN(pb + 5)) { PHASE_VARS pg8::Gemm g{BR, (const bf16*)(ws + WS_WUP + (size_t)l * SZ_WSQ), Mg, D, D, D, D}; pg8::StaticOrder S; S.init(Mg, D, G, bx);
            pg8::EpiUpGate E{MG, D, PROJ + PC_GATE, NPROJ};
            pg8::gemm_phase<pg8::EpiUpGate, pg8::StaticOrder, PG8_ALIGN_RES, PG8_SP2V>((PG8_LAS unsigned char*)lds, g, S, E, tid_);
            if constexpr (!lastl) { int tid2_ = tid; asm volatile("" : "+v"(tid2_)); skinny_phase<1>(BR + (size_t)METAROW * D, D, (const bf16*)(ws + WS_WUP + (size_t)l * SZ_WSQ), D, D, D, nullptr, MG + (size_t)METAROW * D, PROJ + (size_t)METAROW * NPROJ + PC_GATE, lds, tid2_, bx, G); } }
#endif
        SEAM(pb + 5);
        if constexpr (IN(pb + 6)) { PHASE_VARS pg8::Gemm g{MG, (const bf16*)(ws + WS_WOUT + (size_t)l * SZ_WSQ), Mg, D, D, D, D}; pg8::StaticOrder S; S.init(Mg, D, G, bx);
            pg8::EpiResid<(l != 0), true> E{hsrc, HBp};
            pg8::gemm_phase<pg8::EpiResid<(l != 0), true>, pg8::StaticOrder, PG8_ALIGN_RES, PG8_SP2V>((PG8_LAS unsigned char*)lds, g, S, E, tid_);
            if constexpr (!lastl) { int tid2_ = tid; asm volatile("" : "+v"(tid2_)); skinny_phase<0>(MG + (size_t)METAROW * D, D, (const bf16*)(ws + WS_WOUT + (size_t)l * SZ_WSQ), D, D, D, HMETA, nullptr, nullptr, lds, tid2_, bx, G); } }
        SEAM(pb + 6);
        if constexpr (IN(pb + 7)) { PHASE_VARS norm_rows<false, true>(HBp, HMETA, args.in[3] + l * D, XN, Mtail, nullptr, nullptr, nullptr, gw_, NGW, lane_, lds, tid_); }
#if defined(PROBE_REP_NORM)
            if constexpr (IN(pb + 7)) { PHASE_VARS norm_rows<false, true>(HBp, HMETA, args.in[3] + l * D, XN, Mtail, nullptr, nullptr, nullptr, gw_, NGW, lane_, lds, tid_); }
#endif
        SEAM(pb + 7);
        if constexpr (IN(pb + 8)) { PHASE_VARS pg8::Gemm g{XN, (const bf16*)(ws + WS_WGU + (size_t)l * SZ_WGU), Mg, NGU, D, D, D}; pg8::StaticOrder S; S.init(Mg, NGU, G, bx);
            pg8::EpiSwiGLU E{ACT, DFF};
            pg8::gemm_phase<pg8::EpiSwiGLU, pg8::StaticOrder, PG8_ALIGNV, PG8_SP2V>((PG8_LAS unsigned char*)lds, g, S, E, tid_);
            if constexpr (!lastl) { int tid2_ = tid; asm volatile("" : "+v"(tid2_)); skinny_swiglu(XN + (size_t)METAROW * D, (const bf16*)(ws + WS_WGU + (size_t)l * SZ_WGU), ACT + (size_t)METAROW * DFF, lds, tid2_, bx, G); } }
#if defined(PROBE_REP_G8)
        if constexpr (IN(pb + 8)) { PHASE_VARS pg8::Gemm g{XN, (const bf16*)(ws + WS_WGU + (size_t)l * SZ_WGU), Mg, NGU, D, D, D}; pg8::StaticOrder S; S.init(Mg, NGU, G, bx);
            pg8::EpiSwiGLU E{ACT, DFF};
            pg8::gemm_phase<pg8::EpiSwiGLU, pg8::StaticOrder, PG8_ALIGNV, PG8_SP2V>((PG8_LAS unsigned char*)lds, g, S, E, tid_);
            if constexpr (!lastl) { int tid2_ = tid; asm volatile("" : "+v"(tid2_)); skinny_swiglu(XN + (size_t)METAROW * D, (const bf16*)(ws + WS_WGU + (size_t)l * SZ_WGU), ACT + (size_t)METAROW * DFF, lds, tid2_, bx, G); } }
#endif
        SEAM(pb + 8);
        if constexpr (IN(pb + 9)) { PHASE_VARS pg8::Gemm g{ACT, (const bf16*)(ws + WS_WD + (size_t)l * SZ_WD), Mg, D, DFF, DFF, DFF}; pg8::StaticOrder S; S.init(Mg, D, G, bx);
            pg8::EpiResid<true, !lastl> E{HBp, lastl ? (void*)out : (void*)HBp};
            pg8::gemm_phase<pg8::EpiResid<true, !lastl>, pg8::StaticOrder, PG8_ALIGN_RES, PG8_SP2V>((PG8_LAS unsigned char*)lds, g, S, E, tid_);
            if constexpr (!lastl) { int tid2_ = tid; asm volatile("" : "+v"(tid2_)); skinny_phase<0>(ACT + (size_t)METAROW * DFF, DFF, (const bf16*)(ws + WS_WD + (size_t)l * SZ_WD), DFF, D, DFF, HMETA, nullptr, nullptr, lds, tid2_, bx, G); } }
        SEAM(pb + 9);
    }
    {
        constexpr int l = 1;
        constexpr int pb = 1 + 10 * l;
        constexpr bool lastl = (l == NLAYER - 1);
        constexpr int Mtail = lastl ? TREAL : MROWS;
        constexpr int Mg = TREAL;
        const void* hsrc = (l == 0) ? (const void*)x : (const void*)HBp;
        if constexpr (IN(pb + 0)) { PHASE_VARS norm_rows<true, (l != 0)>(hsrc, HMETA, args.in[2] + l * D, XN, MROWS, WIF + (size_t)l * 8 * D, args.in[5] + (size_t)l * NIN + 4096, GIF, gw_, NGW, lane_, lds, tid_); }
#if defined(PROBE_REP_NORM)
            if constexpr (IN(pb + 0)) { PHASE_VARS norm_rows<true, (l != 0)>(hsrc, HMETA, args.in[2] + l * D, XN, MROWS, WIF + (size_t)l * 8 * D, args.in[5] + (size_t)l * NIN + 4096, GIF, gw_, NGW, lane_, lds, tid_); }
#endif
        SEAM(pb + 0);
        if constexpr (IN(pb + 1)) { PHASE_VARS pg8::Gemm g{XN, (const bf16*)(ws + WS_WIN + (size_t)l * SZ_WIN), MROWS, NPROJ, D, D, D}; pg8::StaticOrder S; S.init(MROWS, NPROJ, G, bx);
            pg8::EpiProj E{PROJ, NPROJ, args.in[5] + (size_t)l * NIN, 4096, 8, PC_GATE};
            pg8::gemm_phase<pg8::EpiProj, pg8::StaticOrder, PG8_ALIGNV, PG8_SP2V>((PG8_LAS unsigned char*)lds, g, S, E, tid_); }
#if defined(PROBE_REP_G1)
        if constexpr (IN(pb + 1)) { PHASE_VARS pg8::Gemm g{XN, (const bf16*)(ws + WS_WIN + (size_t)l * SZ_WIN), MROWS, NPROJ, D, D, D}; pg8::StaticOrder S; S.init(MROWS, NPROJ, G, bx);
            pg8::EpiProj E{PROJ, NPROJ, args.in[5] + (size_t)l * NIN, 4096, 8, PC_GATE};
            pg8::gemm_phase<pg8::EpiProj, pg8::StaticOrder, PG8_ALIGNV, PG8_SP2V>((PG8_LAS unsigned char*)lds, g, S, E, tid_); }
#endif
        SEAM(pb + 1);
        if constexpr (IN(pb + 2)) { PHASE_VARS
            for (int w_ = bx; w_ < 520; w_ += G) { const int u = (w_ < 512) ? (w_ >> 6) * NCH + 1 + (w_ & 63) : (w_ - 512) * NCH; mlstm_A(PROJ, GIF, MLS, MLN, MLSC, u, lds, tid_); }
#if defined(PROBE_REP_MLA)
            for (int w_ = bx; w_ < 520; w_ += G) { const int u = (w_ < 512) ? (w_ >> 6) * NCH + 1 + (w_ & 63) : (w_ - 512) * NCH; mlstm_A(PROJ, GIF, MLS, MLN, MLSC, u, lds, tid_); }
#endif
            for (int w_ = (bx + G - 8) % G; w_ < 1040; w_ += G) { const int u = (w_ < 1024) ? (w_ >> 6) * NCH + 1 + (w_ & 63) : (w_ - 1024) * NCH; hg_A(PROJ, LBp + l * 1024, HGS, HGE, u, lds, tid_); }
#if defined(PROBE_REP_HGA)
            for (int w_ = (bx + G - 8) % G; w_ < 1040; w_ += G) { const int u = (w_ < 1024) ? (w_ >> 6) * NCH + 1 + (w_ & 63) : (w_ - 1024) * NCH; hg_A(PROJ, LBp + l * 1024, HGS, HGE, u, lds, tid_); }
#endif
            for (int u = (bx + G - 24) % G; u < 258; u += G) rg_A(PROJ, args.in[11] + l * 4096, args.in[12] + l * 1024, args.in[13] + l * 65536, args.in[14] + l * 1024, args.in[15] + l * 65536, args.in[16] + l * 1024, args.in[17] + l * 1024, RGH, RGP, RGT, u, lds, tid_);
#if defined(PROBE_REP_RGA)
            for (int u = (bx + G - 24) % G; u < 258; u += G) rg_A(PROJ, args.in[11] + l * 4096, args.in[12] + l * 1024, args.in[13] + l * 65536, args.in[14] + l * 1024, args.in[15] + l * 65536, args.in[16] + l * 1024, args.in[17] + l * 1024, RGH, RGP, RGT, u, lds, tid_);
#endif
            for (int r = 0;; ++r) { const int bs = (r == 2) ? (bx + G - 28) % G : bx; const int idx = r * G + ((r & 1) ? (G - 1 - bs) : bs); if (r * G >= (lastl ? 512 : 520)) break; if (idx >= (lastl ? 512 : 520)) continue;
                int b, h, i; if (idx < 512) { i = 32 - (idx >> 4); b = (idx >> 3) & 1; h = idx & 7; } else { i = 0; b = 0; h = idx - 512; }
                sb_unit(PROJ, args.in[7] + l * 128, args.in[8] + l * 128, BR, b, h, i, lds, tid_); }
#if defined(PROBE_REP_SB)
            for (int r = 0;; ++r) { const int bs = (r == 2) ? (bx + G - 28) % G : bx; const int idx = r * G + ((r & 1) ? (G - 1 - bs) : bs); if (r * G >= (lastl ? 512 : 520)) break; if (idx >= (lastl ? 512 : 520)) continue;
                int b, h, i; if (idx < 512) { i = 32 - (idx >> 4); b = (idx >> 3) & 1; h = idx & 7; } else { i = 0; b = 0; h = idx - 512; }
                sb_unit(PROJ, args.in[7] + l * 128, args.in[8] + l * 128, BR, b, h, i, lds, tid_); }
#endif
        }
        SEAM(pb + 2);
        if constexpr (IN(pb + 3)) { PHASE_VARS
            for (int u = bx; u < 256; u += G) mlstm_B(MLS, MLN, MLSC, MLCT, u, lds, tid_);
#if defined(PROBE_REP_MLB)
            for (int u = bx; u < 256; u += G) mlstm_B(MLS, MLN, MLSC, MLCT, u, lds, tid_);
#endif
            for (int u = bx; u < 256; u += G) hg_B(HGS, HGE, u, tid_);
            for (int ch_ = gw_; ch_ < 2048; ch_ += NGW) rg_B(RGT, ch_, lane_);
        }
        SEAM(pb + 3);
        if constexpr (IN(pb + 4)) { PHASE_VARS
            for (int w_ = (bx + G - 64) % G; w_ < (lastl ? 512 : 520); w_ += G) { const int u = (w_ < 512) ? (w_ >> 6) * NCH + 1 + (w_ & 63) : (w_ - 512) * NCH; mlstm_C(PROJ, GIF, MLCT, MLSC, args.in[6] + l * 1024, BR, u, lds, tid_); }
#if defined(PROBE_REP_MLC)
            for (int w_ = (bx + G - 64) % G; w_ < (lastl ? 512 : 520); w_ += G) { const int u = (w_ < 512) ? (w_ >> 6) * NCH + 1 + (w_ & 63) : (w_ - 512) * NCH; mlstm_C(PROJ, GIF, MLCT, MLSC, args.in[6] + l * 1024, BR, u, lds, tid_); }
#endif
            for (int w_ = (bx + G - 72) % G; w_ < (lastl ? 1024 : 1040); w_ += G) { const int u = (w_ < 1024) ? (w_ >> 6) * NCH + 1 + (w_ & 63) : (w_ - 1024) * NCH; hg_C(PROJ, LBp + l * 1024, HGS, args.in[10] + l * 1024, BR, u, lds, tid_); }
#if defined(PROBE_REP_HGC)
            for (int w_ = (bx + G - 72) % G; w_ < (lastl ? 1024 : 1040); w_ += G) { const int u = (w_ < 1024) ? (w_ >> 6) * NCH + 1 + (w_ & 63) : (w_ - 1024) * NCH; hg_C(PROJ, LBp + l * 1024, HGS, args.in[10] + l * 1024, BR, u, lds, tid_); }
#endif
            rg_C(PROJ, RGH, RGP, RGT, BR, gw_, NGW, lane_);
#if defined(PROBE_REP_RGC)
            rg_C(PROJ, RGH, RGP, RGT, BR, gw_, NGW, lane_);
#endif
        }
        SEAM(pb + 4);
        if constexpr (IN(pb + 5)) { PHASE_VARS pg8::Gemm g{BR, (const bf16*)(ws + WS_WUP + (size_t)l * SZ_WSQ), Mg, D, D, D, D}; pg8::StaticOrder S; S.init(Mg, D, G, bx);
            pg8::EpiUpGate E{MG, D, PROJ + PC_GATE, NPROJ};
            pg8::gemm_phase<pg8::EpiUpGate, pg8::StaticOrder, PG8_ALIGN_RES, PG8_SP2V>((PG8_LAS unsigned char*)lds, g, S, E, tid_);
            if constexpr (!lastl) { int tid2_ = tid; asm volatile("" : "+v"(tid2_)); skinny_phase<1>(BR + (size_t)METAROW * D, D, (const bf16*)(ws + WS_WUP + (size_t)l * SZ_WSQ), D, D, D, nullptr, MG + (size_t)METAROW * D, PROJ + (size_t)METAROW * NPROJ + PC_GATE, lds, tid2_, bx, G); } }
#if defined(PROBE_REP_G5)
        if constexpr (IN(pb + 5)) { PHASE_VARS pg8::Gemm g{BR, (const bf16*)(ws + WS_WUP + (size_t)l * SZ_WSQ), Mg, D, D, D, D}; pg8::StaticOrder S; S.init(Mg, D, G, bx);
            pg8::EpiUpGate E{MG, D, PROJ + PC_GATE, NPROJ};
            pg8::gemm_phase<pg8::EpiUpGate, pg8::StaticOrder, PG8_ALIGN_RES, PG8_SP2V>((PG8_LAS unsigned char*)lds, g, S, E, tid_);
            if constexpr (!lastl) { int tid2_ = tid; asm volatile("" : "+v"(tid2_)); skinny_phase<1>(BR + (size_t)METAROW * D, D, (const bf16*)(ws + WS_WUP + (size_t)l * SZ_WSQ), D, D, D, nullptr, MG + (size_t)METAROW * D, PROJ + (size_t)METAROW * NPROJ + PC_GATE, lds, tid2_, bx, G); } }
#endif
        SEAM(pb + 5);
        if constexpr (IN(pb + 6)) { PHASE_VARS pg8::Gemm g{MG, (const bf16*)(ws + WS_WOUT + (size_t)l * SZ_WSQ), Mg, D, D, D, D}; pg8::StaticOrder S; S.init(Mg, D, G, bx);
            pg8::EpiResid<(l != 0), true> E{hsrc, HBp};
            pg8::gemm_phase<pg8::EpiResid<(l != 0), true>, pg8::StaticOrder, PG8_ALIGN_RES, PG8_SP2V>((PG8_LAS unsigned char*)lds, g, S, E, tid_);
            if constexpr (!lastl) { int tid2_ = tid; asm volatile("" : "+v"(tid2_)); skinny_phase<0>(MG + (size_t)METAROW * D, D, (const bf16*)(ws + WS_WOUT + (size_t)l * SZ_WSQ), D, D, D, HMETA, nullptr, nullptr, lds, tid2_, bx, G); } }
        SEAM(pb + 6);
        if constexpr (IN(pb + 7)) { PHASE_VARS norm_rows<false, true>(HBp, HMETA, args.in[3] + l * D, XN, Mtail, nullptr, nullptr, nullptr, gw_, NGW, lane_, lds, tid_); }
#if defined(PROBE_REP_NORM)
            if constexpr (IN(pb + 7)) { PHASE_VARS norm_rows<false, true>(HBp, HMETA, args.in[3] + l * D, XN, Mtail, nullptr, nullptr, nullptr, gw_, NGW, lane_, lds, tid_); }
#endif
        SEAM(pb + 7);
        if constexpr (IN(pb + 8)) { PHASE_VARS pg8::Gemm g{XN, (const bf16*)(ws + WS_WGU + (size_t)l * SZ_WGU), Mg, NGU, D, D, D}; pg8::StaticOrder S; S.init(Mg, NGU, G, bx);
            pg8::EpiSwiGLU E{ACT, DFF};
            pg8::gemm_phase<pg8::EpiSwiGLU, pg8::StaticOrder, PG8_ALIGNV, PG8_SP2V>((PG8_LAS unsigned char*)lds, g, S, E, tid_);
            if constexpr (!lastl) { int tid2_ = tid; asm volatile("" : "+v"(tid2_)); skinny_swiglu(XN + (size_t)METAROW * D, (const bf16*)(ws + WS_WGU + (size_t)l * SZ_WGU), ACT + (size_t)METAROW * DFF, lds, tid2_, bx, G); } }
#if defined(PROBE_REP_G8)
        if constexpr (IN(pb + 8)) { PHASE_VARS pg8::Gemm g{XN, (const bf16*)(ws + WS_WGU + (size_t)l * SZ_WGU), Mg, NGU, D, D, D}; pg8::StaticOrder S; S.init(Mg, NGU, G, bx);
            pg8::EpiSwiGLU E{ACT, DFF};
            pg8::gemm_phase<pg8::EpiSwiGLU, pg8::StaticOrder, PG8_ALIGNV, PG8_SP2V>((PG8_LAS unsigned char*)lds, g, S, E, tid_);
            if constexpr (!lastl) { int tid2_ = tid; asm volatile("" : "+v"(tid2_)); skinny_swiglu(XN + (size_t)METAROW * D, (const bf16*)(ws + WS_WGU + (size_t)l * SZ_WGU), ACT + (size_t)METAROW * DFF, lds, tid2_, bx, G); } }
#endif
        SEAM(pb + 8);
        if constexpr (IN(pb + 9)) { PHASE_VARS pg8::Gemm g{ACT, (const bf16*)(ws + WS_WD + (size_t)l * SZ_WD), Mg, D, DFF, DFF, DFF}; pg8::StaticOrder S; S.init(Mg, D, G, bx);
            pg8::EpiResid<true, !lastl> E{HBp, lastl ? (void*)out : (void*)HBp};
            pg8::gemm_phase<pg8::EpiResid<true, !lastl>, pg8::StaticOrder, PG8_ALIGN_RES, PG8_SP2V>((PG8_LAS unsigned char*)lds, g, S, E, tid_);
            if constexpr (!lastl) { int tid2_ = tid; asm volatile("" : "+v"(tid2_)); skinny_phase<0>(ACT + (size_t)METAROW * DFF, DFF, (const bf16*)(ws + WS_WD + (size_t)l * SZ_WD), DFF, D, DFF, HMETA, nullptr, nullptr, lds, tid2_, bx, G); } }
        SEAM(pb + 9);
    }

#undef IN
#undef SEAM
#undef PHASE_VARS
#undef PROJ
#undef ACT
#undef XN
#undef BR
#undef MG
#undef HMETA
#undef GIF
#undef WIF
#undef LBp
#undef MLS
#undef MLN
#undef MLSC
#undef MLCT
#undef HGS
#undef HGE
#undef RGH
#undef RGP
#undef RGT
#undef HBp
#undef x
#undef out
}


#if MK_N_LAUNCHES == 1
template <class F> static void for_each_kernel(F&& f) { f((const void*)fwd_kernel<0, N_PHASES>); }
static void launch_all(const Args& a, int grid, hipStream_t stream) { hipLaunchKernelGGL((fwd_kernel<0, N_PHASES>), dim3(grid), dim3(NTHR), LDS_BYTES, stream, a); }
#else
template <int K> struct PhaseLaunch {
    template <class F> static void each(F&& f) { f((const void*)fwd_kernel<K, K + 1>); PhaseLaunch<K + 1>::each(f); }
    static void go(const Args& a, int grid, hipStream_t stream) { hipLaunchKernelGGL((fwd_kernel<K, K + 1>), dim3(grid), dim3(NTHR), LDS_BYTES, stream, a); PhaseLaunch<K + 1>::go(a, grid, stream); }
};
template <> struct PhaseLaunch<N_PHASES> { template <class F> static void each(F&&) {} static void go(const Args&, int, hipStream_t) {} };
template <class F> static void for_each_kernel(F&& f) { PhaseLaunch<0>::each(f); }
static void launch_all(const Args& a, int grid, hipStream_t stream) { PhaseLaunch<0>::go(a, grid, stream); }
#endif
extern "C" void kernel_launch(void* const* d_in, const int* in_sizes, int n_in, void* d_out, int out_size, void* d_ws, size_t ws_size, hipStream_t stream) {
    static int grid = 0;
    if (grid == 0) {
        if (n_in != 23 || out_size != TREAL * D || ws_size < WS_END) { fprintf(stderr, "kernel_launch: unexpected shapes (n_in %d, out %d, ws %zu < %zu); nothing launched\n", n_in, out_size, ws_size, (size_t)WS_END); grid = -1; return; }
        int dev = 0, cus = 0, per_cu = 0;
        if (hipGetDevice(&dev) != hipSuccess || hipDeviceGetAttribute(&cus, hipDeviceAttributeMultiprocessorCount, dev) != hipSuccess) { grid = -1; return; }
        bool ok = true;
        for_each_kernel([&](const void* f) { if (hipFuncSetAttribute(f, hipFuncAttributeMaxDynamicSharedMemorySize, LDS_BYTES) != hipSuccess) ok = false; });
        if (!ok) { fprintf(stderr, "kernel_launch: hipFuncSetAttribute failed\n"); grid = -1; return; }
        (void)per_cu; (void)hipGetLastError();
        grid = cus;
    }
    if (grid < 0) return;
    (void)in_sizes;
    if (hipMemsetAsync((char*)d_ws + WS_CTL, 0, CTL_ZERO_BYTES, stream) != hipSuccess) return;
    Args a{};
    for (int i = 0; i < 23; ++i) a.in[i] = (const float*)d_in[i];
    a.out = (float*)d_out; a.ws = (unsigned char*)d_ws; a.ph_lo = 0; a.ph_hi = N_PHASES;
    launch_all(a, grid, stream);
}
```

```cpp
#include <hip/hip_runtime.h>
#include <cstdio>
#include <cstdint>
#define MK_N_LAUNCHES 1
#ifndef PG8_WGM
#define PG8_WGM 8
#endif
namespace pg8 {
#define PG8_LAS __attribute__((address_space(3)))
typedef unsigned short bf16_t;
typedef short bf16x8 __attribute__((ext_vector_type(8)));
typedef float f32x4 __attribute__((ext_vector_type(4)));
typedef unsigned u32x4 __attribute__((ext_vector_type(4)));
constexpr int BM = 256, BK = 64, HALF = 128, HTB = HALF * BK * 2  , STAGE_BYTES = 8 * HTB, NXCD = 8, WGM = PG8_WGM;

__host__ __device__ __forceinline__ int lds_byte(int r, int c) { const int st = (r >> 4) * 2 + (c >> 5), rr = r & 15, cc = c & 31, ob = rr * 64 + cc * 2; return st * 1024 + (ob ^ (((ob >> 9) & 1) << 5)); }
__host__ __device__ __forceinline__ void stage_rc(int b, int& R, int& C) { const int st = b / 1024, sb = b % 1024, swz = sb ^ (((sb >> 9) & 1) << 5); R = (st >> 1) * 16 + swz / 64; C = (st & 1) * 32 + (swz % 64) / 2; }
__host__ __device__ __forceinline__ int perm32(int rho) { const int n = rho >> 4, i = rho & 15; return 8 * (i >> 2) + 4 * n + (i & 3); }

struct Unit { int pm, pn; };
struct Gemm { const bf16_t* A; const bf16_t* Bt; int M, N, K, lda, ldb; };

struct StaticOrder {
    int nM, nN, nwg, G, c;
    __host__ __device__ void init(int M, int N, int G_, int c_) { nM = M / BM; nN = N / BM; nwg = nM * nN; G = G_; c = c_; }
    __host__ __device__ bool next(int i, Unit& u) const {
        const long L = (long)i * G + c; if (L >= nwg) return false;
        int wgid = (int)L;
#if !defined(PG8_NO_XCD_REMAP)
        { const int q = nwg / NXCD, r = nwg % NXCD, xcd = wgid % NXCD, off = wgid / NXCD; wgid = (xcd < r ? xcd * (q + 1) : r * (q + 1) + (xcd - r) * q) + off; }
#endif
        const int nig = WGM * nN, gid = wgid / nig, fm = gid * WGM, gsz = (nM - fm) < WGM ? (nM - fm) : WGM;
        u.pm = fm + ((wgid % nig) % gsz); u.pn = (wgid % nig) / gsz; return true;
    }
    __device__ __forceinline__ void a_ready(const Unit&) const {}
    __device__ __forceinline__ void done(const Unit&) const {}
};

__device__ __forceinline__ unsigned cvt_pk_bf16(float lo, float hi) { unsigned r; asm volatile("v_cvt_pk_bf16_f32 %0, %1, %2" : "=v"(r) : "v"(lo), "v"(hi)); return r; }
typedef float f32x2 __attribute__((ext_vector_type(2)));
typedef float f32x2 __attribute__((ext_vector_type(2)));
__device__ __forceinline__ float bf_lo(unsigned w) { return __uint_as_float(w << 16); }
__device__ __forceinline__ float bf_hi(unsigned w) { return __uint_as_float(w & 0xffff0000u); }
__device__ __forceinline__ float fast_sigmoid(float x) { return __builtin_amdgcn_rcpf(1.0f + __expf(-x)); }

struct EpiProj {
    static constexpr bool PERM = true, AFTER_DRAIN = false, MID = false; static constexpr int SEG = 16;
    bf16_t* O; int ldc; const float* bias; int shift_from, bias_shift, gate_from;
    __device__ __forceinline__ void operator()(const f32x4 (&acc)[2][2][4][2], const Unit& u, int wr, int wc, int fr, int fq) const {
        const int row0 = u.pm * BM + wr * 64 + fr; const int colt = u.pn * BM;
        const int col0 = colt + wc * 32 + 8 * fq; const float* bp = bias + col0 + (colt >= shift_from ? bias_shift : 0);
        const bool isg = colt >= gate_from;
        f32x4 bv[2][2];
#pragma unroll
        for (int bj = 0; bj < 2; ++bj)
#pragma unroll
            for (int n = 0; n < 2; ++n) bv[bj][n] = *(const f32x4*)(bp + bj * HALF + 4 * n);
#pragma unroll
        for (int ai = 0; ai < 2; ++ai)
#pragma unroll
            for (int m = 0; m < 4; ++m) { bf16_t* rowp = O + (size_t)(row0 + ai * HALF + m * 16) * ldc + col0;
#pragma unroll
                for (int bj = 0; bj < 2; ++bj) { f32x4 v0 = acc[ai][bj][m][0] + bv[bj][0], v1 = acc[ai][bj][m][1] + bv[bj][1];
                    if (isg) {
#pragma unroll
                        for (int j = 0; j < 4; ++j) { v0[j] = 1.0f + __expf(-fmaxf(v0[j], -60.f)); v1[j] = 1.0f + __expf(-fmaxf(v1[j], -60.f)); } }
                    u32x4 w; w.x = cvt_pk_bf16(v0[0], v0[1]); w.y = cvt_pk_bf16(v0[2], v0[3]); w.z = cvt_pk_bf16(v1[0], v1[1]); w.w = cvt_pk_bf16(v1[2], v1[3]);
                    *(u32x4*)(rowp + bj * HALF) = w; } }
    }
};

struct EpiUpGate {
    static constexpr bool PERM = true, AFTER_DRAIN = false, MID = true; static constexpr int SEG = 16;
    bf16_t* O; int ldc; const bf16_t* G; int ldg;
    __device__ __forceinline__ void mid(f32x4 (&acc)[2][2][4][2], const Unit& u, int seg, int wr, int wc, int fr, int fq) const {
        const int row0 = u.pm * BM + wr * 64 + fr; const int col0 = u.pn * BM + wc * 32 + 8 * fq;
#pragma unroll
        for (int ai = 0; ai < 2; ++ai) { u32x4 ga[4][2], gb[4][2];
#pragma unroll
            for (int m = 0; m < 4; ++m) { const bf16_t* gp = G + (size_t)(row0 + ai * HALF + m * 16) * ldg + seg * 4096 + col0;
#pragma unroll
                for (int bj = 0; bj < 2; ++bj) { ga[m][bj] = *(const u32x4*)(gp + bj * HALF); gb[m][bj] = *(const u32x4*)(gp + 4096 + bj * HALF); } }
#pragma unroll
            for (int m = 0; m < 4; ++m)
#pragma unroll
                for (int bj = 0; bj < 2; ++bj) { const u32x4 a = ga[m][bj], b = gb[m][bj];
                    const unsigned aw[4] = {a.x, a.y, a.z, a.w}, bw[4] = {b.x, b.y, b.z, b.w};
#pragma unroll
                    for (int j = 0; j < 4; ++j) {
                        const float rl = bf_lo(bw[j]) * __builtin_amdgcn_rcpf(bf_lo(aw[j])), rh = bf_hi(bw[j]) * __builtin_amdgcn_rcpf(bf_hi(aw[j]));
                        acc[ai][bj][m][j >> 1][(j & 1) * 2] *= rl; acc[ai][bj][m][j >> 1][(j & 1) * 2 + 1] *= rh; } }
            asm volatile("" ::: "memory"); }
    }
    __device__ __forceinline__ void operator()(const f32x4 (&acc)[2][2][4][2], const Unit& u, int wr, int wc, int fr, int fq) const {
        const int row0 = u.pm * BM + wr * 64 + fr; const int col0 = u.pn * BM + wc * 32 + 8 * fq;
        u32x4 ga[2][4][2];
#pragma unroll
        for (int ai = 0; ai < 2; ++ai)
#pragma unroll
            for (int m = 0; m < 4; ++m) { const bf16_t* gp = G + (size_t)(row0 + ai * HALF + m * 16) * ldg + 3 * 4096 + col0;
#pragma unroll
                for (int bj = 0; bj < 2; ++bj) ga[ai][m][bj] = *(const u32x4*)(gp + bj * HALF); }
#pragma unroll
        for (int ai = 0; ai < 2; ++ai)
#pragma unroll
            for (int m = 0; m < 4; ++m) { const int row = row0 + ai * HALF + m * 16; bf16_t* rowp = O + (size_t)row * ldc + col0;
#pragma unroll
                for (int bj = 0; bj < 2; ++bj) { const u32x4 a = ga[ai][m][bj]; const unsigned aw[4] = {a.x, a.y, a.z, a.w}; float o[8];
#pragma unroll
                    for (int j = 0; j < 4; ++j) { const float gl = __builtin_amdgcn_rcpf(bf_lo(aw[j])), gh = __builtin_amdgcn_rcpf(bf_hi(aw[j]));
                        o[2 * j] = acc[ai][bj][m][j >> 1][(j & 1) * 2] * gl; o[2 * j + 1] = acc[ai][bj][m][j >> 1][(j & 1) * 2 + 1] * gh; }
                    u32x4 w; w.x = cvt_pk_bf16(o[0], o[1]); w.y = cvt_pk_bf16(o[2], o[3]); w.z = cvt_pk_bf16(o[4], o[5]); w.w = cvt_pk_bf16(o[6], o[7]);
                    *(u32x4*)(rowp + bj * HALF) = w; } }
    }
};

template <bool SB, bool DB> struct EpiResid {
    static constexpr bool PERM = true, AFTER_DRAIN = false, MID = false; static constexpr int SEG = 16;
    const void* src; void* dst;
    __device__ __forceinline__ void operator()(const f32x4 (&acc)[2][2][4][2], const Unit& u, int wr, int wc, int fr, int fq) const {
        const int row0 = u.pm * BM + wr * 64 + fr, col0 = u.pn * BM + wc * 32 + 8 * fq;
        if constexpr (SB) {
            u32x4 rs[2][4][2];
#pragma unroll
            for (int ai = 0; ai < 2; ++ai)
#pragma unroll
                for (int m = 0; m < 4; ++m)
#pragma unroll
                    for (int bj = 0; bj < 2; ++bj) rs[ai][m][bj] = *(const u32x4*)((const bf16_t*)src + (size_t)(row0 + ai * HALF + m * 16) * 4096 + col0 + bj * HALF);
#pragma unroll
            for (int ai = 0; ai < 2; ++ai)
#pragma unroll
                for (int m = 0; m < 4; ++m) { const size_t off = (size_t)(row0 + ai * HALF + m * 16) * 4096 + col0;
#pragma unroll
                    for (int bj = 0; bj < 2; ++bj) { const u32x4 a = rs[ai][m][bj];
                        const f32x4 v0 = (f32x4){bf_lo(a.x), bf_hi(a.x), bf_lo(a.y), bf_hi(a.y)} + acc[ai][bj][m][0], v1 = (f32x4){bf_lo(a.z), bf_hi(a.z), bf_lo(a.w), bf_hi(a.w)} + acc[ai][bj][m][1];
                        if constexpr (DB) { u32x4 w; w.x = cvt_pk_bf16(v0[0], v0[1]); w.y = cvt_pk_bf16(v0[2], v0[3]); w.z = cvt_pk_bf16(v1[0], v1[1]); w.w = cvt_pk_bf16(v1[2], v1[3]);
                            *(u32x4*)((bf16_t*)dst + off + bj * HALF) = w; }
                        else { *(f32x4*)((float*)dst + off + bj * HALF) = v0; *(f32x4*)((float*)dst + off + bj * HALF + 4) = v1; } } }
        } else {
#pragma unroll
            for (int ai = 0; ai < 2; ++ai) { f32x4 rs[4][2][2];
#pragma unroll
                for (int m = 0; m < 4; ++m)
#pragma unroll
                    for (int bj = 0; bj < 2; ++bj) { const float* sp = (const float*)src + (size_t)(row0 + ai * HALF + m * 16) * 4096 + col0 + bj * HALF; rs[m][bj][0] = *(const f32x4*)sp; rs[m][bj][1] = *(const f32x4*)(sp + 4); }
#pragma unroll
                for (int m = 0; m < 4; ++m) { const size_t off = (size_t)(row0 + ai * HALF + m * 16) * 4096 + col0;
#pragma unroll
                    for (int bj = 0; bj < 2; ++bj) { const f32x4 v0 = rs[m][bj][0] + acc[ai][bj][m][0], v1 = rs[m][bj][1] + acc[ai][bj][m][1];
                        if constexpr (DB) { u32x4 w; w.x = cvt_pk_bf16(v0[0], v0[1]); w.y = cvt_pk_bf16(v0[2], v0[3]); w.z = cvt_pk_bf16(v1[0], v1[1]); w.w = cvt_pk_bf16(v1[2], v1[3]);
                            *(u32x4*)((bf16_t*)dst + off + bj * HALF) = w; }
                        else { *(f32x4*)((float*)dst + off + bj * HALF) = v0; *(f32x4*)((float*)dst + off + bj * HALF + 4) = v1; } } }
                asm volatile("" ::: "memory"); }
        }
    }
};

struct EpiSwiGLU {
    static constexpr bool PERM = true, AFTER_DRAIN = false, MID = false; static constexpr int SEG = 16;
    bf16_t* O; int ldc;
    __device__ __forceinline__ void operator()(const f32x4 (&acc)[2][2][4][2], const Unit& u, int wr, int wc, int fr, int fq) const {
        const int row0 = u.pm * BM + wr * 64 + fr; const int col0 = u.pn * HALF + wc * 32 + 8 * fq;
#pragma unroll
        for (int ai = 0; ai < 2; ++ai)
#pragma unroll
            for (int m = 0; m < 4; ++m) { float o[8];
#pragma unroll
                for (int n = 0; n < 2; ++n)
#pragma unroll
                    for (int j = 0; j < 4; ++j) { const float gv = acc[ai][0][m][n][j], uv = acc[ai][1][m][n][j]; o[4 * n + j] = gv * fast_sigmoid(gv) * uv; }
                u32x4 w; w.x = cvt_pk_bf16(o[0], o[1]); w.y = cvt_pk_bf16(o[2], o[3]); w.z = cvt_pk_bf16(o[4], o[5]); w.w = cvt_pk_bf16(o[6], o[7]);
                *(u32x4*)(O + (size_t)(row0 + ai * HALF + m * 16) * ldc + col0) = w; }
    }
};
template <class Epi, class Sched, bool ALIGN_EPI = false, bool SP2 = false>
__device__ __forceinline__ void gemm_phase(PG8_LAS unsigned char* lds, const Gemm g, const Sched& S, const Epi& E, const int tid) {
    const int wid = __builtin_amdgcn_readfirstlane(tid >> 6), lane = tid & 63, wr = wid >> 2, wc = wid & 3, fr = lane & 15, fq = lane >> 4;
    const int K = g.K, nt = K / BK;
    unsigned voffA[2], voffB[2];
#pragma unroll
    for (int i = 0; i < 2; ++i) { int R, C; stage_rc(tid * 16 + i * 8192, R, C); const int Rb = Epi::PERM ? ((R & ~31) + perm32(R & 31)) : R;
        voffA[i] = (unsigned)(R * g.lda + C) * 2u; voffB[i] = (unsigned)(Rb * g.ldb + C) * 2u; }
    const size_t kstep = (size_t)(BK * 2);
    const size_t hstepA = (size_t)HALF * g.lda * 2, hstepB = (size_t)HALF * g.ldb * 2;
    const size_t tstepA = 2 * hstepA, tstepB = 2 * hstepB;
    const unsigned ldsw = (unsigned)wid * 1024u;
    const int aoff = lds_byte(wr * 64 + fr, fq * 8), boff = lds_byte(wc * 32 + fr, fq * 8);
#define PG8_SA(b, h) (((b) * 2 + (h)) * HTB)
#define PG8_SB(b, h) ((4 + (b) * 2 + (h)) * HTB)
#define PG8_STAGE(bufoff, gbase, voff) do { _Pragma("unroll") for (int _i = 0; _i < 2; ++_i) \
        __builtin_amdgcn_global_load_lds((const unsigned*)((const char*)(gbase) + (voff)[_i]), (PG8_LAS unsigned*)(lds + (bufoff) + ldsw + _i * 8192), 16, 0, 0); } while (0)
#define PG8_LDA(dst, b, h) do { _Pragma("unroll") for (int m = 0; m < 4; ++m) _Pragma("unroll") for (int k = 0; k < 2; ++k) dst[m][k] = *(const PG8_LAS bf16x8*)(lds + PG8_SA(b, h) + aoff + m * 2048 + k * 1024); } while (0)
#define PG8_LDB(dst, b, h) do { _Pragma("unroll") for (int n = 0; n < 2; ++n) _Pragma("unroll") for (int k = 0; k < 2; ++k) dst[n][k] = *(const PG8_LAS bf16x8*)(lds + PG8_SB(b, h) + boff + n * 2048 + k * 1024); } while (0)
#define PG8_MMA(ai, bj, At, Bt) do { __builtin_amdgcn_s_setprio(1); _Pragma("unroll") for (int m = 0; m < 4; ++m) _Pragma("unroll") for (int n = 0; n < 2; ++n) _Pragma("unroll") for (int k = 0; k < 2; ++k) \
        acc[ai][bj][m][n] = __builtin_amdgcn_mfma_f32_16x16x32_bf16(Bt[n][k], At[m][k], acc[ai][bj][m][n], 0, 0, 0); __builtin_amdgcn_s_setprio(0); } while (0)
#define PG8_WAIT_V(n) asm volatile("s_waitcnt vmcnt(" #n ")" ::: "memory")
#define PG8_WAIT_L(n) asm volatile("s_waitcnt lgkmcnt(" #n ")" ::: "memory")
#define PG8_BAR __builtin_amdgcn_s_barrier()
#define PG8_SCHED __builtin_amdgcn_sched_barrier(0)
    Unit cur, nxt; int ui = 0;
    if (!S.next(0, cur)) return;
    f32x4 acc[2][2][4][2];
#pragma unroll
    for (int a = 0; a < 2; ++a)
#pragma unroll
        for (int b = 0; b < 2; ++b)
#pragma unroll
            for (int m = 0; m < 4; ++m)
#pragma unroll
                for (int n = 0; n < 2; ++n) acc[a][b][m][n] = (f32x4){0.f, 0.f, 0.f, 0.f};
    bf16x8 At[4][2], B0[2][2], B1[2][2];
    const char* cA = (const char*)g.A + (size_t)cur.pm * tstepA; const char* cB = (const char*)g.Bt + (size_t)cur.pn * tstepB;
    S.a_ready(cur);
    if constexpr (SP2) {
        PG8_STAGE(PG8_SB(0, 0), cB, voffB); PG8_STAGE(PG8_SB(0, 1), cB + hstepB, voffB); PG8_STAGE(PG8_SA(0, 0), cA, voffA); PG8_STAGE(PG8_SA(0, 1), cA + hstepA, voffA);
        if (wr == 1) PG8_BAR;
        PG8_WAIT_V(2); PG8_BAR;
        PG8_STAGE(PG8_SB(1, 0), cB + kstep, voffB); PG8_STAGE(PG8_SA(1, 0), cA + kstep, voffA); PG8_STAGE(PG8_SB(1, 1), cB + hstepB + kstep, voffB);
        PG8_WAIT_V(6); PG8_BAR;
    } else {
        PG8_STAGE(PG8_SB(0, 0), cB, voffB); PG8_STAGE(PG8_SA(0, 0), cA, voffA); PG8_STAGE(PG8_SB(0, 1), cB + hstepB, voffB); PG8_STAGE(PG8_SA(0, 1), cA + hstepA, voffA);
        if (wr == 1) PG8_BAR;
        PG8_WAIT_V(4); PG8_BAR;
        PG8_STAGE(PG8_SB(1, 0), cB + kstep, voffB); PG8_STAGE(PG8_SA(1, 0), cA + kstep, voffA); PG8_STAGE(PG8_SB(1, 1), cB + hstepB + kstep, voffB);
        PG8_WAIT_V(6); PG8_BAR;
    }
    for (;;) {
        const bool has_next = S.next(ui + 1, nxt);
        const char* nA = has_next ? (const char*)g.A + (size_t)nxt.pm * tstepA : cA; const char* nB = has_next ? (const char*)g.Bt + (size_t)nxt.pn * tstepB : cB;
        for (int t = 0; t < nt; t += 2) {
            const bool last = (t == nt - 2);
            const char* a1 = cA + (size_t)(t + 1) * kstep;
            const char* a2 = last ? nA : cA + (size_t)(t + 2) * kstep; const char* b2 = last ? nB : cB + (size_t)(t + 2) * kstep;
            const char* a3 = a2 + kstep; const char* b3 = b2 + kstep;
            if (last && has_next) S.a_ready(nxt);
            if constexpr (SP2) {
            PG8_LDB(B0, 0, 0); PG8_LDB(B1, 0, 1); PG8_SCHED; PG8_LDA(At, 0, 0); PG8_STAGE(PG8_SA(1, 1), a1 + hstepA, voffA);
            PG8_WAIT_V(8); PG8_WAIT_L(0); PG8_BAR; PG8_MMA(0, 0, At, B0); PG8_MMA(0, 1, At, B1); PG8_BAR; PG8_SCHED;
            PG8_LDA(At, 0, 1); PG8_STAGE(PG8_SB(0, 0), b2, voffB); PG8_STAGE(PG8_SB(0, 1), b2 + hstepB, voffB); PG8_STAGE(PG8_SA(0, 0), a2, voffA);
            PG8_WAIT_V(8); PG8_WAIT_L(0); PG8_BAR; PG8_MMA(1, 0, At, B0); PG8_MMA(1, 1, At, B1); PG8_BAR; PG8_SCHED;
            PG8_LDB(B0, 1, 0); PG8_LDB(B1, 1, 1); PG8_SCHED; PG8_LDA(At, 1, 0); PG8_STAGE(PG8_SA(0, 1), a2 + hstepA, voffA);
            PG8_WAIT_V(8); PG8_WAIT_L(0); PG8_BAR; PG8_MMA(0, 0, At, B0); PG8_MMA(0, 1, At, B1); PG8_BAR; PG8_SCHED;
            PG8_LDA(At, 1, 1); PG8_STAGE(PG8_SB(1, 0), b3, voffB); PG8_STAGE(PG8_SB(1, 1), b3 + hstepB, voffB); PG8_STAGE(PG8_SA(1, 0), a3, voffA);
            PG8_WAIT_V(8); PG8_WAIT_L(0); PG8_BAR; PG8_MMA(1, 0, At, B0); PG8_MMA(1, 1, At, B1); PG8_BAR; PG8_SCHED;
            } else {
            PG8_LDB(B0, 0, 0); PG8_SCHED; PG8_LDA(At, 0, 0); PG8_STAGE(PG8_SA(1, 1), a1 + hstepA, voffA);
            PG8_WAIT_L(8); PG8_BAR; PG8_WAIT_L(0); PG8_MMA(0, 0, At, B0); PG8_BAR; PG8_SCHED;
            PG8_LDB(B1, 0, 1); PG8_STAGE(PG8_SB(0, 0), b2, voffB);
            PG8_BAR; PG8_WAIT_L(0); PG8_MMA(0, 1, At, B1); PG8_BAR;
            PG8_LDA(At, 0, 1); PG8_STAGE(PG8_SA(0, 0), a2, voffA);
            PG8_BAR; PG8_WAIT_L(0); PG8_MMA(1, 0, At, B0); PG8_BAR; PG8_SCHED;
            PG8_STAGE(PG8_SB(0, 1), b2 + hstepB, voffB);
            PG8_WAIT_V(6); PG8_BAR; PG8_MMA(1, 1, At, B1); PG8_BAR;
            PG8_LDB(B0, 1, 0); PG8_SCHED; PG8_LDA(At, 1, 0); PG8_STAGE(PG8_SA(0, 1), a2 + hstepA, voffA);
            PG8_WAIT_L(8); PG8_BAR; PG8_WAIT_L(0); PG8_MMA(0, 0, At, B0); PG8_BAR; PG8_SCHED;
            PG8_LDB(B1, 1, 1); PG8_STAGE(PG8_SB(1, 0), b3, voffB);
            PG8_BAR; PG8_WAIT_L(0); PG8_MMA(0, 1, At, B1); PG8_BAR;
            PG8_LDA(At, 1, 1); PG8_STAGE(PG8_SA(1, 0), a3, voffA);
            PG8_BAR; PG8_WAIT_L(0); PG8_MMA(1, 0, At, B0); PG8_BAR; PG8_SCHED;
            PG8_STAGE(PG8_SB(1, 1), b3 + hstepB, voffB);
            PG8_WAIT_V(6); PG8_BAR; PG8_MMA(1, 1, At, B1); PG8_BAR;
            }
            if constexpr (Epi::MID) { if (!last && ((t + 2) % Epi::SEG) == 0) E.mid(acc, cur, (t + 2) / Epi::SEG - 1, wr, wc, fr, fq); }
        }
        if constexpr (ALIGN_EPI) { if (wr == 0) PG8_BAR; }
        if constexpr (!Epi::AFTER_DRAIN) { E(acc, cur, wr, wc, fr, fq); S.done(cur); }
        if (!has_next) break;
#pragma unroll
        for (int a = 0; a < 2; ++a)
#pragma unroll
            for (int b = 0; b < 2; ++b)
#pragma unroll
                for (int m = 0; m < 4; ++m)
#pragma unroll
                    for (int n = 0; n < 2; ++n) acc[a][b][m][n] = (f32x4){0.f, 0.f, 0.f, 0.f};
        cur = nxt; cA = nA; cB = nB; ++ui;
        if constexpr (ALIGN_EPI) { if (wr == 1) PG8_BAR; }
    }
    PG8_WAIT_V(0);
    if constexpr (!ALIGN_EPI) { if (wr == 0) PG8_BAR; }
    PG8_BAR;
    if constexpr (Epi::AFTER_DRAIN) { E.fused(acc, cur, wr, wc, fr, fq, lds, wid, lane); S.done(cur); }
#undef PG8_SA
#undef PG8_SB
#undef PG8_STAGE
#undef PG8_LDA
#undef PG8_LDB
#undef PG8_MMA
#undef PG8_WAIT_V
#undef PG8_WAIT_L
#undef PG8_BAR
#undef PG8_SCHED
}
}
constexpr int D = 4096, TREAL = 8192, NMETA = 16, MROWS = 8448, METAROW = 8192;
constexpr int MIXW = 1024, NPROJ = 29696, NIN = 29704, DFF = 11008, NGU = 22016, NLAYER = 2;
constexpr int PC_MLQ = 0, PC_MLK = 1024, PC_MLV = 2048, PC_MLO = 3072, PC_SBQ = 4096, PC_SBK = 5120, PC_SBV = 6144, PC_HGQ = 7168, PC_HGF = 8192, PC_HGI = 9216, PC_HGG = 10240, PC_RGX = 11264, PC_RGY = 12288, PC_GATE = 13312;
constexpr int NCH = 65;
constexpr float EPS = 1e-6f, NEGF = -1e30f;
constexpr int NWAVES = 8, NTHR = 512;

constexpr size_t MiB = 1u << 20;
constexpr size_t al(size_t x) { return (x + MiB - 1) / MiB * MiB; }
constexpr size_t WS_CTL = 0, CTL_ZERO_BYTES = 1 * MiB;
constexpr size_t SZ_WIN = (size_t)NPROJ * D * 2, SZ_WSQ = (size_t)D * D * 2, SZ_WGU = (size_t)NGU * D * 2, SZ_WD = (size_t)D * DFF * 2;
constexpr size_t WS_WIN = 1 * MiB;
constexpr size_t WS_WUP = WS_WIN + al(2 * SZ_WIN);
constexpr size_t WS_WOUT = WS_WUP + al(2 * SZ_WSQ);
constexpr size_t WS_WGU = WS_WOUT + al(2 * SZ_WSQ);
constexpr size_t WS_WD = WS_WGU + al(2 * SZ_WGU);
constexpr size_t WS_PROJ = WS_WD + al(2 * SZ_WD);
constexpr size_t WS_ACT = WS_PROJ;
constexpr size_t WS_XN = WS_PROJ + al((size_t)MROWS * NPROJ * 2);
constexpr size_t WS_BR = WS_XN + al((size_t)MROWS * D * 2);
constexpr size_t WS_MG = WS_BR + al((size_t)MROWS * D * 2);
constexpr size_t WS_HMETA = WS_MG + al((size_t)MROWS * D * 2);
constexpr size_t WS_GIF = WS_HMETA + al((size_t)256 * D * 4);
constexpr size_t WS_WIF = WS_GIF + al((size_t)MROWS * 8 * 4);
constexpr size_t WS_LB = WS_WIF + al((size_t)2 * 8 * D * 4);
constexpr size_t WS_MLS = WS_LB + MiB;
constexpr size_t WS_MLN = WS_MLS + al((size_t)520 * 65536 * 4);
constexpr size_t WS_MLSC = WS_MLN + al((size_t)520 * 256 * 4);
constexpr size_t WS_HGS = WS_MLSC + MiB;
constexpr size_t WS_HGE = WS_HGS + al((size_t)1040 * 16384 * 4);
constexpr size_t WS_RGH = WS_HGE + al((size_t)1040 * 128 * 4);
constexpr size_t WS_RGP = WS_RGH + al((size_t)MROWS * 1024 * 4);
constexpr size_t WS_RGT = WS_RGP + al((size_t)MROWS * 1024 * 4);
constexpr size_t WS_MLCT = WS_RGT + al((size_t)3 * 2 * 65 * 1024 * 4);
constexpr size_t MLCT_UNIT = (size_t)17 * 8 * 64 * 8;
constexpr size_t WS_HB = WS_MLCT + al((size_t)520 * MLCT_UNIT * 2);
constexpr size_t WS_END = WS_HB + al((size_t)TREAL * D * 2);
static_assert(WS_END <= (size_t)2300 * MiB, "workspace map");
constexpr int CW_BAR = 4096;

constexpr int RING_BYTES = 131072;
constexpr int LDSCTL_OFF = RING_BYTES + 8192, MISC_OFF = LDSCTL_OFF + 320;
constexpr int LDS_BYTES = 147456;
static_assert(MISC_OFF + 128 <= LDS_BYTES, "LDS map");

#define GAS __attribute__((address_space(1)))
#define LAS __attribute__((address_space(3)))
typedef unsigned short bf16;
typedef unsigned v4u __attribute__((ext_vector_type(4)));
typedef unsigned v2u __attribute__((ext_vector_type(2)));
typedef float f32x4 __attribute__((ext_vector_type(4)));
typedef float f32x2 __attribute__((ext_vector_type(2)));
typedef GAS unsigned gu32;
#define RLX_AGENT __ATOMIC_RELAXED, __HIP_MEMORY_SCOPE_AGENT
#define LDS_WAIT() asm volatile("s_waitcnt lgkmcnt(0)" ::: "memory")
#define VM_WAIT() asm volatile("s_waitcnt vmcnt(0)" ::: "memory")
typedef float f32x2c_ __attribute__((ext_vector_type(2)));
typedef __bf16 bf16x2c_ __attribute__((ext_vector_type(2)));
__device__ __forceinline__ unsigned pk2(float lo, float hi) { const f32x2c_ v = {lo, hi}; const bf16x2c_ b = __builtin_convertvector(v, bf16x2c_); return __builtin_bit_cast(unsigned, b); }
__device__ __forceinline__ unsigned f2bf(float f) { const __bf16 b = (__bf16)f; return (unsigned)__builtin_bit_cast(unsigned short, b); }
__device__ __forceinline__ float bflo(unsigned w) { return __uint_as_float(w << 16); }
__device__ __forceinline__ float bfhi(unsigned w) { return __uint_as_float(w & 0xffff0000u); }
__device__ __forceinline__ float bf1(bf16 b) { return __uint_as_float(((unsigned)b) << 16); }
__device__ __forceinline__ void unpack8(const v4u w, float (&o)[8]) { o[0] = bflo(w.x); o[1] = bfhi(w.x); o[2] = bflo(w.y); o[3] = bfhi(w.y); o[4] = bflo(w.z); o[5] = bfhi(w.z); o[6] = bflo(w.w); o[7] = bfhi(w.w); }
__device__ __forceinline__ float wave_sum(float v) {
#pragma unroll
    for (int o = 1; o < 64; o <<= 1) v += __shfl_xor(v, o);
    return v;
}
__device__ __forceinline__ float wave_max(float v) {
#pragma unroll
    for (int o = 1; o < 64; o <<= 1) v = fmaxf(v, __shfl_xor(v, o));
    return v;
}
__device__ __forceinline__ float wave_incl_sum(float v, int lane) {
#pragma unroll
    for (int o = 1; o < 64; o <<= 1) { const float t = __shfl_up(v, o); if (lane >= o) v += t; }
    return v;
}
__device__ __forceinline__ float wave_incl_max(float v, int lane) {
#pragma unroll
    for (int o = 1; o < 64; o <<= 1) { const float t = __shfl_up(v, o); if (lane >= o) v = fmaxf(v, t); }
    return v;
}
__device__ __forceinline__ float sigmoidf_(float x) { return __builtin_amdgcn_rcpf(1.0f + __expf(-x)); }
__device__ __forceinline__ float log_sigmoidf_(float x) { return fminf(x, 0.f) - log1pf(expf(-fabsf(x))); }
__device__ __forceinline__ float softplusf_(float x) { return fmaxf(x, 0.f) + log1pf(expf(-fabsf(x))); }
__device__ __forceinline__ int seq_row(int b, int p) { return p < NMETA ? METAROW + p : b * 4096 + p - NMETA; }
#define XB_TMO      128
#define XB_XCNT(j)  (256  + 64 * (j))
#define XB_XSUB(j)  (1280 + 64 * (j))
#define XB_XGEN(j)  (2304 + 64 * (j))
#define XB_TOP      3328
#define XB_TOPGEN   3392
#define XCD_BAR_WORDS 3456
#define XB_SPIN_CAP (1u << 18)

__device__ __forceinline__ unsigned xb_ld(unsigned* p)              { return __hip_atomic_load(p, __ATOMIC_RELAXED, __HIP_MEMORY_SCOPE_AGENT); }
__device__ __forceinline__ unsigned xb_add(unsigned* p, unsigned v) { return __hip_atomic_fetch_add(p, v, __ATOMIC_RELAXED, __HIP_MEMORY_SCOPE_AGENT); }
__device__ __forceinline__ unsigned xb_xcc_id() { return (unsigned)__builtin_amdgcn_s_getreg((3 << 11) | 20) & 0xFu; }
#define XB_SPIN(cond, bar) do { unsigned _sp = 0; while (cond) { __builtin_amdgcn_s_sleep(1); \
    if ((++_sp & 255u) == 0u) { if (xb_ld(&(bar)[XB_TMO])) break; if (_sp > XB_SPIN_CAP) { atomicAdd(&(bar)[XB_TMO], 1u); break; } } } } while (0)

struct XcdBarrier {
    unsigned* bar; unsigned x;
    volatile LAS unsigned* st;
};

__device__ __forceinline__ XcdBarrier xcd_barrier_post(unsigned* bar, volatile LAS unsigned* st) {
    XcdBarrier b; b.bar = bar; b.x = xb_xcc_id(); b.st = st;
    if (threadIdx.x == 0) (void)xb_add(&bar[XB_XCNT(b.x)], 1u);
    return b;
}
__device__ __forceinline__ void xcd_barrier_complete(unsigned* bar, unsigned x, unsigned& nloc, unsigned& nx) {
    const unsigned G = gridDim.x * gridDim.y * gridDim.z;
    unsigned sum, cnt, mine, sp = 0u;
    for (;;) {
        sum = 0u; cnt = 0u; mine = 0u;
#pragma unroll
        for (unsigned j = 0; j < 16; ++j) { const unsigned c = xb_ld(&bar[XB_XCNT(j)]); sum += c; cnt += (c > 0u) ? 1u : 0u; mine = (j == x) ? c : mine; }
        if (sum == G) break;
        __builtin_amdgcn_s_sleep(1);
        if ((++sp & 255u) == 0u) { if (xb_ld(&bar[XB_TMO])) break; if (sp > XB_SPIN_CAP) { atomicAdd(&bar[XB_TMO], 1u); break; } }
    }
    nloc = mine > 0u ? mine : 1u; nx = cnt > 0u ? cnt : 1u;
}

__device__ __forceinline__ void xcd_barrier(const XcdBarrier& b) {
    asm volatile("s_waitcnt vmcnt(0)" ::: "memory");
    __syncthreads();
    if (threadIdx.x == 0) {
        unsigned* bar = b.bar;
        __builtin_amdgcn_s_waitcnt(0);
        unsigned nloc = b.st[0], nx = b.st[1];
        if (nloc == 0u) { xcd_barrier_complete(bar, b.x, nloc, nx); b.st[0] = nloc; b.st[1] = nx; }
        const unsigned old = xb_add(&bar[XB_XSUB(b.x)], 1u);
        const unsigned gen = old / nloc;
        if (old + 1u == (gen + 1u) * nloc) {
            __builtin_amdgcn_fence(__ATOMIC_RELEASE, "agent");
            asm volatile("s_waitcnt vmcnt(0)" ::: "memory");
            const unsigned og = xb_add(&bar[XB_TOP], 1u);
            const unsigned tg = og / nx;
            if (og + 1u == (tg + 1u) * nx) xb_add(&bar[XB_TOPGEN], 1u);
            else XB_SPIN(xb_ld(&bar[XB_TOPGEN]) == tg, bar);
            __builtin_amdgcn_fence(__ATOMIC_ACQUIRE, "agent");
            xb_add(&bar[XB_XGEN(b.x)], 1u);
            asm volatile("s_waitcnt vmcnt(0)" ::: "memory");
        } else {
            XB_SPIN(xb_ld(&bar[XB_XGEN(b.x)]) == gen, bar);
            __builtin_amdgcn_fence(__ATOMIC_ACQUIRE, "agent");
            asm volatile("s_waitcnt vmcnt(0)" ::: "memory");
        }
    }
    __syncthreads();
}
template <int N> __device__ __forceinline__ float dpp_shr16(float v) { return __builtin_bit_cast(float, __builtin_amdgcn_update_dpp(0, __builtin_bit_cast(int, v), 0x110 + N, 0xf, 0xf, true)); }
typedef __bf16 bf16x2v __attribute__((ext_vector_type(2)));
__device__ __forceinline__ float dot2bf(unsigned a, unsigned b, float acc) { return __builtin_amdgcn_fdot2_f32_bf16(__builtin_bit_cast(bf16x2v, a), __builtin_bit_cast(bf16x2v, b), acc, false); }
typedef short bf16x8v __attribute__((ext_vector_type(8)));
#define MFMA16(a, b, c) __builtin_amdgcn_mfma_f32_16x16x32_bf16(a, b, c, 0, 0, 0)
__device__ __forceinline__ bf16x8v pack8(const float (&x)[8]) { v4u w; w.x = pk2(x[0], x[1]); w.y = pk2(x[2], x[3]); w.z = pk2(x[4], x[5]); w.w = pk2(x[6], x[7]); return __builtin_bit_cast(bf16x8v, w); }
__device__ __forceinline__ float fast_sigmoid_(float x) { return __builtin_amdgcn_rcpf(1.0f + __expf(-x)); }
struct P0Item { const float* src; bf16* dst; int ldw, K; };
struct P0Strip { const float* src0; bf16* dst0; int ldw, K, kb_lo, kb_n; };
constexpr int NSTRIP_DN = 2 * NLAYER * 64, NSTRIP_L = 464 + 344 + 64 + 64, NSTRIP = NSTRIP_DN + NLAYER * NSTRIP_L;
__device__ __forceinline__ P0Strip p0_strip(const float* const* in, unsigned char* ws, int s) {
    P0Strip o;
    if (s < NSTRIP_DN) { const int l = s >> 7, rem = s & 127, nb = rem >> 1, half = rem & 1;
        o.ldw = D; o.K = DFF; o.src0 = in[22] + (size_t)l * DFF * D + 64 * nb; o.dst0 = (bf16*)(ws + WS_WD + (size_t)l * SZ_WD) + (size_t)(64 * nb) * DFF; o.kb_lo = 86 * half; o.kb_n = 86; return o; }
    s -= NSTRIP_DN; const int l = s / NSTRIP_L; int r = s - l * NSTRIP_L; o.K = D; o.kb_lo = 0; o.kb_n = 64;
    if (r < 464) { o.ldw = NIN; o.src0 = in[4] + (size_t)l * D * NIN + 64 * r + (r >= 64 ? 8 : 0); o.dst0 = (bf16*)(ws + WS_WIN + (size_t)l * SZ_WIN) + (size_t)(64 * r) * D; return o; } r -= 464;
    if (r < 344) { const int which = r / 172, nb = r % 172, n0 = 64 * nb; o.ldw = DFF; o.src0 = in[20 + which] + (size_t)l * D * DFF + n0; o.dst0 = (bf16*)(ws + WS_WGU + (size_t)l * SZ_WGU) + (size_t)((n0 >> 7) * 256 + which * 128 + (n0 & 127)) * D; return o; } r -= 344;
    if (r < 64) { o.ldw = D; o.src0 = in[18] + (size_t)l * D * D + 64 * r; o.dst0 = (bf16*)(ws + WS_WUP + (size_t)l * SZ_WSQ) + (size_t)(64 * r) * D; return o; } r -= 64;
    { o.ldw = D; o.src0 = in[19] + (size_t)l * D * D + 64 * r; o.dst0 = (bf16*)(ws + WS_WOUT + (size_t)l * SZ_WSQ) + (size_t)(64 * r) * D; return o; }
}
__device__ __forceinline__ P0Item p0_item(const P0Strip& S, int kb) { P0Item o; o.src = S.src0 + (size_t)(64 * kb) * S.ldw; o.dst = S.dst0 + 64 * kb; o.ldw = S.ldw; o.K = S.K; return o; }
__device__ __forceinline__ void p0_load(const P0Item& I, f32x4 (&v)[16], int lane) {
    const float* p = I.src + (size_t)(2 * (lane >> 4)) * I.ldw + 4 * (lane & 15);
#pragma unroll
#if defined(P0_NT)
    for (int j = 0; j < 16; ++j) v[j] = __builtin_nontemporal_load((const f32x4*)(p + (size_t)(8 * (j >> 1) + (j & 1)) * I.ldw));
#else
    for (int j = 0; j < 16; ++j) v[j] = *(const f32x4*)(p + (size_t)(8 * (j >> 1) + (j & 1)) * I.ldw);
#endif
}
__device__ __forceinline__ void p0_store(const P0Item& I, const f32x4 (&v)[16], unsigned* scr, int lane) {
    const int l15 = lane & 15, l4 = lane >> 4;
#pragma unroll
    for (int m = 0; m < 8; ++m)
#pragma unroll
        for (int i = 0; i < 4; ++i) scr[(4 * l15 + i) * 33 + 4 * m + l4] = pk2(v[2 * m][i], v[2 * m + 1][i]);
    LDS_WAIT(); asm volatile("" ::: "memory");
    const int c = lane & 7;
#pragma unroll
    for (int j = 0; j < 8; ++j) { const int n = (lane >> 3) + 8 * j; const unsigned* s = scr + n * 33 + 4 * c;
        v4u o; o.x = s[0]; o.y = s[1]; o.z = s[2]; o.w = s[3];
        *(v4u*)(I.dst + (size_t)n * I.K + 8 * c) = o; }
    LDS_WAIT(); asm volatile("" ::: "memory");
}
__device__ __forceinline__ void p0_prologue(const float* const* in, unsigned char* ws, unsigned char* lds, int bxp, int Gp, int wave, int lane, int gtid, int NGT) {
    unsigned* scr = (unsigned*)(lds + wave * 16384);
    const float* w_in = in[4];
#if defined(PROBE_P0_STORES)
    for (int sidx = bxp; sidx < NSTRIP; sidx += Gp) { const P0Strip S = p0_strip(in, ws, sidx); const int hi = S.kb_lo + S.kb_n;
        for (int kb = S.kb_lo + wave; kb < hi; kb += NWAVES) { const P0Item I = p0_item(S, kb); const int c = lane & 7;
#pragma unroll
            for (int j = 0; j < 8; ++j) { const int n = (lane >> 3) + 8 * j; *(v4u*)(I.dst + (size_t)n * I.K + 8 * c) = (v4u){(unsigned)kb, (unsigned)j, 0u, 0u}; } } }
    VM_WAIT(); __syncthreads();
#endif
#if defined(PROBE_P0_LOADS)
    for (int sidx = bxp; sidx < NSTRIP; sidx += Gp) { const P0Strip S = p0_strip(in, ws, sidx); const int hi = S.kb_lo + S.kb_n; f32x4 va[16];
        for (int kb = S.kb_lo + wave; kb < hi; kb += NWAVES) { p0_load(p0_item(S, kb), va, lane);
#pragma unroll
            for (int j = 0; j < 16; ++j) asm volatile("" :: "v"(va[j])); } }
    VM_WAIT(); __syncthreads();
#endif
    for (int sidx = bxp; sidx < NSTRIP; sidx += Gp) {
        const P0Strip S = p0_strip(in, ws, sidx); const int hi = S.kb_lo + S.kb_n; int kb = S.kb_lo + wave; f32x4 va[16], vb[16];
        if (kb < hi) p0_load(p0_item(S, kb), va, lane);
        while (kb < hi) {
            const int k1 = kb + NWAVES; if (k1 < hi) p0_load(p0_item(S, k1), vb, lane);
            p0_store(p0_item(S, kb), va, scr, lane);
            if (k1 >= hi) break;
            const int k2 = k1 + NWAVES; if (k2 < hi) p0_load(p0_item(S, k2), va, lane);
            p0_store(p0_item(S, k1), vb, scr, lane);
            kb = k2; }
    }
    { float* hm = (float*)(ws + WS_HMETA); const float* meta = in[1];
      for (int i = gtid; i < 256 * D; i += NGT) hm[i] = (i < NMETA * D) ? meta[i] : 0.f; }
    { unsigned* brp = (unsigned*)(ws + WS_BR + (size_t)(TREAL + NMETA) * D * 2);
      for (int i = gtid; i < (MROWS - TREAL - NMETA) * D / 2; i += NGT) brp[i] = 0u; }
    { float* wif = (float*)(ws + WS_WIF);
      for (int it = bxp * NWAVES + wave; it < NLAYER * 64; it += Gp * NWAVES) { const int l = it >> 6, k = 64 * (it & 63) + lane;
          const float* p = w_in + ((size_t)l * D + k) * NIN + 4096; const f32x4 a = *(const f32x4*)p, b = *(const f32x4*)(p + 4);
          float* wq = wif + (size_t)l * 8 * D + k;
          wq[0] = a.x; wq[D] = a.y; wq[2 * D] = a.z; wq[3 * D] = a.w; wq[4 * D] = b.x; wq[5 * D] = b.y; wq[6 * D] = b.z; wq[7 * D] = b.w; } }
    { float* lb = (float*)(ws + WS_LB); const float* hl = in[9];
      for (int i = gtid; i < 1024; i += NGT) { const float a0 = hl[i], a1 = hl[1024 + i], mx = fmaxf(a0, a1), e0 = expf(a0 - mx), e1 = expf(a1 - mx); const float p1 = e1 / (e0 + e1);
          lb[i] = 0.f; lb[1024 + i] = fminf(fmaxf(p1, 0.f), 0.999f); } }
}

template <bool GATES, bool HBF> __device__ __forceinline__ void norm_rows(const void* hreal, const float* hmeta, const float* gain, bf16* XN, int nrows, const float* wif_g, const float* bif, float* gif, int gw, int NGW, int lane, unsigned char* lds, int tid) {
    const float* wif = (const float*)lds;
    if (GATES) {
        for (int i = tid; i < 8 * D / 4; i += NTHR) *(f32x4*)(lds + (size_t)i * 16) = *(const f32x4*)(wif_g + (size_t)i * 4);
        __syncthreads(); }
    for (int row = gw; row < nrows; row += NGW) {
        f32x4 v[16]; float ss = 0.f;
        const bool real_bf = HBF && row < TREAL;
        const float* hr = row < TREAL ? (const float*)hreal + (size_t)row * D : hmeta + (size_t)(row - TREAL) * D;
        const bf16* hb = (const bf16*)hreal + (size_t)row * D;
#pragma unroll
        for (int j = 0; j < 8; ++j) {
            if (real_bf) { const v4u a = *(const v4u*)(hb + 512 * j + 8 * lane); v[2 * j] = (f32x4){bflo(a.x), bfhi(a.x), bflo(a.y), bfhi(a.y)}; v[2 * j + 1] = (f32x4){bflo(a.z), bfhi(a.z), bflo(a.w), bfhi(a.w)}; }
            else { const float* p = hr + 512 * j + 8 * lane; v[2 * j] = *(const f32x4*)p; v[2 * j + 1] = *(const f32x4*)(p + 4); }
            ss += (v[2 * j].x * v[2 * j].x + v[2 * j].y * v[2 * j].y) + (v[2 * j].z * v[2 * j].z + v[2 * j].w * v[2 * j].w) + (v[2 * j + 1].x * v[2 * j + 1].x + v[2 * j + 1].y * v[2 * j + 1].y) + (v[2 * j + 1].z * v[2 * j + 1].z + v[2 * j + 1].w * v[2 * j + 1].w); }
        const float rstd = __builtin_amdgcn_rsqf(wave_sum(ss) * (1.0f / D) + EPS);
#pragma unroll
        for (int j = 0; j < 8; ++j) { const float* gp = gain + 512 * j + 8 * lane; const f32x4 g0 = *(const f32x4*)gp, g1 = *(const f32x4*)(gp + 4);
            v[2 * j] = v[2 * j] * rstd * g0; v[2 * j + 1] = v[2 * j + 1] * rstd * g1;
            v4u o; o.x = pk2(v[2 * j].x, v[2 * j].y); o.y = pk2(v[2 * j].z, v[2 * j].w); o.z = pk2(v[2 * j + 1].x, v[2 * j + 1].y); o.w = pk2(v[2 * j + 1].z, v[2 * j + 1].w);
            *(v4u*)(XN + (size_t)row * D + 512 * j + 8 * lane) = o; }
        if (GATES) { float mine = 0.f;
#pragma unroll 1
            for (int jj = 0; jj < 8; ++jj) { float dot = 0.f; const float* wp = wif + jj * D + 8 * lane;
#pragma unroll
                for (int j = 0; j < 8; ++j) { const f32x4 w0 = *(const f32x4*)(wp + 512 * j), w1 = *(const f32x4*)(wp + 512 * j + 4);
                    dot += (v[2 * j].x * w0.x + v[2 * j].y * w0.y) + (v[2 * j].z * w0.z + v[2 * j].w * w0.w) + (v[2 * j + 1].x * w1.x + v[2 * j + 1].y * w1.y) + (v[2 * j + 1].z * w1.z + v[2 * j + 1].w * w1.w); }
                dot = wave_sum(dot); if (lane == jj) mine = dot + bif[jj]; }
            if (lane < 8) gif[(size_t)row * 8 + lane] = mine; }
    }
}

__device__ __forceinline__ void mlstm_A(const bf16* PROJ, const float* GIF, float* MLS, float* MLN, float* MLSC, int u, unsigned char* lds, int tid) {
    const int c = u % NCH, bh = u / NCH, h = bh & 3, b = bh >> 2, lane = tid & 63, wave = tid >> 6, lc = lane & 15, g = lane >> 4;
    constexpr int QP = 264;
    bf16* kw = (bf16*)lds; bf16* vs = (bf16*)(lds + 33792); float* wsc = (float*)(lds + RING_BYTES);
    if (tid < 64) {
        const int p = 64 * c + lane - 48; float lf = 0.f, li = NEGF;
        if (p >= 0) { const int row = seq_row(b, p); li = GIF[(size_t)row * 8 + h]; lf = log_sigmoidf_(GIF[(size_t)row * 8 + 4 + h]); }
        const float bc = wave_incl_sum(lf, lane); const float bend = __shfl(bc, 63);
        const float wl = bend - bc + li; const float a = wave_max(wl);
        wsc[lane] = expf(wl - a);
        if (lane == 0) { MLSC[u] = a; MLSC[520 + u] = bend; }
    }
    __syncthreads();
#pragma unroll
    for (int j = 0; j < 4; ++j) { const int id = tid + 512 * j, r = id >> 5, cp = id & 31, p = 64 * c + r - 48;
        v4u vr = (v4u){0u, 0u, 0u, 0u}; float kv[8];
#pragma unroll
        for (int q = 0; q < 8; ++q) kv[q] = 0.f;
        if (p >= 0) { const size_t ro = (size_t)seq_row(b, p) * NPROJ + h * 256 + cp * 8; unpack8(*(const v4u*)(PROJ + ro + PC_MLK), kv); vr = *(const v4u*)(PROJ + ro + PC_MLV); const float w = wsc[r];
#pragma unroll
            for (int q = 0; q < 8; ++q) kv[q] *= w; }
        *(bf16x8v*)(kw + r * QP + cp * 8) = pack8(kv); *(v4u*)(vs + r * QP + cp * 8) = vr; }
    __syncthreads();
    bf16x8v af[2][2];
#pragma unroll
    for (int dt = 0; dt < 2; ++dt)
#pragma unroll
        for (int ks = 0; ks < 2; ++ks)
#pragma unroll
            for (int i = 0; i < 8; ++i) af[dt][ks][i] = (short)kw[(32 * ks + 8 * g + i) * QP + 32 * wave + 16 * dt + lc];
    bf16* out = (bf16*)MLS + (size_t)u * MLCT_UNIT;
    for (int et = 0; et < 17; ++et) { bf16x8v bv[2];
#pragma unroll
        for (int ks = 0; ks < 2; ++ks)
#pragma unroll
            for (int i = 0; i < 8; ++i) bv[ks][i] = (et < 16) ? (short)vs[(32 * ks + 8 * g + i) * QP + 16 * et + lc] : ((lc == 0) ? (short)0x3F80 : (short)0);
#pragma unroll
        for (int dt = 0; dt < 2; ++dt) { f32x4 acc = (f32x4){0.f, 0.f, 0.f, 0.f};
#pragma unroll
            for (int ks = 0; ks < 2; ++ks) acc = MFMA16(af[dt][ks], bv[ks], acc);
            const int d0 = 32 * wave + 16 * dt + 4 * g;
            if (et < 16) { v2u w; w.x = pk2(acc[0], acc[1]); w.y = pk2(acc[2], acc[3]);
                *(v2u*)(out + ((size_t)(et * 8 + wave) * 64 + lc + 16 * (2 * dt + (g >> 1))) * 8 + 4 * (g & 1)) = w; }
            else if (lc == 0) {
#pragma unroll
                for (int r = 0; r < 4; ++r) MLN[(size_t)u * 256 + d0 + r] = acc[r]; } } }
    __syncthreads();
}
__device__ __forceinline__ void mlstm_B(const float* MLS, const float* MLN, float* MLSC, bf16* MLCT, int unit, unsigned char* lds, int tid) {
    const int chain = unit >> 5, slice = unit & 31;
    float* alpha = (float*)lds; float* beta = alpha + 80; float* av = alpha + 160; float* bv = alpha + 240; float* mm = alpha + 320;
    if (tid < NCH) { av[tid] = MLSC[chain * NCH + tid]; bv[tid] = MLSC[520 + chain * NCH + tid]; }
    __syncthreads();
    if (tid == 0) { float m = 0.f;
        for (int c = 0; c < NCH; ++c) { mm[c] = m; m = fmaxf(bv[c] + m, av[c]); } mm[NCH] = m; }
    __syncthreads();
    if (tid < NCH) { const float m = mm[tid], mn = mm[tid + 1]; alpha[tid] = __expf(bv[tid] + m - mn); beta[tid] = __expf(av[tid] - mn); if (slice == 0) MLSC[1040 + chain * NCH + tid] = m; }
    __syncthreads();
    { const int gid = slice * 512 + tid, e = gid & 255, d4 = gid >> 8; float st[4];
#pragma unroll
      for (int i = 0; i < 4; ++i) st[i] = 0.f;
      const size_t fo = ((size_t)((e >> 4) * 8 + (d4 >> 3)) * 64 + (e & 15) + 16 * ((d4 >> 1) & 3)) * 8 + 4 * (d4 & 1);
#pragma unroll 4
      for (int c = 0; c < NCH; ++c) { const size_t uu = (size_t)chain * NCH + c; const v2u dw = *(const v2u*)((const bf16*)MLS + uu * MLCT_UNIT + fo); const float dl[4] = {bflo(dw.x), bfhi(dw.x), bflo(dw.y), bfhi(dw.y)};
          v2u w; w.x = pk2(st[0], st[1]); w.y = pk2(st[2], st[3]); *(v2u*)(MLCT + uu * MLCT_UNIT + fo) = w;
          const float al_ = alpha[c], be_ = beta[c];
#pragma unroll
          for (int i = 0; i < 4; ++i) st[i] = st[i] * al_ + dl[i] * be_; } }
    if (slice == 0) { const int ks = tid >> 6, l = tid & 63; const bool own = (l & 15) == 0; const int d0 = 32 * ks + 8 * (l >> 4); float st[8];
#pragma unroll
      for (int i = 0; i < 8; ++i) st[i] = 0.f;
#pragma unroll 5
      for (int c = 0; c < NCH; ++c) { const size_t uu = (size_t)chain * NCH + c; const f32x4 n0 = *(const f32x4*)(MLN + uu * 256 + d0), n1 = *(const f32x4*)(MLN + uu * 256 + d0 + 4);
          const float sel = own ? 1.f : 0.f; const float dl[8] = {n0.x * sel, n0.y * sel, n0.z * sel, n0.w * sel, n1.x * sel, n1.y * sel, n1.z * sel, n1.w * sel};
          *(bf16x8v*)(MLCT + uu * MLCT_UNIT + ((size_t)(16 * 8 + ks) * 64 + l) * 8) = pack8(st);
          const float al_ = alpha[c], be_ = beta[c];
#pragma unroll
          for (int i = 0; i < 8; ++i) st[i] = st[i] * al_ + dl[i] * be_; } }
    __syncthreads();
}
template <bool DEN> __device__ __forceinline__ void ml_tile(const bf16* CT, const bf16* Qs, const bf16* Sp, const bf16* Vs, const float* inter, int j, f32x4 (&acc)[4], int lane) {
    constexpr int QP = 264, SP = 72; const int lc = lane & 15, g = lane >> 4;
    bf16x8v bfr[8];
#pragma unroll
    for (int ks = 0; ks < 8; ++ks) bfr[ks] = *(const bf16x8v*)(CT + ((size_t)(j * 8 + ks) * 64 + lane) * 8);
#pragma unroll
    for (int m = 0; m < 4; ++m) acc[m] = (f32x4){0.f, 0.f, 0.f, 0.f};
#pragma unroll
    for (int ks = 0; ks < 8; ++ks) {
#pragma unroll
        for (int m = 0; m < 4; ++m) acc[m] = MFMA16(*(const bf16x8v*)(Qs + (16 * m + lc) * QP + 32 * ks + 8 * g), bfr[ks], acc[m]);
        asm volatile("" ::: "memory"); }
#pragma unroll
    for (int m = 0; m < 4; ++m)
#pragma unroll
        for (int r = 0; r < 4; ++r) acc[m][r] *= inter[16 * m + 4 * g + r];
#pragma unroll
    for (int ks = 0; ks < 2; ++ks) { bf16x8v vf;
        if (!DEN) {
#pragma unroll
            for (int i = 0; i < 8; ++i) vf[i] = (short)Vs[(32 * ks + 8 * g + i) * QP + 16 * j + lc]; }
        else {
#pragma unroll
            for (int i = 0; i < 8; ++i) vf[i] = (lc == 0) ? (short)0x3F80 : (short)0; }
#pragma unroll
        for (int m = 0; m < 4; ++m) acc[m] = MFMA16(*(const bf16x8v*)(Sp + (16 * m + lc) * SP + 32 * ks + 8 * g), vf, acc[m]);
        asm volatile("" ::: "memory"); }
}
__device__ __forceinline__ void mlstm_C(const bf16* PROJ, const float* GIF, const bf16* MLCT, const float* MLSC, const float* ml_norm, bf16* BRp, int u, unsigned char* lds, int tid) {
    const int c = u % NCH, bh = u / NCH, h = bh & 3, b = bh >> 2, lane = tid & 63, wave = tid >> 6, lc = lane & 15, g = lane >> 4;
    constexpr int QP = 264, SP = 72;
    bf16* Qs = (bf16*)lds; bf16* Ks = (bf16*)(lds + 33792); bf16* Vs = (bf16*)(lds + 67584); bf16* Sp = (bf16*)(lds + 101376);
    float* bcs = (float*)(lds + RING_BYTES); float* lis = bcs + 64; float* mout = lis + 64; float* inter = mout + 64; float* den = inter + 64; float* rstd = den + 64; float* part = rstd + 64;
    if (tid < 64) {
        const int p = 64 * c + lane - 48; float lf = 0.f, li = NEGF;
        if (p >= 0) { const int row = seq_row(b, p); li = GIF[(size_t)row * 8 + h]; lf = log_sigmoidf_(GIF[(size_t)row * 8 + 4 + h]); }
        const float bc = wave_incl_sum(lf, lane); const float pm = wave_incl_max(li - bc, lane); const float mc = MLSC[1040 + u];
        const float mo = fmaxf(bc + mc, bc + pm);
        bcs[lane] = bc; lis[lane] = li; mout[lane] = mo; inter[lane] = expf(bc + mc - mo) * 0.0625f;
    }
#pragma unroll
    for (int j = 0; j < 4; ++j) { const int id = tid + 512 * j, r = id >> 5, cp = id & 31, p = 64 * c + r - 48;
        v4u qr = (v4u){0u, 0u, 0u, 0u}, kr = qr, vr = qr;
        if (p >= 0) { const size_t ro = (size_t)seq_row(b, p) * NPROJ + h * 256 + cp * 8; qr = *(const v4u*)(PROJ + ro + PC_MLQ); kr = *(const v4u*)(PROJ + ro + PC_MLK); vr = *(const v4u*)(PROJ + ro + PC_MLV); }
        *(v4u*)(Qs + r * QP + cp * 8) = qr; *(v4u*)(Ks + r * QP + cp * 8) = kr; *(v4u*)(Vs + r * QP + cp * 8) = vr; }
    __syncthreads();
    {
        const int tr = wave >> 1;
#pragma unroll
        for (int q = 0; q < 2; ++q) { const int tc = 2 * (wave & 1) + q; f32x4 a = (f32x4){0.f, 0.f, 0.f, 0.f};
#pragma unroll
            for (int ks = 0; ks < 8; ++ks) a = MFMA16(*(const bf16x8v*)(Qs + (16 * tr + lc) * QP + 32 * ks + 8 * g), *(const bf16x8v*)(Ks + (16 * tc + lc) * QP + 32 * ks + 8 * g), a);
            const int s = 16 * tc + lc; const float bs = bcs[s], ls = lis[s];
#pragma unroll
            for (int r = 0; r < 4; ++r) { const int t = 16 * tr + 4 * g + r; float val = 0.f; if (s <= t) val = a[r] * 0.0625f * __expf(bcs[t] - bs + ls - mout[t]);
                Sp[t * SP + s] = (bf16)f2bf(val); } } }
    __syncthreads();
    const bf16* CT = MLCT + (size_t)u * MLCT_UNIT;
    if (wave == 0) { f32x4 ad[4]; ml_tile<true>(CT, Qs, Sp, Vs, inter, 16, ad, lane);
        if (lc == 0) {
#pragma unroll
            for (int m = 0; m < 4; ++m)
#pragma unroll
                for (int r = 0; r < 4; ++r) den[16 * m + 4 * g + r] = ad[m][r]; } }
    f32x4 a0[4], a1[4];
    ml_tile<false>(CT, Qs, Sp, Vs, inter, wave, a0, lane); ml_tile<false>(CT, Qs, Sp, Vs, inter, wave + 8, a1, lane);
    __syncthreads();
#pragma unroll
    for (int m = 0; m < 4; ++m)
#pragma unroll
        for (int r = 0; r < 4; ++r) { const int t = 16 * m + 4 * g + r; const float dinv = __builtin_amdgcn_rcpf(fmaxf(fabsf(den[t]), __expf(-mout[t])));
            a0[m][r] *= dinv; a1[m][r] *= dinv; float sq = a0[m][r] * a0[m][r] + a1[m][r] * a1[m][r];
            sq += __shfl_xor(sq, 1); sq += __shfl_xor(sq, 2); sq += __shfl_xor(sq, 4); sq += __shfl_xor(sq, 8);
            if (lc == 0) part[wave * 64 + t] = sq; }
    __syncthreads();
    if (tid < 64) { float sq = 0.f;
#pragma unroll
        for (int w = 0; w < 8; ++w) sq += part[w * 64 + tid];
        rstd[tid] = __builtin_amdgcn_rsqf(sq * (1.0f / 256.0f) + EPS); }
    __syncthreads();
    { const int e0 = 16 * wave + lc, e1 = e0 + 128; const float g0 = ml_norm[h * 256 + e0], g1 = ml_norm[h * 256 + e1];
#pragma unroll
      for (int m = 0; m < 4; ++m)
#pragma unroll
          for (int r = 0; r < 4; ++r) { const int t = 16 * m + 4 * g + r, p = 64 * c + t - 48;
              if (p >= 0 && (c > 0 || b == 0)) { const int row = seq_row(b, p); const bf16* op = PROJ + (size_t)row * NPROJ + PC_MLO + h * 256; bf16* bp = BRp + (size_t)row * D + h * 256;
                  bp[e0] = (bf16)f2bf(a0[m][r] * rstd[t] * g0 * sigmoidf_(bf1(op[e0]))); bp[e1] = (bf16)f2bf(a1[m][r] * rstd[t] * g1 * sigmoidf_(bf1(op[e1]))); } } }
    __syncthreads();
}

__device__ __forceinline__ void hg_cumsum(const bf16* PROJ, const float* LB, int b, int h, int c, float* bcs, float* kks, int d) {
    const float lb = LB[h * 128 + d]; float bacc = 0.f;
    for (int t = 0; t < 64; ++t) { const int p = 64 * c + t - 48; float lf = 0.f, kk = 0.f;
        if (p >= 0) { const float fp = bf1(PROJ[(size_t)seq_row(b, p) * NPROJ + PC_HGF + h * 128 + d]); const float sig = sigmoidf_(fp), nsig = sigmoidf_(-fp);
            lf = logf(lb + (1.0f - lb) * sig); kk = (1.0f - lb) * nsig; }
        bacc += lf; bcs[t * 128 + d] = bacc; kks[t * 128 + d] = kk; }
}
__device__ __forceinline__ void hg_A(const bf16* PROJ, const float* LB, float* HGS, float* HGE, int u, unsigned char* lds, int tid) {
    const int c = u % NCH, bh = u / NCH, h = bh & 7, b = bh >> 3;
    float* bcs = (float*)lds; float* kkw = bcs + 64 * 128; float* iv = kkw + 64 * 128;
    for (int id = tid; id < 2048; id += 512) { const int which = id >> 10, r = (id >> 4) & 63, cp = id & 15, p = 64 * c + r - 48; float x[8];
        if (which == 0) {
            float lf[8], kk[8];
            if (p >= 0) { unpack8(*(const v4u*)(PROJ + (size_t)seq_row(b, p) * NPROJ + PC_HGF + h * 128 + cp * 8), x);
#pragma unroll
                for (int q = 0; q < 8; ++q) { const float lb = LB[h * 128 + cp * 8 + q]; const float e = __expf(-fminf(fmaxf(x[q], -60.f), 60.f)); const float sig = __builtin_amdgcn_rcpf(1.0f + e), nsig = e * sig; lf[q] = __logf(lb + (1.0f - lb) * sig); kk[q] = (1.0f - lb) * nsig; } }
            else {
#pragma unroll
                for (int q = 0; q < 8; ++q) { lf[q] = 0.f; kk[q] = 0.f; } }
            *(f32x4*)(bcs + r * 128 + cp * 8) = (f32x4){lf[0], lf[1], lf[2], lf[3]}; *(f32x4*)(bcs + r * 128 + cp * 8 + 4) = (f32x4){lf[4], lf[5], lf[6], lf[7]};
            *(f32x4*)(kkw + r * 128 + cp * 8) = (f32x4){kk[0], kk[1], kk[2], kk[3]}; *(f32x4*)(kkw + r * 128 + cp * 8 + 4) = (f32x4){kk[4], kk[5], kk[6], kk[7]};
            continue; }
        {
            if (p >= 0) unpack8(*(const v4u*)(PROJ + (size_t)seq_row(b, p) * NPROJ + PC_HGI + h * 128 + cp * 8), x);
            else {
#pragma unroll
                for (int q = 0; q < 8; ++q) x[q] = 0.f; }
            *(f32x4*)(iv + r * 128 + cp * 8) = (f32x4){x[0], x[1], x[2], x[3]}; *(f32x4*)(iv + r * 128 + cp * 8 + 4) = (f32x4){x[4], x[5], x[6], x[7]}; } }
    __syncthreads();
    if (tid < 128) { float bacc = 0.f;
#pragma unroll 8
        for (int t = 0; t < 64; ++t) { bacc += bcs[t * 128 + tid]; bcs[t * 128 + tid] = bacc; } }
    __syncthreads();
    constexpr int DP = 136; bf16* kb = (bf16*)kkw; bf16* ib = (bf16*)iv;
    float kvv[16], ivv[16];
#pragma unroll
    for (int k = 0; k < 16; ++k) { const int idx = tid + 512 * k, d = idx & 127; kvv[k] = kkw[idx] * __expf(bcs[63 * 128 + d] - bcs[idx]); ivv[k] = iv[idx]; }
    if (tid < 128) HGE[(size_t)u * 128 + tid] = __expf(bcs[63 * 128 + tid]);
    __syncthreads();
#pragma unroll
    for (int k = 0; k < 16; ++k) { const int idx = tid + 512 * k, d = idx & 127, sr = idx >> 7; kb[sr * DP + d] = (bf16)f2bf(kvv[k]); ib[sr * DP + d] = (bf16)f2bf(ivv[k]); }
    __syncthreads();
    { const int lane = tid & 63, wave = tid >> 6, lc = lane & 15, g = lane >> 4;
      bf16x8v af[2];
#pragma unroll
      for (int ks = 0; ks < 2; ++ks)
#pragma unroll
          for (int i = 0; i < 8; ++i) af[ks][i] = (short)kb[(32 * ks + 8 * g + i) * DP + 16 * wave + lc];
      bf16* out = (bf16*)HGS + (size_t)u * 16384;
#pragma unroll 2
      for (int et = 0; et < 8; ++et) { bf16x8v bv[2];
#pragma unroll
          for (int ks = 0; ks < 2; ++ks)
#pragma unroll
              for (int i = 0; i < 8; ++i) bv[ks][i] = (short)ib[(32 * ks + 8 * g + i) * DP + 16 * et + lc];
          f32x4 acc = (f32x4){0.f, 0.f, 0.f, 0.f};
#pragma unroll
          for (int ks = 0; ks < 2; ++ks) acc = MFMA16(af[ks], bv[ks], acc);
          v2u w; w.x = pk2(acc[0], acc[1]); w.y = pk2(acc[2], acc[3]);
          *(v2u*)(out + ((size_t)(et * 4 + (wave >> 1)) * 64 + lc + 16 * ((2 * wave + (g >> 1)) & 3)) * 8 + 4 * (g & 1)) = w; } }
    __syncthreads();
}
__device__ __forceinline__ void hg_B(float* HGS, const float* HGE, int unit, int tid) {
    const int chain = unit >> 4, slice = unit & 15, x = 2 * (slice * 512 + tid), d = 32 * ((x >> 9) & 3) + 8 * ((x >> 7) & 3) + (x & 7); float s0 = 0.f, s1 = 0.f;
#pragma unroll 5
    for (int c = 0; c < NCH; ++c) { const size_t uu = (size_t)chain * NCH + c; unsigned* p = (unsigned*)((bf16*)HGS + uu * 16384 + x); const unsigned dl = *p; const float e0 = HGE[uu * 128 + d], e1 = HGE[uu * 128 + d + 1];
        *p = pk2(s0, s1); s0 = s0 * e0 + bflo(dl); s1 = s1 * e1 + bfhi(dl); }
}
__device__ __forceinline__ void hg_C(const bf16* PROJ, const float* LB, const float* HGS, const float* hg_norm, bf16* BRp, int u, unsigned char* lds, int tid) {
    const int c = u % NCH, bh = u / NCH, h = bh & 7, b = bh >> 3, lane = tid & 63, wave = tid >> 6, lc = lane & 15, g = lane >> 4;
    constexpr int DP = 136, SP = 72;
    float* bcs = (float*)lds;
    bf16* qs = (bf16*)(lds + 32768);
    bf16* kks = (bf16*)(lds + 50176);
    bf16* It = (bf16*)(lds + 67584);
    bf16* QD = (bf16*)(lds + 86016);
    bf16* KD = (bf16*)(lds + 103424);
    bf16* ATT = (bf16*)(lds + 129536);
    for (int id = tid; id < 3072; id += 512) { const int which = id >> 10, r = (id >> 4) & 63, cp = id & 15, p = 64 * c + r - 48; float x[8];
        if (p >= 0) unpack8(*(const v4u*)(PROJ + (size_t)seq_row(b, p) * NPROJ + (which == 0 ? PC_HGF : (which == 1 ? PC_HGQ : PC_HGI)) + h * 128 + cp * 8), x);
        else {
#pragma unroll
            for (int q = 0; q < 8; ++q) x[q] = 0.f; }
        if (which == 0) { float lf[8], kk[8];
#pragma unroll
            for (int q = 0; q < 8; ++q) { const float lb = LB[h * 128 + cp * 8 + q]; const float e = __expf(-fminf(fmaxf(x[q], -60.f), 60.f)); const float sig = __builtin_amdgcn_rcpf(1.0f + e), nsig = e * sig;
                lf[q] = (p >= 0) ? __logf(lb + (1.0f - lb) * sig) : 0.f; kk[q] = (p >= 0) ? (1.0f - lb) * nsig : 0.f; }
            *(f32x4*)(bcs + r * 128 + cp * 8) = (f32x4){lf[0], lf[1], lf[2], lf[3]}; *(f32x4*)(bcs + r * 128 + cp * 8 + 4) = (f32x4){lf[4], lf[5], lf[6], lf[7]};
            *(bf16x8v*)(kks + r * DP + cp * 8) = pack8(kk); }
        else if (which == 1) {
#pragma unroll
            for (int q = 0; q < 8; ++q) x[q] = x[q] * fast_sigmoid_(x[q]);
            *(bf16x8v*)(qs + r * DP + cp * 8) = pack8(x); }
        else {
#pragma unroll
            for (int q = 0; q < 8; ++q) It[(cp * 8 + q) * SP + r] = (bf16)f2bf(x[q]); } }
    __syncthreads();
    for (int i = tid; i < 64 * SP / 8; i += NTHR) *(v4u*)(ATT + i * 8) = (v4u){0u, 0u, 0u, 0u};
    if (tid < 128) { float bacc = 0.f;
#pragma unroll 8
        for (int t = 0; t < 64; ++t) { bacc += bcs[t * 128 + tid]; bcs[t * 128 + tid] = bacc; } }
    __syncthreads();
#pragma unroll 2
    for (int k = 0; k < 12; ++k) { const int idx = tid + 512 * k, t = 16 + (idx >> 7), d = idx & 127, I = t >> 4;
        QD[t * DP + d] = (bf16)f2bf(bf1(qs[t * DP + d]) * __expf(bcs[t * 128 + d] - bcs[(16 * I - 1) * 128 + d])); }
#pragma unroll 2
    for (int k = 0; k < 24; ++k) { const int idx = tid + 512 * k, row = idx >> 7, d = idx & 127; const int I = row < 16 ? 1 : (row < 48 ? 2 : 3), s = row - (I == 1 ? 0 : (I == 2 ? 16 : 48));
        KD[row * DP + d] = (bf16)f2bf(bf1(kks[s * DP + d]) * __expf(bcs[(16 * I - 1) * 128 + d] - bcs[s * 128 + d])); }
    float q2v[16], k2v[16], qev[16];
#pragma unroll
    for (int k = 0; k < 16; ++k) { const int idx = tid + 512 * k, t = idx >> 7, d = idx & 127, mid = 16 * (t >> 4) + 7; const float bt = bcs[idx], bm = bcs[mid * 128 + d], qv = bf1(qs[t * DP + d]);
        q2v[k] = qv * __expf(fminf(bt - bm, 80.f)); k2v[k] = bf1(kks[t * DP + d]) * __expf(fminf(bm - bt, 80.f)); qev[k] = qv * __expf(bt); }
    __syncthreads();
    bf16* QE = (bf16*)lds;
#pragma unroll
    for (int k = 0; k < 16; ++k) { const int idx = tid + 512 * k, t = idx >> 7, d = idx & 127; qs[t * DP + d] = (bf16)f2bf(q2v[k]); kks[t * DP + d] = (bf16)f2bf(k2v[k]); QE[t * DP + d] = (bf16)f2bf(qev[k]); }
    bf16x8v sfr[4];
    { const bf16* Sst = (const bf16*)HGS + (size_t)u * 16384;
#pragma unroll
      for (int ks = 0; ks < 4; ++ks) sfr[ks] = *(const bf16x8v*)(Sst + ((size_t)(wave * 4 + ks) * 64 + lane) * 8); }
    __syncthreads();
#pragma unroll
    for (int rep = 0; rep < 2; ++rep) { const int tl = wave + 8 * rep;
        if (tl < 6) { const int I = tl < 1 ? 1 : (tl < 3 ? 2 : 3), J = tl < 1 ? 0 : (tl < 3 ? tl - 1 : tl - 3), kb = I == 1 ? 0 : (I == 2 ? 16 : 48);
            f32x4 acc = (f32x4){0.f, 0.f, 0.f, 0.f};
#pragma unroll
            for (int ks = 0; ks < 4; ++ks) acc = MFMA16(*(const bf16x8v*)(QD + (16 * I + lc) * DP + 32 * ks + 8 * g), *(const bf16x8v*)(KD + (kb + 16 * J + lc) * DP + 32 * ks + 8 * g), acc);
#pragma unroll
            for (int r = 0; r < 4; ++r) ATT[(16 * I + 4 * g + r) * SP + 16 * J + lc] = (bf16)f2bf(acc[r]); }
        else if (tl < 10) { const int I = tl - 6; f32x4 acc = (f32x4){0.f, 0.f, 0.f, 0.f};
#pragma unroll
            for (int ks = 0; ks < 4; ++ks) acc = MFMA16(*(const bf16x8v*)(qs + (16 * I + lc) * DP + 32 * ks + 8 * g), *(const bf16x8v*)(kks + (16 * I + lc) * DP + 32 * ks + 8 * g), acc);
#pragma unroll
            for (int r = 0; r < 4; ++r) ATT[(16 * I + 4 * g + r) * SP + 16 * I + lc] = (lc <= 4 * g + r) ? (bf16)f2bf(acc[r]) : (bf16)0; } }
    __syncthreads();
    f32x4 acc[4];
#pragma unroll
    for (int m = 0; m < 4; ++m) { acc[m] = (f32x4){0.f, 0.f, 0.f, 0.f};
#pragma unroll
        for (int ks = 0; ks < 2; ++ks) acc[m] = MFMA16(*(const bf16x8v*)(ATT + (16 * m + lc) * SP + 32 * ks + 8 * g), *(const bf16x8v*)(It + (16 * wave + lc) * SP + 32 * ks + 8 * g), acc[m]);
#pragma unroll
        for (int ks = 0; ks < 4; ++ks) acc[m] = MFMA16(*(const bf16x8v*)(QE + (16 * m + lc) * DP + 32 * ks + 8 * g), sfr[ks], acc[m]); }
    float* part = bcs + 5120; float* rstd = bcs + 5120 + 512;
#pragma unroll
    for (int m = 0; m < 4; ++m)
#pragma unroll
        for (int r = 0; r < 4; ++r) { float sq = acc[m][r] * acc[m][r]; sq += __shfl_xor(sq, 1); sq += __shfl_xor(sq, 2); sq += __shfl_xor(sq, 4); sq += __shfl_xor(sq, 8);
            if (lc == 0) part[(16 * m + 4 * g + r) * 8 + wave] = sq; }
    __syncthreads();
    if (tid < 64) { float sq = 0.f;
#pragma unroll
        for (int w = 0; w < 8; ++w) sq += part[tid * 8 + w];
        rstd[tid] = __builtin_amdgcn_rsqf(sq * (1.0f / 128.0f) + EPS); }
    __syncthreads();
    { const int e = 16 * wave + lc; const float gn = hg_norm[h * 128 + e];
#pragma unroll
      for (int m = 0; m < 4; ++m)
#pragma unroll
          for (int r = 0; r < 4; ++r) { const int t = 16 * m + 4 * g + r, p = 64 * c + t - 48;
              if (p >= 0 && (c > 0 || b == 0)) { const int row = seq_row(b, p); const float og = sigmoidf_(bf1(PROJ[(size_t)row * NPROJ + PC_HGG + h * 128 + e]));
                  BRp[(size_t)row * D + 2048 + h * 128 + e] = (bf16)f2bf(acc[m][r] * rstd[t] * gn * og); } } }
    __syncthreads();
}

__device__ __forceinline__ void rg_frags(const float* wa, const float* wx, int n, int jt, int lc, int g, bf16x8v (&fa)[2], bf16x8v (&fx)[2]) {
#pragma unroll
    for (int ks = 0; ks < 2; ++ks) { float xa[8], xx[8];
#pragma unroll
        for (int q = 0; q < 8; ++q) { const int wi = (n * 64 + 32 * ks + 8 * g + q) * 64 + 16 * jt + lc; xa[q] = wa[wi]; xx[q] = wx[wi]; }
        fa[ks] = pack8(xa); fx[ks] = pack8(xx); }
}
__device__ __forceinline__ void rg_A(const bf16* PROJ, const float* conv_w, const float* conv_b, const float* wa, const float* ba, const float* wx, const float* bx, const float* lam, float* RGH, float* RGP, float* RGT, int u, unsigned char* lds, int tid) {
    const int half = u & 1, c = (u < 256) ? 1 + ((u >> 1) & 63) : 0, b = (u < 256) ? (u >> 7) : 0, ch = half * 512 + tid, p0 = 64 * c - 48;
    const int lane = tid & 63, wave = tid >> 6, lc = lane & 15, g = lane >> 4, n = half * 8 + wave;
    constexpr int XP = 520;
    bf16* xs = (bf16*)lds;
    bf16* xcb = (bf16*)(lds + 68608);
    bf16* las = (bf16*)(lds + 68608);
    bf16* us = (bf16*)lds;
    bf16x8v fa[2], fx[2]; rg_frags(wa, wx, n, 0, lc, g, fa, fx);
    for (int id = tid; id < 67 * 64; id += NTHR) { const int r = id >> 6, cp = id & 63, p = p0 - 3 + r; v4u w = (v4u){0u, 0u, 0u, 0u};
        if (p >= 0) w = *(const v4u*)(PROJ + (size_t)seq_row(b, p) * NPROJ + PC_RGX + half * 512 + cp * 8);
        *(v4u*)(xs + r * 512 + cp * 8) = w; }
    __syncthreads();
    { const float w0 = conv_w[ch], w1 = conv_w[1024 + ch], w2 = conv_w[2048 + ch], w3 = conv_w[3072 + ch], cb = conv_b[ch];
      float xm3 = bf1(xs[tid]), xm2 = bf1(xs[512 + tid]), xm1 = bf1(xs[1024 + tid]);
#pragma unroll 8
      for (int t = 0; t < 64; ++t) { const float x0 = bf1(xs[(t + 3) * 512 + tid]); xcb[t * XP + tid] = (bf16)f2bf(cb + (w0 * xm3 + w1 * xm2) + (w2 * xm1 + w3 * x0)); xm3 = xm2; xm2 = xm1; xm1 = x0; } }
    __syncthreads();
    unsigned ru[4][4][2];
    { bf16x8v af[4][2];
#pragma unroll
      for (int m = 0; m < 4; ++m)
#pragma unroll
          for (int ks = 0; ks < 2; ++ks) af[m][ks] = *(const bf16x8v*)(xcb + (16 * m + lc) * XP + 64 * wave + 32 * ks + 8 * g);
      __syncthreads();
#pragma unroll
      for (int jt = 0; jt < 4; ++jt) { bf16x8v na[2], nx[2];
          asm volatile("" ::: "memory");
          if (jt < 3) rg_frags(wa, wx, n, jt + 1, lc, g, na, nx);
          const int cg = 64 * n + 16 * jt + lc, cl = cg - half * 512;
          const float bav = ba[cg], bxv = bx[cg], spv = softplusf_(-lam[cg]), w0 = conv_w[cg], w1 = conv_w[1024 + cg], w2 = conv_w[2048 + cg], w3 = conv_w[3072 + cg], cb = conv_b[cg];
#pragma unroll
          for (int m = 0; m < 4; ++m) { f32x4 aa = (f32x4){0.f, 0.f, 0.f, 0.f}, ax = aa;
#pragma unroll
              for (int ks = 0; ks < 2; ++ks) { aa = MFMA16(af[m][ks], fa[ks], aa); ax = MFMA16(af[m][ks], fx[ks], ax); }
              float uv[4];
#pragma unroll
              for (int r = 0; r < 4; ++r) { const int t = 16 * m + 4 * g + r;
                  const float xc = cb + (w0 * bf1(xs[t * 512 + cl]) + w1 * bf1(xs[(t + 1) * 512 + cl])) + (w2 * bf1(xs[(t + 2) * 512 + cl]) + w3 * bf1(xs[(t + 3) * 512 + cl]));
                  const float rr = fast_sigmoid_(aa[r] + bav), gi = fast_sigmoid_(ax[r] + bxv); const unsigned lb16 = f2bf(-8.0f * rr * spv); const float a = __expf(__uint_as_float(lb16 << 16));
                  las[t * 512 + cl] = (bf16)lb16; uv[r] = __builtin_amdgcn_sqrtf(fmaxf(1.0f - a * a, 0.f)) * gi * xc; }
              ru[jt][m][0] = pk2(uv[0], uv[1]); ru[jt][m][1] = pk2(uv[2], uv[3]); }
          if (jt < 3) { fa[0] = na[0]; fa[1] = na[1]; fx[0] = nx[0]; fx[1] = nx[1]; } } }
    __syncthreads();
#pragma unroll
    for (int jt = 0; jt < 4; ++jt) { const int cl = 64 * wave + 16 * jt + lc;
#pragma unroll
        for (int m = 0; m < 4; ++m)
#pragma unroll
            for (int h2 = 0; h2 < 2; ++h2) { const int t = 16 * m + 4 * g + 2 * h2;
                us[t * 512 + cl] = (bf16)(ru[jt][m][h2] & 0xffffu); us[(t + 1) * 512 + cl] = (bf16)(ru[jt][m][h2] >> 16); } }
    __syncthreads();
    float hh = 0.f, P = 1.f;
    { const int tb = (c == 0 ? 48 : 0); float* ph = RGH + (size_t)seq_row(b, p0 + tb) * 1024 + ch; float* pp = RGP + (size_t)seq_row(b, p0 + tb) * 1024 + ch;
#pragma unroll 4
      for (int t = tb; t < 64; ++t) { const float a = __expf(bf1(las[t * 512 + tid])), uu = bf1(us[t * 512 + tid]);
          hh = a * hh + uu; P *= a; *ph = hh; *pp = P; ph += 1024; pp += 1024; } }
    RGT[(size_t)(0 * 2 + b) * NCH * 1024 + c * 1024 + ch] = P; RGT[(size_t)(1 * 2 + b) * NCH * 1024 + c * 1024 + ch] = hh;
    if (c == 0) { RGT[(size_t)(0 * 2 + 1) * NCH * 1024 + ch] = P; RGT[(size_t)(1 * 2 + 1) * NCH * 1024 + ch] = hh; }
    __syncthreads();
}
__device__ __forceinline__ void rg_B(float* RGT, int chain, int lane) {
    const int b = chain >> 10, ch = chain & 1023;
    float a = RGT[(size_t)(0 * 2 + b) * NCH * 1024 + lane * 1024 + ch], hv = RGT[(size_t)(1 * 2 + b) * NCH * 1024 + lane * 1024 + ch];
#pragma unroll
    for (int o = 1; o < 64; o <<= 1) { const float ap = __shfl_up(a, o), hp = __shfl_up(hv, o); if (lane >= o) { hv = a * hp + hv; a = a * ap; } }
    float* Cc = RGT + (size_t)(2 * 2 + b) * NCH * 1024 + ch;
    const float prev = __shfl_up(hv, 1);
    Cc[lane * 1024] = (lane == 0) ? 0.f : prev;
    if (lane == 63) Cc[64 * 1024] = hv;
}
__device__ __forceinline__ float gelu_tanh(float y) { const float z2 = 1.5957691216057308f * (y + 0.044715f * y * y * y); return y * __builtin_amdgcn_rcpf(1.0f + __expf(-z2)); }
__device__ __forceinline__ void rg_C(const bf16* PROJ, const float* RGH, const float* RGP, const float* RGT, bf16* BR, int gw, int NGW, int lane) {
    for (int row = gw; row < TREAL + NMETA; row += NGW) {
        const int b = row < TREAL ? (row >> 12) : 0, p = row < TREAL ? (row & 4095) + NMETA : row - TREAL, c = (p + 48) >> 6;
        const float* Cc = RGT + (size_t)(2 * 2 + b) * NCH * 1024 + c * 1024;
#pragma unroll
        for (int j = 0; j < 2; ++j) { const int ch = j * 512 + lane * 8; float y[8]; unpack8(*(const v4u*)(PROJ + (size_t)row * NPROJ + PC_RGY + ch), y); float o[8];
#pragma unroll
            for (int q = 0; q < 2; ++q) { const f32x4 hl = *(const f32x4*)(RGH + (size_t)row * 1024 + ch + 4 * q), pp = *(const f32x4*)(RGP + (size_t)row * 1024 + ch + 4 * q), cc = *(const f32x4*)(Cc + ch + 4 * q);
                const f32x4 hv = hl + pp * cc; o[4 * q] = hv.x * gelu_tanh(y[4 * q]); o[4 * q + 1] = hv.y * gelu_tanh(y[4 * q + 1]); o[4 * q + 2] = hv.z * gelu_tanh(y[4 * q + 2]); o[4 * q + 3] = hv.w * gelu_tanh(y[4 * q + 3]); }
            v4u w; w.x = pk2(o[0], o[1]); w.y = pk2(o[2], o[3]); w.z = pk2(o[4], o[5]); w.w = pk2(o[6], o[7]);
            *(v4u*)(BR + (size_t)row * D + 3072 + ch) = w; }
    }
}

__device__ __forceinline__ void sb_unit(const bf16* PROJ, const float* gq, const float* gk, bf16* BRp, int b, int h, int i, unsigned char* lds, int tid) {
    constexpr int KP = 136, VP = 72;
    bf16* Kt = (bf16*)lds; bf16* Vt = (bf16*)(lds + 17408);
    const int lane = tid & 63, wave = tid >> 6, c = lane & 15, g = lane >> 4;
    bf16* Ps = (bf16*)(lds + 35840) + wave * (16 * VP);
    bf16x8v aq[4];
    { const int pq = 128 * i - 112 + 16 * wave + c; float qv[4][8]; float ss = 0.f;
      if (pq >= 0) { const bf16* qp = PROJ + (size_t)seq_row(b, pq) * NPROJ + PC_SBQ + h * 128 + 8 * g;
#pragma unroll
          for (int ks = 0; ks < 4; ++ks) { unpack8(*(const v4u*)(qp + 32 * ks), qv[ks]);
#pragma unroll
              for (int k = 0; k < 8; ++k) ss += qv[ks][k] * qv[ks][k]; } }
      else {
#pragma unroll
          for (int ks = 0; ks < 4; ++ks)
#pragma unroll
              for (int k = 0; k < 8; ++k) qv[ks][k] = 0.f; }
      ss += __shfl_xor(ss, 16); ss += __shfl_xor(ss, 32);
      const float sc = 0.08838834764831845f * __builtin_amdgcn_rsqf(ss * (1.0f / 128.0f) + EPS);
#pragma unroll
      for (int ks = 0; ks < 4; ++ks) { const f32x4 g0 = *(const f32x4*)(gq + 32 * ks + 8 * g), g1 = *(const f32x4*)(gq + 32 * ks + 8 * g + 4);
          qv[ks][0] *= sc * g0.x; qv[ks][1] *= sc * g0.y; qv[ks][2] *= sc * g0.z; qv[ks][3] *= sc * g0.w; qv[ks][4] *= sc * g1.x; qv[ks][5] *= sc * g1.y; qv[ks][6] *= sc * g1.z; qv[ks][7] *= sc * g1.w;
          aq[ks] = pack8(qv[ks]); } }
    const int p0row = 128 * i - 112 + 16 * wave + 4 * g;
    float carry[4] = {0.f, 0.f, 0.f, 0.f};
    f32x4 acc_o[8];
#pragma unroll
    for (int n = 0; n < 8; ++n) acc_o[n] = (f32x4){0.f, 0.f, 0.f, 0.f};
    const int kt_hi = (i == 0) ? 0 : 2 * i;
    v4u pk0 = (v4u){0u, 0u, 0u, 0u}, pk1 = pk0, pv0 = pk0, pv1 = pk0;
#define SB_FETCH(kt_) do { const int pkf = 64 * (kt_) + (tid >> 3); pk0 = (v4u){0u, 0u, 0u, 0u}; pk1 = pk0; pv0 = pk0; pv1 = pk0; \
        if (pkf < 4096 + NMETA) { const bf16* rp = PROJ + (size_t)seq_row(b, pkf) * NPROJ + h * 128 + (tid & 7) * 16; \
            pk0 = *(const v4u*)(rp + PC_SBK); pk1 = *(const v4u*)(rp + PC_SBK + 8); pv0 = *(const v4u*)(rp + PC_SBV); pv1 = *(const v4u*)(rp + PC_SBV + 8); } } while (0)
    SB_FETCH(kt_hi);
    for (int kt = kt_hi; kt >= 0; --kt) {
        { const int kr = tid >> 3, sg = tid & 7; float ka[8], kb[8], va[8], vb[8]; float ss = 0.f;
          unpack8(pk0, ka); unpack8(pk1, kb); unpack8(pv0, va); unpack8(pv1, vb);
#pragma unroll
          for (int k = 0; k < 8; ++k) ss += ka[k] * ka[k] + kb[k] * kb[k];
          ss += __shfl_xor(ss, 1); ss += __shfl_xor(ss, 2); ss += __shfl_xor(ss, 4);
          const float rstd = __builtin_amdgcn_rsqf(ss * (1.0f / 128.0f) + EPS);
          const f32x4 g0 = *(const f32x4*)(gk + sg * 16), g1 = *(const f32x4*)(gk + sg * 16 + 4), g2 = *(const f32x4*)(gk + sg * 16 + 8), g3 = *(const f32x4*)(gk + sg * 16 + 12);
          ka[0] *= rstd * g0.x; ka[1] *= rstd * g0.y; ka[2] *= rstd * g0.z; ka[3] *= rstd * g0.w; ka[4] *= rstd * g1.x; ka[5] *= rstd * g1.y; ka[6] *= rstd * g1.z; ka[7] *= rstd * g1.w;
          kb[0] *= rstd * g2.x; kb[1] *= rstd * g2.y; kb[2] *= rstd * g2.z; kb[3] *= rstd * g2.w; kb[4] *= rstd * g3.x; kb[5] *= rstd * g3.y; kb[6] *= rstd * g3.z; kb[7] *= rstd * g3.w;
          *(bf16x8v*)(Kt + kr * KP + sg * 16) = pack8(ka); *(bf16x8v*)(Kt + kr * KP + sg * 16 + 8) = pack8(kb);
#pragma unroll
          for (int k = 0; k < 8; ++k) { Vt[(sg * 16 + k) * VP + kr] = (bf16)f2bf(va[k]); Vt[(sg * 16 + 8 + k) * VP + kr] = (bf16)f2bf(vb[k]); } }
        __syncthreads();
        if (kt > 0) SB_FETCH(kt - 1);
        f32x4 z[4];
#pragma unroll
        for (int j = 0; j < 4; ++j) { z[j] = (f32x4){0.f, 0.f, 0.f, 0.f};
#pragma unroll
            for (int ks = 0; ks < 4; ++ks) z[j] = MFMA16(aq[ks], *(const bf16x8v*)(Kt + (16 * j + 15 - c) * KP + 32 * ks + 8 * g), z[j]); }
        float lk[4][4], zl[4][4], inc[4][4];
#pragma unroll
        for (int j = 0; j < 4; ++j)
#pragma unroll
            for (int r = 0; r < 4; ++r) { const bool vis = (64 * kt + 16 * j + 15 - c) < (p0row + r); const float zz = z[j][r];
                const float sp = fmaxf(zz, 0.f) + __logf(1.0f + __expf(-fabsf(zz)));
                lk[j][r] = vis ? -sp : 0.f; zl[j][r] = vis ? (zz - sp) : -1e30f; inc[j][r] = lk[j][r]; }
#pragma unroll
        for (int j = 0; j < 4; ++j)
#pragma unroll
            for (int r = 0; r < 4; ++r) { float v = inc[j][r]; v += dpp_shr16<1>(v); v += dpp_shr16<2>(v); v += dpp_shr16<4>(v); v += dpp_shr16<8>(v); inc[j][r] = v; }
#pragma unroll
        for (int r = 0; r < 4; ++r) { float off = carry[r];
#pragma unroll
            for (int j = 3; j >= 0; --j) { const float tot = __shfl(inc[j][r], 15, 16); const float a = __expf(zl[j][r] + off + inc[j][r] - lk[j][r]);
                Ps[(4 * g + r) * VP + 16 * j + 15 - c] = (bf16)f2bf(a); off += tot; }
            carry[r] = off; }
#pragma unroll
        for (int ks = 0; ks < 2; ++ks) { const bf16x8v pf = *(const bf16x8v*)(Ps + c * VP + 32 * ks + 8 * g);
#pragma unroll
            for (int n = 0; n < 8; ++n) acc_o[n] = MFMA16(pf, *(const bf16x8v*)(Vt + (16 * n + c) * VP + 32 * ks + 8 * g), acc_o[n]); }
        { volatile unsigned* flg = (volatile unsigned*)(lds + RING_BYTES) + (kt & 1) * 8;
          bool dn = true;
#pragma unroll
          for (int r = 0; r < 4; ++r) dn = dn && ((p0row + r) < 0 || carry[r] < -104.0f);
          const int alldone = __all(dn ? 1 : 0);
          if (lane == 0) flg[wave] = alldone ? 1u : 0u;
          __syncthreads();
          unsigned d = 1u;
#pragma unroll
          for (int w = 0; w < NWAVES; ++w) d &= flg[w];
          if (d) break; }
    }
#pragma unroll
    for (int r = 0; r < 4; ++r) { const int p = p0row + r; if (p >= 0 && (i > 0 || b == 0)) { bf16* op = BRp + (size_t)seq_row(b, p) * D + 1024 + h * 128 + c;
#pragma unroll
            for (int n = 0; n < 8; ++n) op[16 * n] = (bf16)f2bf(acc_o[n][r]); } }
    __syncthreads();
}

#undef SB_FETCH
template <int MODE> __device__ __forceinline__ void skinny_phase(const bf16* A, int lda, const bf16* Bt, int ldb, int N, int K, float* hmeta, bf16* MGm, const bf16* Gm, unsigned char* lds, int tid, int bx, int G) {
    const int lane = tid & 63, wave = tid >> 6, lc = lane & 15, g = lane >> 4, kw = K / 8, nst = kw / 32;
    f32x4* red = (f32x4*)lds;
    for (int nu = bx; nu < N / 16; nu += G) {
        const bf16* ap = A + (size_t)lc * lda + wave * kw + 8 * g; const bf16* bp = Bt + (size_t)(16 * nu + lc) * ldb + wave * kw + 8 * g;
        f32x4 acc = (f32x4){0.f, 0.f, 0.f, 0.f}; int st = 0;
        for (; st < nst; st += 16) { bf16x8v af[16], bv[16];
#pragma unroll
            for (int i = 0; i < 16; ++i) if (st + i < nst) { af[i] = *(const bf16x8v*)(ap + 32 * (st + i)); bv[i] = *(const bf16x8v*)(bp + 32 * (st + i)); }
#pragma unroll
            for (int i = 0; i < 16; ++i) if (st + i < nst) acc = MFMA16(af[i], bv[i], acc); }
        red[wave * 64 + lane] = acc;
        __syncthreads();
        if (wave == 0) { const int n = 16 * nu + lc;
            if (MODE == 0) { f32x4 v = red[lane];
#pragma unroll
                for (int w = 1; w < 8; ++w) v += red[w * 64 + lane];
#pragma unroll
                for (int r = 0; r < 4; ++r) hmeta[(size_t)(4 * g + r) * D + n] += v[r]; }
            else { f32x4 mg = (f32x4){0.f, 0.f, 0.f, 0.f};
#pragma unroll
                for (int k = 0; k < 4; ++k) { const f32x4 uk = red[(2 * k) * 64 + lane] + red[(2 * k + 1) * 64 + lane];
#pragma unroll
                    for (int r = 0; r < 4; ++r) mg[r] += uk[r] * __builtin_amdgcn_rcpf(bf1(Gm[(size_t)(4 * g + r) * NPROJ + k * 4096 + n])); }
#pragma unroll
                for (int r = 0; r < 4; ++r) MGm[(size_t)(4 * g + r) * D + n] = (bf16)f2bf(mg[r]); } }
        __syncthreads();
    }
}

__device__ __forceinline__ void skinny_swiglu(const bf16* A, const bf16* Bt, bf16* ACTm, unsigned char* lds, int tid, int bx, int G) {
    const int lane = tid & 63, wave = tid >> 6, lc = lane & 15, g = lane >> 4; constexpr int kw = D / 8, nst = kw / 32;
    f32x4* red = (f32x4*)lds;
    for (int nu = bx; nu < DFF / 16; nu += G) { const int j = 16 * nu + lc, brow = (j >> 7) * 256 + (j & 127);
        const bf16* ap = A + (size_t)lc * D + wave * kw + 8 * g; const bf16* bg = Bt + (size_t)brow * D + wave * kw + 8 * g; const bf16* bu = bg + (size_t)128 * D;
        f32x4 ag = (f32x4){0.f, 0.f, 0.f, 0.f}, au = ag;
#pragma unroll
        for (int h2 = 0; h2 < 2; ++h2) { bf16x8v af[8], gv[8], uv[8];
#pragma unroll
            for (int i = 0; i < 8; ++i) { af[i] = *(const bf16x8v*)(ap + 32 * (8 * h2 + i)); gv[i] = *(const bf16x8v*)(bg + 32 * (8 * h2 + i)); uv[i] = *(const bf16x8v*)(bu + 32 * (8 * h2 + i)); }
#pragma unroll
            for (int i = 0; i < 8; ++i) { ag = MFMA16(af[i], gv[i], ag); au = MFMA16(af[i], uv[i], au); } }
        static_assert(nst == 16, "two batches of 8 k-steps");
        red[wave * 64 + lane] = ag; red[512 + wave * 64 + lane] = au;
        __syncthreads();
        if (wave == 0) { f32x4 vg = red[lane], vu = red[512 + lane];
#pragma unroll
            for (int w = 1; w < 8; ++w) { vg += red[w * 64 + lane]; vu += red[512 + w * 64 + lane]; }
#pragma unroll
            for (int r = 0; r < 4; ++r) ACTm[(size_t)(4 * g + r) * DFF + j] = (bf16)f2bf(vg[r] * fast_sigmoid_(vg[r]) * vu[r]); }
        __syncthreads();
    }
}
#ifndef REP_P0
#define REP_P0 1
#endif
#ifndef REP_A
#define REP_A 1
#endif
#ifndef REP_C
#define REP_C 1
#endif
#ifndef REP_G1
#define REP_G1 1
#endif
#ifndef REP_G8
#define REP_G8 1
#endif
#ifndef PG8_ALIGN_RES
#define PG8_ALIGN_RES true
#endif
#ifndef PG8_ALIGNV
#define PG8_ALIGNV true
#endif
#ifndef PG8_SP2V
#define PG8_SP2V true
#endif
#ifndef MK_N_LAUNCHES
#define MK_N_LAUNCHES 1
#endif
constexpr int N_PHASES = 1 + 10 * NLAYER;
struct Args { const float* in[23]; float* out; unsigned char* ws; int ph_lo, ph_hi; };
static_assert(sizeof(Args) == 23 * 8 + 8 + 8 + 8, "Args has no padding bytes");

template <int LO, int HI> __global__ void __launch_bounds__(NTHR, 2) fwd_kernel(Args args) {
    extern __shared__ __attribute__((aligned(16))) unsigned char lds[];
    const int tid = threadIdx.x;
    const int G = gridDim.x, bx = blockIdx.x;
    const int vcu = (G % 8 == 0) ? (bx % 8) * (G / 8) + bx / 8 : bx;
    const int NGW = G * NWAVES, NGT = G * NTHR;
    unsigned char* ws = args.ws;
    unsigned* ctl = (unsigned*)(ws + WS_CTL);
    volatile LAS unsigned* MISC = (volatile LAS unsigned*)((LAS unsigned char*)lds + MISC_OFF);
    for (int u = tid; u < (LDS_BYTES - LDSCTL_OFF) / 4; u += NTHR) ((LAS unsigned*)((LAS unsigned char*)lds + LDSCTL_OFF))[u] = 0u;
    __syncthreads();
    constexpr bool use_bar = (HI - LO) > 1;
    XcdBarrier bar; bar.bar = ctl + CW_BAR; bar.x = 0; bar.st = nullptr;
    if constexpr (use_bar) bar = xcd_barrier_post(ctl + CW_BAR, MISC + 8);
#define IN(k) (LO <= (k) && (k) < HI)
#define PHASE_VARS int tid_ = tid; asm volatile("" : "+v"(tid_)); const int lane_ = tid_ & 63, wave_ = __builtin_amdgcn_readfirstlane(tid_ >> 6), gw_ = vcu * NWAVES + wave_, gtid_ = bx * NTHR + tid_; (void)lane_; (void)wave_; (void)gw_; (void)gtid_;
#if defined(PROBE_DOUBLE_BAR)
#define SEAM(k) do { if constexpr (IN(k) && IN((k) + 1)) { xcd_barrier(bar); xcd_barrier(bar); } } while (0)
#else
#define SEAM(k) do { if constexpr (IN(k) && IN((k) + 1)) xcd_barrier(bar); } while (0)
#endif

#define PROJ ((bf16*)(ws + WS_PROJ))
#define ACT ((bf16*)(ws + WS_ACT))
#define XN ((bf16*)(ws + WS_XN))
#define BR ((bf16*)(ws + WS_BR))
#define MG ((bf16*)(ws + WS_MG))
#define HMETA ((float*)(ws + WS_HMETA))
#define GIF ((float*)(ws + WS_GIF))
#define WIF ((const float*)(ws + WS_WIF))
#define LBp ((const float*)(ws + WS_LB))
#define MLS ((float*)(ws + WS_MLS))
#define MLN ((float*)(ws + WS_MLN))
#define MLSC ((float*)(ws + WS_MLSC))
#define MLCT ((bf16*)(ws + WS_MLCT))
#define HGS ((float*)(ws + WS_HGS))
#define HGE ((float*)(ws + WS_HGE))
#define RGH ((float*)(ws + WS_RGH))
#define RGP ((float*)(ws + WS_RGP))
#define RGT ((float*)(ws + WS_RGT))
#define HBp ((bf16*)(ws + WS_HB))
#define x (args.in[0])
#define out (args.out)

#if defined(PROBE_SPIN_US)
    if constexpr (IN(0)) { const unsigned long long t0 = __builtin_amdgcn_s_memrealtime(); while (__builtin_amdgcn_s_memrealtime() - t0 < (unsigned long long)PROBE_SPIN_US * 100ull) __builtin_amdgcn_s_sleep(8); }
#endif
    if constexpr (IN(0)) { PHASE_VARS p0_prologue(args.in, ws, lds, bx, G, wave_, lane_, gtid_, NGT); }
#if defined(PROBE_REP_P0)
    if constexpr (IN(0)) { PHASE_VARS p0_prologue(args.in, ws, lds, bx, G, wave_, lane_, gtid_, NGT); }
#endif
    SEAM(0);

    {
        constexpr int l = 0;
        constexpr int pb = 1 + 10 * l;
        constexpr bool lastl = (l == NLAYER - 1);
        constexpr int Mtail = lastl ? TREAL : MROWS;
        constexpr int Mg = TREAL;
        const void* hsrc = (l == 0) ? (const void*)x : (const void*)HBp;
        if constexpr (IN(pb + 0)) { PHASE_VARS norm_rows<true, (l != 0)>(hsrc, HMETA, args.in[2] + l * D, XN, MROWS, WIF + (size_t)l * 8 * D, args.in[5] + (size_t)l * NIN + 4096, GIF, gw_, NGW, lane_, lds, tid_); }
#if defined(PROBE_REP_NORM)
            if constexpr (IN(pb + 0)) { PHASE_VARS norm_rows<true, (l != 0)>(hsrc, HMETA, args.in[2] + l * D, XN, MROWS, WIF + (size_t)l * 8 * D, args.in[5] + (size_t)l * NIN + 4096, GIF, gw_, NGW, lane_, lds, tid_); }
#endif
        SEAM(pb + 0);
        if constexpr (IN(pb + 1)) { PHASE_VARS pg8::Gemm g{XN, (const bf16*)(ws + WS_WIN + (size_t)l * SZ_WIN), MROWS, NPROJ, D, D, D}; pg8::StaticOrder S; S.init(MROWS, NPROJ, G, bx);
            pg8::EpiProj E{PROJ, NPROJ, args.in[5] + (size_t)l * NIN, 4096, 8, PC_GATE};
            pg8::gemm_phase<pg8::EpiProj, pg8::StaticOrder, PG8_ALIGNV, PG8_SP2V>((PG8_LAS unsigned char*)lds, g, S, E, tid_); }
#if defined(PROBE_REP_G1)
        if constexpr (IN(pb + 1)) { PHASE_VARS pg8::Gemm g{XN, (const bf16*)(ws + WS_WIN + (size_t)l * SZ_WIN), MROWS, NPROJ, D, D, D}; pg8::StaticOrder S; S.init(MROWS, NPROJ, G, bx);
            pg8::EpiProj E{PROJ, NPROJ, args.in[5] + (size_t)l * NIN, 4096, 8, PC_GATE};
            pg8::gemm_phase<pg8::EpiProj, pg8::StaticOrder, PG8_ALIGNV, PG8_SP2V>((PG8_LAS unsigned char*)lds, g, S, E, tid_); }
#endif
        SEAM(pb + 1);
        if constexpr (IN(pb + 2)) { PHASE_VARS
            for (int w_ = bx; w_ < 520; w_ += G) { const int u = (w_ < 512) ? (w_ >> 6) * NCH + 1 + (w_ & 63) : (w_ - 512) * NCH; mlstm_A(PROJ, GIF, MLS, MLN, MLSC, u, lds, tid_); }
#if defined(PROBE_REP_MLA)
            for (int w_ = bx; w_ < 520; w_ += G) { const int u = (w_ < 512) ? (w_ >> 6) * NCH + 1 + (w_ & 63) : (w_ - 512) * NCH; mlstm_A(PROJ, GIF, MLS, MLN, MLSC, u, lds, tid_); }
#endif
            for (int w_ = (bx + G - 8) % G; w_ < 1040; w_ += G) { const int u = (w_ < 1024) ? (w_ >> 6) * NCH + 1 + (w_ & 63) : (w_ - 1024) * NCH; hg_A(PROJ, LBp + l * 1024, HGS, HGE, u, lds, tid_); }
#if defined(PROBE_REP_HGA)
            for (int w_ = (bx + G - 8) % G; w_ < 1040; w_ += G) { const int u = (w_ < 1024) ? (w_ >> 6) * NCH + 1 + (w_ & 63) : (w_ - 1024) * NCH; hg_A(PROJ, LBp + l * 1024, HGS, HGE, u, lds, tid_); }
#endif
            for (int u = (bx + G - 24) % G; u < 258; u += G) rg_A(PROJ, args.in[11] + l * 4096, args.in[12] + l * 1024, args.in[13] + l * 65536, args.in[14] + l * 1024, args.in[15] + l * 65536, args.in[16] + l * 1024, args.in[17] + l * 1024, RGH, RGP, RGT, u, lds, tid_);
#if defined(PROBE_REP_RGA)
            for (int u = (bx + G - 24) % G; u < 258; u += G) rg_A(PROJ, args.in[11] + l * 4096, args.in[12] + l * 1024, args.in[13] + l * 65536, args.in[14] + l * 1024, args.in[15] + l * 65536, args.in[16] + l * 1024, args.in[17] + l * 1024, RGH, RGP, RGT, u, lds, tid_);
#endif
            for (int r = 0;; ++r) { const int bs = (r == 2) ? (bx + G - 28) % G : bx; const int idx = r * G + ((r & 1) ? (G - 1 - bs) : bs); if (r * G >= (lastl ? 512 : 520)) break; if (idx >= (lastl ? 512 : 520)) continue;
                int b, h, i; if (idx < 512) { i = 32 - (idx >> 4); b = (idx >> 3) & 1; h = idx & 7; } else { i = 0; b = 0; h = idx - 512; }
                sb_unit(PROJ, args.in[7] + l * 128, args.in[8] + l * 128, BR, b, h, i, lds, tid_); }
#if defined(PROBE_REP_SB)
            for (int r = 0;; ++r) { const int bs = (r == 2) ? (bx + G - 28) % G : bx; const int idx = r * G + ((r & 1) ? (G - 1 - bs) : bs); if (r * G >= (lastl ? 512 : 520)) break; if (idx >= (lastl ? 512 : 520)) continue;
                int b, h, i; if (idx < 512) { i = 32 - (idx >> 4); b = (idx >> 3) & 1; h = idx & 7; } else { i = 0; b = 0; h = idx - 512; }
                sb_unit(PROJ, args.in[7] + l * 128, args.in[8] + l * 128, BR, b, h, i, lds, tid_); }
#endif
        }
        SEAM(pb + 2);
        if constexpr (IN(pb + 3)) { PHASE_VARS
            for (int u = bx; u < 256; u += G) mlstm_B(MLS, MLN, MLSC, MLCT, u, lds, tid_);
#if defined(PROBE_REP_MLB)
            for (int u = bx; u < 256; u += G) mlstm_B(MLS, MLN, MLSC, MLCT, u, lds, tid_);
#endif
            for (int u = bx; u < 256; u += G) hg_B(HGS, HGE, u, tid_);
            for (int ch_ = gw_; ch_ < 2048; ch_ += NGW) rg_B(RGT, ch_, lane_);
        }
        SEAM(pb + 3);
        if constexpr (IN(pb + 4)) { PHASE_VARS
            for (int w_ = (bx + G - 64) % G; w_ < (lastl ? 512 : 520); w_ += G) { const int u = (w_ < 512) ? (w_ >> 6) * NCH + 1 + (w_ & 63) : (w_ - 512) * NCH; mlstm_C(PROJ, GIF, MLCT, MLSC, args.in[6] + l * 1024, BR, u, lds, tid_); }
#if defined(PROBE_REP_MLC)
            for (int w_ = (bx + G - 64) % G; w_ < (lastl ? 512 : 520); w_ += G) { const int u = (w_ < 512) ? (w_ >> 6) * NCH + 1 + (w_ & 63) : (w_ - 512) * NCH; mlstm_C(PROJ, GIF, MLCT, MLSC, args.in[6] + l * 1024, BR, u, lds, tid_); }
#endif
            for (int w_ = (bx + G - 72) % G; w_ < (lastl ? 1024 : 1040); w_ += G) { const int u = (w_ < 1024) ? (w_ >> 6) * NCH + 1 + (w_ & 63) : (w_ - 1024) * NCH; hg_C(PROJ, LBp + l * 1024, HGS, args.in[10] + l * 1024, BR, u, lds, tid_); }
#if defined(PROBE_REP_HGC)
            for (int w_ = (bx + G - 72) % G; w_ < (lastl ? 1024 : 1040); w_ += G) { const int u = (w_ < 1024) ? (w_ >> 6) * NCH + 1 + (w_ & 63) : (w_ - 1024) * NCH; hg_C(PROJ, LBp + l * 1024, HGS, args.in[10] + l * 1024, BR, u, lds, tid_); }
#endif
            rg_C(PROJ, RGH, RGP, RGT, BR, gw_, NGW, lane_);
#if defined(PROBE_REP_RGC)
            rg_C(PROJ, RGH, RGP, RGT, BR, gw_, NGW, lane_);
#endif
        }
        SEAM(pb + 4);
        if constexpr (IN(pb + 5)) { PHASE_VARS pg8::Gemm g{BR, (const bf16*)(ws + WS_WUP + (size_t)l * SZ_WSQ), Mg, D, D, D, D}; pg8::StaticOrder S; S.init(Mg, D, G, bx);
            pg8::EpiUpGate E{MG, D, PROJ + PC_GATE, NPROJ};
            pg8::gemm_phase<pg8::EpiUpGate, pg8::StaticOrder, PG8_ALIGN_RES, PG8_SP2V>((PG8_LAS unsigned char*)lds, g, S, E, tid_);
            if constexpr (!lastl) { int tid2_ = tid; asm volatile("" : "+v"(tid2_)); skinny_phase<1>(BR + (size_t)METAROW * D, D, (const bf16*)(ws + WS_WUP + (size_t)l * SZ_WSQ), D, D, D, nullptr, MG + (size_t)METAROW * D, PROJ + (size_t)METAROW * NPROJ + PC_GATE, lds, tid2_, bx, G); } }
#if defined(PROBE_REP_G5)
        if constexpr (IN(pb + 5)) { PHASE_VARS pg8::Gemm g{BR, (const bf16*)(ws + WS_WUP + (size_t)l * SZ_WSQ), Mg, D, D, D, D}; pg8::StaticOrder S; S.init(Mg, D, G, bx);
            pg8::EpiUpGate E{MG, D, PROJ + PC_GATE, NPROJ};
            pg8::gemm_phase<pg8::EpiUpGate, pg8::StaticOrder, PG8_ALIGN_RES, PG8_SP2V>((PG8_LAS unsigned char*)lds, g, S, E, tid_);
            if constexpr (!lastl) { int tid2_ = tid; asm volatile("" : "+v"(tid2_)); skinny_phase<1>(BR + (size_t)METAROW * D, D, (const bf16*)(ws + WS_WUP + (size_t)l * SZ_WSQ), D, D, D, nullptr, MG + (size_t)METAROW * D, PROJ + (size_t)METAROW * NPROJ + PC_GATE, lds, tid2_, bx, G); } }
#endif
        SEAM(pb + 5);
        if constexpr (IN(pb + 6)) { PHASE_VARS pg8::Gemm g{MG, (const bf16*)(ws + WS_WOUT + (size_t)l * SZ_WSQ), Mg, D, D, D, D}; pg8::StaticOrder S; S.init(Mg, D, G, bx);
            pg8::EpiResid<(l != 0), true> E{hsrc, HBp};
            pg8::gemm_phase<pg8::EpiResid<(l != 0), true>, pg8::StaticOrder, PG8_ALIGN_RES, PG8_SP2V>((PG8_LAS unsigned char*)lds, g, S, E, tid_);
            if constexpr (!lastl) { int tid2_ = tid; asm volatile("" : "+v"(tid2_)); skinny_phase<0>(MG + (size_t)METAROW * D, D, (const bf16*)(ws + WS_WOUT + (size_t)l * SZ_WSQ), D, D, D, HMETA, nullptr, nullptr, lds, tid2_, bx, G); } }
        SEAM(pb + 6);
        if constexpr (IN(pb + 7)) { PHASE_VARS norm_rows<false, true>(HBp, HMETA, args.in[3] + l * D, XN, Mtail, nullptr, nullptr, nullptr, gw_, NGW, lane_, lds, tid_); }
#if defined(PROBE_REP_NORM)
            if constexpr (IN(pb + 7)) { PHASE_VARS norm_rows<false, true>(HBp, HMETA, args.in[3] + l * D, XN, Mtail, nullptr, nullptr, nullptr, gw_, NGW, lane_, lds, tid_); }
#endif
        SEAM(pb + 7);
        if constexpr (IN(pb + 8)) { PHASE_VARS pg8::Gemm g{XN, (const bf16*)(ws + WS_WGU + (size_t)l * SZ_WGU), Mg, NGU, D, D, D}; pg8::StaticOrder S; S.init(Mg, NGU, G, bx);
            pg8::EpiSwiGLU E{ACT, DFF};
            pg8::gemm_phase<pg8::EpiSwiGLU, pg8::StaticOrder, PG8_ALIGNV, PG8_SP2V>((PG8_LAS unsigned char*)lds, g, S, E, tid_);
            if constexpr (!lastl) { int tid2_ = tid; asm volatile("" : "+v"(tid2_)); skinny_swiglu(XN + (size_t)METAROW * D, (const bf16*)(ws + WS_WGU + (size_t)l * SZ_WGU), ACT + (size_t)METAROW * DFF, lds, tid2_, bx, G); } }
#if defined(PROBE_REP_G8)
        if constexpr (IN(pb + 8)) { PHASE_VARS pg8::Gemm g{XN, (const bf16*)(ws + WS_WGU + (size_t)l * SZ_WGU), Mg, NGU, D, D, D}; pg8::StaticOrder S; S.init(Mg, NGU, G, bx);
            pg8::EpiSwiGLU E{ACT, DFF};
            pg8::gemm_phase<pg8::EpiSwiGLU, pg8::StaticOrder, PG8_ALIGNV, PG8_SP2V>((PG8_LAS unsigned char*)lds, g, S, E, tid_);
            if constexpr (!lastl) { int tid2_ = tid; asm volatile("" : "+v"(tid2_)); skinny_swiglu(XN + (size_t)METAROW * D, (const bf16*)(ws + WS_WGU + (size_t)l * SZ_WGU), ACT + (size_t)METAROW * DFF, lds, tid2_, bx, G); } }
#endif
        SEAM(pb + 8);
        if constexpr (IN(pb + 9)) { PHASE_VARS pg8::Gemm g{ACT, (const bf16*)(ws + WS_WD + (size_t)l * SZ_WD), Mg, D, DFF, DFF, DFF}; pg8::StaticOrder S; S.init(Mg, D, G, bx);
            pg8::EpiResid<true, !lastl> E{HBp, lastl ? (void*)out : (void*)HBp};
            pg8::gemm_phase<pg8::EpiResid<true, !lastl>, pg8::StaticOrder, PG8_ALIGN_RES, PG8_SP2V>((PG8_LAS unsigned char*)lds, g, S, E, tid_);
            if constexpr (!lastl) { int tid2_ = tid; asm volatile("" : "+v"(tid2_)); skinny_phase<0>(ACT + (size_t)METAROW * DFF, DFF, (const bf16*)(ws + WS_WD + (size_t)l * SZ_WD), DFF, D, DFF, HMETA, nullptr, nullptr, lds, tid2_, bx, G); } }
        SEAM(pb + 9);
    }
    {
        constexpr int l = 1;
        constexpr int pb = 1 + 10 * l;
        constexpr bool lastl = (l == NLAYER - 1);
        constexpr int Mtail = lastl ? TREAL : MROWS;
        constexpr int Mg = TREAL;
        const void* hsrc = (l == 0) ? (const void*)x : (const void*)HBp;
        if constexpr (IN(pb + 0)) { PHASE_VARS norm_rows<true, (l != 0)>(hsrc, HMETA, args.in[2] + l * D, XN, MROWS, WIF + (size_t)l * 8 * D, args.in[5] + (size_t)l * NIN + 4096, GIF, gw_, NGW, lane_, lds, tid_); }
#if defined(PROBE_REP_NORM)
            if constexpr (IN(pb + 0)) { PHASE_VARS norm_rows<true, (l != 0)>(hsrc, HMETA, args.in[2] + l * D, XN, MROWS, WIF + (size_t)l * 8 * D, args.in[5] + (size_t)l * NIN + 4096, GIF, gw_, NGW, lane_, lds, tid_); }
#endif
        SEAM(pb + 0);
        if constexpr (IN(pb + 1)) { PHASE_VARS pg8::Gemm g{XN, (const bf16*)(ws + WS_WIN + (size_t)l * SZ_WIN), MROWS, NPROJ, D, D, D}; pg8::StaticOrder S; S.init(MROWS, NPROJ, G, bx);
            pg8::EpiProj E{PROJ, NPROJ, args.in[5] + (size_t)l * NIN, 4096, 8, PC_GATE};
            pg8::gemm_phase<pg8::EpiProj, pg8::StaticOrder, PG8_ALIGNV, PG8_SP2V>((PG8_LAS unsigned char*)lds, g, S, E, tid_); }
#if defined(PROBE_REP_G1)
        if constexpr (IN(pb + 1)) { PHASE_VARS pg8::Gemm g{XN, (const bf16*)(ws + WS_WIN + (size_t)l * SZ_WIN), MROWS, NPROJ, D, D, D}; pg8::StaticOrder S; S.init(MROWS, NPROJ, G, bx);
            pg8::EpiProj E{PROJ, NPROJ, args.in[5] + (size_t)l * NIN, 4096, 8, PC_GATE};
            pg8::gemm_phase<pg8::EpiProj, pg8::StaticOrder, PG8_ALIGNV, PG8_SP2V>((PG8_LAS unsigned char*)lds, g, S, E, tid_); }
#endif
        SEAM(pb + 1);
        if constexpr (IN(pb + 2)) { PHASE_VARS
            for (int w_ = bx; w_ < 520; w_ += G) { const int u = (w_ < 512) ? (w_ >> 6) * NCH + 1 + (w_ & 63) : (w_ - 512) * NCH; mlstm_A(PROJ, GIF, MLS, MLN, MLSC, u, lds, tid_); }
#if defined(PROBE_REP_MLA)
            for (int w_ = bx; w_ < 520; w_ += G) { const int u = (w_ < 512) ? (w_ >> 6) * NCH + 1 + (w_ & 63) : (w_ - 512) * NCH; mlstm_A(PROJ, GIF, MLS, MLN, MLSC, u, lds, tid_); }
#endif
            for (int w_ = (bx + G - 8) % G; w_ < 1040; w_ += G) { const int u = (w_ < 1024) ? (w_ >> 6) * NCH + 1 + (w_ & 63) : (w_ - 1024) * NCH; hg_A(PROJ, LBp + l * 1024, HGS, HGE, u, lds, tid_); }
#if defined(PROBE_REP_HGA)
            for (int w_ = (bx + G - 8) % G; w_ < 1040; w_ += G) { const int u = (w_ < 1024) ? (w_ >> 6) * NCH + 1 + (w_ & 63) : (w_ - 1024) * NCH; hg_A(PROJ, LBp + l * 1024, HGS, HGE, u, lds, tid_); }
#endif
            for (int u = (bx + G - 24) % G; u < 258; u += G) rg_A(PROJ, args.in[11] + l * 4096, args.in[12] + l * 1024, args.in[13] + l * 65536, args.in[14] + l * 1024, args.in[15] + l * 65536, args.in[16] + l * 1024, args.in[17] + l * 1024, RGH, RGP, RGT, u, lds, tid_);
#if defined(PROBE_REP_RGA)
            for (int u = (bx + G - 24) % G; u < 258; u += G) rg_A(PROJ, args.in[11] + l * 4096, args.in[12] + l * 1024, args.in[13] + l * 65536, args.in[14] + l * 1024, args.in[15] + l * 65536, args.in[16] + l * 1024, args.in[17] + l * 1024, RGH, RGP, RGT, u, lds, tid_);
#endif
            for (int r = 0;; ++r) { const int bs = (r == 2) ? (bx + G - 28) % G : bx; const int idx = r * G + ((r & 1) ? (G - 1 - bs) : bs); if (r * G >= (lastl ? 512 : 520)) break; if (idx >= (lastl ? 512 : 520)) continue;
                int b, h, i; if (idx < 512) { i = 32 - (idx >> 4); b = (idx >> 3) & 1; h = idx & 7; } else { i = 0; b = 0; h = idx - 512; }
                sb_unit(PROJ, args.in[7] + l * 128, args.in[8] + l * 128, BR, b, h, i, lds, tid_); }
#if defined(PROBE_REP_SB)
            for (int r = 0;; ++r) { const int bs = (r == 2) ? (bx + G - 28) % G : bx; const int idx = r * G + ((r & 1) ? (G - 1 - bs) : bs); if (r * G >= (lastl ? 512 : 520)) break; if (idx >= (lastl ? 512 : 520)) continue;
                int b, h, i; if (idx < 512) { i = 32 - (idx >> 4); b = (idx >> 3) & 1; h = idx & 7; } else { i = 0; b = 0; h = idx - 512; }
                sb_unit(PROJ, args.in[7] + l * 128, args.in[8] + l * 128, BR, b, h, i, lds, tid_); }
#endif
        }
        SEAM(pb + 2);
        if constexpr (IN(pb + 3)) { PHASE_VARS
            for (int u = bx; u < 256; u += G) mlstm_B(MLS, MLN, MLSC, MLCT, u, lds, tid_);
#if defined(PROBE_REP_MLB)
            for (int u = bx; u < 256; u += G) mlstm_B(MLS, MLN, MLSC, MLCT, u, lds, tid_);
#endif
            for (int u = bx; u < 256; u += G) hg_B(HGS, HGE, u, tid_);
            for (int ch_ = gw_; ch_ < 2048; ch_ += NGW) rg_B(RGT, ch_, lane_);
        }
        SEAM(pb + 3);
        if constexpr (IN(pb + 4)) { PHASE_VARS
            for (int w_ = (bx + G - 64) % G; w_ < (lastl ? 512 : 520); w_ += G) { const int u = (w_ < 512) ? (w_ >> 6) * NCH + 1 + (w_ & 63) : (w_ - 512) * NCH; mlstm_C(PROJ, GIF, MLCT, MLSC, args.in[6] + l * 1024, BR, u, lds, tid_); }
#if defined(PROBE_REP_MLC)
            for (int w_ = (bx + G - 64) % G; w_ < (lastl ? 512 : 520); w_ += G) { const int u = (w_ < 512) ? (w_ >> 6) * NCH + 1 + (w_ & 63) : (w_ - 512) * NCH; mlstm_C(PROJ, GIF, MLCT, MLSC, args.in[6] + l * 1024, BR, u, lds, tid_); }
#endif
            for (int w_ = (bx + G - 72) % G; w_ < (lastl ? 1024 : 1040); w_ += G) { const int u = (w_ < 1024) ? (w_ >> 6) * NCH + 1 + (w_ & 63) : (w_ - 1024) * NCH; hg_C(PROJ, LBp + l * 1024, HGS, args.in[10] + l * 1024, BR, u, lds, tid_); }
#if defined(PROBE_REP_HGC)
            for (int w_ = (bx + G - 72) % G; w_ < (lastl ? 1024 : 1040); w_ += G) { const int u = (w_ < 1024) ? (w_ >> 6) * NCH + 1 + (w_ & 63) : (w_ - 1024) * NCH; hg_C(PROJ, LBp + l * 1024, HGS, args.in[10] + l * 1024, BR, u, lds, tid_); }
#endif
            rg_C(PROJ, RGH, RGP, RGT, BR, gw_, NGW, lane_);
#if defined(PROBE_REP_RGC)
            rg_C(PROJ, RGH, RGP, RGT, BR, gw_, NGW, lane_);
#endif
        }
        SEAM(pb + 4);
        if constexpr (IN(pb + 5)) { PHASE_VARS pg8::Gemm g{BR, (const bf16*)(ws + WS_WUP + (size_t)l * SZ_WSQ), Mg, D, D, D, D}; pg8::StaticOrder S; S.init(Mg, D, G, bx);
            pg8::EpiUpGate E{MG, D, PROJ + PC_GATE, NPROJ};
            pg8::gemm_phase<pg8::EpiUpGate, pg8::StaticOrder, PG8_ALIGN_RES, PG8_SP2V>((PG8_LAS unsigned char*)lds, g, S, E, tid_);
            if constexpr (!lastl) { int tid2_ = tid; asm volatile("" : "+v"(tid2_)); skinny_phase<1>(BR + (size_t)METAROW * D, D, (const bf16*)(ws + WS_WUP + (size_t)l * SZ_WSQ), D, D, D, nullptr, MG + (size_t)METAROW * D, PROJ + (size_t)METAROW * NPROJ + PC_GATE, lds, tid2_, bx, G); } }
#if defined(PROBE_REP_G5)
        if constexpr (IN(pb + 5)) { PHASE_VARS pg8::Gemm g{BR, (const bf16*)(ws + WS_WUP + (size_t)l * SZ_WSQ), Mg, D, D, D, D}; pg8::StaticOrder S; S.init(Mg, D, G, bx);
            pg8::EpiUpGate E{MG, D, PROJ + PC_GATE, NPROJ};
            pg8::gemm_phase<pg8::EpiUpGate, pg8::StaticOrder, PG8_ALIGN_RES, PG8_SP2V>((PG8_LAS unsigned char*)lds, g, S, E, tid_);
            if constexpr (!lastl) { int tid2_ = tid; asm volatile("" : "+v"(tid2_)); skinny_phase<1>(BR + (size_t)METAROW * D, D, (const bf16*)(ws + WS_WUP + (size_t)l * SZ_WSQ), D, D, D, nullptr, MG + (size_t)METAROW * D, PROJ + (size_t)METAROW * NPROJ + PC_GATE, lds, tid2_, bx, G); } }
#endif
        SEAM(pb + 5);
        if constexpr (IN(pb + 6)) { PHASE_VARS pg8::Gemm g{MG, (const bf16*)(ws + WS_WOUT + (size_t)l * SZ_WSQ), Mg, D, D, D, D}; pg8::StaticOrder S; S.init(Mg, D, G, bx);
            pg8::EpiResid<(l != 0), true> E{hsrc, HBp};
            pg8::gemm_phase<pg8::EpiResid<(l != 0), true>, pg8::StaticOrder, PG8_ALIGN_RES, PG8_SP2V>((PG8_LAS unsigned char*)lds, g, S, E, tid_);
            if constexpr (!lastl) { int tid2_ = tid; asm volatile("" : "+v"(tid2_)); skinny_phase<0>(MG + (size_t)METAROW * D, D, (const bf16*)(ws + WS_WOUT + (size_t)l * SZ_WSQ), D, D, D, HMETA, nullptr, nullptr, lds, tid2_, bx, G); } }
        SEAM(pb + 6);
        if constexpr (IN(pb + 7)) { PHASE_VARS norm_rows<false, true>(HBp, HMETA, args.in[3] + l * D, XN, Mtail, nullptr, nullptr, nullptr, gw_, NGW, lane_, lds, tid_); }
#if defined(PROBE_REP_NORM)
            if constexpr (IN(pb + 7)) { PHASE_VARS norm_rows<false, true>(HBp, HMETA, args.in[3] + l * D, XN, Mtail, nullptr, nullptr, nullptr, gw_, NGW, lane_, lds, tid_); }
#endif
        SEAM(pb + 7);
        if constexpr (IN(pb + 8)) { PHASE_VARS pg8::Gemm g{XN, (const bf16*)(ws + WS_WGU + (size_t)l * SZ_WGU), Mg, NGU, D, D, D}; pg8::StaticOrder S; S.init(Mg, NGU, G, bx);
            pg8::EpiSwiGLU E{ACT, DFF};
            pg8::gemm_phase<pg8::EpiSwiGLU, pg8::StaticOrder, PG8_ALIGNV, PG8_SP2V>((PG8_LAS unsigned char*)lds, g, S, E, tid_);
            if constexpr (!lastl) { int tid2_ = tid; asm volatile("" : "+v"(tid2_)); skinny_swiglu(XN + (size_t)METAROW * D, (const bf16*)(ws + WS_WGU + (size_t)l * SZ_WGU), ACT + (size_t)METAROW * DFF, lds, tid2_, bx, G); } }
#if defined(PROBE_REP_G8)
        if constexpr (IN(pb + 8)) { PHASE_VARS pg8::Gemm g{XN, (const bf16*)(ws + WS_WGU + (size_t)l * SZ_WGU), Mg, NGU, D, D, D}; pg8::StaticOrder S; S.init(Mg, NGU, G, bx);
            pg8::EpiSwiGLU E{ACT, DFF};
            pg8::gemm_phase<pg8::EpiSwiGLU, pg8::StaticOrder, PG8_ALIGNV, PG8_SP2V>((PG8_LAS unsigned char*)lds, g, S, E, tid_);
            if constexpr (!lastl) { int tid2_ = tid; asm volatile("" : "+v"(tid2_)); skinny_swiglu(XN + (size_t)METAROW * D, (const bf16*)(ws + WS_WGU + (size_t)l * SZ_WGU), ACT + (size_t)METAROW * DFF, lds, tid2_, bx, G); } }
#endif
        SEAM(pb + 8);
        if constexpr (IN(pb + 9)) { PHASE_VARS pg8::Gemm g{ACT, (const bf16*)(ws + WS_WD + (size_t)l * SZ_WD), Mg, D, DFF, DFF, DFF}; pg8::StaticOrder S; S.init(Mg, D, G, bx);
            pg8::EpiResid<true, !lastl> E{HBp, lastl ? (void*)out : (void*)HBp};
            pg8::gemm_phase<pg8::EpiResid<true, !lastl>, pg8::StaticOrder, PG8_ALIGN_RES, PG8_SP2V>((PG8_LAS unsigned char*)lds, g, S, E, tid_);
            if constexpr (!lastl) { int tid2_ = tid; asm volatile("" : "+v"(tid2_)); skinny_phase<0>(ACT + (size_t)METAROW * DFF, DFF, (const bf16*)(ws + WS_WD + (size_t)l * SZ_WD), DFF, D, DFF, HMETA, nullptr, nullptr, lds, tid2_, bx, G); } }
        SEAM(pb + 9);
    }

#undef IN
#undef SEAM
#undef PHASE_VARS
#undef PROJ
#undef ACT
#undef XN
#undef BR
#undef MG
#undef HMETA
#undef GIF
#undef WIF
#undef LBp
#undef MLS
#undef MLN
#undef MLSC
#undef MLCT
#undef HGS
#undef HGE
#undef RGH
#undef RGP
#undef RGT
#undef HBp
#undef x
#undef out
}


#if MK_N_LAUNCHES == 1
template <class F> static void for_each_kernel(F&& f) { f((const void*)fwd_kernel<0, N_PHASES>); }
static void launch_all(const Args& a, int grid, hipStream_t stream) { hipLaunchKernelGGL((fwd_kernel<0, N_PHASES>), dim3(grid), dim3(NTHR), LDS_BYTES, stream, a); }
#else
template <int K> struct PhaseLaunch {
    template <class F> static void each(F&& f) { f((const void*)fwd_kernel<K, K + 1>); PhaseLaunch<K + 1>::each(f); }
    static void go(const Args& a, int grid, hipStream_t stream) { hipLaunchKernelGGL((fwd_kernel<K, K + 1>), dim3(grid), dim3(NTHR), LDS_BYTES, stream, a); PhaseLaunch<K + 1>::go(a, grid, stream); }
};
template <> struct PhaseLaunch<N_PHASES> { template <class F> static void each(F&&) {} static void go(const Args&, int, hipStream_t) {} };
template <class F> static void for_each_kernel(F&& f) { PhaseLaunch<0>::each(f); }
static void launch_all(const Args& a, int grid, hipStream_t stream) { PhaseLaunch<0>::go(a, grid, stream); }
#endif
extern "C" void kernel_launch(void* const* d_in, const int* in_sizes, int n_in, void* d_out, int out_size, void* d_ws, size_t ws_size, hipStream_t stream) {
    static int grid = 0;
    if (grid == 0) {
        if (n_in != 23 || out_size != TREAL * D || ws_size < WS_END) { fprintf(stderr, "kernel_launch: unexpected shapes (n_in %d, out %d, ws %zu < %zu); nothing launched\n", n_in, out_size, ws_size, (size_t)WS_END); grid = -1; return; }
        int dev = 0, cus = 0, per_cu = 0;
        if (hipGetDevice(&dev) != hipSuccess || hipDeviceGetAttribute(&cus, hipDeviceAttributeMultiprocessorCount, dev) != hipSuccess) { grid = -1; return; }
        bool ok = true;
        for_each_kernel([&](const void* f) { if (hipFuncSetAttribute(f, hipFuncAttributeMaxDynamicSharedMemorySize, LDS_BYTES) != hipSuccess) ok = false; });
        if (!ok) { fprintf(stderr, "kernel_launch: hipFuncSetAttribute failed\n"); grid = -1; return; }
        (void)per_cu; (void)hipGetLastError();
        grid = cus;
    }
    if (grid < 0) return;
    (void)in_sizes;
    if (hipMemsetAsync((char*)d_ws + WS_CTL, 0, CTL_ZERO_BYTES, stream) != hipSuccess) return;
    Args a{};
    for (int i = 0; i < 23; ++i) a.in[i] = (const float*)d_in[i];
    a.out = (float*)d_out; a.ws = (unsigned char*)d_ws; a.ph_lo = 0; a.ph_hi = N_PHASES;
    launch_all(a, grid, stream);
}
```
